# Optimizing an MI355X kernel written in HIP

```python
import math
import jax, jax.numpy as jnp
from jax import lax
import numpy as np

D_MODEL = 1024
BATCH = 8
SEQ = 2048
DEPTH = 1

CHUNK = 64
Q_BLOCK = 128
ATTN_WIDTH = D_MODEL // 2
POOL_WIDTH = D_MODEL - ATTN_WIDTH
DIFF_HEAD_DIM = 64
N_ATTN_HEADS = ATTN_WIDTH // (2 * DIFF_HEAD_DIM)
POOL_WINDOWS = (2, 4, 8, 16)
N_POOL_GROUPS = len(POOL_WINDOWS)
POOL_GROUP = POOL_WIDTH // N_POOL_GROUPS
IN_COLS = 3 * ATTN_WIDTH + POOL_WIDTH
N_BUCKETS = 32
MAX_DISTANCE = 128
N_EXPERTS = 32
TOP_K = 4
D_FF = D_MODEL
SWIGLU_LIMIT = 7.0
SWIGLU_ALPHA = 1.702
EXPERT_BLOCK = 128
DEEPNORM_ALPHA = (2.0 * DEPTH) ** 0.25
DEEPNORM_BETA = (8.0 * DEPTH) ** -0.25
LN_EPS = 1e-5

kernel_name = "hybrid_diffattn_pool_moe_deepnorm_adaln"


def layer_norm(x, g=None, b=None, eps=LN_EPS):
    xf = x.astype(jnp.float32)
    mu = jnp.mean(xf, axis=-1, keepdims=True)
    var = jnp.mean(jnp.square(xf - mu), axis=-1, keepdims=True)
    y = (xf - mu) * lax.rsqrt(var + eps)
    if g is not None:
        y = y * g.astype(jnp.float32) + b.astype(jnp.float32)
    return y.astype(x.dtype)


def rms_norm(x, g, eps=LN_EPS):
    xf = x.astype(jnp.float32)
    y = xf * lax.rsqrt(jnp.mean(jnp.square(xf), axis=-1, keepdims=True) + eps)
    return (y * g.astype(jnp.float32)).astype(x.dtype)


def modulate(h, shift, scale):
    return h * (1.0 + scale[:, None, :]) + shift[:, None, :]


def t5_bucket(rel):
    nb = N_BUCKETS // 2
    ret = (rel > 0).astype(jnp.int32) * nb
    n = jnp.abs(rel)
    max_exact = nb // 2
    nf = jnp.maximum(n, 1).astype(jnp.float32)
    large = max_exact + (jnp.log(nf / max_exact) / math.log(MAX_DISTANCE / max_exact)
                         * (nb - max_exact)).astype(jnp.int32)
    large = jnp.minimum(large, nb - 1)
    return ret + jnp.where(n < max_exact, n, large)


def diff_attention(q, k, v, lam, rel_bias):
    S = q.shape[1]
    scale = DIFF_HEAD_DIM ** -0.5
    neg = jnp.finfo(jnp.float32).min
    outs = []
    for i in range(S // Q_BLOCK):
        q0 = i * Q_BLOCK
        kend = q0 + Q_BLOCK
        qb = q[:, q0:kend]
        kb = k[:, :kend]
        vb = v[:, :kend]
        s = jnp.einsum('bqhmd,bkhmd->bhmqk', qb, kb).astype(jnp.float32) * scale
        qpos = q0 + jnp.arange(Q_BLOCK, dtype=jnp.int32)
        kpos = jnp.arange(kend, dtype=jnp.int32)
        bias = rel_bias.astype(jnp.float32)[t5_bucket(kpos[None, :] - qpos[:, None])]
        bias = jnp.transpose(bias, (2, 0, 1))
        mask = (kpos[None, :] // CHUNK) <= (qpos[:, None] // CHUNK)
        s = jnp.where(mask, s + bias[None, :, None], neg)
        p = jax.nn.softmax(s, axis=-1)
        a = p[:, :, 0] - lam * p[:, :, 1]
        outs.append(jnp.einsum('bhqk,bkhe->bqhe', a.astype(vb.dtype), vb))
    return jnp.concatenate(outs, axis=1)


def pool_mixer(u, w_pool, b_pool, pool_scale):
    B, S, C = u.shape
    uf = u.astype(jnp.float32)
    cs = jnp.concatenate([jnp.zeros((B, 1, C), jnp.float32), jnp.cumsum(uf, axis=1)], axis=1)
    t = jnp.arange(S, dtype=jnp.int32)
    groups = []
    for g, w in enumerate(POOL_WINDOWS):
        lo_c, hi_c = g * POOL_GROUP, (g + 1) * POOL_GROUP
        lo = jnp.maximum(t + 1 - w, 0)
        win_sum = cs[:, 1:, lo_c:hi_c] - cs[:, lo, lo_c:hi_c]
        cnt = jnp.minimum(t + 1, w).astype(jnp.float32)[None, :, None]
        groups.append(win_sum / cnt - uf[..., lo_c:hi_c])
    pooled = jnp.stack(groups, axis=2).astype(u.dtype)
    y = jnp.einsum('bsgc,gcd->bsgd', pooled, w_pool) + b_pool
    return y.reshape(B, S, C) * pool_scale


def moe_ffn(h, w_router, b_router, w_gate_up, b_gate_up, w_down, b_down):
    N, D = h.shape
    logits = (h @ w_router + b_router).astype(jnp.float32)
    top_v, top_i = lax.top_k(logits, TOP_K)
    gates = jax.nn.softmax(top_v, axis=-1)
    NK = N * TOP_K
    flat_e = top_i.reshape(-1).astype(jnp.int32)
    flat_tok = jnp.arange(NK, dtype=jnp.int32) // TOP_K
    flat_g = gates.reshape(-1)
    order = jnp.argsort(flat_e)
    sorted_e = flat_e[order]
    sorted_tok = flat_tok[order]
    sorted_g = flat_g[order]
    counts = jnp.bincount(flat_e, length=N_EXPERTS).astype(jnp.int32)
    padded = ((counts + EXPERT_BLOCK - 1) // EXPERT_BLOCK) * EXPERT_BLOCK
    pad_end = jnp.cumsum(padded)
    pad_start = pad_end - padded
    start = jnp.cumsum(counts) - counts
    rank = jnp.arange(NK, dtype=jnp.int32) - start[sorted_e]
    dest = pad_start[sorted_e] + rank
    n_blocks = -(-NK // EXPERT_BLOCK) + N_EXPERTS
    P = n_blocks * EXPERT_BLOCK
    row_tok = jnp.full((P,), N, jnp.int32).at[dest].set(sorted_tok)
    h_pad = jnp.concatenate([h, jnp.zeros((1, D), h.dtype)], axis=0)[row_tok]
    h_pad = h_pad.reshape(n_blocks, EXPERT_BLOCK, D)
    block_e = jnp.searchsorted(pad_end, jnp.arange(n_blocks, dtype=jnp.int32) * EXPERT_BLOCK, side='right')
    block_e = jnp.minimum(block_e, N_EXPERTS - 1).astype(jnp.int32)

    def expert_block(args):
        xb, e = args
        hgu = xb @ w_gate_up[e] + b_gate_up[e]
        gate = jnp.minimum(hgu[:, :D_FF], SWIGLU_LIMIT)
        up = jnp.clip(hgu[:, D_FF:], -SWIGLU_LIMIT, SWIGLU_LIMIT)
        act = (up + 1.0) * (gate * jax.nn.sigmoid(SWIGLU_ALPHA * gate))
        return act @ w_down[e] + b_down[e]

    y_pad = lax.map(expert_block, (h_pad, block_e)).reshape(P, D)
    y_sorted = y_pad[dest] * sorted_g[:, None].astype(y_pad.dtype)
    return jax.ops.segment_sum(y_sorted, sorted_tok, num_segments=N)


def setup_inputs(seed: int = 0) -> dict:
    key = jax.random.key(seed)
    ks = jax.random.split(key, 26)
    f32 = jnp.float32
    nrm = lambda k, shape, s: jax.random.normal(k, shape, f32) * s
    D, L, E, H = D_MODEL, DEPTH, N_EXPERTS, N_ATTN_HEADS
    return {
        "x": nrm(ks[0], (BATCH, SEQ, D), 1.0),
        "c": nrm(ks[1], (BATCH, D), 1.0),
        "w_ada": nrm(ks[2], (L, D, 6 * D), 0.5 * D ** -0.5),
        "b_ada": nrm(ks[3], (L, 6 * D), 0.01),
        "w_in": nrm(ks[4], (L, D, IN_COLS), D ** -0.5),
        "lambda_q1": nrm(ks[5], (L, DIFF_HEAD_DIM), 0.1),
        "lambda_k1": nrm(ks[6], (L, DIFF_HEAD_DIM), 0.1),
        "lambda_q2": nrm(ks[7], (L, DIFF_HEAD_DIM), 0.1),
        "lambda_k2": nrm(ks[8], (L, DIFF_HEAD_DIM), 0.1),
        "subln_g": 1.0 + nrm(ks[9], (L, 2 * DIFF_HEAD_DIM), 0.1),
        "rel_bias": nrm(ks[10], (N_BUCKETS, H), 0.5),
        "w_pool": nrm(ks[11], (L, N_POOL_GROUPS, POOL_GROUP, POOL_GROUP), POOL_GROUP ** -0.5),
        "b_pool": nrm(ks[12], (L, N_POOL_GROUPS, POOL_GROUP), 0.01),
        "pool_scale": 1.0 + nrm(ks[13], (L, POOL_WIDTH), 0.1),
        "w_out": nrm(ks[14], (L, D, D), D ** -0.5 * DEEPNORM_BETA),
        "ln1_g": 1.0 + nrm(ks[15], (L, D), 0.1),
        "ln1_b": nrm(ks[16], (L, D), 0.01),
        "w_router": nrm(ks[17], (L, D, E), D ** -0.5),
        "b_router": nrm(ks[18], (L, E), 0.01),
        "w_gate_up": nrm(ks[19], (L, E, D, 2 * D_FF), D ** -0.5),
        "b_gate_up": nrm(ks[20], (L, E, 2 * D_FF), 0.01),
        "w_down": nrm(ks[21], (L, E, D_FF, D), D_FF ** -0.5 * DEEPNORM_BETA),
        "b_down": nrm(ks[22], (L, E, D), 0.01),
        "ln2_g": 1.0 + nrm(ks[23], (L, D), 0.1),
        "ln2_b": nrm(ks[24], (L, D), 0.01),
    }


def reference(x, c, w_ada, b_ada, w_in, lambda_q1, lambda_k1, lambda_q2, lambda_k2, subln_g,
              rel_bias, w_pool, b_pool, pool_scale, w_out, ln1_g, ln1_b, w_router, b_router,
              w_gate_up, b_gate_up, w_down, b_down, ln2_g, ln2_b):
    B, S, D = x.shape
    A = ATTN_WIDTH
    cond = jax.nn.silu(c)
    for l in range(DEPTH):
        mod = cond @ w_ada[l] + b_ada[l]
        sh1, sc1, g1, sh2, sc2, g2 = jnp.split(mod, 6, axis=-1)

        h = modulate(layer_norm(x), sh1, sc1)
        proj = h @ w_in[l]
        q = proj[..., :A].reshape(B, S, N_ATTN_HEADS, 2, DIFF_HEAD_DIM)
        k = proj[..., A:2 * A].reshape(B, S, N_ATTN_HEADS, 2, DIFF_HEAD_DIM)
        v = proj[..., 2 * A:3 * A].reshape(B, S, N_ATTN_HEADS, 2 * DIFF_HEAD_DIM)
        u = proj[..., 3 * A:]
        lam_init = 0.8 - 0.6 * math.exp(-0.3 * l)
        lam = (jnp.exp(jnp.sum(lambda_q1[l].astype(jnp.float32) * lambda_k1[l].astype(jnp.float32)))
               - jnp.exp(jnp.sum(lambda_q2[l].astype(jnp.float32) * lambda_k2[l].astype(jnp.float32)))
               + lam_init)
        o = diff_attention(q, k, v, lam, rel_bias)
        o = rms_norm(o, subln_g[l]) * (1.0 - lam_init)
        p = pool_mixer(u, w_pool[l], b_pool[l], pool_scale[l])
        mix = jnp.concatenate([o.reshape(B, S, A), p], axis=-1) @ w_out[l]
        x = layer_norm(DEEPNORM_ALPHA * x + g1[:, None, :] * mix, ln1_g[l], ln1_b[l])

        h2 = modulate(layer_norm(x), sh2, sc2)
        y = moe_ffn(h2.reshape(B * S, D), w_router[l], b_router[l], w_gate_up[l], b_gate_up[l],
                    w_down[l], b_down[l]).reshape(B, S, D)
        x = layer_norm(DEEPNORM_ALPHA * x + g2[:, None, :] * y, ln2_g[l], ln2_b[l])
    return x
```

```cpp
#include <hip/hip_runtime.h>
#include <hip/hip_bf16.h>
#include <cstdio>
#include <cstdint>
#include <cmath>

#ifndef MK_ONE_LAUNCH
#define MK_ONE_LAUNCH 1
#endif
#ifndef NAIVE_GEMM
#define NAIVE_GEMM 0
#endif
#ifndef NAIVE_ATTN
#define NAIVE_ATTN 0
#endif

#define GAS __attribute__((address_space(1)))
#define LAS __attribute__((address_space(3)))

constexpr int NB = 8, SEQ = 2048, D = 1024, M = NB * SEQ;
constexpr int AW = 512;
constexpr int NIN = 2048;
constexpr int NE = 32, TOPK = 4, FF = 1024;
constexpr int ECAP = 16384;
constexpr int PMAX = (M * TOPK) / 256 + NE;
constexpr float LN_EPS = 1e-5f;
constexpr float DN_ALPHA = 1.189207115002721f;
constexpr float LAM_INIT = 0.2f;
constexpr float LOG2E = 1.4426950408889634f;
constexpr float QSCALE = 0.125f * LOG2E;
constexpr int NWAVES = 8;

namespace pg8 {
#define PG8_LAS __attribute__((address_space(3)))
typedef unsigned short bf16_t;
typedef short bf16x8 __attribute__((ext_vector_type(8)));
typedef float f32x4 __attribute__((ext_vector_type(4)));
typedef unsigned u32x4 __attribute__((ext_vector_type(4)));
constexpr int BM = 256, BK = 64, HALF = 128, HTB = HALF * BK * 2, STAGE_BYTES = 8 * HTB, NXCD = 8, WGM = 8;
constexpr int GK = 1024;

__host__ __device__ __forceinline__ int lds_byte(int r, int c) { const int st = (r >> 4) * 2 + (c >> 5), rr = r & 15, cc = c & 31, ob = rr * 64 + cc * 2; return st * 1024 + (ob ^ (((ob >> 9) & 1) << 5)); }
__host__ __device__ __forceinline__ void stage_rc(int b, int& R, int& C) { const int st = b / 1024, sb = b % 1024, swz = sb ^ (((sb >> 9) & 1) << 5); R = (st >> 1) * 16 + swz / 64; C = (st & 1) * 32 + (swz % 64) / 2; }
__host__ __device__ __forceinline__ int perm32(int rho) { const int n = rho >> 4, i = rho & 15; return 8 * (i >> 2) + 4 * n + (i & 3); }

struct Unit { int pm, pn, e, lrow0, cnt; };

__device__ __forceinline__ unsigned cvt_pk_bf16(float lo, float hi) { unsigned r; asm volatile("v_cvt_pk_bf16_f32 %0, %1, %2" : "=v"(r) : "v"(lo), "v"(hi)); return r; }
__device__ __forceinline__ float bf2f(unsigned short v) { return __uint_as_float((unsigned)v << 16); }

#if !NAIVE_GEMM
template <class Epi, class Sched, bool ALIGN_EPI>
__device__ __forceinline__ void gemm_phase(PG8_LAS unsigned char* lds, const Sched& S, const Epi& E) {
    constexpr int K = GK, nt = K / BK;
    const int tid = threadIdx.x, wid = __builtin_amdgcn_readfirstlane(tid >> 6), lane = tid & 63, wr = wid >> 2, wc = wid & 3, fr = lane & 15, fq = lane >> 4;
    int Rr[2], Cc[2]; unsigned voffB[2];
#pragma unroll
    for (int i = 0; i < 2; ++i) { int R, C; stage_rc(tid * 16 + i * 8192, R, C); Rr[i] = R; Cc[i] = C; const int Rb = Epi::PERM ? ((R & ~31) + perm32(R & 31)) : R; voffB[i] = (unsigned)(Rb * K + C) * 2u; }
    const size_t kstep = (size_t)(BK * 2);
    const size_t hB = S.b_hstep();
    const unsigned ldsw = (unsigned)wid * 1024u;
    const int aoff = lds_byte(wr * 64 + fr, fq * 8), boff = lds_byte(wc * 32 + fr, fq * 8);
#define PG8_SA(b, h) (((b) * 2 + (h)) * HTB)
#define PG8_SB(b, h) ((4 + (b) * 2 + (h)) * HTB)
#define PG8_STAGE(bufoff, gbase, voff) do { _Pragma("unroll") for (int _i = 0; _i < 2; ++_i) \
        __builtin_amdgcn_global_load_lds((const unsigned*)((const char*)(gbase) + (voff)[_i]), (PG8_LAS unsigned*)(lds + (bufoff) + ldsw + _i * 8192), 16, 0, 0); } while (0)
#define PG8_LDA(dst, b, h) do { _Pragma("unroll") for (int m = 0; m < 4; ++m) _Pragma("unroll") for (int k = 0; k < 2; ++k) dst[m][k] = *(const PG8_LAS bf16x8*)(lds + PG8_SA(b, h) + aoff + m * 2048 + k * 1024); } while (0)
#define PG8_LDB(dst, b, h) do { _Pragma("unroll") for (int n = 0; n < 2; ++n) _Pragma("unroll") for (int k = 0; k < 2; ++k) dst[n][k] = *(const PG8_LAS bf16x8*)(lds + PG8_SB(b, h) + boff + n * 2048 + k * 1024); } while (0)
#define PG8_MMA(ai, bj, At, Bt) do { __builtin_amdgcn_s_setprio(1); _Pragma("unroll") for (int m = 0; m < 4; ++m) _Pragma("unroll") for (int n = 0; n < 2; ++n) _Pragma("unroll") for (int k = 0; k < 2; ++k) \
        acc[ai][bj][m][n] = __builtin_amdgcn_mfma_f32_16x16x32_bf16(Bt[n][k], At[m][k], acc[ai][bj][m][n], 0, 0, 0); __builtin_amdgcn_s_setprio(0); } while (0)
#define PG8_WAIT_V(n) asm volatile("s_waitcnt vmcnt(" #n ")" ::: "memory")
#define PG8_WAIT_L(n) asm volatile("s_waitcnt lgkmcnt(" #n ")" ::: "memory")
#define PG8_BAR __builtin_amdgcn_s_barrier()
#define PG8_SCHED __builtin_amdgcn_sched_barrier(0)
    Unit cur, nxt; int ui = 0;
    if (!S.next(0, cur)) return;
    f32x4 acc[2][2][4][2];
#pragma unroll
    for (int a = 0; a < 2; ++a)
#pragma unroll
        for (int b = 0; b < 2; ++b)
#pragma unroll
            for (int m = 0; m < 4; ++m)
#pragma unroll
                for (int n = 0; n < 2; ++n) acc[a][b][m][n] = (f32x4){0.f, 0.f, 0.f, 0.f};
    bf16x8 At[4][2], B0[2][2], B1[2][2];
    const char* cA = S.a_base(cur); const char* cB = S.b_base(cur);
    unsigned va0[2], va1[2];
    S.a_voff(cur, Rr, Cc, va0, va1);
    PG8_STAGE(PG8_SB(0, 0), cB, voffB); PG8_STAGE(PG8_SB(0, 1), cB + hB, voffB); PG8_STAGE(PG8_SA(0, 0), cA, va0); PG8_STAGE(PG8_SA(0, 1), cA, va1);
    if (wr == 1) PG8_BAR;
    PG8_WAIT_V(2); PG8_BAR;
    PG8_STAGE(PG8_SB(1, 0), cB + kstep, voffB); PG8_STAGE(PG8_SA(1, 0), cA + kstep, va0); PG8_STAGE(PG8_SB(1, 1), cB + hB + kstep, voffB);
    PG8_WAIT_V(6); PG8_BAR;
    for (;;) {
        const bool has_next = S.next(ui + 1, nxt);
        const char* nA = has_next ? S.a_base(nxt) : cA; const char* nB = has_next ? S.b_base(nxt) : cB;
        unsigned vn0[2], vn1[2];
        if (has_next) S.a_voff(nxt, Rr, Cc, vn0, vn1); else { vn0[0] = va0[0]; vn0[1] = va0[1]; vn1[0] = va1[0]; vn1[1] = va1[1]; }
        for (int t = 0; t < nt; t += 2) {
            const bool last = (t == nt - 2);
            const char* a1 = cA + (size_t)(t + 1) * kstep;
            const char* a2 = last ? nA : cA + (size_t)(t + 2) * kstep; const char* b2 = last ? nB : cB + (size_t)(t + 2) * kstep;
            const char* a3 = a2 + kstep; const char* b3 = b2 + kstep;
            unsigned v20[2], v21[2];
            v20[0] = last ? vn0[0] : va0[0]; v20[1] = last ? vn0[1] : va0[1]; v21[0] = last ? vn1[0] : va1[0]; v21[1] = last ? vn1[1] : va1[1];
            PG8_LDB(B0, 0, 0); PG8_LDB(B1, 0, 1); PG8_SCHED; PG8_LDA(At, 0, 0); PG8_STAGE(PG8_SA(1, 1), a1, va1);
            PG8_WAIT_V(8); PG8_WAIT_L(0); PG8_BAR; PG8_MMA(0, 0, At, B0); PG8_MMA(0, 1, At, B1); PG8_BAR; PG8_SCHED;
            PG8_LDA(At, 0, 1); PG8_STAGE(PG8_SB(0, 0), b2, voffB); PG8_STAGE(PG8_SB(0, 1), b2 + hB, voffB); PG8_STAGE(PG8_SA(0, 0), a2, v20);
            PG8_WAIT_V(8); PG8_WAIT_L(0); PG8_BAR; PG8_MMA(1, 0, At, B0); PG8_MMA(1, 1, At, B1); PG8_BAR; PG8_SCHED;
            PG8_LDB(B0, 1, 0); PG8_LDB(B1, 1, 1); PG8_SCHED; PG8_LDA(At, 1, 0); PG8_STAGE(PG8_SA(0, 1), a2, v21);
            PG8_WAIT_V(8); PG8_WAIT_L(0); PG8_BAR; PG8_MMA(0, 0, At, B0); PG8_MMA(0, 1, At, B1); PG8_BAR; PG8_SCHED;
            PG8_LDA(At, 1, 1); PG8_STAGE(PG8_SB(1, 0), b3, voffB); PG8_STAGE(PG8_SB(1, 1), b3 + hB, voffB); PG8_STAGE(PG8_SA(1, 0), a3, v20);
            PG8_WAIT_V(8); PG8_WAIT_L(0); PG8_BAR; PG8_MMA(1, 0, At, B0); PG8_MMA(1, 1, At, B1); PG8_BAR; PG8_SCHED;
        }
        if constexpr (ALIGN_EPI) { if (wr == 0) PG8_BAR; }
        E(acc, cur, wr, wc, fr, fq);
        if (!has_next) break;
#pragma unroll
        for (int a = 0; a < 2; ++a)
#pragma unroll
            for (int b = 0; b < 2; ++b)
#pragma unroll
                for (int m = 0; m < 4; ++m)
#pragma unroll
                    for (int n = 0; n < 2; ++n) acc[a][b][m][n] = (f32x4){0.f, 0.f, 0.f, 0.f};
        cur = nxt; cA = nA; cB = nB; va0[0] = vn0[0]; va0[1] = vn0[1]; va1[0] = vn1[0]; va1[1] = vn1[1]; ++ui;
        if constexpr (ALIGN_EPI) { if (wr == 1) PG8_BAR; }
    }
    PG8_WAIT_V(0);
    if constexpr (!ALIGN_EPI) { if (wr == 0) PG8_BAR; }
    PG8_BAR;
#undef PG8_SA
#undef PG8_SB
#undef PG8_STAGE
#undef PG8_LDA
#undef PG8_LDB
#undef PG8_MMA
#undef PG8_WAIT_V
#undef PG8_WAIT_L
#undef PG8_BAR
#undef PG8_SCHED
}
#else
template <class Epi, class Sched, bool ALIGN_EPI>
__device__ __forceinline__ void gemm_phase(PG8_LAS unsigned char*, const Sched& S, const Epi& E) {
    constexpr int K = GK;
    const int tid = threadIdx.x, wid = __builtin_amdgcn_readfirstlane(tid >> 6), lane = tid & 63, wr = wid >> 2, wc = wid & 3, fr = lane & 15, fq = lane >> 4;
    Unit u;
    for (int ui = 0; S.next(ui, u); ++ui) {
        f32x4 acc[2][2][4][2];
#pragma unroll
        for (int ai = 0; ai < 2; ++ai)
#pragma unroll
            for (int bj = 0; bj < 2; ++bj) {
                const bf16_t* ar[4]; const bf16_t* br[2][4];
#pragma unroll
                for (int m = 0; m < 4; ++m) ar[m] = S.a_row(u, ai * 128 + wr * 64 + m * 16 + fr);
#pragma unroll
                for (int n = 0; n < 2; ++n)
#pragma unroll
                    for (int x = 0; x < 4; ++x) br[n][x] = S.b_row(u, bj * 128 + wc * 32 + (Epi::PERM ? 8 * fq + 4 * n + x : 16 * n + 4 * fq + x));
                float s[4][2][4];
#pragma unroll
                for (int m = 0; m < 4; ++m)
#pragma unroll
                    for (int n = 0; n < 2; ++n)
#pragma unroll
                        for (int x = 0; x < 4; ++x) s[m][n][x] = 0.f;
                for (int k0 = 0; k0 < K; k0 += 8) {
                    bf16x8 av[4], bv[2][4];
#pragma unroll
                    for (int m = 0; m < 4; ++m) av[m] = *(const bf16x8*)(ar[m] + k0);
#pragma unroll
                    for (int n = 0; n < 2; ++n)
#pragma unroll
                        for (int x = 0; x < 4; ++x) bv[n][x] = *(const bf16x8*)(br[n][x] + k0);
#pragma unroll
                    for (int kk = 0; kk < 8; ++kk)
#pragma unroll
                        for (int m = 0; m < 4; ++m) { const float a = bf2f((unsigned short)av[m][kk]);
#pragma unroll
                            for (int n = 0; n < 2; ++n)
#pragma unroll
                                for (int x = 0; x < 4; ++x) s[m][n][x] += a * bf2f((unsigned short)bv[n][x][kk]); }
                }
#pragma unroll
                for (int m = 0; m < 4; ++m)
#pragma unroll
                    for (int n = 0; n < 2; ++n) acc[ai][bj][m][n] = (f32x4){s[m][n][0], s[m][n][1], s[m][n][2], s[m][n][3]};
            }
        E(acc, u, wr, wc, fr, fq);
    }
}
#endif
}

constexpr size_t MiB = 1u << 20;
constexpr size_t WS_CTL = 0, CTL_ZERO_BYTES = 1 * MiB;
constexpr size_t WS_MOD = 1 * MiB;
constexpr size_t WS_WPOOL = 1 * MiB + 512 * 1024;
constexpr size_t WS_WIN = 2 * MiB;
constexpr size_t WS_WOUT = 6 * MiB;
constexpr size_t WS_WGU = 8 * MiB;
constexpr size_t WS_WD = 136 * MiB;
constexpr size_t WS_XN = 200 * MiB;
constexpr size_t WS_Q = 232 * MiB, WS_K = 248 * MiB, WS_V = 264 * MiB, WS_U = 280 * MiB;
constexpr size_t WS_OA = 296 * MiB;
constexpr size_t WS_MIX = 328 * MiB;
constexpr size_t WS_T1 = 360 * MiB;
constexpr size_t WS_X1 = 424 * MiB;
constexpr size_t WS_XN2 = 488 * MiB;
constexpr size_t WS_RE = 520 * MiB, WS_RP = 521 * MiB, WS_RG = 522 * MiB;
constexpr size_t WS_ROWTOK = 524 * MiB;
constexpr size_t WS_H = 528 * MiB;
constexpr size_t WS_Y = 672 * MiB;
constexpr size_t WS_END = 816 * MiB;
static_assert((size_t)PMAX * 256 * 1024 * 2 == 144 * MiB, "H / Y size");
constexpr int CW_TMO = 0, CW_CODE = 1;
constexpr int CW_BAR = 4096;
constexpr int CW_CNT = 8192;

constexpr int RING_BYTES = 131072;
constexpr int LDS_BYTES = 147456;
constexpr int LCTL_OFF = 139264;
constexpr int L_MISC = LCTL_OFF;
constexpr int L_CNT = LCTL_OFF + 128;
constexpr int L_PFIRST = LCTL_OFF + 256;
constexpr int L_PEXP = LCTL_OFF + 512;
constexpr int L_HIST = LCTL_OFF + 512 + 4 * 320;
constexpr int L_TB = 90112;
static_assert(L_TB + 4 * 704 * 4 <= RING_BYTES && L_HIST + 256 <= LDS_BYTES && PMAX <= 320, "LDS map");

typedef unsigned short bf16;
typedef unsigned v4u __attribute__((ext_vector_type(4)));
typedef unsigned v2u __attribute__((ext_vector_type(2)));
typedef float f32x4 __attribute__((ext_vector_type(4)));
typedef float f32x16 __attribute__((ext_vector_type(16)));
typedef short bf16x8 __attribute__((ext_vector_type(8)));
typedef GAS unsigned gu32;
#define RLX_AGENT __ATOMIC_RELAXED, __HIP_MEMORY_SCOPE_AGENT
#define LDS_WAIT() asm volatile("s_waitcnt lgkmcnt(0)" ::: "memory")
#define VM_WAIT() asm volatile("s_waitcnt vmcnt(0)" ::: "memory")
__device__ __forceinline__ unsigned f2bf(float f) { unsigned u = __builtin_bit_cast(unsigned, f); return (u + 0x7fffu + ((u >> 16) & 1u)) >> 16; }
__device__ __forceinline__ unsigned pk2(float lo, float hi) { return f2bf(lo) | (f2bf(hi) << 16); }
__device__ __forceinline__ float bfl(unsigned w) { return __uint_as_float(w << 16); }
__device__ __forceinline__ float bfh(unsigned w) { return __uint_as_float(w & 0xffff0000u); }

namespace attn_body {
using bf16=__hip_bfloat16;
using bf16x8=__attribute__((ext_vector_type(8)))short;
using s16x4=__attribute__((ext_vector_type(4)))short;
using f32x16=__attribute__((ext_vector_type(16)))float;
using u32x4=__attribute__((ext_vector_type(4)))unsigned;
constexpr int SEQ=2048,DH=64,PQ=512,PO=1024;
constexpr int NW=8,QBLK=32,QB=QBLK*NW,KVBLK=64,NQB=SEQ/QB;
__device__ __forceinline__ int crow(int r,int hi){return (r&3)+8*(r>>2)+4*hi;}
#define SBAR() __builtin_amdgcn_sched_barrier(0)
constexpr int TBN=704, TBOFF=447;
__device__ __forceinline__ void bandinit(f32x16&p0,f32x16&p1,int t,int q0,int wid,int r32,int hi,const __attribute__((address_space(3))) float*tb){
  const __attribute__((address_space(3))) float*tp=tb+(64*t+4*hi-(q0+32*wid+r32)+TBOFF);
  #pragma unroll
  for(int r=0;r<16;++r){p0[r]=tp[(r&3)+8*(r>>2)]; p1[r]=tp[(r&3)+8*(r>>2)+32];}
}
__device__ __forceinline__ void bandpost(f32x16&p0,f32x16&p1,const f32x16&negm,int t,int q0,int wid){
  const float nm=(t>(q0>>6)+(wid>>1))?-INFINITY:negm[0];
  #pragma unroll
  for(int r=0;r<16;++r){p0[r]+=nm;p1[r]+=nm;}
}
constexpr int NSLOT=3, SLOTB=8192;
constexpr int LDS_K=0, LDS_V=NSLOT*SLOTB, LDS_WS=2*NSLOT*SLOTB, LDS_OST=LDS_WS+NW*64*4, LDS_BYTES=LDS_OST+NW*4096;
__device__ __forceinline__ void glds16(const void*gsrc,unsigned lds_dst){unsigned keep;
  asm volatile("s_mov_b32 %0, m0\n\ts_mov_b32 m0, %2\n\ts_nop 0\n\tglobal_load_lds_dwordx4 %1, off\n\ts_mov_b32 m0, %0":"=&s"(keep):"v"(gsrc),"s"(lds_dst):"memory");}
__device__ __forceinline__ float max3f(float a,float b,float c){float r;asm("v_max3_f32 %0, %1, %2, %3":"=v"(r):"v"(a),"v"(b),"v"(c));return r;}
__device__ __forceinline__ float max2f(float a,float b){float r;asm("v_max_f32_e32 %0, %1, %2":"=v"(r):"v"(a),"v"(b));return r;}
__device__ __forceinline__ float fadd_s(float a,float b){float r;asm("v_add_f32_e32 %0, %1, %2":"=v"(r):"v"(a),"v"(b));return r;}
__device__ __forceinline__ float fsub_s(float a,float b){float r;asm("v_sub_f32_e32 %0, %1, %2":"=v"(r):"v"(a),"v"(b));return r;}
typedef float f32x2_t __attribute__((ext_vector_type(2))); typedef __bf16 bf16x2_t __attribute__((ext_vector_type(2)));
__device__ __forceinline__ unsigned cvtpk_s(float lo,float hi){f32x2_t v={lo,hi};bf16x2_t b=__builtin_convertvector(v,bf16x2_t);return __builtin_bit_cast(unsigned,b);}
#define WAIT_BAR(N) asm volatile("s_waitcnt vmcnt(" #N ") lgkmcnt(0)\n\ts_barrier":::"memory")

__device__ __forceinline__ void qkt(f32x16&p0,f32x16&p1,const char*Kslot,const bf16x8*qr,int r32,int hi){
  const char*kb=Kslot+hi*1024+r32*16;
  #pragma unroll
  for(int d0=0;d0<4;++d0){
    const bf16x8 b0=*reinterpret_cast<const bf16x8*>(kb+d0*2048);
    const bf16x8 b1=*reinterpret_cast<const bf16x8*>(kb+d0*2048+512);
    p0=__builtin_amdgcn_mfma_f32_32x32x16_bf16(b0,qr[d0],p0,0,0,0);p1=__builtin_amdgcn_mfma_f32_32x32x16_bf16(b1,qr[d0],p1,0,0,0);}
}
typedef __attribute__((address_space(3))) const char* lds_cptr;
typedef short v4i16_t __attribute__((ext_vector_type(4)));
__device__ __forceinline__ void kload8(bf16x8*kf,lds_cptr kp){
  kf[0]=*(const __attribute__((address_space(3))) bf16x8*)(kp);      kf[1]=*(const __attribute__((address_space(3))) bf16x8*)(kp+512);
  kf[2]=*(const __attribute__((address_space(3))) bf16x8*)(kp+2048); kf[3]=*(const __attribute__((address_space(3))) bf16x8*)(kp+2560);
  kf[4]=*(const __attribute__((address_space(3))) bf16x8*)(kp+4096); kf[5]=*(const __attribute__((address_space(3))) bf16x8*)(kp+4608);
  kf[6]=*(const __attribute__((address_space(3))) bf16x8*)(kp+6144); kf[7]=*(const __attribute__((address_space(3))) bf16x8*)(kp+6656);
}
__device__ __forceinline__ void kload2(bf16x8*kf,lds_cptr kp,int j){ kf[2*j]=*(const __attribute__((address_space(3))) bf16x8*)(kp+j*2048); kf[2*j+1]=*(const __attribute__((address_space(3))) bf16x8*)(kp+j*2048+512); }
__device__ __forceinline__ s16x4 vtr(lds_cptr p){ return __builtin_bit_cast(s16x4,__builtin_amdgcn_ds_read_tr16_b64_v4i16((__attribute__((address_space(3))) v4i16_t*)p)); }
__device__ __forceinline__ float rowmax(const f32x16&p0,const f32x16&p1){
  float a=max3f(p0[0],p0[1],p1[0]),b=max3f(p0[2],p0[3],p1[1]);a=max3f(a,p1[2],p1[3]);
  #pragma unroll
  for(int r=4;r<16;r+=4){a=max3f(a,p0[r],p0[r+1]);b=max3f(b,p0[r+2],p0[r+3]);a=max3f(a,p1[r],p1[r+1]);b=max3f(b,p1[r+2],p1[r+3]);}
  const float m=max2f(a,b);
  auto rr=__builtin_amdgcn_permlane32_swap(__float_as_uint(m),__float_as_uint(m),false,false);
  return max2f(__uint_as_float(rr[0]),__uint_as_float(rr[1]));
}
__device__ __forceinline__ void pv(f32x16*o,int vb,bf16x8 pa0,bf16x8 pa1,bf16x8 pa2,bf16x8 pa3){
  #pragma unroll
  for(int d0=0;d0<2;++d0){s16x4 lo[4],hi[4];
    #pragma unroll
    for(int ks=0;ks<4;++ks){
      asm volatile("ds_read_b64_tr_b16 %0,%1 offset:%c2":"=&v"(lo[ks]):"v"(vb),"i"(d0*4096+ks*1024):"memory");
      asm volatile("ds_read_b64_tr_b16 %0,%1 offset:%c2":"=&v"(hi[ks]):"v"(vb),"i"(d0*4096+ks*1024+512):"memory");}
    asm volatile("s_waitcnt lgkmcnt(0)":::"memory");SBAR();
    #define PK(k) (bf16x8){lo[k][0],lo[k][1],lo[k][2],lo[k][3],hi[k][0],hi[k][1],hi[k][2],hi[k][3]}
    o[d0]=__builtin_amdgcn_mfma_f32_32x32x16_bf16(pa0,PK(0),o[d0],0,0,0);
    o[d0]=__builtin_amdgcn_mfma_f32_32x32x16_bf16(pa1,PK(1),o[d0],0,0,0);
    o[d0]=__builtin_amdgcn_mfma_f32_32x32x16_bf16(pa2,PK(2),o[d0],0,0,0);
    o[d0]=__builtin_amdgcn_mfma_f32_32x32x16_bf16(pa3,PK(3),o[d0],0,0,0);
    #undef PK
  }
}
#define ATTN_STORE16(p,v) (*(u32x4*)(p)=(v))
template<int THRL> __device__ __forceinline__ void attn_unit(int b,int j,int vh,int qb,const bf16*Q,const bf16*__restrict__ K,const bf16*__restrict__ V,bf16*O,char*shm,const __attribute__((address_space(3))) float*tbh){
  int tid_=threadIdx.x; asm volatile("":"+v"(tid_));
  const int tid=tid_,lane=tid&63,r32=lane&31,hi=lane>>5; const int wid=__builtin_amdgcn_readfirstlane(tid>>6);
  const long rowbase=(long)b*SEQ; const int q0=qb*QB;
  const bf16*Qw=Q+(rowbase+q0+wid*QBLK)*PQ+j*DH;
  const bf16*Kh=K+rowbase*PQ+j*DH,*Vh=V+rowbase*PQ+(j>>1)*128+vh*64;
  const unsigned lds0=(unsigned)(uintptr_t)shm;
  float*wsf=(float*)(shm+LDS_WS)+wid*64;
  const bf16*ksrc=Kh+(long)lane*PQ+wid*8;
  const bf16*vsrc=Vh+(long)(16*(wid&3)+(lane>>2))*PQ+(wid>>2)*32+(lane&3)*8;
  const unsigned kdst=lds0+LDS_K+wid*1024, vdst=lds0+LDS_V+wid*1024;
  #define DMA_K(t,slot) glds16(ksrc+(long)(t)*KVBLK*PQ,(unsigned)__builtin_amdgcn_readfirstlane(kdst+(slot)))
  #define DMA_V(t,slot) glds16(vsrc+(long)(t)*KVBLK*PQ,(unsigned)__builtin_amdgcn_readfirstlane(vdst+(slot)))
  const int vb0=(int)(lds0+LDS_V)+((lane>>4)&1)*32+(lane&3)*8+(4*hi+((lane&15)>>2))*64;
  const char*Kbase=shm+LDS_K; bf16x8 kf[8];
  const lds_cptr shm3=(lds_cptr)shm; const lds_cptr kp0=shm3+LDS_K+hi*1024+r32*16; const lds_cptr vp0=shm3+LDS_V+((lane>>4)&1)*32+(lane&3)*8+(4*hi+((lane&15)>>2))*64;
  const int NT=(q0+QB)/KVBLK;
  DMA_K(0,0);DMA_V(0,0);DMA_K(1,SLOTB);
  bf16x8 qr[4];
  #pragma unroll
  for(int d0=0;d0<4;++d0)qr[d0]=*reinterpret_cast<const bf16x8*>(&Qw[(long)r32*PQ+d0*16+hi*8]);
  float mhat=0.f,l_reg=0.f;f32x16 o[2];o[0]=f32x16{};o[1]=f32x16{};f32x16 negm=f32x16{};asm volatile("":"+v"(negm));
  #define BINIT(C0,C1,t) bandinit(C0,C1,(t),q0,wid,r32,hi,tbh)
  bool resc=false;
  #define START(P0,P1) do{ const float rm=rowmax(P0,P1); resc=false; \
    { const float dl=rm; mhat=fadd_s(mhat,dl); \
      _Pragma("unroll") for(int r=0;r<16;++r){P0[r]=fsub_s(P0[r],dl);P1[r]=fsub_s(P1[r],dl);} \
      _Pragma("unroll") for(int r=0;r<16;++r)negm[r]=-mhat; asm volatile("":"+v"(negm)); } \
    _Pragma("unroll") for(int r=0;r<16;++r)P0[r]=__builtin_amdgcn_exp2f(P0[r]); }while(0)
  #define RESC() do{ if(resc){ asm volatile("s_waitcnt lgkmcnt(0)":::"memory"); \
      _Pragma("unroll") for(int d_=0;d_<2;++d_) _Pragma("unroll") for(int r=0;r<16;++r)o[d_][r]*=wsf[crow(r,hi)]; } }while(0)
  f32x16 pA0,pA1,pB0,pB1;
  int sl_prev=0,sl_cur=0,sl_next=SLOTB;
  #define ROT() do{sl_prev=sl_cur;sl_cur=sl_next;sl_next=(sl_next==(NSLOT-1)*SLOTB)?0:sl_next+SLOTB;}while(0)
  DMA_K(2,2*SLOTB);
  WAIT_BAR(3);
  if(NT<=7){BINIT(pA0,pA1,0);}else{pA0=f32x16{};pA1=f32x16{};}
  qkt(pA0,pA1,Kbase,qr,r32,hi);asm volatile("s_nop 15\n\ts_nop 7":"+v"(pA0),"+v"(pA1));
  START(pA0,pA1);
  _Pragma("unroll") for(int r=0;r<16;++r)pA1[r]=__builtin_amdgcn_exp2f(pA1[r]);
  WAIT_BAR(0);
  DMA_K(3,0);DMA_V(1,SLOTB);
  ROT();
  kload8(kf,kp0+sl_cur);
  WAIT_BAR(2);
  s16x4 vlo[8],vhi[8]; u32x4 pw0,pw1,pw2,pw3;
  #define PKW(P,B) cvtpk_s(P[B],P[B+1])
  #define PAF(k) __builtin_bit_cast(bf16x8,pw##k)
  #define VFR(i) (bf16x8){vlo[i][0],vlo[i][1],vlo[i][2],vlo[i][3],vhi[i][0],vhi[i][1],vhi[i][2],vhi[i][3]}
  #define PIN(x) asm volatile("":"+v"(x))
  #define MX3(a,b,c) __builtin_fmaxf(__builtin_fmaxf((a),(b)),(c))
  #define GAPA(MF,A0,A1,A2,A3,W0,W1,PW) do{ MF; sacc+=A0; sacc+=A1; sacc+=A2; sacc+=A3; PIN(sacc); W0; W1; PIN(PW); SBAR(); }while(0)
  #define EX(v) __builtin_amdgcn_exp2f(v)
  #define GAPB(MF,X,B) do{ MF; X[B]=EX(X[B]); X[B+1]=EX(X[B+1]); X[B+2]=EX(X[B+2]); X[B+3]=EX(X[B+3]); PIN(X); SBAR(); }while(0)
  #define VRD(i) do{ vlo[i]=vtr(vp_+(((i)>>2)*4096+((i)&3)*1024)); vhi[i]=vtr(vp_+(((i)>>2)*4096+((i)&3)*1024+512)); }while(0)
  #define KRD(G,j) do{ if(G){ kload2(kf,kp0+sl_next,j); SBAR(); } }while(0)
  #define STEP(C0,C1,P0,P1,t,GK,GV,GL,PRE,I0,I1,POST) do{ SBAR(); PRE; SBAR(); \
    const lds_cptr vp_=vp0+sl_prev; \
    VRD(0); SBAR(); float sacc=(P0[0]+P0[1]); \
    GAPA(C0=__builtin_amdgcn_mfma_f32_32x32x16_bf16(kf[0],qr[0],I0,0,0,0), P0[2],P0[3],P0[4],P0[5],     pw0[0]=PKW(P0,0), pw0[1]=PKW(P0,2), pw0); \
    VRD(4); SBAR(); GAPA(C1=__builtin_amdgcn_mfma_f32_32x32x16_bf16(kf[1],qr[0],I1,0,0,0), P0[6],P0[7],P0[8],P0[9],     pw0[2]=PKW(P0,4), pw0[3]=PKW(P0,6), pw0); \
    VRD(1); SBAR(); GAPA(C0=__builtin_amdgcn_mfma_f32_32x32x16_bf16(kf[2],qr[1],C0,0,0,0),   P0[10],P0[11],P0[12],P0[13], pw1[0]=PKW(P0,8), pw1[1]=PKW(P0,10), pw1); \
    VRD(5); SBAR(); GAPA(C1=__builtin_amdgcn_mfma_f32_32x32x16_bf16(kf[3],qr[1],C1,0,0,0),   P0[14],P0[15],P1[0],P1[1],   pw1[2]=PKW(P0,12),pw1[3]=PKW(P0,14), pw1); \
    VRD(2); SBAR(); GAPA(C0=__builtin_amdgcn_mfma_f32_32x32x16_bf16(kf[4],qr[2],C0,0,0,0),   P1[2],P1[3],P1[4],P1[5],     pw2[0]=PKW(P1,0), pw2[1]=PKW(P1,2), pw2); \
    VRD(6); SBAR(); GAPA(C1=__builtin_amdgcn_mfma_f32_32x32x16_bf16(kf[5],qr[2],C1,0,0,0),   P1[6],P1[7],P1[8],P1[9],     pw2[2]=PKW(P1,4), pw2[3]=PKW(P1,6), pw2); \
    VRD(3); SBAR(); GAPA(C0=__builtin_amdgcn_mfma_f32_32x32x16_bf16(kf[6],qr[3],C0,0,0,0),   P1[10],P1[11],P1[12],P1[13], pw3[0]=PKW(P1,8), pw3[1]=PKW(P1,10), pw3); \
    VRD(7); SBAR(); GAPA(C1=__builtin_amdgcn_mfma_f32_32x32x16_bf16(kf[7],qr[3],C1,0,0,0),   P1[14],P1[15],0.f,0.f,       pw3[2]=PKW(P1,12),pw3[3]=PKW(P1,14), pw3); \
    l_reg+=sacc; \
    if(GK){DMA_K((t)+3,sl_cur);} if(GV){DMA_V((t)+1,sl_next);} \
    POST; \
    { float a=MX3(C0[0],C0[1],C1[0]),b=MX3(C0[2],C0[3],C1[1]); a=MX3(a,C1[2],C1[3]); \
      _Pragma("unroll") for(int r=4;r<16;r+=4){a=MX3(a,C0[r],C0[r+1]);b=MX3(b,C0[r+2],C0[r+3]);a=MX3(a,C1[r],C1[r+1]);b=MX3(b,C1[r+2],C1[r+3]);} \
      float rm=__builtin_fmaxf(a,b); { auto rr=__builtin_amdgcn_permlane32_swap(__float_as_uint(rm),__float_as_uint(rm),false,false); rm=__builtin_fmaxf(__uint_as_float(rr[0]),__uint_as_float(rr[1])); } \
      resc=false; \
      if(__builtin_expect(__any(rm>(float)THRL),0)){ const float dl=__builtin_fmaxf(rm,0.f); mhat+=dl; \
        _Pragma("unroll") for(int r=0;r<16;++r){C0[r]-=dl;C1[r]-=dl;} \
        _Pragma("unroll") for(int r=0;r<16;++r)negm[r]=-mhat; asm volatile("":"+v"(negm)); \
        const float f=__builtin_amdgcn_exp2f(-dl); l_reg*=f; if(hi==0)wsf[r32]=f; resc=true; } } \
    SBAR(); \
    GAPB(o[0]=__builtin_amdgcn_mfma_f32_32x32x16_bf16(PAF(0),VFR(0),o[0],0,0,0), C0,0); \
    GAPB(o[1]=__builtin_amdgcn_mfma_f32_32x32x16_bf16(PAF(0),VFR(4),o[1],0,0,0), C0,4); \
    KRD(GL,0); GAPB(o[0]=__builtin_amdgcn_mfma_f32_32x32x16_bf16(PAF(1),VFR(1),o[0],0,0,0), C0,8); \
    KRD(GL,1); GAPB(o[1]=__builtin_amdgcn_mfma_f32_32x32x16_bf16(PAF(1),VFR(5),o[1],0,0,0), C0,12); \
    KRD(GL,2); GAPB(o[0]=__builtin_amdgcn_mfma_f32_32x32x16_bf16(PAF(2),VFR(2),o[0],0,0,0), C1,0); \
    KRD(GL,3); GAPB(o[1]=__builtin_amdgcn_mfma_f32_32x32x16_bf16(PAF(2),VFR(6),o[1],0,0,0), C1,4); \
    GAPB(o[0]=__builtin_amdgcn_mfma_f32_32x32x16_bf16(PAF(3),VFR(3),o[0],0,0,0), C1,8); \
    GAPB(o[1]=__builtin_amdgcn_mfma_f32_32x32x16_bf16(PAF(3),VFR(7),o[1],0,0,0), C1,12); \
    }while(0)
  int t=1;
  for(;t+7<NT;t+=2){
    STEP(pB0,pB1,pA0,pA1,t,true,true,true,,negm,negm,);     WAIT_BAR(2); RESC(); ROT();
    STEP(pA0,pA1,pB0,pB1,t+1,true,true,true,,negm,negm,);   WAIT_BAR(2); RESC(); ROT();
  }
  #define ENDW(tt) do{ if((tt)+3<NT){WAIT_BAR(2);} else if((tt)+2<NT){WAIT_BAR(1);} else {WAIT_BAR(0);} }while(0)
  for(;t+1<NT;t+=2){
    STEP(pB0,pB1,pA0,pA1,t,(t+3<NT),(t+1<NT),(t+1<NT),BINIT(pB0,pB1,t),pB0,pB1,bandpost(pB0,pB1,negm,t,q0,wid));           ENDW(t);   RESC(); ROT();
    STEP(pA0,pA1,pB0,pB1,t+1,(t+4<NT),(t+2<NT),(t+2<NT),BINIT(pA0,pA1,t+1),pA0,pA1,bandpost(pA0,pA1,negm,t+1,q0,wid));       ENDW(t+1); RESC(); ROT();
  }
  STEP(pB0,pB1,pA0,pA1,NT-1,false,false,false,BINIT(pB0,pB1,NT-1),pB0,pB1,bandpost(pB0,pB1,negm,NT-1,q0,wid)); RESC();
  { float sacc=pB0[0]+pB0[1]; _Pragma("unroll") for(int r=2;r<16;++r)sacc+=pB0[r]; _Pragma("unroll") for(int r=0;r<16;++r)sacc+=pB1[r]; l_reg+=sacc;
    pw0=(u32x4){PKW(pB0,0),PKW(pB0,2),PKW(pB0,4),PKW(pB0,6)};pw1=(u32x4){PKW(pB0,8),PKW(pB0,10),PKW(pB0,12),PKW(pB0,14)};pw2=(u32x4){PKW(pB1,0),PKW(pB1,2),PKW(pB1,4),PKW(pB1,6)};pw3=(u32x4){PKW(pB1,8),PKW(pB1,10),PKW(pB1,12),PKW(pB1,14)};
    SBAR(); pv(o,vb0+sl_cur,PAF(0),PAF(1),PAF(2),PAF(3)); }
  #undef PKW
  #undef PAF
  #undef VFR
  #undef PIN
  #undef MX3
  #undef GAPA
  #undef GAPB
  #undef EX
  #undef VRD
  #undef KRD
  #undef STEP
  #undef ENDW
  {auto rr=__builtin_amdgcn_permlane32_swap(__float_as_uint(l_reg),__float_as_uint(l_reg),false,false);l_reg=__uint_as_float(rr[0])+__uint_as_float(rr[1]);}
  if(hi==0)wsf[32+r32]=l_reg;asm volatile("s_waitcnt lgkmcnt(0)":::"memory");
  float rli[16];
  #pragma unroll
  for(int r=0;r<16;++r)rli[r]=__builtin_amdgcn_rcpf(wsf[32+crow(r,hi)]);
  bf16*Ow=O+(rowbase+q0+wid*QBLK)*PO+j*128+vh*64;
  { bf16*stg=(bf16*)(shm+LDS_OST)+wid*2048;
    #pragma unroll
    for(int r=0;r<16;++r){const int orow=crow(r,hi);
      #pragma unroll
      for(int d0=0;d0<2;++d0)stg[orow*64+d0*32+r32]=__float2bfloat16(o[d0][r]*rli[r]);}
    asm volatile("s_waitcnt lgkmcnt(0)":::"memory");
    #pragma unroll
    for(int i=0;i<4;++i){const int row=i*8+(lane>>3),ch=lane&7; const u32x4 v=*(const u32x4*)(stg+row*64+ch*8); ATTN_STORE16(Ow+(long)row*PO+ch*8,v);} }
  asm volatile("s_waitcnt lgkmcnt(0)\n\ts_barrier":::"memory");
  #undef DMA_K
  #undef DMA_V
  #undef BINIT
  #undef START
  #undef RESC
  #undef ROT
}
constexpr int ATTN_LDS_BYTES=LDS_BYTES;
#undef SBAR
#undef WAIT_BAR
}

#define XB_TMO      128
#define XB_XCNT(j)  (256  + 64 * (j))
#define XB_XSUB(j)  (1280 + 64 * (j))
#define XB_XGEN(j)  (2304 + 64 * (j))
#define XB_TOP      3328
#define XB_TOPGEN   3392
#define XCD_BAR_WORDS 3456
#define XB_SPIN_CAP (1u << 18)
__device__ __forceinline__ unsigned xb_ld(unsigned* p)              { return __hip_atomic_load(p, __ATOMIC_RELAXED, __HIP_MEMORY_SCOPE_AGENT); }
__device__ __forceinline__ unsigned xb_add(unsigned* p, unsigned v) { return __hip_atomic_fetch_add(p, v, __ATOMIC_RELAXED, __HIP_MEMORY_SCOPE_AGENT); }
__device__ __forceinline__ unsigned xb_xcc_id() { return (unsigned)__builtin_amdgcn_s_getreg((3 << 11) | 20) & 0xFu; }
#define XB_SPIN(cond, bar) do { unsigned _sp = 0; while (cond) { __builtin_amdgcn_s_sleep(1); \
    if ((++_sp & 255u) == 0u) { if (xb_ld(&(bar)[XB_TMO])) break; if (_sp > XB_SPIN_CAP) { atomicAdd(&(bar)[XB_TMO], 1u); break; } } } } while (0)
struct XcdBarrier { unsigned* bar; unsigned x; volatile LAS unsigned* st; };
__device__ __forceinline__ XcdBarrier xcd_barrier_post(unsigned* bar, volatile LAS unsigned* st) {
    XcdBarrier b; b.bar = bar; b.x = xb_xcc_id(); b.st = st;
    if (threadIdx.x == 0) (void)xb_add(&bar[XB_XCNT(b.x)], 1u);
    return b;
}
__device__ __forceinline__ void xcd_barrier_complete(unsigned* bar, unsigned x, unsigned& nloc, unsigned& nx) {
    const unsigned G = gridDim.x * gridDim.y * gridDim.z;
    unsigned sum, cnt, mine, sp = 0u;
    for (;;) {
        sum = 0u; cnt = 0u; mine = 0u;
#pragma unroll
        for (unsigned j = 0; j < 16; ++j) { const unsigned c = xb_ld(&bar[XB_XCNT(j)]); sum += c; cnt += (c > 0u) ? 1u : 0u; mine = (j == x) ? c : mine; }
        if (sum == G) break;
        __builtin_amdgcn_s_sleep(1);
        if ((++sp & 255u) == 0u) { if (xb_ld(&bar[XB_TMO])) break; if (sp > XB_SPIN_CAP) { atomicAdd(&bar[XB_TMO], 1u); break; } }
    }
    nloc = mine > 0u ? mine : 1u; nx = cnt > 0u ? cnt : 1u;
}
__device__ __forceinline__ void xcd_barrier(const XcdBarrier& b) {
    asm volatile("s_waitcnt vmcnt(0)" ::: "memory");
    __syncthreads();
    if (threadIdx.x == 0) {
        unsigned* bar = b.bar;
        __builtin_amdgcn_s_waitcnt(0);
        unsigned nloc = b.st[0], nx = b.st[1];
        if (nloc == 0u) { xcd_barrier_complete(bar, b.x, nloc, nx); b.st[0] = nloc; b.st[1] = nx; }
        const unsigned old = xb_add(&bar[XB_XSUB(b.x)], 1u);
        const unsigned gen = old / nloc;
        if (old + 1u == (gen + 1u) * nloc) {
            __builtin_amdgcn_fence(__ATOMIC_RELEASE, "agent");
            asm volatile("s_waitcnt vmcnt(0)" ::: "memory");
            const unsigned og = xb_add(&bar[XB_TOP], 1u);
            const unsigned tg = og / nx;
            if (og + 1u == (tg + 1u) * nx) xb_add(&bar[XB_TOPGEN], 1u);
            else XB_SPIN(xb_ld(&bar[XB_TOPGEN]) == tg, bar);
            __builtin_amdgcn_fence(__ATOMIC_ACQUIRE, "agent");
            xb_add(&bar[XB_XGEN(b.x)], 1u);
            asm volatile("s_waitcnt vmcnt(0)" ::: "memory");
        } else {
            XB_SPIN(xb_ld(&bar[XB_XGEN(b.x)]) == gen, bar);
            __builtin_amdgcn_fence(__ATOMIC_ACQUIRE, "agent");
            asm volatile("s_waitcnt vmcnt(0)" ::: "memory");
        }
    }
    __syncthreads();
}

struct Frame {
    LAS unsigned char* lds;
    unsigned char* ws;
    gu32* ctl;
    int tid, lane, wave;
    int vcu, G;
};
__device__ __forceinline__ float wave_sum(float v) {
#pragma unroll
    for (int o = 1; o < 64; o <<= 1) v += __shfl_xor(v, o);
    return v;
}
__device__ __forceinline__ void p0_transpose_item(const float* W, int K, int N, bf16* WT, LAS float* scr, int item, int lane) {
    const int nblk = N / 32, kb = item / nblk, nb = item % nblk, k0 = 64 * kb, n0 = 32 * nb;
#pragma unroll 8
    for (int i = 0; i < 32; ++i) { const int kk = 2 * i + (lane >> 5); scr[kk * 33 + (lane & 31)] = W[(size_t)(k0 + kk) * N + n0 + (lane & 31)]; }
    LDS_WAIT(); asm volatile("" ::: "memory");
    const int c = lane & 7;
#pragma unroll
    for (int j = 0; j < 4; ++j) { const int n = (lane >> 3) + 8 * j; const LAS float* s = scr + (8 * c) * 33 + n;
        v4u o; o.x = pk2(s[0 * 33], s[1 * 33]); o.y = pk2(s[2 * 33], s[3 * 33]); o.z = pk2(s[4 * 33], s[5 * 33]); o.w = pk2(s[6 * 33], s[7 * 33]);
        *(GAS v4u*)(WT + (size_t)(n0 + n) * K + k0 + 8 * c) = o; }
    LDS_WAIT(); asm volatile("" ::: "memory");
}
__device__ __forceinline__ int t5_bucket(int rel) {
    const int n = rel < 0 ? -rel : rel; int b;
    if (n < 8) b = n; else if (n < 12) b = 8; else if (n < 16) b = 9; else if (n < 23) b = 10; else if (n < 32) b = 11; else if (n < 46) b = 12; else if (n < 64) b = 13; else if (n < 91) b = 14; else b = 15;
    return b + (rel > 0 ? 16 : 0);
}

struct DenseSched {
    const bf16* A; const bf16* Bt; int nM, nN, nwg, G, c;
    __device__ __forceinline__ void init(const bf16* A_, const bf16* Bt_, int M_, int N_, int G_, int c_) { A = A_; Bt = Bt_; nM = M_ / 256; nN = N_ / 256; nwg = nM * nN; G = G_; c = c_; }
    __device__ __forceinline__ bool next(int i, pg8::Unit& u) const {
        const long L = (long)i * G + c; if (L >= nwg) return false;
        int wgid = (int)L; { const int q = nwg / 8, r = nwg % 8, xcd = wgid % 8, off = wgid / 8; wgid = (xcd < r ? xcd * (q + 1) : r * (q + 1) + (xcd - r) * q) + off; }
        const int nig = 8 * nN, gid = wgid / nig, fm = gid * 8, gsz = (nM - fm) < 8 ? (nM - fm) : 8;
        u.pm = fm + ((wgid % nig) % gsz); u.pn = (wgid % nig) / gsz; u.e = 0; u.lrow0 = 0; u.cnt = 0; return true;
    }
    __device__ __forceinline__ const char* a_base(const pg8::Unit& u) const { return (const char*)A + (size_t)u.pm * (256 * 1024 * 2); }
    __device__ __forceinline__ const char* b_base(const pg8::Unit& u) const { return (const char*)Bt + (size_t)u.pn * (256 * 1024 * 2); }
    __device__ __forceinline__ size_t b_hstep() const { return (size_t)128 * 1024 * 2; }
    __device__ __forceinline__ void a_voff(const pg8::Unit&, const int (&R)[2], const int (&C)[2], unsigned (&v0)[2], unsigned (&v1)[2]) const {
#pragma unroll
        for (int i = 0; i < 2; ++i) { v0[i] = (unsigned)(R[i] * 1024 + C[i]) * 2u; v1[i] = v0[i] + 128u * 1024u * 2u; } }
    __device__ __forceinline__ const bf16* a_row(const pg8::Unit& u, int r) const { return A + (size_t)(u.pm * 256 + r) * 1024; }
    __device__ __forceinline__ const bf16* b_row(const pg8::Unit& u, int c_) const { return Bt + (size_t)(u.pn * 256 + c_) * 1024; }
};
struct MoeSched {
    const bf16* A; const bf16* W; const int* rowtok; const LAS int* pexp; const LAS int* pfirst; const LAS int* cntl;
    int NP, NT, G, vcu; bool gather; size_t wexp  , wtile  , whalf;
    __device__ __forceinline__ bool next(int i, pg8::Unit& u) const {
        const int L = i * G + vcu; if (L >= NP * NT) return false;
        const int pi = L / NT; const int e = __builtin_amdgcn_readfirstlane(pexp[pi]);
        u.pm = pi; u.pn = L - pi * NT; u.e = e; u.lrow0 = (pi - __builtin_amdgcn_readfirstlane(pfirst[e])) * 256; u.cnt = __builtin_amdgcn_readfirstlane(cntl[e]); return true;
    }
    __device__ __forceinline__ const char* a_base(const pg8::Unit& u) const { return gather ? (const char*)A : (const char*)A + (size_t)u.pm * (256 * 1024 * 2); }
    __device__ __forceinline__ const char* b_base(const pg8::Unit& u) const { return (const char*)W + (size_t)u.e * wexp + (size_t)u.pn * wtile; }
    __device__ __forceinline__ size_t b_hstep() const { return whalf; }
    __device__ __forceinline__ int tok_of(const pg8::Unit& u, int r) const { const int lr = u.lrow0 + r; return lr < u.cnt ? ((const GAS int*)rowtok)[u.e * ECAP + lr] : 0; }
    __device__ __forceinline__ void a_voff(const pg8::Unit& u, const int (&R)[2], const int (&C)[2], unsigned (&v0)[2], unsigned (&v1)[2]) const {
        if (gather) {
#pragma unroll
            for (int i = 0; i < 2; ++i) { v0[i] = (unsigned)(tok_of(u, R[i]) * 1024 + C[i]) * 2u; v1[i] = (unsigned)(tok_of(u, 128 + R[i]) * 1024 + C[i]) * 2u; }
        } else {
#pragma unroll
            for (int i = 0; i < 2; ++i) { v0[i] = (unsigned)(R[i] * 1024 + C[i]) * 2u; v1[i] = v0[i] + 128u * 1024u * 2u; }
        }
    }
    __device__ __forceinline__ const bf16* a_row(const pg8::Unit& u, int r) const { return gather ? A + (size_t)tok_of(u, r) * 1024 : A + (size_t)(u.pm * 256 + r) * 1024; }
    __device__ __forceinline__ const bf16* b_row(const pg8::Unit& u, int c_) const { return (const bf16*)((const char*)W + (size_t)u.e * wexp + (size_t)u.pn * wtile + (c_ >= 128 ? whalf : 0) + (size_t)(c_ & 127) * 2048); }
};

struct EpiQKVU {
    static constexpr bool PERM = true;
    bf16* O; size_t stride;
    __device__ __forceinline__ void operator()(const pg8::f32x4 (&acc)[2][2][4][2], const pg8::Unit& u, int wr, int wc, int fr, int fq) const {
        const int t = u.pn >> 1; const float sc = t == 0 ? QSCALE : 1.f;
        bf16* base = O + (size_t)t * stride; const int col0 = (u.pn & 1) * 256 + wc * 32 + 8 * fq; const int row0 = u.pm * 256 + wr * 64 + fr;
#pragma unroll
        for (int ai = 0; ai < 2; ++ai)
#pragma unroll
            for (int m = 0; m < 4; ++m) { bf16* rowp = base + (size_t)(row0 + ai * 128 + m * 16) * 512 + col0;
#pragma unroll
                for (int bj = 0; bj < 2; ++bj) { const pg8::f32x4 v0 = acc[ai][bj][m][0] * sc, v1 = acc[ai][bj][m][1] * sc;
                    pg8::u32x4 w; w.x = pg8::cvt_pk_bf16(v0[0], v0[1]); w.y = pg8::cvt_pk_bf16(v0[2], v0[3]); w.z = pg8::cvt_pk_bf16(v1[0], v1[1]); w.w = pg8::cvt_pk_bf16(v1[2], v1[3]);
                    *(pg8::u32x4*)(rowp + bj * 128) = w; } }
    }
};
struct EpiT1 {
    static constexpr bool PERM = false;
    const float* x; const float* mod; float* T1;
    __device__ __forceinline__ void operator()(const pg8::f32x4 (&acc)[2][2][4][2], const pg8::Unit& u, int wr, int wc, int fr, int fq) const {
        const int b = u.pm >> 3; const float* g1 = mod + (size_t)b * 6144 + 2048;
        const int col0 = u.pn * 256 + wc * 32 + 4 * fq;
        pg8::f32x4 gv[2][2];
#pragma unroll
        for (int bj = 0; bj < 2; ++bj)
#pragma unroll
            for (int n = 0; n < 2; ++n) gv[bj][n] = *(const pg8::f32x4*)(g1 + col0 + bj * 128 + n * 16);
#pragma unroll
        for (int ai = 0; ai < 2; ++ai)
#pragma unroll
            for (int m = 0; m < 4; ++m) { const size_t off = (size_t)(u.pm * 256 + ai * 128 + wr * 64 + m * 16 + fr) * 1024 + col0;
#pragma unroll
                for (int bj = 0; bj < 2; ++bj)
#pragma unroll
                    for (int n = 0; n < 2; ++n) { const pg8::f32x4 xv = *(const pg8::f32x4*)(x + off + bj * 128 + n * 16);
                        *(pg8::f32x4*)(T1 + off + bj * 128 + n * 16) = xv * DN_ALPHA + gv[bj][n] * acc[ai][bj][m][n]; } }
    }
};
struct EpiSwiglu {
    static constexpr bool PERM = true;
    const float* bgu; bf16* H;
    __device__ __forceinline__ void operator()(const pg8::f32x4 (&acc)[2][2][4][2], const pg8::Unit& u, int wr, int wc, int fr, int fq) const {
        const int c0 = u.pn * 128 + wc * 32 + 8 * fq; const float* bg = bgu + (size_t)u.e * 2048 + c0;
        pg8::f32x4 bgv[2], buv[2];
#pragma unroll
        for (int n = 0; n < 2; ++n) { bgv[n] = *(const pg8::f32x4*)(bg + 4 * n); buv[n] = *(const pg8::f32x4*)(bg + 1024 + 4 * n); }
#pragma unroll
        for (int ai = 0; ai < 2; ++ai)
#pragma unroll
            for (int m = 0; m < 4; ++m) { float r[8];
#pragma unroll
                for (int n = 0; n < 2; ++n)
#pragma unroll
                    for (int x = 0; x < 4; ++x) { const float g = fminf(acc[ai][0][m][n][x] + bgv[n][x], 7.0f); const float up = fminf(fmaxf(acc[ai][1][m][n][x] + buv[n][x], -7.0f), 7.0f);
                        const float sg = __builtin_amdgcn_rcpf(1.0f + __builtin_amdgcn_exp2f(-1.702f * LOG2E * g)); r[4 * n + x] = (up + 1.0f) * (g * sg); }
                pg8::u32x4 w; w.x = pg8::cvt_pk_bf16(r[0], r[1]); w.y = pg8::cvt_pk_bf16(r[2], r[3]); w.z = pg8::cvt_pk_bf16(r[4], r[5]); w.w = pg8::cvt_pk_bf16(r[6], r[7]);
                *(pg8::u32x4*)(H + (size_t)(u.pm * 256 + ai * 128 + wr * 64 + m * 16 + fr) * 1024 + c0) = w; }
    }
};
struct EpiDown {
    static constexpr bool PERM = true;
    const float* bd; bf16* Y;
    __device__ __forceinline__ void operator()(const pg8::f32x4 (&acc)[2][2][4][2], const pg8::Unit& u, int wr, int wc, int fr, int fq) const {
        const int c0 = u.pn * 256 + wc * 32 + 8 * fq; const float* bp = bd + (size_t)u.e * 1024 + c0;
        pg8::f32x4 bv[2][2];
#pragma unroll
        for (int bj = 0; bj < 2; ++bj)
#pragma unroll
            for (int n = 0; n < 2; ++n) bv[bj][n] = *(const pg8::f32x4*)(bp + bj * 128 + 4 * n);
#pragma unroll
        for (int ai = 0; ai < 2; ++ai)
#pragma unroll
            for (int m = 0; m < 4; ++m) { bf16* rowp = Y + (size_t)(u.pm * 256 + ai * 128 + wr * 64 + m * 16 + fr) * 1024 + c0;
#pragma unroll
                for (int bj = 0; bj < 2; ++bj) { const pg8::f32x4 v0 = acc[ai][bj][m][0] + bv[bj][0], v1 = acc[ai][bj][m][1] + bv[bj][1];
                    pg8::u32x4 w; w.x = pg8::cvt_pk_bf16(v0[0], v0[1]); w.y = pg8::cvt_pk_bf16(v0[2], v0[3]); w.z = pg8::cvt_pk_bf16(v1[0], v1[1]); w.w = pg8::cvt_pk_bf16(v1[2], v1[3]);
                    *(pg8::u32x4*)(rowp + bj * 128) = w; } }
    }
};

__device__ __forceinline__ void build_expert_tables(Frame& F) {
    LAS int* cntl = (LAS int*)(F.lds + L_CNT); LAS int* pfirst = (LAS int*)(F.lds + L_PFIRST); LAS int* pexp = (LAS int*)(F.lds + L_PEXP);
    __syncthreads();
    if (F.tid < NE) { int c = (int)__hip_atomic_load(F.ctl + CW_CNT + 64 * F.tid, RLX_AGENT); c = c < 0 ? 0 : (c > ECAP ? ECAP : c); cntl[F.tid] = c; }
    __syncthreads();
    if (F.tid == 0) { int p = 0; for (int e = 0; e < NE; ++e) { pfirst[e] = p; const int np = (cntl[e] + 255) >> 8; for (int k = 0; k < np; ++k) if (p + k < PMAX) pexp[p + k] = e; p += np; if (p > PMAX) p = PMAX; } pfirst[NE] = p; }
    __syncthreads();
}

struct Args { const float* in[25]; float* out; unsigned char* ws; int ph_lo, ph_hi; };
constexpr int NPHASE = 10;

__global__ void __launch_bounds__(NWAVES * 64, 2) mk_fwd(Args args) {
    extern __shared__ __attribute__((aligned(16))) unsigned char lds[];
    Frame F;
    F.lds = (LAS unsigned char*)lds; F.ws = args.ws; F.ctl = (gu32*)(args.ws + WS_CTL);
    F.tid = threadIdx.x; F.lane = F.tid & 63; F.wave = __builtin_amdgcn_readfirstlane(F.tid >> 6);
    F.G = gridDim.x; { const int bx = blockIdx.x; F.vcu = (F.G % 8 == 0) ? (bx % 8) * (F.G / 8) + bx / 8 : bx; }
    volatile LAS unsigned* MISC = (volatile LAS unsigned*)(F.lds + L_MISC);
    for (int u = F.tid; u < (LDS_BYTES - LCTL_OFF) / 4; u += NWAVES * 64) ((LAS unsigned*)(F.lds + LCTL_OFF))[u] = 0u;
    __syncthreads();
    XcdBarrier bar; bar.bar = (unsigned*)(F.ctl + CW_BAR); bar.x = 0; bar.st = nullptr;
#if MK_ONE_LAUNCH
    bar = xcd_barrier_post((unsigned*)(F.ctl + CW_BAR), MISC + 8);
#define GRID_BAR() xcd_barrier(bar)
#else
#define GRID_BAR() do { } while (0)
#endif
    const int lo = args.ph_lo, hi = args.ph_hi;
#ifndef PH_MASK
#define PH_MASK 0x3ff
#endif
#define IN(k) (((PH_MASK >> (k)) & 1) && lo <= (k) && (k) < hi)
#define BOTH(k) (IN(k) && IN((k) + 1))
    const float* x = args.in[0]; const float* cvec = args.in[1]; const float* w_ada = args.in[2]; const float* b_ada = args.in[3]; const float* w_in = args.in[4];
    const float* lq1 = args.in[5]; const float* lk1 = args.in[6]; const float* lq2 = args.in[7]; const float* lk2 = args.in[8]; const float* subln_g = args.in[9];
    const float* rel_bias = args.in[10]; const float* w_pool = args.in[11]; const float* b_pool = args.in[12]; const float* pool_scale = args.in[13]; const float* w_out = args.in[14];
    const float* ln1_g = args.in[15]; const float* ln1_b = args.in[16]; const float* w_router = args.in[17]; const float* b_router = args.in[18];
    const float* w_gu = args.in[19]; const float* b_gu = args.in[20]; const float* w_dn = args.in[21]; const float* b_dn = args.in[22]; const float* ln2_g = args.in[23]; const float* ln2_b = args.in[24];
    float* out = args.out; unsigned char* ws = args.ws;
    float* MOD = (float*)(ws + WS_MOD); bf16* WPOOL = (bf16*)(ws + WS_WPOOL); bf16* WIN = (bf16*)(ws + WS_WIN); bf16* WOUT = (bf16*)(ws + WS_WOUT);
    bf16* WGU = (bf16*)(ws + WS_WGU); bf16* WD = (bf16*)(ws + WS_WD); bf16* XN = (bf16*)(ws + WS_XN);
    bf16* QB = (bf16*)(ws + WS_Q); bf16* KB = (bf16*)(ws + WS_K); bf16* VB = (bf16*)(ws + WS_V); bf16* UB = (bf16*)(ws + WS_U);
    bf16* OA = (bf16*)(ws + WS_OA); bf16* MIX = (bf16*)(ws + WS_MIX); float* T1 = (float*)(ws + WS_T1); float* X1 = (float*)(ws + WS_X1); bf16* XN2 = (bf16*)(ws + WS_XN2);
    int* RE = (int*)(ws + WS_RE); int* RP = (int*)(ws + WS_RP); float* RG = (float*)(ws + WS_RG); int* ROWTOK = (int*)(ws + WS_ROWTOK);
    bf16* HB = (bf16*)(ws + WS_H); bf16* YB = (bf16*)(ws + WS_Y);
    const int gw = F.vcu * NWAVES + F.wave, NGW = F.G * NWAVES;

    if (IN(0)) {
        LAS float* scr = (LAS float*)(F.lds + F.wave * 8448);
        LAS float* sil = (LAS float*)(F.lds + 8 * 8448);
        for (int i = F.tid; i < NB * D; i += NWAVES * 64) { const float v = cvec[i]; sil[i] = v / (1.0f + __expf(-v)); }
        __syncthreads();
        constexpr int I_MOD = 6144 / 16, I_IN = (D / 64) * (NIN / 32), I_OUT = (D / 64) * (D / 32), I_POOL = 4 * 2 * 4, I_GU1 = (D / 64) * (2048 / 32), I_D1 = (FF / 64) * (D / 32);
        constexpr int NITEMS = I_MOD + I_IN + I_OUT + I_POOL + NE * I_GU1 + NE * I_D1;
        for (int it = gw; it < NITEMS; it += NGW) {
            int r = it;
            if (r < I_MOD) {
                const int kq = F.lane >> 4, col = r * 16 + (F.lane & 15); float a[NB];
#pragma unroll
                for (int b = 0; b < NB; ++b) a[b] = 0.f;
                for (int k = kq; k < D; k += 4) { const float w = w_ada[(size_t)k * 6144 + col];
#pragma unroll
                    for (int b = 0; b < NB; ++b) a[b] += sil[b * D + k] * w; }
#pragma unroll
                for (int b = 0; b < NB; ++b) { a[b] += __shfl_xor(a[b], 16); a[b] += __shfl_xor(a[b], 32); }
                if (kq == 0) { const float bb = b_ada[col];
#pragma unroll
                    for (int b = 0; b < NB; ++b) MOD[(size_t)b * 6144 + col] = a[b] + bb; }
                continue; }
            r -= I_MOD;
            if (r < I_IN) { p0_transpose_item(w_in, D, NIN, WIN, scr, r, F.lane); continue; } r -= I_IN;
            if (r < I_OUT) { p0_transpose_item(w_out, D, D, WOUT, scr, r, F.lane); continue; } r -= I_OUT;
            if (r < I_POOL) { const int g = r >> 3; p0_transpose_item(w_pool + (size_t)g * 128 * 128, 128, 128, WPOOL + (size_t)g * 128 * 128, scr, r & 7, F.lane); continue; } r -= I_POOL;
            if (r < NE * I_GU1) { const int e = r / I_GU1; p0_transpose_item(w_gu + (size_t)e * D * 2048, D, 2048, WGU + (size_t)e * 2048 * D, scr, r % I_GU1, F.lane); continue; } r -= NE * I_GU1;
            { const int e = r / I_D1; p0_transpose_item(w_dn + (size_t)e * FF * D, FF, D, WD + (size_t)e * D * FF, scr, r % I_D1, F.lane); }
        }
        if (BOTH(0)) GRID_BAR();
    }
    if (IN(1)) {
        for (int m = gw; m < M; m += NGW) {
            const int b = m >> 11; const float* sh = MOD + (size_t)b * 6144; const float* sc = sh + 1024;
            const GAS f32x4* xr = (const GAS f32x4*)(x + (size_t)m * D) + F.lane;
            f32x4 v[4]; float s = 0.f;
#pragma unroll
            for (int j = 0; j < 4; ++j) { v[j] = xr[64 * j]; s += (v[j].x + v[j].y) + (v[j].z + v[j].w); }
            const float mean = wave_sum(s) * (1.f / D); float s2 = 0.f;
#pragma unroll
            for (int j = 0; j < 4; ++j) { v[j] = v[j] - mean; s2 += (v[j].x * v[j].x + v[j].y * v[j].y) + (v[j].z * v[j].z + v[j].w * v[j].w); }
            const float rstd = 1.f / sqrtf(wave_sum(s2) * (1.f / D) + LN_EPS);
            GAS v2u* o8 = (GAS v2u*)(XN + (size_t)m * D) + F.lane;
#pragma unroll
            for (int j = 0; j < 4; ++j) { const f32x4 sv = *(const f32x4*)(sc + 4 * F.lane + 256 * j), hv = *(const f32x4*)(sh + 4 * F.lane + 256 * j);
                const f32x4 h = (v[j] * rstd) * (sv + 1.0f) + hv; v2u w; w.x = pk2(h.x, h.y); w.y = pk2(h.z, h.w); o8[64 * j] = w; }
        }
        if (BOTH(1)) GRID_BAR();
    }
    if (IN(2)) {
        DenseSched S; S.init(XN, WIN, M, NIN, F.G, (int)blockIdx.x);
        EpiQKVU E{QB, (size_t)(WS_K - WS_Q) / 2};
        pg8::gemm_phase<EpiQKVU, DenseSched, true>(F.lds, S, E);
        if (BOTH(2)) GRID_BAR();
    }
    if (IN(3)) {
        LAS float* tb = (LAS float*)(F.lds + L_TB);
        for (int i = F.tid; i < 4 * attn_body::TBN; i += NWAVES * 64) { const int h = i / attn_body::TBN, idx = i % attn_body::TBN; const int d = idx - attn_body::TBOFF;
            tb[i] = (d <= 63) ? (rel_bias[t5_bucket(d) * 4 + h] - rel_bias[15 * 4 + h]) * LOG2E : 0.f; }
        __syncthreads();
#if !NAIVE_ATTN
        for (int vv = F.vcu; vv < 256; vv += F.G) {
            const int bjm = vv >> 2, s = vv & 3, b = bjm >> 3, j = bjm & 7;
#pragma unroll 1
            for (int i = 0; i < 4; ++i) { const int vh = i >> 1, qb = (i & 1) ? 7 - s : s;
                attn_body::attn_unit<8>(b, j, vh, qb, (const attn_body::bf16*)QB, (const attn_body::bf16*)KB, (const attn_body::bf16*)VB, (attn_body::bf16*)OA, (char*)lds, tb + (j >> 1) * attn_body::TBN); }
        }
#else
        for (int idx = blockIdx.x * 512 + F.tid; idx < NB * 8 * 2 * SEQ; idx += F.G * 512) {
            const int q = idx & 2047, vh = (idx >> 11) & 1, j = (idx >> 12) & 7, b = idx >> 15, h = j >> 1;
            const bf16* qp = QB + (size_t)(b * SEQ + q) * 512 + j * 64; float qv[64];
#pragma unroll
            for (int d = 0; d < 64; ++d) qv[d] = pg8::bf2f(qp[d]);
            float o[64];
#pragma unroll
            for (int d = 0; d < 64; ++d) o[d] = 0.f;
            float mx = -INFINITY, l = 0.f; const int kend = ((q >> 6) + 1) << 6;
            for (int k = 0; k < kend; ++k) {
                const bf16* kp = KB + (size_t)(b * SEQ + k) * 512 + j * 64; float sdot = 0.f;
#pragma unroll
                for (int d = 0; d < 64; ++d) sdot += qv[d] * pg8::bf2f(kp[d]);
                const int dd = k - q; const int ti = dd + attn_body::TBOFF < 0 ? 0 : dd + attn_body::TBOFF; sdot += tb[h * attn_body::TBN + ti];
                const float mn = fmaxf(mx, sdot), f = exp2f(mx - mn), p = exp2f(sdot - mn); l = l * f + p; mx = mn;
                const bf16* vp = VB + (size_t)(b * SEQ + k) * 512 + h * 128 + vh * 64;
#pragma unroll
                for (int d = 0; d < 64; ++d) o[d] = o[d] * f + p * pg8::bf2f(vp[d]);
            }
            bf16* op = OA + (size_t)(b * SEQ + q) * 1024 + j * 128 + vh * 64; const float il = 1.0f / l;
#pragma unroll
            for (int d = 0; d < 64; ++d) op[d] = (bf16)f2bf(o[d] * il);
        }
#endif
        if (BOTH(3)) GRID_BAR();
    }
    if (IN(4)) {
        float lam;
        { const float a = lq1[F.lane] * lk1[F.lane], b2 = lq2[F.lane] * lk2[F.lane]; lam = __expf(wave_sum(a)) - __expf(wave_sum(b2)) + LAM_INIT; }
        for (int m = gw; m < M; m += NGW) {
            const int h = F.lane >> 4, e0 = (F.lane & 15) * 8;
            const v4u a = *(const GAS v4u*)(OA + (size_t)m * 1024 + h * 256 + e0), b2 = *(const GAS v4u*)(OA + (size_t)m * 1024 + h * 256 + 128 + e0);
            float o[8];
            o[0] = bfl(a.x) - lam * bfl(b2.x); o[1] = bfh(a.x) - lam * bfh(b2.x); o[2] = bfl(a.y) - lam * bfl(b2.y); o[3] = bfh(a.y) - lam * bfh(b2.y);
            o[4] = bfl(a.z) - lam * bfl(b2.z); o[5] = bfh(a.z) - lam * bfh(b2.z); o[6] = bfl(a.w) - lam * bfl(b2.w); o[7] = bfh(a.w) - lam * bfh(b2.w);
            float ss = 0.f;
#pragma unroll
            for (int i = 0; i < 8; ++i) ss += o[i] * o[i];
            ss += __shfl_xor(ss, 1); ss += __shfl_xor(ss, 2); ss += __shfl_xor(ss, 4); ss += __shfl_xor(ss, 8);
            const float rs = (1.0f - LAM_INIT) / sqrtf(ss * (1.0f / 128.0f) + LN_EPS);
            const f32x4 g0 = *(const f32x4*)(subln_g + e0), g1v = *(const f32x4*)(subln_g + e0 + 4);
            v4u w; w.x = pk2(o[0] * rs * g0.x, o[1] * rs * g0.y); w.y = pk2(o[2] * rs * g0.z, o[3] * rs * g0.w); w.z = pk2(o[4] * rs * g1v.x, o[5] * rs * g1v.y); w.w = pk2(o[6] * rs * g1v.z, o[7] * rs * g1v.w);
            *(GAS v4u*)(MIX + (size_t)m * 1024 + h * 128 + e0) = w;
        }
        for (int it = gw; it < (M / 32) * 4; it += NGW) {
            const int g = it & 3, tile = it >> 2, row0 = tile * 32, r32 = F.lane & 31, hi = F.lane >> 5;
            const int win = 2 << g; const int row = row0 + r32, tpos = row & (SEQ - 1);
            const int nwin = tpos + 1 < win ? tpos + 1 : win; const float inv = 1.0f / (float)nwin;
            bf16x8 pf[8];
#pragma unroll
            for (int s = 0; s < 8; ++s) {
                const bf16* up = UB + (size_t)row * 512 + g * 128 + s * 16 + hi * 8; float sum[8];
#pragma unroll
                for (int i = 0; i < 8; ++i) sum[i] = 0.f;
                v4u self = *(const GAS v4u*)up;
                for (int k = 0; k < nwin; ++k) { const v4u u4 = *(const GAS v4u*)(up - (size_t)k * 512);
                    sum[0] += bfl(u4.x); sum[1] += bfh(u4.x); sum[2] += bfl(u4.y); sum[3] += bfh(u4.y); sum[4] += bfl(u4.z); sum[5] += bfh(u4.z); sum[6] += bfl(u4.w); sum[7] += bfh(u4.w); }
                v4u w; w.x = pk2(sum[0] * inv - bfl(self.x), sum[1] * inv - bfh(self.x)); w.y = pk2(sum[2] * inv - bfl(self.y), sum[3] * inv - bfh(self.y));
                w.z = pk2(sum[4] * inv - bfl(self.z), sum[5] * inv - bfh(self.z)); w.w = pk2(sum[6] * inv - bfl(self.w), sum[7] * inv - bfh(self.w));
                pf[s] = __builtin_bit_cast(bf16x8, w);
            }
#pragma unroll
            for (int db = 0; db < 4; ++db) {
                f32x16 acc = f32x16{};
                const bf16* wp = WPOOL + (size_t)g * 128 * 128 + (size_t)(db * 32 + r32) * 128 + hi * 8;
#pragma unroll
                for (int s = 0; s < 8; ++s) { const bf16x8 wf = __builtin_bit_cast(bf16x8, *(const GAS v4u*)(wp + s * 16)); acc = __builtin_amdgcn_mfma_f32_32x32x16_bf16(wf, pf[s], acc, 0, 0, 0); }
#pragma unroll
                for (int rq = 0; rq < 4; ++rq) { const int d0 = db * 32 + 8 * rq + 4 * hi; const int cg = g * 128 + d0;
                    const f32x4 bp = *(const f32x4*)(b_pool + cg), ps = *(const f32x4*)(pool_scale + cg);
                    v2u w; w.x = pk2((acc[4 * rq + 0] + bp.x) * ps.x, (acc[4 * rq + 1] + bp.y) * ps.y); w.y = pk2((acc[4 * rq + 2] + bp.z) * ps.z, (acc[4 * rq + 3] + bp.w) * ps.w);
                    *(GAS v2u*)(MIX + (size_t)row * 1024 + 512 + cg) = w; }
            }
        }
        if (BOTH(4)) GRID_BAR();
    }
    if (IN(5)) {
        DenseSched S; S.init(MIX, WOUT, M, D, F.G, (int)blockIdx.x);
        EpiT1 E{x, MOD, T1};
        pg8::gemm_phase<EpiT1, DenseSched, true>(F.lds, S, E);
        if (BOTH(5)) GRID_BAR();
    }
    if (IN(6)) {
        LAS float* H2 = (LAS float*)F.lds;
        LAS float* PART = (LAS float*)F.lds;
        LAS float* LOG = (LAS float*)(F.lds + 131200);
        LAS unsigned* hist = (LAS unsigned*)(F.lds + L_HIST); LAS unsigned* hbase = hist + 32;
        for (int tile = F.vcu; tile < M / 32; tile += F.G) {
            if (F.tid < 32) hist[F.tid] = 0u;
#pragma unroll 1
            for (int rr = 0; rr < 4; ++rr) {
                const int lr = F.wave * 4 + rr, m = tile * 32 + lr, b = m >> 11;
                const GAS f32x4* tr = (const GAS f32x4*)(T1 + (size_t)m * D) + F.lane;
                f32x4 v[4]; float s = 0.f;
#pragma unroll
                for (int j = 0; j < 4; ++j) { v[j] = tr[64 * j]; s += (v[j].x + v[j].y) + (v[j].z + v[j].w); }
                float mean = wave_sum(s) * (1.f / D); float s2 = 0.f;
#pragma unroll
                for (int j = 0; j < 4; ++j) { v[j] = v[j] - mean; s2 += (v[j].x * v[j].x + v[j].y * v[j].y) + (v[j].z * v[j].z + v[j].w * v[j].w); }
                float rstd = 1.f / sqrtf(wave_sum(s2) * (1.f / D) + LN_EPS);
                s = 0.f;
#pragma unroll
                for (int j = 0; j < 4; ++j) { const f32x4 gv = *(const f32x4*)(ln1_g + 4 * F.lane + 256 * j), bv = *(const f32x4*)(ln1_b + 4 * F.lane + 256 * j);
                    v[j] = (v[j] * rstd) * gv + bv; ((GAS f32x4*)(X1 + (size_t)m * D) + F.lane)[64 * j] = v[j]; s += (v[j].x + v[j].y) + (v[j].z + v[j].w); }
                mean = wave_sum(s) * (1.f / D); s2 = 0.f;
#pragma unroll
                for (int j = 0; j < 4; ++j) { v[j] = v[j] - mean; s2 += (v[j].x * v[j].x + v[j].y * v[j].y) + (v[j].z * v[j].z + v[j].w * v[j].w); }
                rstd = 1.f / sqrtf(wave_sum(s2) * (1.f / D) + LN_EPS);
                const float* sh = MOD + (size_t)b * 6144 + 3072; const float* sc = sh + 1024;
                GAS v2u* o8 = (GAS v2u*)(XN2 + (size_t)m * D) + F.lane;
#pragma unroll
                for (int j = 0; j < 4; ++j) { const f32x4 sv = *(const f32x4*)(sc + 4 * F.lane + 256 * j), hv = *(const f32x4*)(sh + 4 * F.lane + 256 * j);
                    const f32x4 h = (v[j] * rstd) * (sv + 1.0f) + hv; v2u w; w.x = pk2(h.x, h.y); w.y = pk2(h.z, h.w); o8[64 * j] = w;
                    LAS float* hp = H2 + lr * 1025 + 4 * F.lane + 256 * j; hp[0] = h.x; hp[1] = h.y; hp[2] = h.z; hp[3] = h.w; }
            }
            __syncthreads();
            f32x16 acc = f32x16{};
            { const int i = F.lane & 31, kh = F.lane >> 5, kb = F.wave * 128;
#pragma unroll 8
              for (int kk = 0; kk < 64; ++kk) { const int k = kb + 2 * kk + kh; acc = __builtin_amdgcn_mfma_f32_32x32x2f32(H2[i * 1025 + k], w_router[(size_t)k * NE + i], acc, 0, 0, 0); } }
            __syncthreads();
#pragma unroll
            for (int r = 0; r < 16; ++r) PART[(F.wave * 32 + ((r & 3) + 8 * (r >> 2) + 4 * (F.lane >> 5))) * 32 + (F.lane & 31)] = acc[r];
            __syncthreads();
#pragma unroll
            for (int q = 0; q < 2; ++q) { const int idx = F.tid + 512 * q, i = idx >> 5, e = idx & 31; float sl = b_router[e];
#pragma unroll
                for (int w = 0; w < 8; ++w) sl += PART[(w * 32 + i) * 32 + e];
                LOG[i * 33 + e] = sl; }
            __syncthreads();
            int li[4]; float lv[4]; unsigned lrk[4];
            if (F.tid < 32) {
                unsigned used = 0u;
#pragma unroll
                for (int k = 0; k < 4; ++k) { float best = -INFINITY; int bi = 0;
                    for (int e = 0; e < NE; ++e) { const float vv = LOG[F.tid * 33 + e]; if (!((used >> e) & 1u) && vv > best) { best = vv; bi = e; } }
                    used |= 1u << bi; lv[k] = best; li[k] = bi; }
                float ssum = 0.f; const float lmx = lv[0];
#pragma unroll
                for (int k = 0; k < 4; ++k) { lv[k] = __expf(lv[k] - lmx); ssum += lv[k]; }
#pragma unroll
                for (int k = 0; k < 4; ++k) lrk[k] = __hip_atomic_fetch_add(hist + li[k], 1u, __ATOMIC_RELAXED, __HIP_MEMORY_SCOPE_WORKGROUP);
                const float is = 1.0f / ssum;
#pragma unroll
                for (int k = 0; k < 4; ++k) lv[k] *= is;
            }
            __syncthreads();
            if (F.tid < 32) { const unsigned n = hist[F.tid]; hbase[F.tid] = n ? __hip_atomic_fetch_add(F.ctl + CW_CNT + 64 * F.tid, n, RLX_AGENT) : 0u; }
            __syncthreads();
            if (F.tid < 32) { const int m = tile * 32 + F.tid;
#pragma unroll
                for (int k = 0; k < 4; ++k) { const int p = (int)(hbase[li[k]] + lrk[k]); RE[m * 4 + k] = li[k]; RP[m * 4 + k] = p; RG[m * 4 + k] = lv[k]; if (p < ECAP) ROWTOK[li[k] * ECAP + p] = m; } }
            __syncthreads();
        }
        if (BOTH(6)) GRID_BAR();
    }
    if (IN(7)) {
        build_expert_tables(F);
        MoeSched S; S.A = XN2; S.W = WGU; S.rowtok = ROWTOK; S.pexp = (const LAS int*)(F.lds + L_PEXP); S.pfirst = (const LAS int*)(F.lds + L_PFIRST); S.cntl = (const LAS int*)(F.lds + L_CNT);
        S.NP = ((const LAS int*)(F.lds + L_PFIRST))[NE]; S.NT = 8; S.G = F.G; S.vcu = F.vcu; S.gather = true; S.wexp = (size_t)2048 * 1024 * 2; S.wtile = (size_t)128 * 1024 * 2; S.whalf = (size_t)1024 * 1024 * 2;
        EpiSwiglu E{b_gu, HB};
        pg8::gemm_phase<EpiSwiglu, MoeSched, true>(F.lds, S, E);
        if (BOTH(7)) GRID_BAR();
    }
    if (IN(8)) {
        build_expert_tables(F);
        MoeSched S; S.A = HB; S.W = WD; S.rowtok = ROWTOK; S.pexp = (const LAS int*)(F.lds + L_PEXP); S.pfirst = (const LAS int*)(F.lds + L_PFIRST); S.cntl = (const LAS int*)(F.lds + L_CNT);
        S.NP = ((const LAS int*)(F.lds + L_PFIRST))[NE]; S.NT = 4; S.G = F.G; S.vcu = F.vcu; S.gather = false; S.wexp = (size_t)1024 * 1024 * 2; S.wtile = (size_t)256 * 1024 * 2; S.whalf = (size_t)128 * 1024 * 2;
        EpiDown E{b_dn, YB};
        pg8::gemm_phase<EpiDown, MoeSched, true>(F.lds, S, E);
        if (BOTH(8)) GRID_BAR();
    }
    if (IN(9)) {
        build_expert_tables(F);
        const LAS int* pfirst = (const LAS int*)(F.lds + L_PFIRST);
        const unsigned bad = __hip_atomic_load(F.ctl + CW_BAR + XB_TMO, RLX_AGENT);
        for (int m = gw; m < M; m += NGW) {
            const int b = m >> 11; const float* g2 = MOD + (size_t)b * 6144 + 5120;
            f32x4 a[4];
#pragma unroll
            for (int j = 0; j < 4; ++j) a[j] = (f32x4){0.f, 0.f, 0.f, 0.f};
#pragma unroll
            for (int k = 0; k < 4; ++k) { const int e = __builtin_amdgcn_readfirstlane(RE[m * 4 + k]), p = __builtin_amdgcn_readfirstlane(RP[m * 4 + k]); const float gk = RG[m * 4 + k];
                const size_t yrow = (size_t)pfirst[e] * 256 + (size_t)p; const GAS v2u* yp = (const GAS v2u*)(YB + yrow * 1024) + F.lane;
#pragma unroll
                for (int j = 0; j < 4; ++j) { const v2u w = yp[64 * j]; a[j] += (f32x4){bfl(w.x), bfh(w.x), bfl(w.y), bfh(w.y)} * gk; } }
            f32x4 v[4]; float s = 0.f;
#pragma unroll
            for (int j = 0; j < 4; ++j) { const f32x4 xv = ((const GAS f32x4*)(X1 + (size_t)m * D) + F.lane)[64 * j]; const f32x4 gv = *(const f32x4*)(g2 + 4 * F.lane + 256 * j);
                v[j] = xv * DN_ALPHA + gv * a[j]; s += (v[j].x + v[j].y) + (v[j].z + v[j].w); }
            const float mean = wave_sum(s) * (1.f / D); float s2 = 0.f;
#pragma unroll
            for (int j = 0; j < 4; ++j) { v[j] = v[j] - mean; s2 += (v[j].x * v[j].x + v[j].y * v[j].y) + (v[j].z * v[j].z + v[j].w * v[j].w); }
            const float rstd = 1.f / sqrtf(wave_sum(s2) * (1.f / D) + LN_EPS);
#pragma unroll
            for (int j = 0; j < 4; ++j) { const f32x4 gv = *(const f32x4*)(ln2_g + 4 * F.lane + 256 * j), bv = *(const f32x4*)(ln2_b + 4 * F.lane + 256 * j);
                f32x4 o = (v[j] * rstd) * gv + bv; if (bad) { const float qn = __builtin_nanf(""); o = (f32x4){qn, qn, qn, qn}; }
                ((GAS f32x4*)(out + (size_t)m * D) + F.lane)[64 * j] = o; }
        }
    }
#undef IN
#undef BOTH
}

extern "C" void kernel_launch(void* const* d_in, const int* in_sizes, int n_in, void* d_out, int out_size, void* d_ws, size_t ws_size, hipStream_t stream) {
    static int grid = 0;
    if (grid == 0) {
        if (n_in != 25 || in_sizes[0] != M * D || out_size != M * D || ws_size < WS_END) { fprintf(stderr, "kernel_launch: unexpected shapes (n_in %d, in0 %d, out %d, ws %zu); nothing launched\n", n_in, n_in > 0 ? in_sizes[0] : -1, out_size, ws_size); grid = -1; return; }
        int dev = 0, cus = 0, per_cu = 0;
        if (hipGetDevice(&dev) != hipSuccess || hipDeviceGetAttribute(&cus, hipDeviceAttributeMultiprocessorCount, dev) != hipSuccess) { grid = -1; return; }
        if (hipFuncSetAttribute((const void*)mk_fwd, hipFuncAttributeMaxDynamicSharedMemorySize, LDS_BYTES) != hipSuccess) { fprintf(stderr, "kernel_launch: hipFuncSetAttribute failed\n"); grid = -1; return; }
        if (hipOccupancyMaxActiveBlocksPerMultiprocessor(&per_cu, (const void*)mk_fwd, NWAVES * 64, LDS_BYTES) != hipSuccess || per_cu < 1) { fprintf(stderr, "kernel_launch: occupancy query reports %d workgroups per CU\n", per_cu); (void)hipGetLastError(); }
        grid = cus;
    }
    if (grid < 0) return;
    if (hipMemsetAsync((char*)d_ws + WS_CTL, 0, CTL_ZERO_BYTES, stream) != hipSuccess) return;
    Args a{};
    for (int i = 0; i < 25; ++i) a.in[i] = (const float*)d_in[i];
    a.out = (float*)d_out; a.ws = (unsigned char*)d_ws;
#if MK_ONE_LAUNCH
    a.ph_lo = 0; a.ph_hi = NPHASE;
    hipLaunchKernelGGL(mk_fwd, dim3(grid), dim3(NWAVES * 64), LDS_BYTES, stream, a);
#else
    for (int p = 0; p < NPHASE; ++p) { a.ph_lo = p; a.ph_hi = p + 1; hipLaunchKernelGGL(mk_fwd, dim3(grid), dim3(NWAVES * 64), LDS_BYTES, stream, a); }
#endif
}
```

```cpp
#include <hip/hip_runtime.h>
#include <hip/hip_bf16.h>
#include <cstdio>
#include <cstdint>
#include <cmath>
#include <type_traits>

#ifndef MK_ONE_LAUNCH
#define MK_ONE_LAUNCH 1
#endif
#ifndef NAIVE_GEMM
#define NAIVE_GEMM 0
#endif
#ifndef NAIVE_ATTN
#define NAIVE_ATTN 0
#endif

#define GAS __attribute__((address_space(1)))
#define LAS __attribute__((address_space(3)))

constexpr int NB = 8, SEQ = 2048, D = 1024, M = NB * SEQ;
constexpr int AW = 512;
constexpr int NIN = 2048;
constexpr int NE = 32, TOPK = 4, FF = 1024;
constexpr int ECAP = 16384;
constexpr int PMAX = (M * TOPK) / 256 + NE;
constexpr float LN_EPS = 1e-5f;
constexpr float DN_ALPHA = 1.189207115002721f;
constexpr float LAM_INIT = 0.2f;
constexpr float LOG2E = 1.4426950408889634f;
constexpr float QSCALE = 0.125f * LOG2E;
constexpr int NWAVES = 8;

namespace pg8 {
#define PG8_LAS __attribute__((address_space(3)))
typedef unsigned short bf16_t;
typedef short bf16x8 __attribute__((ext_vector_type(8)));
typedef float f32x4 __attribute__((ext_vector_type(4)));
typedef unsigned u32x4 __attribute__((ext_vector_type(4)));
constexpr int BM = 256, BK = 64, HALF = 128, HTB = HALF * BK * 2, STAGE_BYTES = 8 * HTB, NXCD = 8, WGM = 8;
constexpr int GK = 1024;

__host__ __device__ __forceinline__ int lds_byte(int r, int c) { const int st = (r >> 4) * 2 + (c >> 5), rr = r & 15, cc = c & 31, ob = rr * 64 + cc * 2; return st * 1024 + (ob ^ (((ob >> 9) & 1) << 5)); }
__host__ __device__ __forceinline__ void stage_rc(int b, int& R, int& C) { const int st = b / 1024, sb = b % 1024, swz = sb ^ (((sb >> 9) & 1) << 5); R = (st >> 1) * 16 + swz / 64; C = (st & 1) * 32 + (swz % 64) / 2; }
__host__ __device__ __forceinline__ int perm32(int rho) { const int n = rho >> 4, i = rho & 15; return 8 * (i >> 2) + 4 * n + (i & 3); }

struct Unit { int pm, pn, e, lrow0, cnt; };

__device__ __forceinline__ unsigned cvt_pk_bf16(float lo, float hi) { unsigned r; asm volatile("v_cvt_pk_bf16_f32 %0, %1, %2" : "=v"(r) : "v"(lo), "v"(hi)); return r; }
__device__ __forceinline__ float bf2f(unsigned short v) { return __uint_as_float((unsigned)v << 16); }

#if !NAIVE_GEMM
template <class Epi, class Sched, bool ALIGN_EPI>
__device__ __forceinline__ void gemm_phase(PG8_LAS unsigned char* lds, const Sched& S, const Epi& E) {
    constexpr int K = GK, nt = K / BK;
    const int tid = threadIdx.x, wid = __builtin_amdgcn_readfirstlane(tid >> 6), lane = tid & 63, wr = wid >> 2, wc = wid & 3, fr = lane & 15, fq = lane >> 4;
    int Rr[2], Cc[2]; unsigned voffB[2];
#pragma unroll
    for (int i = 0; i < 2; ++i) { int R, C; stage_rc(tid * 16 + i * 8192, R, C); Rr[i] = R; Cc[i] = C; const int Rb = Epi::PERM ? ((R & ~31) + perm32(R & 31)) : R; voffB[i] = (unsigned)(Rb * K + C) * 2u; }
    const size_t kstep = (size_t)(BK * 2);
    const size_t hB = S.b_hstep();
    const unsigned ldsw = (unsigned)wid * 1024u;
    const int aoff = lds_byte(wr * 64 + fr, fq * 8), boff = lds_byte(wc * 32 + fr, fq * 8);
#define PG8_SA(b, h) (((b) * 2 + (h)) * HTB)
#define PG8_SB(b, h) ((4 + (b) * 2 + (h)) * HTB)
#define PG8_STAGE(bufoff, gbase, voff) do { _Pragma("unroll") for (int _i = 0; _i < 2; ++_i) \
        __builtin_amdgcn_global_load_lds((const unsigned*)((const char*)(gbase) + (voff)[_i]), (PG8_LAS unsigned*)(lds + (bufoff) + ldsw + _i * 8192), 16, 0, 0); } while (0)
#define PG8_LDA(dst, b, h) do { _Pragma("unroll") for (int m = 0; m < 4; ++m) _Pragma("unroll") for (int k = 0; k < 2; ++k) dst[m][k] = *(const PG8_LAS bf16x8*)(lds + PG8_SA(b, h) + aoff + m * 2048 + k * 1024); } while (0)
#define PG8_LDB(dst, b, h) do { _Pragma("unroll") for (int n = 0; n < 2; ++n) _Pragma("unroll") for (int k = 0; k < 2; ++k) dst[n][k] = *(const PG8_LAS bf16x8*)(lds + PG8_SB(b, h) + boff + n * 2048 + k * 1024); } while (0)
#define PG8_MMA(ai, bj, At, Bt) do { __builtin_amdgcn_s_setprio(1); _Pragma("unroll") for (int m = 0; m < 4; ++m) _Pragma("unroll") for (int n = 0; n < 2; ++n) _Pragma("unroll") for (int k = 0; k < 2; ++k) \
        acc[ai][bj][m][n] = __builtin_amdgcn_mfma_f32_16x16x32_bf16(Bt[n][k], At[m][k], acc[ai][bj][m][n], 0, 0, 0); __builtin_amdgcn_s_setprio(0); } while (0)
#define PG8_WAIT_V(n) asm volatile("s_waitcnt vmcnt(" #n ")" ::: "memory")
#define PG8_WAIT_L(n) asm volatile("s_waitcnt lgkmcnt(" #n ")" ::: "memory")
#define PG8_BAR __builtin_amdgcn_s_barrier()
#define PG8_SCHED __builtin_amdgcn_sched_barrier(0)
    Unit cur, nxt; int ui = 0;
    if (!S.next(0, cur)) return;
    f32x4 acc[2][2][4][2];
#pragma unroll
    for (int a = 0; a < 2; ++a)
#pragma unroll
        for (int b = 0; b < 2; ++b)
#pragma unroll
            for (int m = 0; m < 4; ++m)
#pragma unroll
                for (int n = 0; n < 2; ++n) acc[a][b][m][n] = (f32x4){0.f, 0.f, 0.f, 0.f};
    bf16x8 At[4][2], B0[2][2], B1[2][2];
    const char* cA = S.a_base(cur); const char* cB = S.b_base(cur);
    unsigned va0[2], va1[2];
    S.a_voff(cur, Rr, Cc, va0, va1);
    PG8_STAGE(PG8_SB(0, 0), cB, voffB); PG8_STAGE(PG8_SB(0, 1), cB + hB, voffB); PG8_STAGE(PG8_SA(0, 0), cA, va0); PG8_STAGE(PG8_SA(0, 1), cA, va1);
    if (wr == 1) PG8_BAR;
    PG8_WAIT_V(2); PG8_BAR;
    PG8_STAGE(PG8_SB(1, 0), cB + kstep, voffB); PG8_STAGE(PG8_SA(1, 0), cA + kstep, va0); PG8_STAGE(PG8_SB(1, 1), cB + hB + kstep, voffB);
    PG8_WAIT_V(6); PG8_BAR;
    for (;;) {
        const bool has_next = S.next(ui + 1, nxt);
        const char* nA = has_next ? S.a_base(nxt) : cA; const char* nB = has_next ? S.b_base(nxt) : cB;
        unsigned vn0[2], vn1[2];
        if (has_next) S.a_voff(nxt, Rr, Cc, vn0, vn1); else { vn0[0] = va0[0]; vn0[1] = va0[1]; vn1[0] = va1[0]; vn1[1] = va1[1]; }
        for (int t = 0; t < nt; t += 2) {
            const bool last = (t == nt - 2);
            const char* a1 = cA + (size_t)(t + 1) * kstep;
            const char* a2 = last ? nA : cA + (size_t)(t + 2) * kstep; const char* b2 = last ? nB : cB + (size_t)(t + 2) * kstep;
            const char* a3 = a2 + kstep; const char* b3 = b2 + kstep;
            unsigned v20[2], v21[2];
            v20[0] = last ? vn0[0] : va0[0]; v20[1] = last ? vn0[1] : va0[1]; v21[0] = last ? vn1[0] : va1[0]; v21[1] = last ? vn1[1] : va1[1];
            PG8_LDB(B0, 0, 0); PG8_LDB(B1, 0, 1); PG8_SCHED; PG8_LDA(At, 0, 0); PG8_STAGE(PG8_SA(1, 1), a1, va1);
            PG8_WAIT_V(8); PG8_WAIT_L(0); PG8_BAR; PG8_MMA(0, 0, At, B0); PG8_MMA(0, 1, At, B1); PG8_BAR; PG8_SCHED;
            PG8_LDA(At, 0, 1); PG8_STAGE(PG8_SB(0, 0), b2, voffB); PG8_STAGE(PG8_SB(0, 1), b2 + hB, voffB); PG8_STAGE(PG8_SA(0, 0), a2, v20);
            PG8_WAIT_V(8); PG8_WAIT_L(0); PG8_BAR; PG8_MMA(1, 0, At, B0); PG8_MMA(1, 1, At, B1); PG8_BAR; PG8_SCHED;
            PG8_LDB(B0, 1, 0); PG8_LDB(B1, 1, 1); PG8_SCHED; PG8_LDA(At, 1, 0); PG8_STAGE(PG8_SA(0, 1), a2, v21);
            PG8_WAIT_V(8); PG8_WAIT_L(0); PG8_BAR; PG8_MMA(0, 0, At, B0); PG8_MMA(0, 1, At, B1); PG8_BAR; PG8_SCHED;
            PG8_LDA(At, 1, 1); PG8_STAGE(PG8_SB(1, 0), b3, voffB); PG8_STAGE(PG8_SB(1, 1), b3 + hB, voffB); PG8_STAGE(PG8_SA(1, 0), a3, v20);
            PG8_WAIT_V(8); PG8_WAIT_L(0); PG8_BAR; PG8_MMA(1, 0, At, B0); PG8_MMA(1, 1, At, B1); PG8_BAR; PG8_SCHED;
        }
        if constexpr (ALIGN_EPI) { if (wr == 0) PG8_BAR; }
        E(acc, cur, wr, wc, fr, fq);
        if (!has_next) break;
#pragma unroll
        for (int a = 0; a < 2; ++a)
#pragma unroll
            for (int b = 0; b < 2; ++b)
#pragma unroll
                for (int m = 0; m < 4; ++m)
#pragma unroll
                    for (int n = 0; n < 2; ++n) acc[a][b][m][n] = (f32x4){0.f, 0.f, 0.f, 0.f};
        cur = nxt; cA = nA; cB = nB; va0[0] = vn0[0]; va0[1] = vn0[1]; va1[0] = vn1[0]; va1[1] = vn1[1]; ++ui;
        if constexpr (ALIGN_EPI) { if (wr == 1) PG8_BAR; }
    }
    PG8_WAIT_V(0);
    if constexpr (!ALIGN_EPI) { if (wr == 0) PG8_BAR; }
    PG8_BAR;
#undef PG8_SA
#undef PG8_SB
#undef PG8_STAGE
#undef PG8_LDA
#undef PG8_LDB
#undef PG8_MMA
#undef PG8_WAIT_V
#undef PG8_WAIT_L
#undef PG8_BAR
#undef PG8_SCHED
}
#else
template <class Epi, class Sched, bool ALIGN_EPI>
__device__ __forceinline__ void gemm_phase(PG8_LAS unsigned char*, const Sched& S, const Epi& E) {
    constexpr int K = GK;
    const int tid = threadIdx.x, wid = __builtin_amdgcn_readfirstlane(tid >> 6), lane = tid & 63, wr = wid >> 2, wc = wid & 3, fr = lane & 15, fq = lane >> 4;
    Unit u;
    for (int ui = 0; S.next(ui, u); ++ui) {
        f32x4 acc[2][2][4][2];
#pragma unroll
        for (int ai = 0; ai < 2; ++ai)
#pragma unroll
            for (int bj = 0; bj < 2; ++bj) {
                const bf16_t* ar[4]; const bf16_t* br[2][4];
#pragma unroll
                for (int m = 0; m < 4; ++m) ar[m] = S.a_row(u, ai * 128 + wr * 64 + m * 16 + fr);
#pragma unroll
                for (int n = 0; n < 2; ++n)
#pragma unroll
                    for (int x = 0; x < 4; ++x) br[n][x] = S.b_row(u, bj * 128 + wc * 32 + (Epi::PERM ? 8 * fq + 4 * n + x : 16 * n + 4 * fq + x));
                float s[4][2][4];
#pragma unroll
                for (int m = 0; m < 4; ++m)
#pragma unroll
                    for (int n = 0; n < 2; ++n)
#pragma unroll
                        for (int x = 0; x < 4; ++x) s[m][n][x] = 0.f;
                for (int k0 = 0; k0 < K; k0 += 8) {
                    bf16x8 av[4], bv[2][4];
#pragma unroll
                    for (int m = 0; m < 4; ++m) av[m] = *(const bf16x8*)(ar[m] + k0);
#pragma unroll
                    for (int n = 0; n < 2; ++n)
#pragma unroll
                        for (int x = 0; x < 4; ++x) bv[n][x] = *(const bf16x8*)(br[n][x] + k0);
#pragma unroll
                    for (int kk = 0; kk < 8; ++kk)
#pragma unroll
                        for (int m = 0; m < 4; ++m) { const float a = bf2f((unsigned short)av[m][kk]);
#pragma unroll
                            for (int n = 0; n < 2; ++n)
#pragma unroll
                                for (int x = 0; x < 4; ++x) s[m][n][x] += a * bf2f((unsigned short)bv[n][x][kk]); }
                }
#pragma unroll
                for (int m = 0; m < 4; ++m)
#pragma unroll
                    for (int n = 0; n < 2; ++n) acc[ai][bj][m][n] = (f32x4){s[m][n][0], s[m][n][1], s[m][n][2], s[m][n][3]};
            }
        E(acc, u, wr, wc, fr, fq);
    }
}
#endif
}

constexpr size_t MiB = 1u << 20;
constexpr size_t WS_CTL = 0, CTL_ZERO_BYTES = 1 * MiB;
constexpr size_t WS_MOD = 1 * MiB;
constexpr size_t WS_WPOOL = 1 * MiB + 512 * 1024;
constexpr size_t WS_WIN = 2 * MiB;
constexpr size_t WS_WOUT = 6 * MiB;
constexpr size_t WS_WGU = 8 * MiB;
constexpr size_t WS_WD = 136 * MiB;
constexpr size_t WS_XN = 200 * MiB;
constexpr size_t WS_Q = 232 * MiB, WS_K = 248 * MiB, WS_V = 264 * MiB, WS_U = 280 * MiB;
constexpr size_t WS_OA = 296 * MiB;
constexpr size_t WS_MIX = 328 * MiB;
constexpr size_t WS_T1 = 360 * MiB;
constexpr size_t WS_X1 = 424 * MiB;
constexpr size_t WS_XN2 = 488 * MiB;
constexpr size_t WS_RE = 520 * MiB, WS_RP = 521 * MiB, WS_RG = 522 * MiB;
constexpr size_t WS_ROWTOK = 524 * MiB;
constexpr size_t WS_H = 528 * MiB;
constexpr size_t WS_Y = 672 * MiB;
constexpr size_t WS_END = 816 * MiB;
static_assert((size_t)PMAX * 256 * 1024 * 2 == 144 * MiB, "H / Y size");
constexpr int CW_TMO = 0, CW_CODE = 1;
constexpr int CW_BAR = 4096;
constexpr int CW_CNT = 8192;

constexpr int RING_BYTES = 131072;
constexpr int LDS_BYTES = 147456;
constexpr int LCTL_OFF = 139264;
constexpr int L_MISC = LCTL_OFF;
constexpr int L_CNT = LCTL_OFF + 128;
constexpr int L_PFIRST = LCTL_OFF + 256;
constexpr int L_PEXP = LCTL_OFF + 512;
constexpr int L_HIST = LCTL_OFF + 512 + 4 * 320;
constexpr int L_TB = 90112;
static_assert(L_TB + 4 * 704 * 4 <= RING_BYTES && L_HIST + 256 <= LDS_BYTES && PMAX <= 320, "LDS map");

typedef unsigned short bf16;
typedef unsigned v4u __attribute__((ext_vector_type(4)));
typedef unsigned v2u __attribute__((ext_vector_type(2)));
typedef float f32x4 __attribute__((ext_vector_type(4)));
typedef float f32x16 __attribute__((ext_vector_type(16)));
typedef short bf16x8 __attribute__((ext_vector_type(8)));
typedef GAS unsigned gu32;
#define RLX_AGENT __ATOMIC_RELAXED, __HIP_MEMORY_SCOPE_AGENT
#define LDS_WAIT() asm volatile("s_waitcnt lgkmcnt(0)" ::: "memory")
#define VM_WAIT() asm volatile("s_waitcnt vmcnt(0)" ::: "memory")
__device__ __forceinline__ unsigned f2bf(float f) { unsigned u = __builtin_bit_cast(unsigned, f); return (u + 0x7fffu + ((u >> 16) & 1u)) >> 16; }
__device__ __forceinline__ unsigned pk2(float lo, float hi) { return f2bf(lo) | (f2bf(hi) << 16); }
__device__ __forceinline__ float bfl(unsigned w) { return __uint_as_float(w << 16); }
__device__ __forceinline__ float bfh(unsigned w) { return __uint_as_float(w & 0xffff0000u); }

namespace attn_body {
using bf16=__hip_bfloat16;
using bf16x8=__attribute__((ext_vector_type(8)))short;
using s16x4=__attribute__((ext_vector_type(4)))short;
using f32x16=__attribute__((ext_vector_type(16)))float;
using u32x4=__attribute__((ext_vector_type(4)))unsigned;
constexpr int SEQ=2048,DH=64,PQ=512,PO=1024;
constexpr int NW=8,QBLK=32,QB=QBLK*NW,KVBLK=64,NQB=SEQ/QB;
__device__ __forceinline__ int crow(int r,int hi){return (r&3)+8*(r>>2)+4*hi;}
#define SBAR() __builtin_amdgcn_sched_barrier(0)
constexpr int TBN=704, TBOFF=447;
__device__ __forceinline__ void bandinit(f32x16&p0,f32x16&p1,int t,int q0,int wid,int r32,int hi,const __attribute__((address_space(3))) float*tb){
  const __attribute__((address_space(3))) float*tp=tb+(64*t+4*hi-(q0+32*wid+r32)+TBOFF);
  #pragma unroll
  for(int r=0;r<16;++r){p0[r]=tp[(r&3)+8*(r>>2)]; p1[r]=tp[(r&3)+8*(r>>2)+32];}
}
__device__ __forceinline__ void bandpost(f32x16&p0,f32x16&p1,const f32x16&negm,int t,int q0,int wid){
  const float nm=(t>(q0>>6)+(wid>>1))?-INFINITY:negm[0];
  #pragma unroll
  for(int r=0;r<16;++r){p0[r]+=nm;p1[r]+=nm;}
}
constexpr int NSLOT=3, SLOTB=8192;
constexpr int LDS_K=0, LDS_V=NSLOT*SLOTB, LDS_WS=2*NSLOT*SLOTB, LDS_OST=LDS_WS+NW*64*4, LDS_BYTES=LDS_OST+NW*4096;
__device__ __forceinline__ void glds16(const void*gsrc,unsigned lds_dst){unsigned keep;
  asm volatile("s_mov_b32 %0, m0\n\ts_mov_b32 m0, %2\n\ts_nop 0\n\tglobal_load_lds_dwordx4 %1, off\n\ts_mov_b32 m0, %0":"=&s"(keep):"v"(gsrc),"s"(lds_dst):"memory");}
__device__ __forceinline__ float max3f(float a,float b,float c){float r;asm("v_max3_f32 %0, %1, %2, %3":"=v"(r):"v"(a),"v"(b),"v"(c));return r;}
__device__ __forceinline__ float max2f(float a,float b){float r;asm("v_max_f32_e32 %0, %1, %2":"=v"(r):"v"(a),"v"(b));return r;}
__device__ __forceinline__ float fadd_s(float a,float b){float r;asm("v_add_f32_e32 %0, %1, %2":"=v"(r):"v"(a),"v"(b));return r;}
__device__ __forceinline__ float fsub_s(float a,float b){float r;asm("v_sub_f32_e32 %0, %1, %2":"=v"(r):"v"(a),"v"(b));return r;}
typedef float f32x2_t __attribute__((ext_vector_type(2))); typedef __bf16 bf16x2_t __attribute__((ext_vector_type(2)));
__device__ __forceinline__ unsigned cvtpk_s(float lo,float hi){f32x2_t v={lo,hi};bf16x2_t b=__builtin_convertvector(v,bf16x2_t);return __builtin_bit_cast(unsigned,b);}
#define WAIT_BAR(N) asm volatile("s_waitcnt vmcnt(" #N ") lgkmcnt(0)\n\ts_barrier":::"memory")

__device__ __forceinline__ void qkt(f32x16&p0,f32x16&p1,const char*Kslot,const bf16x8*qr,int r32,int hi){
  const char*kb=Kslot+hi*1024+r32*16;
  #pragma unroll
  for(int d0=0;d0<4;++d0){
    const bf16x8 b0=*reinterpret_cast<const bf16x8*>(kb+d0*2048);
    const bf16x8 b1=*reinterpret_cast<const bf16x8*>(kb+d0*2048+512);
    p0=__builtin_amdgcn_mfma_f32_32x32x16_bf16(b0,qr[d0],p0,0,0,0);p1=__builtin_amdgcn_mfma_f32_32x32x16_bf16(b1,qr[d0],p1,0,0,0);}
}
typedef __attribute__((address_space(3))) const char* lds_cptr;
typedef short v4i16_t __attribute__((ext_vector_type(4)));
__device__ __forceinline__ void kload8(bf16x8*kf,lds_cptr kp){
  kf[0]=*(const __attribute__((address_space(3))) bf16x8*)(kp);      kf[1]=*(const __attribute__((address_space(3))) bf16x8*)(kp+512);
  kf[2]=*(const __attribute__((address_space(3))) bf16x8*)(kp+2048); kf[3]=*(const __attribute__((address_space(3))) bf16x8*)(kp+2560);
  kf[4]=*(const __attribute__((address_space(3))) bf16x8*)(kp+4096); kf[5]=*(const __attribute__((address_space(3))) bf16x8*)(kp+4608);
  kf[6]=*(const __attribute__((address_space(3))) bf16x8*)(kp+6144); kf[7]=*(const __attribute__((address_space(3))) bf16x8*)(kp+6656);
}
__device__ __forceinline__ void kload2(bf16x8*kf,lds_cptr kp,int j){ kf[2*j]=*(const __attribute__((address_space(3))) bf16x8*)(kp+j*2048); kf[2*j+1]=*(const __attribute__((address_space(3))) bf16x8*)(kp+j*2048+512); }
__device__ __forceinline__ s16x4 vtr(lds_cptr p){ return __builtin_bit_cast(s16x4,__builtin_amdgcn_ds_read_tr16_b64_v4i16((__attribute__((address_space(3))) v4i16_t*)p)); }
__device__ __forceinline__ float rowmax(const f32x16&p0,const f32x16&p1){
  float a=max3f(p0[0],p0[1],p1[0]),b=max3f(p0[2],p0[3],p1[1]);a=max3f(a,p1[2],p1[3]);
  #pragma unroll
  for(int r=4;r<16;r+=4){a=max3f(a,p0[r],p0[r+1]);b=max3f(b,p0[r+2],p0[r+3]);a=max3f(a,p1[r],p1[r+1]);b=max3f(b,p1[r+2],p1[r+3]);}
  const float m=max2f(a,b);
  auto rr=__builtin_amdgcn_permlane32_swap(__float_as_uint(m),__float_as_uint(m),false,false);
  return max2f(__uint_as_float(rr[0]),__uint_as_float(rr[1]));
}
__device__ __forceinline__ void pv(f32x16*o,int vb,bf16x8 pa0,bf16x8 pa1,bf16x8 pa2,bf16x8 pa3){
  #pragma unroll
  for(int d0=0;d0<2;++d0){s16x4 lo[4],hi[4];
    #pragma unroll
    for(int ks=0;ks<4;++ks){
      asm volatile("ds_read_b64_tr_b16 %0,%1 offset:%c2":"=&v"(lo[ks]):"v"(vb),"i"(d0*4096+ks*1024):"memory");
      asm volatile("ds_read_b64_tr_b16 %0,%1 offset:%c2":"=&v"(hi[ks]):"v"(vb),"i"(d0*4096+ks*1024+512):"memory");}
    asm volatile("s_waitcnt lgkmcnt(0)":::"memory");SBAR();
    #define PK(k) (bf16x8){lo[k][0],lo[k][1],lo[k][2],lo[k][3],hi[k][0],hi[k][1],hi[k][2],hi[k][3]}
    o[d0]=__builtin_amdgcn_mfma_f32_32x32x16_bf16(pa0,PK(0),o[d0],0,0,0);
    o[d0]=__builtin_amdgcn_mfma_f32_32x32x16_bf16(pa1,PK(1),o[d0],0,0,0);
    o[d0]=__builtin_amdgcn_mfma_f32_32x32x16_bf16(pa2,PK(2),o[d0],0,0,0);
    o[d0]=__builtin_amdgcn_mfma_f32_32x32x16_bf16(pa3,PK(3),o[d0],0,0,0);
    #undef PK
  }
}
#define ATTN_STORE16(p,v) (*(u32x4*)(p)=(v))
template<int THRL> __device__ __forceinline__ void attn_unit(int b,int j,int vh,int qb,const bf16*Q,const bf16*__restrict__ K,const bf16*__restrict__ V,bf16*O,char*shm,const __attribute__((address_space(3))) float*tbh){
  int tid_=threadIdx.x; asm volatile("":"+v"(tid_));
  const int tid=tid_,lane=tid&63,r32=lane&31,hi=lane>>5; const int wid=__builtin_amdgcn_readfirstlane(tid>>6);
  const long rowbase=(long)b*SEQ; const int q0=qb*QB;
  const bf16*Qw=Q+(rowbase+q0+wid*QBLK)*PQ+j*DH;
  const bf16*Kh=K+rowbase*PQ+j*DH,*Vh=V+rowbase*PQ+(j>>1)*128+vh*64;
  const unsigned lds0=(unsigned)(uintptr_t)shm;
  float*wsf=(float*)(shm+LDS_WS)+wid*64;
  const bf16*ksrc=Kh+(long)lane*PQ+wid*8;
  const bf16*vsrc=Vh+(long)(16*(wid&3)+(lane>>2))*PQ+(wid>>2)*32+(lane&3)*8;
  const unsigned kdst=lds0+LDS_K+wid*1024, vdst=lds0+LDS_V+wid*1024;
  #define DMA_K(t,slot) glds16(ksrc+(long)(t)*KVBLK*PQ,(unsigned)__builtin_amdgcn_readfirstlane(kdst+(slot)))
  #define DMA_V(t,slot) glds16(vsrc+(long)(t)*KVBLK*PQ,(unsigned)__builtin_amdgcn_readfirstlane(vdst+(slot)))
  const int vb0=(int)(lds0+LDS_V)+((lane>>4)&1)*32+(lane&3)*8+(4*hi+((lane&15)>>2))*64;
  const char*Kbase=shm+LDS_K; bf16x8 kf[8];
  const lds_cptr shm3=(lds_cptr)shm; const lds_cptr kp0=shm3+LDS_K+hi*1024+r32*16; const lds_cptr vp0=shm3+LDS_V+((lane>>4)&1)*32+(lane&3)*8+(4*hi+((lane&15)>>2))*64;
  const int NT=(q0+QB)/KVBLK;
  DMA_K(0,0);DMA_V(0,0);DMA_K(1,SLOTB);
  bf16x8 qr[4];
  #pragma unroll
  for(int d0=0;d0<4;++d0)qr[d0]=*reinterpret_cast<const bf16x8*>(&Qw[(long)r32*PQ+d0*16+hi*8]);
  float mhat=0.f,l_reg=0.f;f32x16 o[2];o[0]=f32x16{};o[1]=f32x16{};f32x16 negm=f32x16{};asm volatile("":"+v"(negm));
  #define BINIT(C0,C1,t) bandinit(C0,C1,(t),q0,wid,r32,hi,tbh)
  bool resc=false;
  #define START(P0,P1) do{ const float rm=rowmax(P0,P1); resc=false; \
    { const float dl=rm; mhat=fadd_s(mhat,dl); \
      _Pragma("unroll") for(int r=0;r<16;++r){P0[r]=fsub_s(P0[r],dl);P1[r]=fsub_s(P1[r],dl);} \
      _Pragma("unroll") for(int r=0;r<16;++r)negm[r]=-mhat; asm volatile("":"+v"(negm)); } \
    _Pragma("unroll") for(int r=0;r<16;++r)P0[r]=__builtin_amdgcn_exp2f(P0[r]); }while(0)
  #define RESC() do{ if(resc){ asm volatile("s_waitcnt lgkmcnt(0)":::"memory"); \
      _Pragma("unroll") for(int d_=0;d_<2;++d_) _Pragma("unroll") for(int r=0;r<16;++r)o[d_][r]*=wsf[crow(r,hi)]; } }while(0)
  f32x16 pA0,pA1,pB0,pB1;
  int sl_prev=0,sl_cur=0,sl_next=SLOTB;
  #define ROT() do{sl_prev=sl_cur;sl_cur=sl_next;sl_next=(sl_next==(NSLOT-1)*SLOTB)?0:sl_next+SLOTB;}while(0)
  DMA_K(2,2*SLOTB);
  WAIT_BAR(3);
  if(NT<=7){BINIT(pA0,pA1,0);}else{pA0=f32x16{};pA1=f32x16{};}
  qkt(pA0,pA1,Kbase,qr,r32,hi);asm volatile("s_nop 15\n\ts_nop 7":"+v"(pA0),"+v"(pA1));
  START(pA0,pA1);
  _Pragma("unroll") for(int r=0;r<16;++r)pA1[r]=__builtin_amdgcn_exp2f(pA1[r]);
  WAIT_BAR(0);
  DMA_K(3,0);DMA_V(1,SLOTB);
  ROT();
  kload8(kf,kp0+sl_cur);
  WAIT_BAR(2);
  s16x4 vlo[8],vhi[8]; u32x4 pw0,pw1,pw2,pw3;
  #define PKW(P,B) cvtpk_s(P[B],P[B+1])
  #define PAF(k) __builtin_bit_cast(bf16x8,pw##k)
  #define VFR(i) (bf16x8){vlo[i][0],vlo[i][1],vlo[i][2],vlo[i][3],vhi[i][0],vhi[i][1],vhi[i][2],vhi[i][3]}
  #define PIN(x) asm volatile("":"+v"(x))
  #define MX3(a,b,c) __builtin_fmaxf(__builtin_fmaxf((a),(b)),(c))
  #define GAPA(MF,A0,A1,A2,A3,W0,W1,PW) do{ MF; sacc+=A0; sacc+=A1; sacc+=A2; sacc+=A3; PIN(sacc); W0; W1; PIN(PW); SBAR(); }while(0)
  #define EX(v) __builtin_amdgcn_exp2f(v)
  #define GAPB(MF,X,B) do{ MF; X[B]=EX(X[B]); X[B+1]=EX(X[B+1]); X[B+2]=EX(X[B+2]); X[B+3]=EX(X[B+3]); PIN(X); SBAR(); }while(0)
  #define VRD(i) do{ vlo[i]=vtr(vp_+(((i)>>2)*4096+((i)&3)*1024)); vhi[i]=vtr(vp_+(((i)>>2)*4096+((i)&3)*1024+512)); }while(0)
  #define KRD(G,j) do{ if(G){ kload2(kf,kp0+sl_next,j); SBAR(); } }while(0)
  #define STEP(C0,C1,P0,P1,t,GK,GV,GL,PRE,I0,I1,POST) do{ SBAR(); PRE; SBAR(); \
    const lds_cptr vp_=vp0+sl_prev; \
    VRD(0); SBAR(); float sacc=(P0[0]+P0[1]); \
    GAPA(C0=__builtin_amdgcn_mfma_f32_32x32x16_bf16(kf[0],qr[0],I0,0,0,0), P0[2],P0[3],P0[4],P0[5],     pw0[0]=PKW(P0,0), pw0[1]=PKW(P0,2), pw0); \
    VRD(4); SBAR(); GAPA(C1=__builtin_amdgcn_mfma_f32_32x32x16_bf16(kf[1],qr[0],I1,0,0,0), P0[6],P0[7],P0[8],P0[9],     pw0[2]=PKW(P0,4), pw0[3]=PKW(P0,6), pw0); \
    VRD(1); SBAR(); GAPA(C0=__builtin_amdgcn_mfma_f32_32x32x16_bf16(kf[2],qr[1],C0,0,0,0),   P0[10],P0[11],P0[12],P0[13], pw1[0]=PKW(P0,8), pw1[1]=PKW(P0,10), pw1); \
    VRD(5); SBAR(); GAPA(C1=__builtin_amdgcn_mfma_f32_32x32x16_bf16(kf[3],qr[1],C1,0,0,0),   P0[14],P0[15],P1[0],P1[1],   pw1[2]=PKW(P0,12),pw1[3]=PKW(P0,14), pw1); \
    VRD(2); SBAR(); GAPA(C0=__builtin_amdgcn_mfma_f32_32x32x16_bf16(kf[4],qr[2],C0,0,0,0),   P1[2],P1[3],P1[4],P1[5],     pw2[0]=PKW(P1,0), pw2[1]=PKW(P1,2), pw2); \
    VRD(6); SBAR(); GAPA(C1=__builtin_amdgcn_mfma_f32_32x32x16_bf16(kf[5],qr[2],C1,0,0,0),   P1[6],P1[7],P1[8],P1[9],     pw2[2]=PKW(P1,4), pw2[3]=PKW(P1,6), pw2); \
    VRD(3); SBAR(); GAPA(C0=__builtin_amdgcn_mfma_f32_32x32x16_bf16(kf[6],qr[3],C0,0,0,0),   P1[10],P1[11],P1[12],P1[13], pw3[0]=PKW(P1,8), pw3[1]=PKW(P1,10), pw3); \
    VRD(7); SBAR(); GAPA(C1=__builtin_amdgcn_mfma_f32_32x32x16_bf16(kf[7],qr[3],C1,0,0,0),   P1[14],P1[15],0.f,0.f,       pw3[2]=PKW(P1,12),pw3[3]=PKW(P1,14), pw3); \
    l_reg+=sacc; \
    if(GK){DMA_K((t)+3,sl_cur);} if(GV){DMA_V((t)+1,sl_next);} \
    POST; \
    { float a=MX3(C0[0],C0[1],C1[0]),b=MX3(C0[2],C0[3],C1[1]); a=MX3(a,C1[2],C1[3]); \
      _Pragma("unroll") for(int r=4;r<16;r+=4){a=MX3(a,C0[r],C0[r+1]);b=MX3(b,C0[r+2],C0[r+3]);a=MX3(a,C1[r],C1[r+1]);b=MX3(b,C1[r+2],C1[r+3]);} \
      float rm=__builtin_fmaxf(a,b); { auto rr=__builtin_amdgcn_permlane32_swap(__float_as_uint(rm),__float_as_uint(rm),false,false); rm=__builtin_fmaxf(__uint_as_float(rr[0]),__uint_as_float(rr[1])); } \
      resc=false; \
      if(__builtin_expect(__any(rm>(float)THRL),0)){ const float dl=__builtin_fmaxf(rm,0.f); mhat+=dl; \
        _Pragma("unroll") for(int r=0;r<16;++r){C0[r]-=dl;C1[r]-=dl;} \
        _Pragma("unroll") for(int r=0;r<16;++r)negm[r]=-mhat; asm volatile("":"+v"(negm)); \
        const float f=__builtin_amdgcn_exp2f(-dl); l_reg*=f; if(hi==0)wsf[r32]=f; resc=true; } } \
    SBAR(); \
    GAPB(o[0]=__builtin_amdgcn_mfma_f32_32x32x16_bf16(PAF(0),VFR(0),o[0],0,0,0), C0,0); \
    GAPB(o[1]=__builtin_amdgcn_mfma_f32_32x32x16_bf16(PAF(0),VFR(4),o[1],0,0,0), C0,4); \
    KRD(GL,0); GAPB(o[0]=__builtin_amdgcn_mfma_f32_32x32x16_bf16(PAF(1),VFR(1),o[0],0,0,0), C0,8); \
    KRD(GL,1); GAPB(o[1]=__builtin_amdgcn_mfma_f32_32x32x16_bf16(PAF(1),VFR(5),o[1],0,0,0), C0,12); \
    KRD(GL,2); GAPB(o[0]=__builtin_amdgcn_mfma_f32_32x32x16_bf16(PAF(2),VFR(2),o[0],0,0,0), C1,0); \
    KRD(GL,3); GAPB(o[1]=__builtin_amdgcn_mfma_f32_32x32x16_bf16(PAF(2),VFR(6),o[1],0,0,0), C1,4); \
    GAPB(o[0]=__builtin_amdgcn_mfma_f32_32x32x16_bf16(PAF(3),VFR(3),o[0],0,0,0), C1,8); \
    GAPB(o[1]=__builtin_amdgcn_mfma_f32_32x32x16_bf16(PAF(3),VFR(7),o[1],0,0,0), C1,12); \
    }while(0)
  int t=1;
  for(;t+7<NT;t+=2){
    STEP(pB0,pB1,pA0,pA1,t,true,true,true,,negm,negm,);     WAIT_BAR(2); RESC(); ROT();
    STEP(pA0,pA1,pB0,pB1,t+1,true,true,true,,negm,negm,);   WAIT_BAR(2); RESC(); ROT();
  }
  #define ENDW(tt) do{ if((tt)+3<NT){WAIT_BAR(2);} else if((tt)+2<NT){WAIT_BAR(1);} else {WAIT_BAR(0);} }while(0)
  for(;t+1<NT;t+=2){
    STEP(pB0,pB1,pA0,pA1,t,(t+3<NT),(t+1<NT),(t+1<NT),BINIT(pB0,pB1,t),pB0,pB1,bandpost(pB0,pB1,negm,t,q0,wid));           ENDW(t);   RESC(); ROT();
    STEP(pA0,pA1,pB0,pB1,t+1,(t+4<NT),(t+2<NT),(t+2<NT),BINIT(pA0,pA1,t+1),pA0,pA1,bandpost(pA0,pA1,negm,t+1,q0,wid));       ENDW(t+1); RESC(); ROT();
  }
  STEP(pB0,pB1,pA0,pA1,NT-1,false,false,false,BINIT(pB0,pB1,NT-1),pB0,pB1,bandpost(pB0,pB1,negm,NT-1,q0,wid)); RESC();
  { float sacc=pB0[0]+pB0[1]; _Pragma("unroll") for(int r=2;r<16;++r)sacc+=pB0[r]; _Pragma("unroll") for(int r=0;r<16;++r)sacc+=pB1[r]; l_reg+=sacc;
    pw0=(u32x4){PKW(pB0,0),PKW(pB0,2),PKW(pB0,4),PKW(pB0,6)};pw1=(u32x4){PKW(pB0,8),PKW(pB0,10),PKW(pB0,12),PKW(pB0,14)};pw2=(u32x4){PKW(pB1,0),PKW(pB1,2),PKW(pB1,4),PKW(pB1,6)};pw3=(u32x4){PKW(pB1,8),PKW(pB1,10),PKW(pB1,12),PKW(pB1,14)};
    SBAR(); pv(o,vb0+sl_cur,PAF(0),PAF(1),PAF(2),PAF(3)); }
  #undef PKW
  #undef PAF
  #undef VFR
  #undef PIN
  #undef MX3
  #undef GAPA
  #undef GAPB
  #undef EX
  #undef VRD
  #undef KRD
  #undef STEP
  #undef ENDW
  {auto rr=__builtin_amdgcn_permlane32_swap(__float_as_uint(l_reg),__float_as_uint(l_reg),false,false);l_reg=__uint_as_float(rr[0])+__uint_as_float(rr[1]);}
  if(hi==0)wsf[32+r32]=l_reg;asm volatile("s_waitcnt lgkmcnt(0)":::"memory");
  float rli[16];
  #pragma unroll
  for(int r=0;r<16;++r)rli[r]=__builtin_amdgcn_rcpf(wsf[32+crow(r,hi)]);
  bf16*Ow=O+(rowbase+q0+wid*QBLK)*PO+j*128+vh*64;
  { bf16*stg=(bf16*)(shm+LDS_OST)+wid*2048;
    #pragma unroll
    for(int r=0;r<16;++r){const int orow=crow(r,hi);
      #pragma unroll
      for(int d0=0;d0<2;++d0)stg[orow*64+d0*32+r32]=__float2bfloat16(o[d0][r]*rli[r]);}
    asm volatile("s_waitcnt lgkmcnt(0)":::"memory");
    #pragma unroll
    for(int i=0;i<4;++i){const int row=i*8+(lane>>3),ch=lane&7; const u32x4 v=*(const u32x4*)(stg+row*64+ch*8); ATTN_STORE16(Ow+(long)row*PO+ch*8,v);} }
  asm volatile("s_waitcnt lgkmcnt(0)\n\ts_barrier":::"memory");
  #undef DMA_K
  #undef DMA_V
  #undef BINIT
  #undef START
  #undef RESC
  #undef ROT
}
constexpr int ATTN_LDS_BYTES=LDS_BYTES;
#undef SBAR
#undef WAIT_BAR
}

#define XB_TMO      128
#define XB_XCNT(j)  (256  + 64 * (j))
#define XB_XSUB(j)  (1280 + 64 * (j))
#define XB_XGEN(j)  (2304 + 64 * (j))
#define XB_TOP      3328
#define XB_TOPGEN   3392
#define XCD_BAR_WORDS 3456
#define XB_SPIN_CAP (1u << 18)
__device__ __forceinline__ unsigned xb_ld(unsigned* p)              { return __hip_atomic_load(p, __ATOMIC_RELAXED, __HIP_MEMORY_SCOPE_AGENT); }
__device__ __forceinline__ unsigned xb_add(unsigned* p, unsigned v) { return __hip_atomic_fetch_add(p, v, __ATOMIC_RELAXED, __HIP_MEMORY_SCOPE_AGENT); }
__device__ __forceinline__ unsigned xb_xcc_id() { return (unsigned)__builtin_amdgcn_s_getreg((3 << 11) | 20) & 0xFu; }
#define XB_SPIN(cond, bar) do { unsigned _sp = 0; while (cond) { __builtin_amdgcn_s_sleep(1); \
    if ((++_sp & 255u) == 0u) { if (xb_ld(&(bar)[XB_TMO])) break; if (_sp > XB_SPIN_CAP) { atomicAdd(&(bar)[XB_TMO], 1u); break; } } } } while (0)
struct XcdBarrier { unsigned* bar; unsigned x; volatile LAS unsigned* st; };
__device__ __forceinline__ XcdBarrier xcd_barrier_post(unsigned* bar, volatile LAS unsigned* st) {
    XcdBarrier b; b.bar = bar; b.x = xb_xcc_id(); b.st = st;
    if (threadIdx.x == 0) (void)xb_add(&bar[XB_XCNT(b.x)], 1u);
    return b;
}
__device__ __forceinline__ void xcd_barrier_complete(unsigned* bar, unsigned x, unsigned& nloc, unsigned& nx) {
    const unsigned G = gridDim.x * gridDim.y * gridDim.z;
    unsigned sum, cnt, mine, sp = 0u;
    for (;;) {
        sum = 0u; cnt = 0u; mine = 0u;
#pragma unroll
        for (unsigned j = 0; j < 16; ++j) { const unsigned c = xb_ld(&bar[XB_XCNT(j)]); sum += c; cnt += (c > 0u) ? 1u : 0u; mine = (j == x) ? c : mine; }
        if (sum == G) break;
        __builtin_amdgcn_s_sleep(1);
        if ((++sp & 255u) == 0u) { if (xb_ld(&bar[XB_TMO])) break; if (sp > XB_SPIN_CAP) { atomicAdd(&bar[XB_TMO], 1u); break; } }
    }
    nloc = mine > 0u ? mine : 1u; nx = cnt > 0u ? cnt : 1u;
}
__device__ __forceinline__ void xcd_barrier(const XcdBarrier& b) {
    asm volatile("s_waitcnt vmcnt(0)" ::: "memory");
    __syncthreads();
    if (threadIdx.x == 0) {
        unsigned* bar = b.bar;
        __builtin_amdgcn_s_waitcnt(0);
        unsigned nloc = b.st[0], nx = b.st[1];
        if (nloc == 0u) { xcd_barrier_complete(bar, b.x, nloc, nx); b.st[0] = nloc; b.st[1] = nx; }
        const unsigned old = xb_add(&bar[XB_XSUB(b.x)], 1u);
        const unsigned gen = old / nloc;
        if (old + 1u == (gen + 1u) * nloc) {
            __builtin_amdgcn_fence(__ATOMIC_RELEASE, "agent");
            asm volatile("s_waitcnt vmcnt(0)" ::: "memory");
            const unsigned og = xb_add(&bar[XB_TOP], 1u);
            const unsigned tg = og / nx;
            if (og + 1u == (tg + 1u) * nx) xb_add(&bar[XB_TOPGEN], 1u);
            else XB_SPIN(xb_ld(&bar[XB_TOPGEN]) == tg, bar);
            __builtin_amdgcn_fence(__ATOMIC_ACQUIRE, "agent");
            xb_add(&bar[XB_XGEN(b.x)], 1u);
            asm volatile("s_waitcnt vmcnt(0)" ::: "memory");
        } else {
            XB_SPIN(xb_ld(&bar[XB_XGEN(b.x)]) == gen, bar);
            __builtin_amdgcn_fence(__ATOMIC_ACQUIRE, "agent");
            asm volatile("s_waitcnt vmcnt(0)" ::: "memory");
        }
    }
    __syncthreads();
}

struct Frame {
    LAS unsigned char* lds;
    unsigned char* ws;
    gu32* ctl;
    int tid, lane, wave;
    int vcu, G;
};
__device__ __forceinline__ float wave_sum(float v) {
#pragma unroll
    for (int o = 1; o < 64; o <<= 1) v += __shfl_xor(v, o);
    return v;
}
struct TItem { const float* src; bf16* dst; int K, N; };
__device__ __forceinline__ void p0_load(const TItem& t, f32x4 (&v)[8], int lane) {
    const GAS float* sp = (const GAS float*)t.src + (size_t)(lane >> 3) * t.N + 4 * (lane & 7);
#pragma unroll
    for (int i = 0; i < 8; ++i) v[i] = *(const GAS f32x4*)(sp + (size_t)(8 * i) * t.N);
}
__device__ __forceinline__ void p0_store(const TItem& t, const f32x4 (&v)[8], LAS float* scr, int lane) {
    { LAS float* wp = scr + (lane >> 3) * 33 + 4 * (lane & 7);
#pragma unroll
      for (int i = 0; i < 8; ++i) { wp[(8 * i) * 33 + 0] = v[i].x; wp[(8 * i) * 33 + 1] = v[i].y; wp[(8 * i) * 33 + 2] = v[i].z; wp[(8 * i) * 33 + 3] = v[i].w; } }
    LDS_WAIT(); asm volatile("" ::: "memory");
    const int c = lane & 7;
#pragma unroll
    for (int j = 0; j < 4; ++j) { const int n = (lane >> 3) + 8 * j; const LAS float* sr = scr + (8 * c) * 33 + n;
        v4u o; o.x = pk2(sr[0 * 33], sr[1 * 33]); o.y = pk2(sr[2 * 33], sr[3 * 33]); o.z = pk2(sr[4 * 33], sr[5 * 33]); o.w = pk2(sr[6 * 33], sr[7 * 33]);
        *(GAS v4u*)(t.dst + (size_t)n * t.K + 8 * c) = o; }
    LDS_WAIT(); asm volatile("" ::: "memory");
}
__device__ __forceinline__ int t5_bucket(int rel) {
    const int n = rel < 0 ? -rel : rel; int b;
    if (n < 8) b = n; else if (n < 12) b = 8; else if (n < 16) b = 9; else if (n < 23) b = 10; else if (n < 32) b = 11; else if (n < 46) b = 12; else if (n < 64) b = 13; else if (n < 91) b = 14; else b = 15;
    return b + (rel > 0 ? 16 : 0);
}

struct DenseSched {
    const bf16* A; const bf16* Bt; int nM, nN, nwg, G, c;
    __device__ __forceinline__ void init(const bf16* A_, const bf16* Bt_, int M_, int N_, int G_, int c_) { A = A_; Bt = Bt_; nM = M_ / 256; nN = N_ / 256; nwg = nM * nN; G = G_; c = c_; }
    __device__ __forceinline__ bool next(int i, pg8::Unit& u) const {
        const long L = (long)i * G + c; if (L >= nwg) return false;
        int wgid = (int)L; { const int q = nwg / 8, r = nwg % 8, xcd = wgid % 8, off = wgid / 8; wgid = (xcd < r ? xcd * (q + 1) : r * (q + 1) + (xcd - r) * q) + off; }
        const int nig = 8 * nN, gid = wgid / nig, fm = gid * 8, gsz = (nM - fm) < 8 ? (nM - fm) : 8;
        u.pm = fm + ((wgid % nig) % gsz); u.pn = (wgid % nig) / gsz; u.e = 0; u.lrow0 = 0; u.cnt = 0; return true;
    }
    __device__ __forceinline__ const char* a_base(const pg8::Unit& u) const { return (const char*)A + (size_t)u.pm * (256 * 1024 * 2); }
    __device__ __forceinline__ const char* b_base(const pg8::Unit& u) const { return (const char*)Bt + (size_t)u.pn * (256 * 1024 * 2); }
    __device__ __forceinline__ size_t b_hstep() const { return (size_t)128 * 1024 * 2; }
    __device__ __forceinline__ void a_voff(const pg8::Unit&, const int (&R)[2], const int (&C)[2], unsigned (&v0)[2], unsigned (&v1)[2]) const {
#pragma unroll
        for (int i = 0; i < 2; ++i) { v0[i] = (unsigned)(R[i] * 1024 + C[i]) * 2u; v1[i] = v0[i] + 128u * 1024u * 2u; } }
    __device__ __forceinline__ const bf16* a_row(const pg8::Unit& u, int r) const { return A + (size_t)(u.pm * 256 + r) * 1024; }
    __device__ __forceinline__ const bf16* b_row(const pg8::Unit& u, int c_) const { return Bt + (size_t)(u.pn * 256 + c_) * 1024; }
};
struct MoeSched {
    const bf16* A; const bf16* W; const int* rowtok; const LAS int* pexp; const LAS int* pfirst; const LAS int* cntl;
    int NP, NT, G, vcu; bool gather; size_t wexp  , wtile  , whalf;
    __device__ __forceinline__ bool next(int i, pg8::Unit& u) const {
        const int L = i * G + vcu; if (L >= NP * NT) return false;
        const int pi = L / NT; const int e = __builtin_amdgcn_readfirstlane(pexp[pi]);
        u.pm = pi; u.pn = L - pi * NT; u.e = e; u.lrow0 = (pi - __builtin_amdgcn_readfirstlane(pfirst[e])) * 256; u.cnt = __builtin_amdgcn_readfirstlane(cntl[e]); return true;
    }
    __device__ __forceinline__ const char* a_base(const pg8::Unit& u) const { return gather ? (const char*)A : (const char*)A + (size_t)u.pm * (256 * 1024 * 2); }
    __device__ __forceinline__ const char* b_base(const pg8::Unit& u) const { return (const char*)W + (size_t)u.e * wexp + (size_t)u.pn * wtile; }
    __device__ __forceinline__ size_t b_hstep() const { return whalf; }
    __device__ __forceinline__ int tok_of(const pg8::Unit& u, int r) const { const int lr = u.lrow0 + r; return lr < u.cnt ? ((const GAS int*)rowtok)[u.e * ECAP + lr] : 0; }
    __device__ __forceinline__ void a_voff(const pg8::Unit& u, const int (&R)[2], const int (&C)[2], unsigned (&v0)[2], unsigned (&v1)[2]) const {
        if (gather) {
#pragma unroll
            for (int i = 0; i < 2; ++i) { v0[i] = (unsigned)(tok_of(u, R[i]) * 1024 + C[i]) * 2u; v1[i] = (unsigned)(tok_of(u, 128 + R[i]) * 1024 + C[i]) * 2u; }
        } else {
#pragma unroll
            for (int i = 0; i < 2; ++i) { v0[i] = (unsigned)(R[i] * 1024 + C[i]) * 2u; v1[i] = v0[i] + 128u * 1024u * 2u; }
        }
    }
    __device__ __forceinline__ const bf16* a_row(const pg8::Unit& u, int r) const { return gather ? A + (size_t)tok_of(u, r) * 1024 : A + (size_t)(u.pm * 256 + r) * 1024; }
    __device__ __forceinline__ const bf16* b_row(const pg8::Unit& u, int c_) const { return (const bf16*)((const char*)W + (size_t)u.e * wexp + (size_t)u.pn * wtile + (c_ >= 128 ? whalf : 0) + (size_t)(c_ & 127) * 2048); }
};

struct EpiQKVU {
    static constexpr bool PERM = true;
    bf16* O; size_t stride;
    __device__ __forceinline__ void operator()(const pg8::f32x4 (&acc)[2][2][4][2], const pg8::Unit& u, int wr, int wc, int fr, int fq) const {
        const int t = u.pn >> 1; const float sc = t == 0 ? QSCALE : 1.f;
        bf16* base = O + (size_t)t * stride; const int col0 = (u.pn & 1) * 256 + wc * 32 + 8 * fq; const int row0 = u.pm * 256 + wr * 64 + fr;
#pragma unroll
        for (int ai = 0; ai < 2; ++ai)
#pragma unroll
            for (int m = 0; m < 4; ++m) { bf16* rowp = base + (size_t)(row0 + ai * 128 + m * 16) * 512 + col0;
#pragma unroll
                for (int bj = 0; bj < 2; ++bj) { const pg8::f32x4 v0 = acc[ai][bj][m][0] * sc, v1 = acc[ai][bj][m][1] * sc;
                    pg8::u32x4 w; w.x = pg8::cvt_pk_bf16(v0[0], v0[1]); w.y = pg8::cvt_pk_bf16(v0[2], v0[3]); w.z = pg8::cvt_pk_bf16(v1[0], v1[1]); w.w = pg8::cvt_pk_bf16(v1[2], v1[3]);
                    *(pg8::u32x4*)(rowp + bj * 128) = w; } }
    }
};
struct EpiT1 {
    static constexpr bool PERM = false;
    const float* x; const float* mod; float* T1;
    __device__ __forceinline__ void operator()(const pg8::f32x4 (&acc)[2][2][4][2], const pg8::Unit& u, int wr, int wc, int fr, int fq) const {
        const int b = u.pm >> 3; const float* g1 = mod + (size_t)b * 6144 + 2048;
        const int col0 = u.pn * 256 + wc * 32 + 4 * fq;
        pg8::f32x4 gv[2][2];
#pragma unroll
        for (int bj = 0; bj < 2; ++bj)
#pragma unroll
            for (int n = 0; n < 2; ++n) gv[bj][n] = *(const pg8::f32x4*)(g1 + col0 + bj * 128 + n * 16);
#pragma unroll
        for (int ai = 0; ai < 2; ++ai)
#pragma unroll
            for (int m = 0; m < 4; ++m) { const size_t off = (size_t)(u.pm * 256 + ai * 128 + wr * 64 + m * 16 + fr) * 1024 + col0;
#pragma unroll
                for (int bj = 0; bj < 2; ++bj)
#pragma unroll
                    for (int n = 0; n < 2; ++n) { const pg8::f32x4 xv = *(const pg8::f32x4*)(x + off + bj * 128 + n * 16);
                        *(pg8::f32x4*)(T1 + off + bj * 128 + n * 16) = xv * DN_ALPHA + gv[bj][n] * acc[ai][bj][m][n]; } }
    }
};
struct EpiSwiglu {
    static constexpr bool PERM = true;
    const float* bgu; bf16* H;
    __device__ __forceinline__ void operator()(const pg8::f32x4 (&acc)[2][2][4][2], const pg8::Unit& u, int wr, int wc, int fr, int fq) const {
        const int c0 = u.pn * 128 + wc * 32 + 8 * fq; const float* bg = bgu + (size_t)u.e * 2048 + c0;
        pg8::f32x4 bgv[2], buv[2];
#pragma unroll
        for (int n = 0; n < 2; ++n) { bgv[n] = *(const pg8::f32x4*)(bg + 4 * n); buv[n] = *(const pg8::f32x4*)(bg + 1024 + 4 * n); }
#pragma unroll
        for (int ai = 0; ai < 2; ++ai)
#pragma unroll
            for (int m = 0; m < 4; ++m) { float r[8];
#pragma unroll
                for (int n = 0; n < 2; ++n)
#pragma unroll
                    for (int x = 0; x < 4; ++x) { const float g = fminf(acc[ai][0][m][n][x] + bgv[n][x], 7.0f); const float up = fminf(fmaxf(acc[ai][1][m][n][x] + buv[n][x], -7.0f), 7.0f);
                        const float sg = __builtin_amdgcn_rcpf(1.0f + __builtin_amdgcn_exp2f(-1.702f * LOG2E * g)); r[4 * n + x] = (up + 1.0f) * (g * sg); }
                pg8::u32x4 w; w.x = pg8::cvt_pk_bf16(r[0], r[1]); w.y = pg8::cvt_pk_bf16(r[2], r[3]); w.z = pg8::cvt_pk_bf16(r[4], r[5]); w.w = pg8::cvt_pk_bf16(r[6], r[7]);
                *(pg8::u32x4*)(H + (size_t)(u.pm * 256 + ai * 128 + wr * 64 + m * 16 + fr) * 1024 + c0) = w; }
    }
};
struct EpiDown {
    static constexpr bool PERM = true;
    const float* bd; bf16* Y;
    __device__ __forceinline__ void operator()(const pg8::f32x4 (&acc)[2][2][4][2], const pg8::Unit& u, int wr, int wc, int fr, int fq) const {
        const int c0 = u.pn * 256 + wc * 32 + 8 * fq; const float* bp = bd + (size_t)u.e * 1024 + c0;
        pg8::f32x4 bv[2][2];
#pragma unroll
        for (int bj = 0; bj < 2; ++bj)
#pragma unroll
            for (int n = 0; n < 2; ++n) bv[bj][n] = *(const pg8::f32x4*)(bp + bj * 128 + 4 * n);
#pragma unroll
        for (int ai = 0; ai < 2; ++ai)
#pragma unroll
            for (int m = 0; m < 4; ++m) { bf16* rowp = Y + (size_t)(u.pm * 256 + ai * 128 + wr * 64 + m * 16 + fr) * 1024 + c0;
#pragma unroll
                for (int bj = 0; bj < 2; ++bj) { const pg8::f32x4 v0 = acc[ai][bj][m][0] + bv[bj][0], v1 = acc[ai][bj][m][1] + bv[bj][1];
                    pg8::u32x4 w; w.x = pg8::cvt_pk_bf16(v0[0], v0[1]); w.y = pg8::cvt_pk_bf16(v0[2], v0[3]); w.z = pg8::cvt_pk_bf16(v1[0], v1[1]); w.w = pg8::cvt_pk_bf16(v1[2], v1[3]);
                    *(pg8::u32x4*)(rowp + bj * 128) = w; } }
    }
};

__device__ __forceinline__ void build_expert_tables(Frame& F) {
    LAS int* cntl = (LAS int*)(F.lds + L_CNT); LAS int* pfirst = (LAS int*)(F.lds + L_PFIRST); LAS int* pexp = (LAS int*)(F.lds + L_PEXP);
    __syncthreads();
    if (F.tid < NE) { int c = (int)__hip_atomic_load(F.ctl + CW_CNT + 64 * F.tid, RLX_AGENT); c = c < 0 ? 0 : (c > ECAP ? ECAP : c); cntl[F.tid] = c; }
    __syncthreads();
    if (F.tid == 0) { int p = 0; for (int e = 0; e < NE; ++e) { pfirst[e] = p; const int np = (cntl[e] + 255) >> 8; for (int k = 0; k < np; ++k) if (p + k < PMAX) pexp[p + k] = e; p += np; if (p > PMAX) p = PMAX; } pfirst[NE] = p; }
    __syncthreads();
}

struct Args { const float* in[25]; float* out; unsigned char* ws; int ph_lo, ph_hi; };
constexpr int NPHASE = 10;

__global__ void __launch_bounds__(NWAVES * 64, 2) mk_fwd(Args args) {
    extern __shared__ __attribute__((aligned(16))) unsigned char lds[];
    Frame F;
    F.lds = (LAS unsigned char*)lds; F.ws = args.ws; F.ctl = (gu32*)(args.ws + WS_CTL);
    F.tid = threadIdx.x; F.lane = F.tid & 63; F.wave = __builtin_amdgcn_readfirstlane(F.tid >> 6);
    F.G = gridDim.x; { const int bx = blockIdx.x; F.vcu = (F.G % 8 == 0) ? (bx % 8) * (F.G / 8) + bx / 8 : bx; }
    volatile LAS unsigned* MISC = (volatile LAS unsigned*)(F.lds + L_MISC);
    for (int u = F.tid; u < (LDS_BYTES - LCTL_OFF) / 4; u += NWAVES * 64) ((LAS unsigned*)(F.lds + LCTL_OFF))[u] = 0u;
    __syncthreads();
    XcdBarrier bar; bar.bar = (unsigned*)(F.ctl + CW_BAR); bar.x = 0; bar.st = nullptr;
#if MK_ONE_LAUNCH
    bar = xcd_barrier_post((unsigned*)(F.ctl + CW_BAR), MISC + 8);
#define GRID_BAR() xcd_barrier(bar)
#else
#define GRID_BAR() do { } while (0)
#endif
    const int lo = args.ph_lo, hi = args.ph_hi;
#ifndef PH_MASK
#define PH_MASK 0x3ff
#endif
#ifndef REP_MASK
#define REP_MASK 0x0
#endif
#define REPS(k) (1 + ((REP_MASK >> (k)) & 1))
#define IN(k) (((PH_MASK >> (k)) & 1) && lo <= (k) && (k) < hi)
#define BOTH(k) (IN(k) && IN((k) + 1))
    const float* x = args.in[0]; const float* cvec = args.in[1]; const float* w_ada = args.in[2]; const float* b_ada = args.in[3]; const float* w_in = args.in[4];
    const float* lq1 = args.in[5]; const float* lk1 = args.in[6]; const float* lq2 = args.in[7]; const float* lk2 = args.in[8]; const float* subln_g = args.in[9];
    const float* rel_bias = args.in[10]; const float* w_pool = args.in[11]; const float* b_pool = args.in[12]; const float* pool_scale = args.in[13]; const float* w_out = args.in[14];
    const float* ln1_g = args.in[15]; const float* ln1_b = args.in[16]; const float* w_router = args.in[17]; const float* b_router = args.in[18];
    const float* w_gu = args.in[19]; const float* b_gu = args.in[20]; const float* w_dn = args.in[21]; const float* b_dn = args.in[22]; const float* ln2_g = args.in[23]; const float* ln2_b = args.in[24];
    float* out = args.out; unsigned char* ws = args.ws;
    float* MOD = (float*)(ws + WS_MOD); bf16* WPOOL = (bf16*)(ws + WS_WPOOL); bf16* WIN = (bf16*)(ws + WS_WIN); bf16* WOUT = (bf16*)(ws + WS_WOUT);
    bf16* WGU = (bf16*)(ws + WS_WGU); bf16* WD = (bf16*)(ws + WS_WD); bf16* XN = (bf16*)(ws + WS_XN);
    bf16* QB = (bf16*)(ws + WS_Q); bf16* KB = (bf16*)(ws + WS_K); bf16* VB = (bf16*)(ws + WS_V); bf16* UB = (bf16*)(ws + WS_U);
    bf16* OA = (bf16*)(ws + WS_OA); bf16* MIX = (bf16*)(ws + WS_MIX); float* T1 = (float*)(ws + WS_T1); float* X1 = (float*)(ws + WS_X1); bf16* XN2 = (bf16*)(ws + WS_XN2);
    int* RE = (int*)(ws + WS_RE); int* RP = (int*)(ws + WS_RP); float* RG = (float*)(ws + WS_RG); int* ROWTOK = (int*)(ws + WS_ROWTOK);
    bf16* HB = (bf16*)(ws + WS_H); bf16* YB = (bf16*)(ws + WS_Y);
    const int gw = F.vcu * NWAVES + F.wave, NGW = F.G * NWAVES;

    if (IN(0)) _Pragma("unroll") for (int rep_ = 0; rep_ < REPS(0); ++rep_) {
        LAS float* scr = (LAS float*)(F.lds + F.wave * 8448);
        LAS float* sil = (LAS float*)(F.lds + 8 * 8448);
        for (int i = F.tid; i < NB * D; i += NWAVES * 64) { const float v = cvec[i]; sil[i] = v / (1.0f + __expf(-v)); }
        __syncthreads();
        constexpr int I_MOD = 6144 / 16, I_IN = (D / 64) * (NIN / 32), I_OUT = (D / 64) * (D / 32), I_POOL = 4 * 2 * 4, I_GU1 = (D / 64) * (2048 / 32), I_D1 = (FF / 64) * (D / 32);
        constexpr int NTR = I_IN + I_OUT + I_POOL + NE * I_GU1 + NE * I_D1;
        for (int r = gw; r < I_MOD; r += NGW) {
            const int kq = F.lane >> 4, col = r * 16 + (F.lane & 15); float a[NB];
#pragma unroll
            for (int b = 0; b < NB; ++b) a[b] = 0.f;
#pragma unroll 16
            for (int k = kq; k < D; k += 4) { const float w = ((const GAS float*)w_ada)[(size_t)k * 6144 + col];
#pragma unroll
                for (int b = 0; b < NB; ++b) a[b] += sil[b * D + k] * w; }
#pragma unroll
            for (int b = 0; b < NB; ++b) { a[b] += __shfl_xor(a[b], 16); a[b] += __shfl_xor(a[b], 32); }
            if (kq == 0) { const float bb = b_ada[col];
#pragma unroll
                for (int b = 0; b < NB; ++b) MOD[(size_t)b * 6144 + col] = a[b] + bb; }
        }
        auto decode = [&](int r) -> TItem {
            const float* W; bf16* WT; int K, N, item;
            if (r < I_IN) { W = w_in; WT = WIN; K = D; N = NIN; item = r; }
            else if ((r -= I_IN) < I_OUT) { W = w_out; WT = WOUT; K = D; N = D; item = r; }
            else if ((r -= I_OUT) < I_POOL) { const int g = r >> 3; W = w_pool + (size_t)g * 128 * 128; WT = WPOOL + (size_t)g * 128 * 128; K = 128; N = 128; item = r & 7; }
            else if ((r -= I_POOL) < NE * I_GU1) { const int e = r / I_GU1; W = w_gu + (size_t)e * D * 2048; WT = WGU + (size_t)e * 2048 * D; K = D; N = 2048; item = r - e * I_GU1; }
            else { r -= NE * I_GU1; const int e = r / I_D1; W = w_dn + (size_t)e * FF * D; WT = WD + (size_t)e * D * FF; K = FF; N = D; item = r - e * I_D1; }
            const int nblk = N / 32, kb = item / nblk, nb = item - kb * nblk;
            TItem t; t.src = W + (size_t)(64 * kb) * N + 32 * nb; t.dst = WT + (size_t)(32 * nb) * K + 64 * kb; t.K = K; t.N = N; return t;
        };
        if (gw < NTR) {
            TItem cur = decode(gw); f32x4 vc[8], vn[8]; p0_load(cur, vc, F.lane);
            for (int it = gw; it < NTR; it += NGW) {
                const bool more = it + NGW < NTR; TItem nx = cur;
                if (more) { nx = decode(it + NGW); p0_load(nx, vn, F.lane); }
                p0_store(cur, vc, scr, F.lane);
                cur = nx;
#pragma unroll
                for (int i = 0; i < 8; ++i) vc[i] = vn[i];
            }
        }
        if (BOTH(0) || rep_ + 1 < REPS(0)) GRID_BAR();
    }
    if (IN(1)) _Pragma("unroll") for (int rep_ = 0; rep_ < REPS(1); ++rep_) {
        for (int m = gw; m < M; m += NGW) {
            const int b = m >> 11; const float* sh = MOD + (size_t)b * 6144; const float* sc = sh + 1024;
            const GAS f32x4* xr = (const GAS f32x4*)(x + (size_t)m * D) + F.lane;
            f32x4 v[4]; float s = 0.f;
#pragma unroll
            for (int j = 0; j < 4; ++j) { v[j] = xr[64 * j]; s += (v[j].x + v[j].y) + (v[j].z + v[j].w); }
            const float mean = wave_sum(s) * (1.f / D); float s2 = 0.f;
#pragma unroll
            for (int j = 0; j < 4; ++j) { v[j] = v[j] - mean; s2 += (v[j].x * v[j].x + v[j].y * v[j].y) + (v[j].z * v[j].z + v[j].w * v[j].w); }
            const float rstd = 1.f / sqrtf(wave_sum(s2) * (1.f / D) + LN_EPS);
            GAS v2u* o8 = (GAS v2u*)(XN + (size_t)m * D) + F.lane;
#pragma unroll
            for (int j = 0; j < 4; ++j) { const f32x4 sv = *(const f32x4*)(sc + 4 * F.lane + 256 * j), hv = *(const f32x4*)(sh + 4 * F.lane + 256 * j);
                const f32x4 h = (v[j] * rstd) * (sv + 1.0f) + hv; v2u w; w.x = pk2(h.x, h.y); w.y = pk2(h.z, h.w); o8[64 * j] = w; }
        }
        if (BOTH(1) || rep_ + 1 < REPS(1)) GRID_BAR();
    }
    if (IN(2)) _Pragma("unroll") for (int rep_ = 0; rep_ < REPS(2); ++rep_) {
        DenseSched S; S.init(XN, WIN, M, NIN, F.G, (int)blockIdx.x);
        EpiQKVU E{QB, (size_t)(WS_K - WS_Q) / 2};
        pg8::gemm_phase<EpiQKVU, DenseSched, true>(F.lds, S, E);
        if (BOTH(2) || rep_ + 1 < REPS(2)) GRID_BAR();
    }
    if (IN(3)) _Pragma("unroll") for (int rep_ = 0; rep_ < REPS(3); ++rep_) {
        LAS float* tb = (LAS float*)(F.lds + L_TB);
        for (int i = F.tid; i < 4 * attn_body::TBN; i += NWAVES * 64) { const int h = i / attn_body::TBN, idx = i % attn_body::TBN; const int d = idx - attn_body::TBOFF;
            tb[i] = (d <= 63) ? (rel_bias[t5_bucket(d) * 4 + h] - rel_bias[15 * 4 + h]) * LOG2E : 0.f; }
        __syncthreads();
#if !NAIVE_ATTN
        for (int vv = F.vcu; vv < 256; vv += F.G) {
            const int bjm = vv >> 2, s = vv & 3, b = bjm >> 3, j = bjm & 7;
#pragma unroll 1
            for (int i = 0; i < 4; ++i) { const int vh = i >> 1, qb = (i & 1) ? 7 - s : s;
                attn_body::attn_unit<8>(b, j, vh, qb, (const attn_body::bf16*)QB, (const attn_body::bf16*)KB, (const attn_body::bf16*)VB, (attn_body::bf16*)OA, (char*)lds, tb + (j >> 1) * attn_body::TBN); }
        }
#else
        for (int idx = blockIdx.x * 512 + F.tid; idx < NB * 8 * 2 * SEQ; idx += F.G * 512) {
            const int q = idx & 2047, vh = (idx >> 11) & 1, j = (idx >> 12) & 7, b = idx >> 15, h = j >> 1;
            const bf16* qp = QB + (size_t)(b * SEQ + q) * 512 + j * 64; float qv[64];
#pragma unroll
            for (int d = 0; d < 64; ++d) qv[d] = pg8::bf2f(qp[d]);
            float o[64];
#pragma unroll
            for (int d = 0; d < 64; ++d) o[d] = 0.f;
            float mx = -INFINITY, l = 0.f; const int kend = ((q >> 6) + 1) << 6;
            for (int k = 0; k < kend; ++k) {
                const bf16* kp = KB + (size_t)(b * SEQ + k) * 512 + j * 64; float sdot = 0.f;
#pragma unroll
                for (int d = 0; d < 64; ++d) sdot += qv[d] * pg8::bf2f(kp[d]);
                const int dd = k - q; const int ti = dd + attn_body::TBOFF < 0 ? 0 : dd + attn_body::TBOFF; sdot += tb[h * attn_body::TBN + ti];
                const float mn = fmaxf(mx, sdot), f = exp2f(mx - mn), p = exp2f(sdot - mn); l = l * f + p; mx = mn;
                const bf16* vp = VB + (size_t)(b * SEQ + k) * 512 + h * 128 + vh * 64;
#pragma unroll
                for (int d = 0; d < 64; ++d) o[d] = o[d] * f + p * pg8::bf2f(vp[d]);
            }
            bf16* op = OA + (size_t)(b * SEQ + q) * 1024 + j * 128 + vh * 64; const float il = 1.0f / l;
#pragma unroll
            for (int d = 0; d < 64; ++d) op[d] = (bf16)f2bf(o[d] * il);
        }
#endif
        if (BOTH(3) || rep_ + 1 < REPS(3)) GRID_BAR();
    }
    if (IN(4)) _Pragma("unroll") for (int rep_ = 0; rep_ < REPS(4); ++rep_) {
        float lam;
        { const float a = lq1[F.lane] * lk1[F.lane], b2 = lq2[F.lane] * lk2[F.lane]; lam = __expf(wave_sum(a)) - __expf(wave_sum(b2)) + LAM_INIT; }
        for (int m0 = gw; m0 < M; m0 += 2 * NGW) {
            const int h = F.lane >> 4, e0 = (F.lane & 15) * 8; const bool two = m0 + NGW < M;
            v4u a[2], b2[2];
#pragma unroll
            for (int q = 0; q < 2; ++q) if (q == 0 || two) { const size_t m = (size_t)m0 + (size_t)q * NGW;
                a[q] = *(const GAS v4u*)(OA + m * 1024 + h * 256 + e0); b2[q] = *(const GAS v4u*)(OA + m * 1024 + h * 256 + 128 + e0); }
            const f32x4 g0 = *(const f32x4*)(subln_g + e0), g1v = *(const f32x4*)(subln_g + e0 + 4);
#pragma unroll
            for (int q = 0; q < 2; ++q) if (q == 0 || two) { const size_t m = (size_t)m0 + (size_t)q * NGW;
                float o[8];
                o[0] = bfl(a[q].x) - lam * bfl(b2[q].x); o[1] = bfh(a[q].x) - lam * bfh(b2[q].x); o[2] = bfl(a[q].y) - lam * bfl(b2[q].y); o[3] = bfh(a[q].y) - lam * bfh(b2[q].y);
                o[4] = bfl(a[q].z) - lam * bfl(b2[q].z); o[5] = bfh(a[q].z) - lam * bfh(b2[q].z); o[6] = bfl(a[q].w) - lam * bfl(b2[q].w); o[7] = bfh(a[q].w) - lam * bfh(b2[q].w);
                float ss = 0.f;
#pragma unroll
                for (int i = 0; i < 8; ++i) ss += o[i] * o[i];
                ss += __shfl_xor(ss, 1); ss += __shfl_xor(ss, 2); ss += __shfl_xor(ss, 4); ss += __shfl_xor(ss, 8);
                const float rs = (1.0f - LAM_INIT) / sqrtf(ss * (1.0f / 128.0f) + LN_EPS);
                v4u w; w.x = pk2(o[0] * rs * g0.x, o[1] * rs * g0.y); w.y = pk2(o[2] * rs * g0.z, o[3] * rs * g0.w); w.z = pk2(o[4] * rs * g1v.x, o[5] * rs * g1v.y); w.w = pk2(o[6] * rs * g1v.z, o[7] * rs * g1v.w);
                *(GAS v4u*)(MIX + m * 1024 + h * 128 + e0) = w; }
        }
        for (int it = gw; it < (M / 32) * 4; it += NGW) {
            const int g = it & 3, tile = it >> 2, row0 = tile * 32, r32 = F.lane & 31, hi = F.lane >> 5;
            const int row = row0 + r32, tpos = row & (SEQ - 1), tp0 = row0 & (SEQ - 1);
            LAS unsigned char* ut = F.lds + F.wave * 12800;
#pragma unroll
            for (int i = 0; i < 12; ++i) { const int pc = F.lane + 64 * i, rr = pc >> 4, c16 = pc & 15;
                if (rr < 47) { v4u v = (v4u){0u, 0u, 0u, 0u}; if (tp0 - 15 + rr >= 0) v = *(const GAS v4u*)(UB + (size_t)(row0 - 15 + rr) * 512 + g * 128 + c16 * 8); *(LAS v4u*)(ut + rr * 272 + c16 * 16) = v; } }
            LDS_WAIT(); asm volatile("" ::: "memory");
            bf16x8 pf[8];
            const LAS unsigned char* ub = ut + (r32 + 15) * 272 + hi * 16;
            auto pooled = [&](auto WIN_) {
                constexpr int WIN = decltype(WIN_)::value;
                const int nwin = tpos + 1 < WIN ? tpos + 1 : WIN; const float inv = 1.0f / (float)nwin;
#pragma unroll
                for (int s8 = 0; s8 < 8; ++s8) {
                    float sum[8];
#pragma unroll
                    for (int i = 0; i < 8; ++i) sum[i] = 0.f;
                    v4u self;
#pragma unroll
                    for (int k = 0; k < WIN; ++k) { const v4u u4 = *(const LAS v4u*)(ub - k * 272 + s8 * 32); if (k == 0) self = u4;
                        sum[0] += bfl(u4.x); sum[1] += bfh(u4.x); sum[2] += bfl(u4.y); sum[3] += bfh(u4.y); sum[4] += bfl(u4.z); sum[5] += bfh(u4.z); sum[6] += bfl(u4.w); sum[7] += bfh(u4.w); }
                    v4u w; w.x = pk2(sum[0] * inv - bfl(self.x), sum[1] * inv - bfh(self.x)); w.y = pk2(sum[2] * inv - bfl(self.y), sum[3] * inv - bfh(self.y));
                    w.z = pk2(sum[4] * inv - bfl(self.z), sum[5] * inv - bfh(self.z)); w.w = pk2(sum[6] * inv - bfl(self.w), sum[7] * inv - bfh(self.w));
                    pf[s8] = __builtin_bit_cast(bf16x8, w);
                }
            };
            if (g == 0) pooled(std::integral_constant<int, 2>{}); else if (g == 1) pooled(std::integral_constant<int, 4>{}); else if (g == 2) pooled(std::integral_constant<int, 8>{}); else pooled(std::integral_constant<int, 16>{});
            LDS_WAIT(); asm volatile("" ::: "memory");
#pragma unroll
            for (int db = 0; db < 4; ++db) {
                f32x16 acc = f32x16{};
                const bf16* wp = WPOOL + (size_t)g * 128 * 128 + (size_t)(db * 32 + r32) * 128 + hi * 8;
#pragma unroll
                for (int s8 = 0; s8 < 8; ++s8) { const bf16x8 wf = __builtin_bit_cast(bf16x8, *(const GAS v4u*)(wp + s8 * 16)); acc = __builtin_amdgcn_mfma_f32_32x32x16_bf16(wf, pf[s8], acc, 0, 0, 0); }
#pragma unroll
                for (int rq = 0; rq < 4; ++rq) { const int d0 = db * 32 + 8 * rq + 4 * hi; const int cg = g * 128 + d0;
                    const f32x4 bp = *(const f32x4*)(b_pool + cg), ps = *(const f32x4*)(pool_scale + cg);
                    v2u w; w.x = pk2((acc[4 * rq + 0] + bp.x) * ps.x, (acc[4 * rq + 1] + bp.y) * ps.y); w.y = pk2((acc[4 * rq + 2] + bp.z) * ps.z, (acc[4 * rq + 3] + bp.w) * ps.w);
                    *(GAS v2u*)(MIX + (size_t)row * 1024 + 512 + cg) = w; }
            }
        }
        if (BOTH(4) || rep_ + 1 < REPS(4)) GRID_BAR();
    }
    if (IN(5)) _Pragma("unroll") for (int rep_ = 0; rep_ < REPS(5); ++rep_) {
        DenseSched S; S.init(MIX, WOUT, M, D, F.G, (int)blockIdx.x);
        EpiT1 E{x, MOD, T1};
        pg8::gemm_phase<EpiT1, DenseSched, true>(F.lds, S, E);
        if (BOTH(5) || rep_ + 1 < REPS(5)) GRID_BAR();
    }
    if (IN(6)) _Pragma("unroll") for (int rep_ = 0; rep_ < REPS(6); ++rep_) {
        LAS float* H2 = (LAS float*)F.lds;
        LAS float* PART = (LAS float*)F.lds;
        LAS float* LOG = (LAS float*)(F.lds + 131200);
        LAS unsigned* hist = (LAS unsigned*)(F.lds + L_HIST); LAS unsigned* hbase = hist + 32;
        for (int tile = F.vcu; tile < M / 32; tile += F.G) {
            if (F.tid < 32) hist[F.tid] = 0u;
#pragma unroll 1
            for (int rr = 0; rr < 4; ++rr) {
                const int lr = F.wave * 4 + rr, m = tile * 32 + lr, b = m >> 11;
                const GAS f32x4* tr = (const GAS f32x4*)(T1 + (size_t)m * D) + F.lane;
                f32x4 v[4]; float s = 0.f;
#pragma unroll
                for (int j = 0; j < 4; ++j) { v[j] = tr[64 * j]; s += (v[j].x + v[j].y) + (v[j].z + v[j].w); }
                float mean = wave_sum(s) * (1.f / D); float s2 = 0.f;
#pragma unroll
                for (int j = 0; j < 4; ++j) { v[j] = v[j] - mean; s2 += (v[j].x * v[j].x + v[j].y * v[j].y) + (v[j].z * v[j].z + v[j].w * v[j].w); }
                float rstd = 1.f / sqrtf(wave_sum(s2) * (1.f / D) + LN_EPS);
                s = 0.f;
#pragma unroll
                for (int j = 0; j < 4; ++j) { const f32x4 gv = *(const f32x4*)(ln1_g + 4 * F.lane + 256 * j), bv = *(const f32x4*)(ln1_b + 4 * F.lane + 256 * j);
                    v[j] = (v[j] * rstd) * gv + bv; ((GAS f32x4*)(X1 + (size_t)m * D) + F.lane)[64 * j] = v[j]; s += (v[j].x + v[j].y) + (v[j].z + v[j].w); }
                mean = wave_sum(s) * (1.f / D); s2 = 0.f;
#pragma unroll
                for (int j = 0; j < 4; ++j) { v[j] = v[j] - mean; s2 += (v[j].x * v[j].x + v[j].y * v[j].y) + (v[j].z * v[j].z + v[j].w * v[j].w); }
                rstd = 1.f / sqrtf(wave_sum(s2) * (1.f / D) + LN_EPS);
                const float* sh = MOD + (size_t)b * 6144 + 3072; const float* sc = sh + 1024;
                GAS v2u* o8 = (GAS v2u*)(XN2 + (size_t)m * D) + F.lane;
#pragma unroll
                for (int j = 0; j < 4; ++j) { const f32x4 sv = *(const f32x4*)(sc + 4 * F.lane + 256 * j), hv = *(const f32x4*)(sh + 4 * F.lane + 256 * j);
                    const f32x4 h = (v[j] * rstd) * (sv + 1.0f) + hv; v2u w; w.x = pk2(h.x, h.y); w.y = pk2(h.z, h.w); o8[64 * j] = w;
                    LAS float* hp = H2 + lr * 1025 + 4 * F.lane + 256 * j; hp[0] = h.x; hp[1] = h.y; hp[2] = h.z; hp[3] = h.w; }
            }
            __syncthreads();
            f32x16 acc = f32x16{};
            { const int i = F.lane & 31, kh = F.lane >> 5, kb = F.wave * 128;
#pragma unroll 8
              for (int kk = 0; kk < 64; ++kk) { const int k = kb + 2 * kk + kh; acc = __builtin_amdgcn_mfma_f32_32x32x2f32(H2[i * 1025 + k], w_router[(size_t)k * NE + i], acc, 0, 0, 0); } }
            __syncthreads();
#pragma unroll
            for (int r = 0; r < 16; ++r) PART[(F.wave * 32 + ((r & 3) + 8 * (r >> 2) + 4 * (F.lane >> 5))) * 32 + (F.lane & 31)] = acc[r];
            __syncthreads();
#pragma unroll
            for (int q = 0; q < 2; ++q) { const int idx = F.tid + 512 * q, i = idx >> 5, e = idx & 31; float sl = b_router[e];
#pragma unroll
                for (int w = 0; w < 8; ++w) sl += PART[(w * 32 + i) * 32 + e];
                LOG[i * 33 + e] = sl; }
            __syncthreads();
            int li[4]; float lv[4]; unsigned lrk[4];
            if (F.tid < 32) {
                unsigned used = 0u;
#pragma unroll
                for (int k = 0; k < 4; ++k) { float best = -INFINITY; int bi = 0;
                    for (int e = 0; e < NE; ++e) { const float vv = LOG[F.tid * 33 + e]; if (!((used >> e) & 1u) && vv > best) { best = vv; bi = e; } }
                    used |= 1u << bi; lv[k] = best; li[k] = bi; }
                float ssum = 0.f; const float lmx = lv[0];
#pragma unroll
                for (int k = 0; k < 4; ++k) { lv[k] = __expf(lv[k] - lmx); ssum += lv[k]; }
#pragma unroll
                for (int k = 0; k < 4; ++k) lrk[k] = __hip_atomic_fetch_add(hist + li[k], 1u, __ATOMIC_RELAXED, __HIP_MEMORY_SCOPE_WORKGROUP);
                const float is = 1.0f / ssum;
#pragma unroll
                for (int k = 0; k < 4; ++k) lv[k] *= is;
            }
            __syncthreads();
            if (F.tid < 32) { const unsigned n = hist[F.tid]; hbase[F.tid] = n ? __hip_atomic_fetch_add(F.ctl + CW_CNT + 64 * F.tid, n, RLX_AGENT) : 0u; }
            __syncthreads();
            if (F.tid < 32) { const int m = tile * 32 + F.tid;
#pragma unroll
                for (int k = 0; k < 4; ++k) { const int p = (int)(hbase[li[k]] + lrk[k]); RE[m * 4 + k] = li[k]; RP[m * 4 + k] = p; RG[m * 4 + k] = lv[k]; if (p < ECAP) ROWTOK[li[k] * ECAP + p] = m; } }
            __syncthreads();
        }
        if (BOTH(6) || rep_ + 1 < REPS(6)) GRID_BAR();
    }
    if (IN(7)) _Pragma("unroll") for (int rep_ = 0; rep_ < REPS(7); ++rep_) {
        build_expert_tables(F);
        MoeSched S; S.A = XN2; S.W = WGU; S.rowtok = ROWTOK; S.pexp = (const LAS int*)(F.lds + L_PEXP); S.pfirst = (const LAS int*)(F.lds + L_PFIRST); S.cntl = (const LAS int*)(F.lds + L_CNT);
        S.NP = ((const LAS int*)(F.lds + L_PFIRST))[NE]; S.NT = 8; S.G = F.G; S.vcu = F.vcu; S.gather = true; S.wexp = (size_t)2048 * 1024 * 2; S.wtile = (size_t)128 * 1024 * 2; S.whalf = (size_t)1024 * 1024 * 2;
        EpiSwiglu E{b_gu, HB};
        pg8::gemm_phase<EpiSwiglu, MoeSched, true>(F.lds, S, E);
        if (BOTH(7) || rep_ + 1 < REPS(7)) GRID_BAR();
    }
    if (IN(8)) _Pragma("unroll") for (int rep_ = 0; rep_ < REPS(8); ++rep_) {
        build_expert_tables(F);
        MoeSched S; S.A = HB; S.W = WD; S.rowtok = ROWTOK; S.pexp = (const LAS int*)(F.lds + L_PEXP); S.pfirst = (const LAS int*)(F.lds + L_PFIRST); S.cntl = (const LAS int*)(F.lds + L_CNT);
        S.NP = ((const LAS int*)(F.lds + L_PFIRST))[NE]; S.NT = 4; S.G = F.G; S.vcu = F.vcu; S.gather = false; S.wexp = (size_t)1024 * 1024 * 2; S.wtile = (size_t)256 * 1024 * 2; S.whalf = (size_t)128 * 1024 * 2;
        EpiDown E{b_dn, YB};
        pg8::gemm_phase<EpiDown, MoeSched, true>(F.lds, S, E);
        if (BOTH(8) || rep_ + 1 < REPS(8)) GRID_BAR();
    }
    if (IN(9)) _Pragma("unroll") for (int rep_ = 0; rep_ < REPS(9); ++rep_) {
        build_expert_tables(F);
        const LAS int* pfirst = (const LAS int*)(F.lds + L_PFIRST);
        const unsigned bad = __hip_atomic_load(F.ctl + CW_BAR + XB_TMO, RLX_AGENT);
        for (int m = gw; m < M; m += NGW) {
            const int b = m >> 11; const float* g2 = MOD + (size_t)b * 6144 + 5120;
            f32x4 a[4];
#pragma unroll
            for (int j = 0; j < 4; ++j) a[j] = (f32x4){0.f, 0.f, 0.f, 0.f};
#pragma unroll
            for (int k = 0; k < 4; ++k) { const int e = __builtin_amdgcn_readfirstlane(RE[m * 4 + k]), p = __builtin_amdgcn_readfirstlane(RP[m * 4 + k]); const float gk = RG[m * 4 + k];
                const size_t yrow = (size_t)pfirst[e] * 256 + (size_t)p; const GAS v2u* yp = (const GAS v2u*)(YB + yrow * 1024) + F.lane;
#pragma unroll
                for (int j = 0; j < 4; ++j) { const v2u w = yp[64 * j]; a[j] += (f32x4){bfl(w.x), bfh(w.x), bfl(w.y), bfh(w.y)} * gk; } }
            f32x4 v[4]; float s = 0.f;
#pragma unroll
            for (int j = 0; j < 4; ++j) { const f32x4 xv = ((const GAS f32x4*)(X1 + (size_t)m * D) + F.lane)[64 * j]; const f32x4 gv = *(const f32x4*)(g2 + 4 * F.lane + 256 * j);
                v[j] = xv * DN_ALPHA + gv * a[j]; s += (v[j].x + v[j].y) + (v[j].z + v[j].w); }
            const float mean = wave_sum(s) * (1.f / D); float s2 = 0.f;
#pragma unroll
            for (int j = 0; j < 4; ++j) { v[j] = v[j] - mean; s2 += (v[j].x * v[j].x + v[j].y * v[j].y) + (v[j].z * v[j].z + v[j].w * v[j].w); }
            const float rstd = 1.f / sqrtf(wave_sum(s2) * (1.f / D) + LN_EPS);
#pragma unroll
            for (int j = 0; j < 4; ++j) { const f32x4 gv = *(const f32x4*)(ln2_g + 4 * F.lane + 256 * j), bv = *(const f32x4*)(ln2_b + 4 * F.lane + 256 * j);
                f32x4 o = (v[j] * rstd) * gv + bv; if (bad) { const float qn = __builtin_nanf(""); o = (f32x4){qn, qn, qn, qn}; }
                ((GAS f32x4*)(out + (size_t)m * D) + F.lane)[64 * j] = o; }
        }
    }
#undef IN
#undef BOTH
}

extern "C" void kernel_launch(void* const* d_in, const int* in_sizes, int n_in, void* d_out, int out_size, void* d_ws, size_t ws_size, hipStream_t stream) {
    static int grid = 0;
    if (grid == 0) {
        if (n_in != 25 || in_sizes[0] != M * D || out_size != M * D || ws_size < WS_END) { fprintf(stderr, "kernel_launch: unexpected shapes (n_in %d, in0 %d, out %d, ws %zu); nothing launched\n", n_in, n_in > 0 ? in_sizes[0] : -1, out_size, ws_size); grid = -1; return; }
        int dev = 0, cus = 0, per_cu = 0;
        if (hipGetDevice(&dev) != hipSuccess || hipDeviceGetAttribute(&cus, hipDeviceAttributeMultiprocessorCount, dev) != hipSuccess) { grid = -1; return; }
        if (hipFuncSetAttribute((const void*)mk_fwd, hipFuncAttributeMaxDynamicSharedMemorySize, LDS_BYTES) != hipSuccess) { fprintf(stderr, "kernel_launch: hipFuncSetAttribute failed\n"); grid = -1; return; }
        if (hipOccupancyMaxActiveBlocksPerMultiprocessor(&per_cu, (const void*)mk_fwd, NWAVES * 64, LDS_BYTES) != hipSuccess || per_cu < 1) { fprintf(stderr, "kernel_launch: occupancy query reports %d workgroups per CU\n", per_cu); (void)hipGetLastError(); }
        grid = cus;
    }
    if (grid < 0) return;
    if (hipMemsetAsync((char*)d_ws + WS_CTL, 0, CTL_ZERO_BYTES, stream) != hipSuccess) return;
    Args a{};
    for (int i = 0; i < 25; ++i) a.in[i] = (const float*)d_in[i];
    a.out = (float*)d_out; a.ws = (unsigned char*)d_ws;
#if MK_ONE_LAUNCH
    a.ph_lo = 0; a.ph_hi = NPHASE;
    hipLaunchKernelGGL(mk_fwd, dim3(grid), dim3(NWAVES * 64), LDS_BYTES, stream, a);
#else
    for (int p = 0; p < NPHASE; ++p) { a.ph_lo = p; a.ph_hi = p + 1; hipLaunchKernelGGL(mk_fwd, dim3(grid), dim3(NWAVES * 64), LDS_BYTES, stream, a); }
#endif
}
```

```cpp
#include <hip/hip_runtime.h>
#include <hip/hip_bf16.h>
#include <cstdio>
#include <cstdint>
#include <cmath>
#include <type_traits>

#ifndef MK_ONE_LAUNCH
#define MK_ONE_LAUNCH 1
#endif
#ifndef NAIVE_GEMM
#define NAIVE_GEMM 0
#endif
#ifndef DLY_PH
#define DLY_PH (-1)
#endif
#ifndef NAIVE_ATTN
#define NAIVE_ATTN 0
#endif

#define GAS __attribute__((address_space(1)))
#define LAS __attribute__((address_space(3)))

constexpr int NB = 8, SEQ = 2048, D = 1024, M = NB * SEQ;
constexpr int AW = 512;
constexpr int NIN = 2048;
constexpr int NE = 32, TOPK = 4, FF = 1024;
constexpr int ECAP = 16384;
constexpr int PMAX = (M * TOPK) / 256 + NE;
constexpr float LN_EPS = 1e-5f;
constexpr float DN_ALPHA = 1.189207115002721f;
constexpr float LAM_INIT = 0.2f;
constexpr float LOG2E = 1.4426950408889634f;
constexpr float QSCALE = 0.125f * LOG2E;
constexpr int NWAVES = 8;

namespace pg8 {
#define PG8_LAS __attribute__((address_space(3)))
typedef unsigned short bf16_t;
typedef short bf16x8 __attribute__((ext_vector_type(8)));
typedef float f32x4 __attribute__((ext_vector_type(4)));
typedef unsigned u32x4 __attribute__((ext_vector_type(4)));
constexpr int BM = 256, BK = 64, HALF = 128, HTB = HALF * BK * 2, STAGE_BYTES = 8 * HTB, NXCD = 8, WGM = 8;
constexpr int GK = 1024;

__host__ __device__ __forceinline__ int lds_byte(int r, int c) { const int st = (r >> 4) * 2 + (c >> 5), rr = r & 15, cc = c & 31, ob = rr * 64 + cc * 2; return st * 1024 + (ob ^ (((ob >> 9) & 1) << 5)); }
__host__ __device__ __forceinline__ void stage_rc(int b, int& R, int& C) { const int st = b / 1024, sb = b % 1024, swz = sb ^ (((sb >> 9) & 1) << 5); R = (st >> 1) * 16 + swz / 64; C = (st & 1) * 32 + (swz % 64) / 2; }
__host__ __device__ __forceinline__ int perm32(int rho) { const int n = rho >> 4, i = rho & 15; return 8 * (i >> 2) + 4 * n + (i & 3); }

struct Unit { int pm, pn, e, lrow0, cnt; };

__device__ __forceinline__ unsigned cvt_pk_bf16(float lo, float hi) { unsigned r; asm volatile("v_cvt_pk_bf16_f32 %0, %1, %2" : "=v"(r) : "v"(lo), "v"(hi)); return r; }
__device__ __forceinline__ float bf2f(unsigned short v) { return __uint_as_float((unsigned)v << 16); }

#if !NAIVE_GEMM
template <class Epi, class Sched, bool ALIGN_EPI>
__device__ __forceinline__ void gemm_phase(PG8_LAS unsigned char* lds, const Sched& S, const Epi& E) {
    constexpr int K = GK, nt = K / BK;
    const int tid = threadIdx.x, wid = __builtin_amdgcn_readfirstlane(tid >> 6), lane = tid & 63, wr = wid >> 2, wc = wid & 3, fr = lane & 15, fq = lane >> 4;
    int Rr[2], Cc[2]; unsigned voffB[2];
#pragma unroll
    for (int i = 0; i < 2; ++i) { int R, C; stage_rc(tid * 16 + i * 8192, R, C); Rr[i] = R; Cc[i] = C; const int Rb = Epi::PERM ? ((R & ~31) + perm32(R & 31)) : R; voffB[i] = (unsigned)(Rb * K + C) * 2u; }
    const size_t kstep = (size_t)(BK * 2);
    const size_t hB = S.b_hstep();
    const unsigned ldsw = (unsigned)wid * 1024u;
    const int aoff = lds_byte(wr * 64 + fr, fq * 8), boff = lds_byte(wc * 32 + fr, fq * 8);
#define PG8_SA(b, h) (((b) * 2 + (h)) * HTB)
#define PG8_SB(b, h) ((4 + (b) * 2 + (h)) * HTB)
#define PG8_STAGE(bufoff, gbase, voff) do { _Pragma("unroll") for (int _i = 0; _i < 2; ++_i) \
        __builtin_amdgcn_global_load_lds((const unsigned*)((const char*)(gbase) + (voff)[_i]), (PG8_LAS unsigned*)(lds + (bufoff) + ldsw + _i * 8192), 16, 0, 0); } while (0)
#define PG8_LDA(dst, b, h) do { _Pragma("unroll") for (int m = 0; m < 4; ++m) _Pragma("unroll") for (int k = 0; k < 2; ++k) dst[m][k] = *(const PG8_LAS bf16x8*)(lds + PG8_SA(b, h) + aoff + m * 2048 + k * 1024); } while (0)
#define PG8_LDB(dst, b, h) do { _Pragma("unroll") for (int n = 0; n < 2; ++n) _Pragma("unroll") for (int k = 0; k < 2; ++k) dst[n][k] = *(const PG8_LAS bf16x8*)(lds + PG8_SB(b, h) + boff + n * 2048 + k * 1024); } while (0)
#define PG8_MMA(ai, bj, At, Bt) do { __builtin_amdgcn_s_setprio(1); _Pragma("unroll") for (int m = 0; m < 4; ++m) _Pragma("unroll") for (int n = 0; n < 2; ++n) _Pragma("unroll") for (int k = 0; k < 2; ++k) \
        acc[ai][bj][m][n] = __builtin_amdgcn_mfma_f32_16x16x32_bf16(Bt[n][k], At[m][k], acc[ai][bj][m][n], 0, 0, 0); __builtin_amdgcn_s_setprio(0); } while (0)
#define PG8_WAIT_V(n) asm volatile("s_waitcnt vmcnt(" #n ")" ::: "memory")
#define PG8_WAIT_L(n) asm volatile("s_waitcnt lgkmcnt(" #n ")" ::: "memory")
#define PG8_BAR __builtin_amdgcn_s_barrier()
#define PG8_SCHED __builtin_amdgcn_sched_barrier(0)
    Unit cur, nxt; int ui = 0;
    if (!S.next(0, cur)) return;
    f32x4 acc[2][2][4][2];
#pragma unroll
    for (int a = 0; a < 2; ++a)
#pragma unroll
        for (int b = 0; b < 2; ++b)
#pragma unroll
            for (int m = 0; m < 4; ++m)
#pragma unroll
                for (int n = 0; n < 2; ++n) acc[a][b][m][n] = (f32x4){0.f, 0.f, 0.f, 0.f};
    bf16x8 At[4][2], B0[2][2], B1[2][2];
    const char* cA = S.a_base(cur); const char* cB = S.b_base(cur);
    unsigned va0[2], va1[2];
    S.a_voff(cur, Rr, Cc, va0, va1);
    PG8_STAGE(PG8_SB(0, 0), cB, voffB); PG8_STAGE(PG8_SB(0, 1), cB + hB, voffB); PG8_STAGE(PG8_SA(0, 0), cA, va0); PG8_STAGE(PG8_SA(0, 1), cA, va1);
    if (wr == 1) PG8_BAR;
    PG8_WAIT_V(2); PG8_BAR;
    PG8_STAGE(PG8_SB(1, 0), cB + kstep, voffB); PG8_STAGE(PG8_SA(1, 0), cA + kstep, va0); PG8_STAGE(PG8_SB(1, 1), cB + hB + kstep, voffB);
    PG8_WAIT_V(6); PG8_BAR;
    for (;;) {
        const bool has_next = S.next(ui + 1, nxt);
        const char* nA = has_next ? S.a_base(nxt) : cA; const char* nB = has_next ? S.b_base(nxt) : cB;
        unsigned vn0[2], vn1[2];
        if (has_next) S.a_voff(nxt, Rr, Cc, vn0, vn1); else { vn0[0] = va0[0]; vn0[1] = va0[1]; vn1[0] = va1[0]; vn1[1] = va1[1]; }
        for (int t = 0; t < nt; t += 2) {
            const bool last = (t == nt - 2);
            const char* a1 = cA + (size_t)(t + 1) * kstep;
            const char* a2 = last ? nA : cA + (size_t)(t + 2) * kstep; const char* b2 = last ? nB : cB + (size_t)(t + 2) * kstep;
            const char* a3 = a2 + kstep; const char* b3 = b2 + kstep;
            unsigned v20[2], v21[2];
            v20[0] = last ? vn0[0] : va0[0]; v20[1] = last ? vn0[1] : va0[1]; v21[0] = last ? vn1[0] : va1[0]; v21[1] = last ? vn1[1] : va1[1];
            PG8_LDB(B0, 0, 0); PG8_LDB(B1, 0, 1); PG8_SCHED; PG8_LDA(At, 0, 0); PG8_STAGE(PG8_SA(1, 1), a1, va1);
            PG8_WAIT_V(8); PG8_WAIT_L(0); PG8_BAR; PG8_MMA(0, 0, At, B0); PG8_MMA(0, 1, At, B1); PG8_BAR; PG8_SCHED;
            PG8_LDA(At, 0, 1); PG8_STAGE(PG8_SB(0, 0), b2, voffB); PG8_STAGE(PG8_SB(0, 1), b2 + hB, voffB); PG8_STAGE(PG8_SA(0, 0), a2, v20);
            PG8_WAIT_V(8); PG8_WAIT_L(0); PG8_BAR; PG8_MMA(1, 0, At, B0); PG8_MMA(1, 1, At, B1); PG8_BAR; PG8_SCHED;
            PG8_LDB(B0, 1, 0); PG8_LDB(B1, 1, 1); PG8_SCHED; PG8_LDA(At, 1, 0); PG8_STAGE(PG8_SA(0, 1), a2, v21);
            PG8_WAIT_V(8); PG8_WAIT_L(0); PG8_BAR; PG8_MMA(0, 0, At, B0); PG8_MMA(0, 1, At, B1); PG8_BAR; PG8_SCHED;
            PG8_LDA(At, 1, 1); PG8_STAGE(PG8_SB(1, 0), b3, voffB); PG8_STAGE(PG8_SB(1, 1), b3 + hB, voffB); PG8_STAGE(PG8_SA(1, 0), a3, v20);
            PG8_WAIT_V(8); PG8_WAIT_L(0); PG8_BAR; PG8_MMA(1, 0, At, B0); PG8_MMA(1, 1, At, B1); PG8_BAR; PG8_SCHED;
        }
        if constexpr (ALIGN_EPI) { if (wr == 0) PG8_BAR; }
        E(acc, cur, wr, wc, fr, fq);
        if (!has_next) break;
#pragma unroll
        for (int a = 0; a < 2; ++a)
#pragma unroll
            for (int b = 0; b < 2; ++b)
#pragma unroll
                for (int m = 0; m < 4; ++m)
#pragma unroll
                    for (int n = 0; n < 2; ++n) acc[a][b][m][n] = (f32x4){0.f, 0.f, 0.f, 0.f};
        cur = nxt; cA = nA; cB = nB; va0[0] = vn0[0]; va0[1] = vn0[1]; va1[0] = vn1[0]; va1[1] = vn1[1]; ++ui;
        if constexpr (ALIGN_EPI) { if (wr == 1) PG8_BAR; }
    }
    PG8_WAIT_V(0);
    if constexpr (!ALIGN_EPI) { if (wr == 0) PG8_BAR; }
    PG8_BAR;
#undef PG8_SA
#undef PG8_SB
#undef PG8_STAGE
#undef PG8_LDA
#undef PG8_LDB
#undef PG8_MMA
#undef PG8_WAIT_V
#undef PG8_WAIT_L
#undef PG8_BAR
#undef PG8_SCHED
}
#else
template <class Epi, class Sched, bool ALIGN_EPI>
__device__ __forceinline__ void gemm_phase(PG8_LAS unsigned char*, const Sched& S, const Epi& E) {
    constexpr int K = GK;
    const int tid = threadIdx.x, wid = __builtin_amdgcn_readfirstlane(tid >> 6), lane = tid & 63, wr = wid >> 2, wc = wid & 3, fr = lane & 15, fq = lane >> 4;
    Unit u;
    for (int ui = 0; S.next(ui, u); ++ui) {
        f32x4 acc[2][2][4][2];
#pragma unroll
        for (int ai = 0; ai < 2; ++ai)
#pragma unroll
            for (int bj = 0; bj < 2; ++bj) {
                const bf16_t* ar[4]; const bf16_t* br[2][4];
#pragma unroll
                for (int m = 0; m < 4; ++m) ar[m] = S.a_row(u, ai * 128 + wr * 64 + m * 16 + fr);
#pragma unroll
                for (int n = 0; n < 2; ++n)
#pragma unroll
                    for (int x = 0; x < 4; ++x) br[n][x] = S.b_row(u, bj * 128 + wc * 32 + (Epi::PERM ? 8 * fq + 4 * n + x : 16 * n + 4 * fq + x));
                float s[4][2][4];
#pragma unroll
                for (int m = 0; m < 4; ++m)
#pragma unroll
                    for (int n = 0; n < 2; ++n)
#pragma unroll
                        for (int x = 0; x < 4; ++x) s[m][n][x] = 0.f;
                for (int k0 = 0; k0 < K; k0 += 8) {
                    bf16x8 av[4], bv[2][4];
#pragma unroll
                    for (int m = 0; m < 4; ++m) av[m] = *(const bf16x8*)(ar[m] + k0);
#pragma unroll
                    for (int n = 0; n < 2; ++n)
#pragma unroll
                        for (int x = 0; x < 4; ++x) bv[n][x] = *(const bf16x8*)(br[n][x] + k0);
#pragma unroll
                    for (int kk = 0; kk < 8; ++kk)
#pragma unroll
                        for (int m = 0; m < 4; ++m) { const float a = bf2f((unsigned short)av[m][kk]);
#pragma unroll
                            for (int n = 0; n < 2; ++n)
#pragma unroll
                                for (int x = 0; x < 4; ++x) s[m][n][x] += a * bf2f((unsigned short)bv[n][x][kk]); }
                }
#pragma unroll
                for (int m = 0; m < 4; ++m)
#pragma unroll
                    for (int n = 0; n < 2; ++n) acc[ai][bj][m][n] = (f32x4){s[m][n][0], s[m][n][1], s[m][n][2], s[m][n][3]};
            }
        E(acc, u, wr, wc, fr, fq);
    }
}
#endif
}

constexpr size_t MiB = 1u << 20;
constexpr size_t WS_CTL = 0, CTL_ZERO_BYTES = 1 * MiB;
constexpr size_t WS_MOD = 1 * MiB;
constexpr size_t WS_WPOOL = 1 * MiB + 512 * 1024;
constexpr size_t WS_WIN = 2 * MiB;
constexpr size_t WS_WOUT = 6 * MiB;
constexpr size_t WS_WGU = 8 * MiB;
constexpr size_t WS_WD = 136 * MiB;
constexpr size_t WS_XN = 200 * MiB;
constexpr size_t WS_Q = 232 * MiB, WS_K = 248 * MiB, WS_V = 264 * MiB, WS_U = 280 * MiB;
constexpr size_t WS_OA = 296 * MiB;
constexpr size_t WS_MIX = 328 * MiB;
constexpr size_t WS_T1 = 360 * MiB;
constexpr size_t WS_X1 = 424 * MiB;
constexpr size_t WS_XN2 = 488 * MiB;
constexpr size_t WS_RE = 520 * MiB, WS_RP = 521 * MiB, WS_RG = 522 * MiB;
constexpr size_t WS_ROWTOK = 524 * MiB;
constexpr size_t WS_H = 528 * MiB;
constexpr size_t WS_Y = 672 * MiB;
constexpr size_t WS_END = 816 * MiB;
static_assert((size_t)PMAX * 256 * 1024 * 2 == 144 * MiB, "H / Y size");
constexpr int CW_TMO = 0, CW_CODE = 1;
constexpr int CW_BAR = 4096;
constexpr int CW_CNT = 8192;

constexpr int RING_BYTES = 131072;
constexpr int LDS_BYTES = 147456;
constexpr int LCTL_OFF = 139264;
constexpr int L_MISC = LCTL_OFF;
constexpr int L_CNT = LCTL_OFF + 128;
constexpr int L_PFIRST = LCTL_OFF + 256;
constexpr int L_PEXP = LCTL_OFF + 512;
constexpr int L_HIST = LCTL_OFF + 512 + 4 * 320;
constexpr int L_TB = 90112;
static_assert(L_TB + 4 * 704 * 4 <= RING_BYTES && L_HIST + 256 <= LDS_BYTES && PMAX <= 320, "LDS map");

typedef unsigned short bf16;
typedef unsigned v4u __attribute__((ext_vector_type(4)));
typedef unsigned v2u __attribute__((ext_vector_type(2)));
typedef float f32x4 __attribute__((ext_vector_type(4)));
typedef float f32x16 __attribute__((ext_vector_type(16)));
typedef short bf16x8 __attribute__((ext_vector_type(8)));
typedef GAS unsigned gu32;
#define RLX_AGENT __ATOMIC_RELAXED, __HIP_MEMORY_SCOPE_AGENT
#define LDS_WAIT() asm volatile("s_waitcnt lgkmcnt(0)" ::: "memory")
#define VM_WAIT() asm volatile("s_waitcnt vmcnt(0)" ::: "memory")
__device__ __forceinline__ unsigned f2bf(float f) { unsigned u = __builtin_bit_cast(unsigned, f); return (u + 0x7fffu + ((u >> 16) & 1u)) >> 16; }
__device__ __forceinline__ unsigned pk2(float lo, float hi) { return f2bf(lo) | (f2bf(hi) << 16); }
__device__ __forceinline__ float bfl(unsigned w) { return __uint_as_float(w << 16); }
__device__ __forceinline__ float bfh(unsigned w) { return __uint_as_float(w & 0xffff0000u); }

namespace attn_body {
using bf16=__hip_bfloat16;
using bf16x8=__attribute__((ext_vector_type(8)))short;
using s16x4=__attribute__((ext_vector_type(4)))short;
using f32x16=__attribute__((ext_vector_type(16)))float;
using u32x4=__attribute__((ext_vector_type(4)))unsigned;
constexpr int SEQ=2048,DH=64,PQ=512,PO=1024;
constexpr int NW=8,QBLK=32,QB=QBLK*NW,KVBLK=64,NQB=SEQ/QB;
__device__ __forceinline__ int crow(int r,int hi){return (r&3)+8*(r>>2)+4*hi;}
#define SBAR() __builtin_amdgcn_sched_barrier(0)
constexpr int TBN=704, TBOFF=447;
__device__ __forceinline__ void bandinit(f32x16&p0,f32x16&p1,int t,int q0,int wid,int r32,int hi,const __attribute__((address_space(3))) float*tb){
  const __attribute__((address_space(3))) float*tp=tb+(64*t+4*hi-(q0+32*wid+r32)+TBOFF);
  #pragma unroll
  for(int r=0;r<16;++r){p0[r]=tp[(r&3)+8*(r>>2)]; p1[r]=tp[(r&3)+8*(r>>2)+32];}
}
__device__ __forceinline__ void bandpost(f32x16&p0,f32x16&p1,const f32x16&negm,int t,int q0,int wid){
  const float nm=(t>(q0>>6)+(wid>>1))?-INFINITY:negm[0];
  #pragma unroll
  for(int r=0;r<16;++r){p0[r]+=nm;p1[r]+=nm;}
}
constexpr int NSLOT=3, SLOTB=8192;
constexpr int LDS_K=0, LDS_V=NSLOT*SLOTB, LDS_WS=2*NSLOT*SLOTB, LDS_OST=LDS_WS+NW*64*4, LDS_BYTES=LDS_OST+NW*4096;
__device__ __forceinline__ void glds16(const void*gsrc,unsigned lds_dst){unsigned keep;
  asm volatile("s_mov_b32 %0, m0\n\ts_mov_b32 m0, %2\n\ts_nop 0\n\tglobal_load_lds_dwordx4 %1, off\n\ts_mov_b32 m0, %0":"=&s"(keep):"v"(gsrc),"s"(lds_dst):"memory");}
__device__ __forceinline__ float max3f(float a,float b,float c){float r;asm("v_max3_f32 %0, %1, %2, %3":"=v"(r):"v"(a),"v"(b),"v"(c));return r;}
__device__ __forceinline__ float max2f(float a,float b){float r;asm("v_max_f32_e32 %0, %1, %2":"=v"(r):"v"(a),"v"(b));return r;}
__device__ __forceinline__ float fadd_s(float a,float b){float r;asm("v_add_f32_e32 %0, %1, %2":"=v"(r):"v"(a),"v"(b));return r;}
__device__ __forceinline__ float fsub_s(float a,float b){float r;asm("v_sub_f32_e32 %0, %1, %2":"=v"(r):"v"(a),"v"(b));return r;}
typedef float f32x2_t __attribute__((ext_vector_type(2))); typedef __bf16 bf16x2_t __attribute__((ext_vector_type(2)));
__device__ __forceinline__ unsigned cvtpk_s(float lo,float hi){f32x2_t v={lo,hi};bf16x2_t b=__builtin_convertvector(v,bf16x2_t);return __builtin_bit_cast(unsigned,b);}
#define WAIT_BAR(N) asm volatile("s_waitcnt vmcnt(" #N ") lgkmcnt(0)\n\ts_barrier":::"memory")

__device__ __forceinline__ void qkt(f32x16&p0,f32x16&p1,const char*Kslot,const bf16x8*qr,int r32,int hi){
  const char*kb=Kslot+hi*1024+r32*16;
  #pragma unroll
  for(int d0=0;d0<4;++d0){
    const bf16x8 b0=*reinterpret_cast<const bf16x8*>(kb+d0*2048);
    const bf16x8 b1=*reinterpret_cast<const bf16x8*>(kb+d0*2048+512);
    p0=__builtin_amdgcn_mfma_f32_32x32x16_bf16(b0,qr[d0],p0,0,0,0);p1=__builtin_amdgcn_mfma_f32_32x32x16_bf16(b1,qr[d0],p1,0,0,0);}
}
typedef __attribute__((address_space(3))) const char* lds_cptr;
typedef short v4i16_t __attribute__((ext_vector_type(4)));
__device__ __forceinline__ void kload8(bf16x8*kf,lds_cptr kp){
  kf[0]=*(const __attribute__((address_space(3))) bf16x8*)(kp);      kf[1]=*(const __attribute__((address_space(3))) bf16x8*)(kp+512);
  kf[2]=*(const __attribute__((address_space(3))) bf16x8*)(kp+2048); kf[3]=*(const __attribute__((address_space(3))) bf16x8*)(kp+2560);
  kf[4]=*(const __attribute__((address_space(3))) bf16x8*)(kp+4096); kf[5]=*(const __attribute__((address_space(3))) bf16x8*)(kp+4608);
  kf[6]=*(const __attribute__((address_space(3))) bf16x8*)(kp+6144); kf[7]=*(const __attribute__((address_space(3))) bf16x8*)(kp+6656);
}
__device__ __forceinline__ void kload2(bf16x8*kf,lds_cptr kp,int j){ kf[2*j]=*(const __attribute__((address_space(3))) bf16x8*)(kp+j*2048); kf[2*j+1]=*(const __attribute__((address_space(3))) bf16x8*)(kp+j*2048+512); }
__device__ __forceinline__ s16x4 vtr(lds_cptr p){ return __builtin_bit_cast(s16x4,__builtin_amdgcn_ds_read_tr16_b64_v4i16((__attribute__((address_space(3))) v4i16_t*)p)); }
__device__ __forceinline__ float rowmax(const f32x16&p0,const f32x16&p1){
  float a=max3f(p0[0],p0[1],p1[0]),b=max3f(p0[2],p0[3],p1[1]);a=max3f(a,p1[2],p1[3]);
  #pragma unroll
  for(int r=4;r<16;r+=4){a=max3f(a,p0[r],p0[r+1]);b=max3f(b,p0[r+2],p0[r+3]);a=max3f(a,p1[r],p1[r+1]);b=max3f(b,p1[r+2],p1[r+3]);}
  const float m=max2f(a,b);
  auto rr=__builtin_amdgcn_permlane32_swap(__float_as_uint(m),__float_as_uint(m),false,false);
  return max2f(__uint_as_float(rr[0]),__uint_as_float(rr[1]));
}
__device__ __forceinline__ void pv(f32x16*o,int vb,bf16x8 pa0,bf16x8 pa1,bf16x8 pa2,bf16x8 pa3){
  #pragma unroll
  for(int d0=0;d0<2;++d0){s16x4 lo[4],hi[4];
    #pragma unroll
    for(int ks=0;ks<4;++ks){
      asm volatile("ds_read_b64_tr_b16 %0,%1 offset:%c2":"=&v"(lo[ks]):"v"(vb),"i"(d0*4096+ks*1024):"memory");
      asm volatile("ds_read_b64_tr_b16 %0,%1 offset:%c2":"=&v"(hi[ks]):"v"(vb),"i"(d0*4096+ks*1024+512):"memory");}
    asm volatile("s_waitcnt lgkmcnt(0)":::"memory");SBAR();
    #define PK(k) (bf16x8){lo[k][0],lo[k][1],lo[k][2],lo[k][3],hi[k][0],hi[k][1],hi[k][2],hi[k][3]}
    o[d0]=__builtin_amdgcn_mfma_f32_32x32x16_bf16(pa0,PK(0),o[d0],0,0,0);
    o[d0]=__builtin_amdgcn_mfma_f32_32x32x16_bf16(pa1,PK(1),o[d0],0,0,0);
    o[d0]=__builtin_amdgcn_mfma_f32_32x32x16_bf16(pa2,PK(2),o[d0],0,0,0);
    o[d0]=__builtin_amdgcn_mfma_f32_32x32x16_bf16(pa3,PK(3),o[d0],0,0,0);
    #undef PK
  }
}
#define ATTN_STORE16(p,v) (*(u32x4*)(p)=(v))
template<int THRL> __device__ __forceinline__ void attn_unit(int b,int j,int vh,int qb,const bf16*Q,const bf16*__restrict__ K,const bf16*__restrict__ V,bf16*O,char*shm,const __attribute__((address_space(3))) float*tbh){
  int tid_=threadIdx.x; asm volatile("":"+v"(tid_));
  const int tid=tid_,lane=tid&63,r32=lane&31,hi=lane>>5; const int wid=__builtin_amdgcn_readfirstlane(tid>>6);
  const long rowbase=(long)b*SEQ; const int q0=qb*QB;
  const bf16*Qw=Q+(rowbase+q0+wid*QBLK)*PQ+j*DH;
  const bf16*Kh=K+rowbase*PQ+j*DH,*Vh=V+rowbase*PQ+(j>>1)*128+vh*64;
  const unsigned lds0=(unsigned)(uintptr_t)shm;
  float*wsf=(float*)(shm+LDS_WS)+wid*64;
  const bf16*ksrc=Kh+(long)lane*PQ+wid*8;
  const bf16*vsrc=Vh+(long)(16*(wid&3)+(lane>>2))*PQ+(wid>>2)*32+(lane&3)*8;
  const unsigned kdst=lds0+LDS_K+wid*1024, vdst=lds0+LDS_V+wid*1024;
  #define DMA_K(t,slot) glds16(ksrc+(long)(t)*KVBLK*PQ,(unsigned)__builtin_amdgcn_readfirstlane(kdst+(slot)))
  #define DMA_V(t,slot) glds16(vsrc+(long)(t)*KVBLK*PQ,(unsigned)__builtin_amdgcn_readfirstlane(vdst+(slot)))
  const int vb0=(int)(lds0+LDS_V)+((lane>>4)&1)*32+(lane&3)*8+(4*hi+((lane&15)>>2))*64;
  const char*Kbase=shm+LDS_K; bf16x8 kf[8];
  const lds_cptr shm3=(lds_cptr)shm; const lds_cptr kp0=shm3+LDS_K+hi*1024+r32*16; const lds_cptr vp0=shm3+LDS_V+((lane>>4)&1)*32+(lane&3)*8+(4*hi+((lane&15)>>2))*64;
  const int NT=(q0+QB)/KVBLK;
  DMA_K(0,0);DMA_V(0,0);DMA_K(1,SLOTB);
  bf16x8 qr[4];
  #pragma unroll
  for(int d0=0;d0<4;++d0)qr[d0]=*reinterpret_cast<const bf16x8*>(&Qw[(long)r32*PQ+d0*16+hi*8]);
  float mhat=0.f,l_reg=0.f;f32x16 o[2];o[0]=f32x16{};o[1]=f32x16{};f32x16 negm=f32x16{};asm volatile("":"+v"(negm));
  #define BINIT(C0,C1,t) bandinit(C0,C1,(t),q0,wid,r32,hi,tbh)
  bool resc=false;
  #define START(P0,P1) do{ const float rm=rowmax(P0,P1); resc=false; \
    { const float dl=rm; mhat=fadd_s(mhat,dl); \
      _Pragma("unroll") for(int r=0;r<16;++r){P0[r]=fsub_s(P0[r],dl);P1[r]=fsub_s(P1[r],dl);} \
      _Pragma("unroll") for(int r=0;r<16;++r)negm[r]=-mhat; asm volatile("":"+v"(negm)); } \
    _Pragma("unroll") for(int r=0;r<16;++r)P0[r]=__builtin_amdgcn_exp2f(P0[r]); }while(0)
  #define RESC() do{ if(resc){ asm volatile("s_waitcnt lgkmcnt(0)":::"memory"); \
      _Pragma("unroll") for(int d_=0;d_<2;++d_) _Pragma("unroll") for(int r=0;r<16;++r)o[d_][r]*=wsf[crow(r,hi)]; } }while(0)
  f32x16 pA0,pA1,pB0,pB1;
  int sl_prev=0,sl_cur=0,sl_next=SLOTB;
  #define ROT() do{sl_prev=sl_cur;sl_cur=sl_next;sl_next=(sl_next==(NSLOT-1)*SLOTB)?0:sl_next+SLOTB;}while(0)
  DMA_K(2,2*SLOTB);
  WAIT_BAR(3);
  if(NT<=7){BINIT(pA0,pA1,0);}else{pA0=f32x16{};pA1=f32x16{};}
  qkt(pA0,pA1,Kbase,qr,r32,hi);asm volatile("s_nop 15\n\ts_nop 7":"+v"(pA0),"+v"(pA1));
  START(pA0,pA1);
  _Pragma("unroll") for(int r=0;r<16;++r)pA1[r]=__builtin_amdgcn_exp2f(pA1[r]);
  WAIT_BAR(0);
  DMA_K(3,0);DMA_V(1,SLOTB);
  ROT();
  kload8(kf,kp0+sl_cur);
  WAIT_BAR(2);
  s16x4 vlo[8],vhi[8]; u32x4 pw0,pw1,pw2,pw3;
  #define PKW(P,B) cvtpk_s(P[B],P[B+1])
  #define PAF(k) __builtin_bit_cast(bf16x8,pw##k)
  #define VFR(i) (bf16x8){vlo[i][0],vlo[i][1],vlo[i][2],vlo[i][3],vhi[i][0],vhi[i][1],vhi[i][2],vhi[i][3]}
  #define PIN(x) asm volatile("":"+v"(x))
  #define MX3(a,b,c) __builtin_fmaxf(__builtin_fmaxf((a),(b)),(c))
  #define GAPA(MF,A0,A1,A2,A3,W0,W1,PW) do{ MF; sacc+=A0; sacc+=A1; sacc+=A2; sacc+=A3; PIN(sacc); W0; W1; PIN(PW); SBAR(); }while(0)
  #define EX(v) __builtin_amdgcn_exp2f(v)
  #define GAPB(MF,X,B) do{ MF; X[B]=EX(X[B]); X[B+1]=EX(X[B+1]); X[B+2]=EX(X[B+2]); X[B+3]=EX(X[B+3]); PIN(X); SBAR(); }while(0)
  #define VRD(i) do{ vlo[i]=vtr(vp_+(((i)>>2)*4096+((i)&3)*1024)); vhi[i]=vtr(vp_+(((i)>>2)*4096+((i)&3)*1024+512)); }while(0)
  #define KRD(G,j) do{ if(G){ kload2(kf,kp0+sl_next,j); SBAR(); } }while(0)
  #define STEP(C0,C1,P0,P1,t,GK,GV,GL,PRE,I0,I1,POST) do{ SBAR(); PRE; SBAR(); \
    const lds_cptr vp_=vp0+sl_prev; \
    VRD(0); SBAR(); float sacc=(P0[0]+P0[1]); \
    GAPA(C0=__builtin_amdgcn_mfma_f32_32x32x16_bf16(kf[0],qr[0],I0,0,0,0), P0[2],P0[3],P0[4],P0[5],     pw0[0]=PKW(P0,0), pw0[1]=PKW(P0,2), pw0); \
    VRD(4); SBAR(); GAPA(C1=__builtin_amdgcn_mfma_f32_32x32x16_bf16(kf[1],qr[0],I1,0,0,0), P0[6],P0[7],P0[8],P0[9],     pw0[2]=PKW(P0,4), pw0[3]=PKW(P0,6), pw0); \
    VRD(1); SBAR(); GAPA(C0=__builtin_amdgcn_mfma_f32_32x32x16_bf16(kf[2],qr[1],C0,0,0,0),   P0[10],P0[11],P0[12],P0[13], pw1[0]=PKW(P0,8), pw1[1]=PKW(P0,10), pw1); \
    VRD(5); SBAR(); GAPA(C1=__builtin_amdgcn_mfma_f32_32x32x16_bf16(kf[3],qr[1],C1,0,0,0),   P0[14],P0[15],P1[0],P1[1],   pw1[2]=PKW(P0,12),pw1[3]=PKW(P0,14), pw1); \
    VRD(2); SBAR(); GAPA(C0=__builtin_amdgcn_mfma_f32_32x32x16_bf16(kf[4],qr[2],C0,0,0,0),   P1[2],P1[3],P1[4],P1[5],     pw2[0]=PKW(P1,0), pw2[1]=PKW(P1,2), pw2); \
    VRD(6); SBAR(); GAPA(C1=__builtin_amdgcn_mfma_f32_32x32x16_bf16(kf[5],qr[2],C1,0,0,0),   P1[6],P1[7],P1[8],P1[9],     pw2[2]=PKW(P1,4), pw2[3]=PKW(P1,6), pw2); \
    VRD(3); SBAR(); GAPA(C0=__builtin_amdgcn_mfma_f32_32x32x16_bf16(kf[6],qr[3],C0,0,0,0),   P1[10],P1[11],P1[12],P1[13], pw3[0]=PKW(P1,8), pw3[1]=PKW(P1,10), pw3); \
    VRD(7); SBAR(); GAPA(C1=__builtin_amdgcn_mfma_f32_32x32x16_bf16(kf[7],qr[3],C1,0,0,0),   P1[14],P1[15],0.f,0.f,       pw3[2]=PKW(P1,12),pw3[3]=PKW(P1,14), pw3); \
    l_reg+=sacc; \
    if(GK){DMA_K((t)+3,sl_cur);} if(GV){DMA_V((t)+1,sl_next);} \
    POST; \
    { float a=MX3(C0[0],C0[1],C1[0]),b=MX3(C0[2],C0[3],C1[1]); a=MX3(a,C1[2],C1[3]); \
      _Pragma("unroll") for(int r=4;r<16;r+=4){a=MX3(a,C0[r],C0[r+1]);b=MX3(b,C0[r+2],C0[r+3]);a=MX3(a,C1[r],C1[r+1]);b=MX3(b,C1[r+2],C1[r+3]);} \
      float rm=__builtin_fmaxf(a,b); { auto rr=__builtin_amdgcn_permlane32_swap(__float_as_uint(rm),__float_as_uint(rm),false,false); rm=__builtin_fmaxf(__uint_as_float(rr[0]),__uint_as_float(rr[1])); } \
      resc=false; \
      if(__builtin_expect(__any(rm>(float)THRL),0)){ const float dl=__builtin_fmaxf(rm,0.f); mhat+=dl; \
        _Pragma("unroll") for(int r=0;r<16;++r){C0[r]-=dl;C1[r]-=dl;} \
        _Pragma("unroll") for(int r=0;r<16;++r)negm[r]=-mhat; asm volatile("":"+v"(negm)); \
        const float f=__builtin_amdgcn_exp2f(-dl); l_reg*=f; if(hi==0)wsf[r32]=f; resc=true; } } \
    SBAR(); \
    GAPB(o[0]=__builtin_amdgcn_mfma_f32_32x32x16_bf16(PAF(0),VFR(0),o[0],0,0,0), C0,0); \
    GAPB(o[1]=__builtin_amdgcn_mfma_f32_32x32x16_bf16(PAF(0),VFR(4),o[1],0,0,0), C0,4); \
    KRD(GL,0); GAPB(o[0]=__builtin_amdgcn_mfma_f32_32x32x16_bf16(PAF(1),VFR(1),o[0],0,0,0), C0,8); \
    KRD(GL,1); GAPB(o[1]=__builtin_amdgcn_mfma_f32_32x32x16_bf16(PAF(1),VFR(5),o[1],0,0,0), C0,12); \
    KRD(GL,2); GAPB(o[0]=__builtin_amdgcn_mfma_f32_32x32x16_bf16(PAF(2),VFR(2),o[0],0,0,0), C1,0); \
    KRD(GL,3); GAPB(o[1]=__builtin_amdgcn_mfma_f32_32x32x16_bf16(PAF(2),VFR(6),o[1],0,0,0), C1,4); \
    GAPB(o[0]=__builtin_amdgcn_mfma_f32_32x32x16_bf16(PAF(3),VFR(3),o[0],0,0,0), C1,8); \
    GAPB(o[1]=__builtin_amdgcn_mfma_f32_32x32x16_bf16(PAF(3),VFR(7),o[1],0,0,0), C1,12); \
    }while(0)
  int t=1;
  for(;t+7<NT;t+=2){
    STEP(pB0,pB1,pA0,pA1,t,true,true,true,,negm,negm,);     WAIT_BAR(2); RESC(); ROT();
    STEP(pA0,pA1,pB0,pB1,t+1,true,true,true,,negm,negm,);   WAIT_BAR(2); RESC(); ROT();
  }
  #define ENDW(tt) do{ if((tt)+3<NT){WAIT_BAR(2);} else if((tt)+2<NT){WAIT_BAR(1);} else {WAIT_BAR(0);} }while(0)
  for(;t+1<NT;t+=2){
    STEP(pB0,pB1,pA0,pA1,t,(t+3<NT),(t+1<NT),(t+1<NT),BINIT(pB0,pB1,t),pB0,pB1,bandpost(pB0,pB1,negm,t,q0,wid));           ENDW(t);   RESC(); ROT();
    STEP(pA0,pA1,pB0,pB1,t+1,(t+4<NT),(t+2<NT),(t+2<NT),BINIT(pA0,pA1,t+1),pA0,pA1,bandpost(pA0,pA1,negm,t+1,q0,wid));       ENDW(t+1); RESC(); ROT();
  }
  STEP(pB0,pB1,pA0,pA1,NT-1,false,false,false,BINIT(pB0,pB1,NT-1),pB0,pB1,bandpost(pB0,pB1,negm,NT-1,q0,wid)); RESC();
  { float sacc=pB0[0]+pB0[1]; _Pragma("unroll") for(int r=2;r<16;++r)sacc+=pB0[r]; _Pragma("unroll") for(int r=0;r<16;++r)sacc+=pB1[r]; l_reg+=sacc;
    pw0=(u32x4){PKW(pB0,0),PKW(pB0,2),PKW(pB0,4),PKW(pB0,6)};pw1=(u32x4){PKW(pB0,8),PKW(pB0,10),PKW(pB0,12),PKW(pB0,14)};pw2=(u32x4){PKW(pB1,0),PKW(pB1,2),PKW(pB1,4),PKW(pB1,6)};pw3=(u32x4){PKW(pB1,8),PKW(pB1,10),PKW(pB1,12),PKW(pB1,14)};
    SBAR(); pv(o,vb0+sl_cur,PAF(0),PAF(1),PAF(2),PAF(3)); }
  #undef PKW
  #undef PAF
  #undef VFR
  #undef PIN
  #undef MX3
  #undef GAPA
  #undef GAPB
  #undef EX
  #undef VRD
  #undef KRD
  #undef STEP
  #undef ENDW
  {auto rr=__builtin_amdgcn_permlane32_swap(__float_as_uint(l_reg),__float_as_uint(l_reg),false,false);l_reg=__uint_as_float(rr[0])+__uint_as_float(rr[1]);}
  if(hi==0)wsf[32+r32]=l_reg;asm volatile("s_waitcnt lgkmcnt(0)":::"memory");
  float rli[16];
  #pragma unroll
  for(int r=0;r<16;++r)rli[r]=__builtin_amdgcn_rcpf(wsf[32+crow(r,hi)]);
  bf16*Ow=O+(rowbase+q0+wid*QBLK)*PO+j*128+vh*64;
  { bf16*stg=(bf16*)(shm+LDS_OST)+wid*2048;
    #pragma unroll
    for(int r=0;r<16;++r){const int orow=crow(r,hi);
      #pragma unroll
      for(int d0=0;d0<2;++d0)stg[orow*64+d0*32+r32]=__float2bfloat16(o[d0][r]*rli[r]);}
    asm volatile("s_waitcnt lgkmcnt(0)":::"memory");
    #pragma unroll
    for(int i=0;i<4;++i){const int row=i*8+(lane>>3),ch=lane&7; const u32x4 v=*(const u32x4*)(stg+row*64+ch*8); ATTN_STORE16(Ow+(long)row*PO+ch*8,v);} }
  asm volatile("s_waitcnt lgkmcnt(0)\n\ts_barrier":::"memory");
  #undef DMA_K
  #undef DMA_V
  #undef BINIT
  #undef START
  #undef RESC
  #undef ROT
}
constexpr int ATTN_LDS_BYTES=LDS_BYTES;
#undef SBAR
#undef WAIT_BAR
}

#define XB_TMO      128
#define XB_XCNT(j)  (256  + 64 * (j))
#define XB_XSUB(j)  (1280 + 64 * (j))
#define XB_XGEN(j)  (2304 + 64 * (j))
#define XB_TOP      3328
#define XB_TOPGEN   3392
#define XCD_BAR_WORDS 3456
#define XB_SPIN_CAP (1u << 18)
__device__ __forceinline__ unsigned xb_ld(unsigned* p)              { return __hip_atomic_load(p, __ATOMIC_RELAXED, __HIP_MEMORY_SCOPE_AGENT); }
__device__ __forceinline__ unsigned xb_add(unsigned* p, unsigned v) { return __hip_atomic_fetch_add(p, v, __ATOMIC_RELAXED, __HIP_MEMORY_SCOPE_AGENT); }
__device__ __forceinline__ unsigned xb_xcc_id() { return (unsigned)__builtin_amdgcn_s_getreg((3 << 11) | 20) & 0xFu; }
#define XB_SPIN(cond, bar) do { unsigned _sp = 0; while (cond) { __builtin_amdgcn_s_sleep(1); \
    if ((++_sp & 255u) == 0u) { if (xb_ld(&(bar)[XB_TMO])) break; if (_sp > XB_SPIN_CAP) { atomicAdd(&(bar)[XB_TMO], 1u); break; } } } } while (0)
struct XcdBarrier { unsigned* bar; unsigned x; volatile LAS unsigned* st; };
__device__ __forceinline__ XcdBarrier xcd_barrier_post(unsigned* bar, volatile LAS unsigned* st) {
    XcdBarrier b; b.bar = bar; b.x = xb_xcc_id(); b.st = st;
    if (threadIdx.x == 0) (void)xb_add(&bar[XB_XCNT(b.x)], 1u);
    return b;
}
__device__ __forceinline__ void xcd_barrier_complete(unsigned* bar, unsigned x, unsigned& nloc, unsigned& nx) {
    const unsigned G = gridDim.x * gridDim.y * gridDim.z;
    unsigned sum, cnt, mine, sp = 0u;
    for (;;) {
        sum = 0u; cnt = 0u; mine = 0u;
#pragma unroll
        for (unsigned j = 0; j < 16; ++j) { const unsigned c = xb_ld(&bar[XB_XCNT(j)]); sum += c; cnt += (c > 0u) ? 1u : 0u; mine = (j == x) ? c : mine; }
        if (sum == G) break;
        __builtin_amdgcn_s_sleep(1);
        if ((++sp & 255u) == 0u) { if (xb_ld(&bar[XB_TMO])) break; if (sp > XB_SPIN_CAP) { atomicAdd(&bar[XB_TMO], 1u); break; } }
    }
    nloc = mine > 0u ? mine : 1u; nx = cnt > 0u ? cnt : 1u;
}
__device__ __forceinline__ void xcd_barrier(const XcdBarrier& b) {
    asm volatile("s_waitcnt vmcnt(0)" ::: "memory");
    __syncthreads();
    if (threadIdx.x == 0) {
        unsigned* bar = b.bar;
        __builtin_amdgcn_s_waitcnt(0);
        unsigned nloc = b.st[0], nx = b.st[1];
        if (nloc == 0u) { xcd_barrier_complete(bar, b.x, nloc, nx); b.st[0] = nloc; b.st[1] = nx; }
        const unsigned old = xb_add(&bar[XB_XSUB(b.x)], 1u);
        const unsigned gen = old / nloc;
        if (old + 1u == (gen + 1u) * nloc) {
            __builtin_amdgcn_fence(__ATOMIC_RELEASE, "agent");
            asm volatile("s_waitcnt vmcnt(0)" ::: "memory");
            const unsigned og = xb_add(&bar[XB_TOP], 1u);
            const unsigned tg = og / nx;
            if (og + 1u == (tg + 1u) * nx) xb_add(&bar[XB_TOPGEN], 1u);
            else XB_SPIN(xb_ld(&bar[XB_TOPGEN]) == tg, bar);
            __builtin_amdgcn_fence(__ATOMIC_ACQUIRE, "agent");
            xb_add(&bar[XB_XGEN(b.x)], 1u);
            asm volatile("s_waitcnt vmcnt(0)" ::: "memory");
        } else {
            XB_SPIN(xb_ld(&bar[XB_XGEN(b.x)]) == gen, bar);
            __builtin_amdgcn_fence(__ATOMIC_ACQUIRE, "agent");
            asm volatile("s_waitcnt vmcnt(0)" ::: "memory");
        }
    }
    __syncthreads();
}

struct Frame {
    LAS unsigned char* lds;
    unsigned char* ws;
    gu32* ctl;
    int tid, lane, wave;
    int vcu, G;
};
__device__ __forceinline__ float wave_sum(float v) {
#pragma unroll
    for (int o = 1; o < 64; o <<= 1) v += __shfl_xor(v, o);
    return v;
}
struct TItem { const float* src; bf16* dst; int K, N; };
__device__ __forceinline__ void p0_load(const TItem& t, f32x4 (&v)[8], int wave, int lane) {
    const GAS float* sp = (const GAS float*)t.src + (size_t)(8 * (2 * wave + (lane >> 5))) * t.N + 4 * (lane & 31);
#pragma unroll
    for (int i = 0; i < 8; ++i) v[i] = *(const GAS f32x4*)(sp + (size_t)i * t.N);
}
__device__ __forceinline__ void p0_store(const TItem& t, const f32x4 (&v)[8], LAS unsigned char* img, int wave, int lane) {
    const int kg = 2 * wave + (lane >> 5), n4 = lane & 31;
#pragma unroll
    for (int x = 0; x < 4; ++x) { v4u w; w.x = pg8::cvt_pk_bf16(v[0][x], v[1][x]); w.y = pg8::cvt_pk_bf16(v[2][x], v[3][x]); w.z = pg8::cvt_pk_bf16(v[4][x], v[5][x]); w.w = pg8::cvt_pk_bf16(v[6][x], v[7][x]);
        *(LAS v4u*)(img + (4 * n4 + x) * 272 + kg * 16) = w; }
    asm volatile("s_waitcnt lgkmcnt(0)\n\ts_barrier" ::: "memory");
#pragma unroll
    for (int j = 0; j < 4; ++j) { const int n = 16 * wave + 4 * j + (lane >> 4), kc = lane & 15;
        const v4u o = *(const LAS v4u*)(img + n * 272 + kc * 16);
        *(GAS v4u*)(t.dst + (size_t)n * t.K + 8 * kc) = o; }
}
__device__ __forceinline__ int t5_bucket(int rel) {
    const int n = rel < 0 ? -rel : rel; int b;
    if (n < 8) b = n; else if (n < 12) b = 8; else if (n < 16) b = 9; else if (n < 23) b = 10; else if (n < 32) b = 11; else if (n < 46) b = 12; else if (n < 64) b = 13; else if (n < 91) b = 14; else b = 15;
    return b + (rel > 0 ? 16 : 0);
}

struct DenseSched {
    const bf16* A; const bf16* Bt; int nM, nN, nwg, G, c;
    __device__ __forceinline__ void init(const bf16* A_, const bf16* Bt_, int M_, int N_, int G_, int c_) { A = A_; Bt = Bt_; nM = M_ / 256; nN = N_ / 256; nwg = nM * nN; G = G_; c = c_; }
    __device__ __forceinline__ bool next(int i, pg8::Unit& u) const {
        const long L = (long)i * G + c; if (L >= nwg) return false;
        int wgid = (int)L; { const int q = nwg / 8, r = nwg % 8, xcd = wgid % 8, off = wgid / 8; wgid = (xcd < r ? xcd * (q + 1) : r * (q + 1) + (xcd - r) * q) + off; }
        const int nig = 8 * nN, gid = wgid / nig, fm = gid * 8, gsz = (nM - fm) < 8 ? (nM - fm) : 8;
        u.pm = fm + ((wgid % nig) % gsz); u.pn = (wgid % nig) / gsz; u.e = 0; u.lrow0 = 0; u.cnt = 0; return true;
    }
    __device__ __forceinline__ const char* a_base(const pg8::Unit& u) const { return (const char*)A + (size_t)u.pm * (256 * 1024 * 2); }
    __device__ __forceinline__ const char* b_base(const pg8::Unit& u) const { return (const char*)Bt + (size_t)u.pn * (256 * 1024 * 2); }
    __device__ __forceinline__ size_t b_hstep() const { return (size_t)128 * 1024 * 2; }
    __device__ __forceinline__ void a_voff(const pg8::Unit&, const int (&R)[2], const int (&C)[2], unsigned (&v0)[2], unsigned (&v1)[2]) const {
#pragma unroll
        for (int i = 0; i < 2; ++i) { v0[i] = (unsigned)(R[i] * 1024 + C[i]) * 2u; v1[i] = v0[i] + 128u * 1024u * 2u; } }
    __device__ __forceinline__ const bf16* a_row(const pg8::Unit& u, int r) const { return A + (size_t)(u.pm * 256 + r) * 1024; }
    __device__ __forceinline__ const bf16* b_row(const pg8::Unit& u, int c_) const { return Bt + (size_t)(u.pn * 256 + c_) * 1024; }
};
struct MoeSched {
    const bf16* A; const bf16* W; const int* rowtok; const LAS int* pexp; const LAS int* pfirst; const LAS int* cntl;
    int NP, NT, G, vcu; bool gather; size_t wexp  , wtile  , whalf;
    __device__ __forceinline__ bool next(int i, pg8::Unit& u) const {
        const int L = i * G + vcu; if (L >= NP * NT) return false;
        const int pi = L / NT; const int e = __builtin_amdgcn_readfirstlane(pexp[pi]);
        u.pm = pi; u.pn = L - pi * NT; u.e = e; u.lrow0 = (pi - __builtin_amdgcn_readfirstlane(pfirst[e])) * 256; u.cnt = __builtin_amdgcn_readfirstlane(cntl[e]); return true;
    }
    __device__ __forceinline__ const char* a_base(const pg8::Unit& u) const { return gather ? (const char*)A : (const char*)A + (size_t)u.pm * (256 * 1024 * 2); }
    __device__ __forceinline__ const char* b_base(const pg8::Unit& u) const { return (const char*)W + (size_t)u.e * wexp + (size_t)u.pn * wtile; }
    __device__ __forceinline__ size_t b_hstep() const { return whalf; }
    __device__ __forceinline__ int tok_of(const pg8::Unit& u, int r) const { const int lr = u.lrow0 + r; return lr < u.cnt ? ((const GAS int*)rowtok)[u.e * ECAP + lr] : 0; }
    __device__ __forceinline__ void a_voff(const pg8::Unit& u, const int (&R)[2], const int (&C)[2], unsigned (&v0)[2], unsigned (&v1)[2]) const {
        if (gather) {
#pragma unroll
            for (int i = 0; i < 2; ++i) { v0[i] = (unsigned)(tok_of(u, R[i]) * 1024 + C[i]) * 2u; v1[i] = (unsigned)(tok_of(u, 128 + R[i]) * 1024 + C[i]) * 2u; }
        } else {
#pragma unroll
            for (int i = 0; i < 2; ++i) { v0[i] = (unsigned)(R[i] * 1024 + C[i]) * 2u; v1[i] = v0[i] + 128u * 1024u * 2u; }
        }
    }
    __device__ __forceinline__ const bf16* a_row(const pg8::Unit& u, int r) const { return gather ? A + (size_t)tok_of(u, r) * 1024 : A + (size_t)(u.pm * 256 + r) * 1024; }
    __device__ __forceinline__ const bf16* b_row(const pg8::Unit& u, int c_) const { return (const bf16*)((const char*)W + (size_t)u.e * wexp + (size_t)u.pn * wtile + (c_ >= 128 ? whalf : 0) + (size_t)(c_ & 127) * 2048); }
};

struct EpiQKVU {
    static constexpr bool PERM = true;
    bf16* O; size_t stride;
    __device__ __forceinline__ void operator()(const pg8::f32x4 (&acc)[2][2][4][2], const pg8::Unit& u, int wr, int wc, int fr, int fq) const {
        const int t = u.pn >> 1; const float sc = t == 0 ? QSCALE : 1.f;
        bf16* base = O + (size_t)t * stride; const int col0 = (u.pn & 1) * 256 + wc * 32 + 8 * fq; const int row0 = u.pm * 256 + wr * 64 + fr;
#pragma unroll
        for (int ai = 0; ai < 2; ++ai)
#pragma unroll
            for (int m = 0; m < 4; ++m) { bf16* rowp = base + (size_t)(row0 + ai * 128 + m * 16) * 512 + col0;
#pragma unroll
                for (int bj = 0; bj < 2; ++bj) { const pg8::f32x4 v0 = acc[ai][bj][m][0] * sc, v1 = acc[ai][bj][m][1] * sc;
                    pg8::u32x4 w; w.x = pg8::cvt_pk_bf16(v0[0], v0[1]); w.y = pg8::cvt_pk_bf16(v0[2], v0[3]); w.z = pg8::cvt_pk_bf16(v1[0], v1[1]); w.w = pg8::cvt_pk_bf16(v1[2], v1[3]);
                    *(pg8::u32x4*)(rowp + bj * 128) = w; } }
    }
};
struct EpiT1 {
    static constexpr bool PERM = false;
    const float* x; const float* mod; float* T1;
    __device__ __forceinline__ void operator()(const pg8::f32x4 (&acc)[2][2][4][2], const pg8::Unit& u, int wr, int wc, int fr, int fq) const {
        const int b = u.pm >> 3; const float* g1 = mod + (size_t)b * 6144 + 2048;
        const int col0 = u.pn * 256 + wc * 32 + 4 * fq;
        pg8::f32x4 gv[2][2];
#pragma unroll
        for (int bj = 0; bj < 2; ++bj)
#pragma unroll
            for (int n = 0; n < 2; ++n) gv[bj][n] = *(const pg8::f32x4*)(g1 + col0 + bj * 128 + n * 16);
#pragma unroll
        for (int ai = 0; ai < 2; ++ai)
#pragma unroll
            for (int m = 0; m < 4; ++m) { const size_t off = (size_t)(u.pm * 256 + ai * 128 + wr * 64 + m * 16 + fr) * 1024 + col0;
#pragma unroll
                for (int bj = 0; bj < 2; ++bj)
#pragma unroll
                    for (int n = 0; n < 2; ++n) { const pg8::f32x4 xv = *(const pg8::f32x4*)(x + off + bj * 128 + n * 16);
                        *(pg8::f32x4*)(T1 + off + bj * 128 + n * 16) = xv * DN_ALPHA + gv[bj][n] * acc[ai][bj][m][n]; } }
    }
};
struct EpiSwiglu {
    static constexpr bool PERM = true;
    const float* bgu; bf16* H;
    __device__ __forceinline__ void operator()(const pg8::f32x4 (&acc)[2][2][4][2], const pg8::Unit& u, int wr, int wc, int fr, int fq) const {
        const int c0 = u.pn * 128 + wc * 32 + 8 * fq; const float* bg = bgu + (size_t)u.e * 2048 + c0;
        pg8::f32x4 bgv[2], buv[2];
#pragma unroll
        for (int n = 0; n < 2; ++n) { bgv[n] = *(const pg8::f32x4*)(bg + 4 * n); buv[n] = *(const pg8::f32x4*)(bg + 1024 + 4 * n); }
#pragma unroll
        for (int ai = 0; ai < 2; ++ai)
#pragma unroll
            for (int m = 0; m < 4; ++m) { float r[8];
#pragma unroll
                for (int n = 0; n < 2; ++n)
#pragma unroll
                    for (int x = 0; x < 4; ++x) { const float g = fminf(acc[ai][0][m][n][x] + bgv[n][x], 7.0f); const float up = fminf(fmaxf(acc[ai][1][m][n][x] + buv[n][x], -7.0f), 7.0f);
                        const float sg = __builtin_amdgcn_rcpf(1.0f + __builtin_amdgcn_exp2f(-1.702f * LOG2E * g)); r[4 * n + x] = (up + 1.0f) * (g * sg); }
                pg8::u32x4 w; w.x = pg8::cvt_pk_bf16(r[0], r[1]); w.y = pg8::cvt_pk_bf16(r[2], r[3]); w.z = pg8::cvt_pk_bf16(r[4], r[5]); w.w = pg8::cvt_pk_bf16(r[6], r[7]);
                *(pg8::u32x4*)(H + (size_t)(u.pm * 256 + ai * 128 + wr * 64 + m * 16 + fr) * 1024 + c0) = w; }
    }
};
struct EpiDown {
    static constexpr bool PERM = true;
    const float* bd; bf16* Y;
    __device__ __forceinline__ void operator()(const pg8::f32x4 (&acc)[2][2][4][2], const pg8::Unit& u, int wr, int wc, int fr, int fq) const {
        const int c0 = u.pn * 256 + wc * 32 + 8 * fq; const float* bp = bd + (size_t)u.e * 1024 + c0;
        pg8::f32x4 bv[2][2];
#pragma unroll
        for (int bj = 0; bj < 2; ++bj)
#pragma unroll
            for (int n = 0; n < 2; ++n) bv[bj][n] = *(const pg8::f32x4*)(bp + bj * 128 + 4 * n);
#pragma unroll
        for (int ai = 0; ai < 2; ++ai)
#pragma unroll
            for (int m = 0; m < 4; ++m) { bf16* rowp = Y + (size_t)(u.pm * 256 + ai * 128 + wr * 64 + m * 16 + fr) * 1024 + c0;
#pragma unroll
                for (int bj = 0; bj < 2; ++bj) { const pg8::f32x4 v0 = acc[ai][bj][m][0] + bv[bj][0], v1 = acc[ai][bj][m][1] + bv[bj][1];
                    pg8::u32x4 w; w.x = pg8::cvt_pk_bf16(v0[0], v0[1]); w.y = pg8::cvt_pk_bf16(v0[2], v0[3]); w.z = pg8::cvt_pk_bf16(v1[0], v1[1]); w.w = pg8::cvt_pk_bf16(v1[2], v1[3]);
                    *(pg8::u32x4*)(rowp + bj * 128) = w; } }
    }
};

__device__ __forceinline__ void build_expert_tables(Frame& F) {
    LAS int* cntl = (LAS int*)(F.lds + L_CNT); LAS int* pfirst = (LAS int*)(F.lds + L_PFIRST); LAS int* pexp = (LAS int*)(F.lds + L_PEXP);
    __syncthreads();
    if (F.tid < NE) { int c = (int)__hip_atomic_load(F.ctl + CW_CNT + 64 * F.tid, RLX_AGENT); c = c < 0 ? 0 : (c > ECAP ? ECAP : c); cntl[F.tid] = c; }
    __syncthreads();
    if (F.tid == 0) { int p = 0; for (int e = 0; e < NE; ++e) { pfirst[e] = p; const int np = (cntl[e] + 255) >> 8; for (int k = 0; k < np; ++k) if (p + k < PMAX) pexp[p + k] = e; p += np; if (p > PMAX) p = PMAX; } pfirst[NE] = p; }
    __syncthreads();
}

struct Args { const float* in[25]; float* out; unsigned char* ws; int ph_lo, ph_hi; };
constexpr int NPHASE = 10;

__global__ void __launch_bounds__(NWAVES * 64, 2) mk_fwd(Args args) {
    extern __shared__ __attribute__((aligned(16))) unsigned char lds[];
    Frame F;
    F.lds = (LAS unsigned char*)lds; F.ws = args.ws; F.ctl = (gu32*)(args.ws + WS_CTL);
    F.tid = threadIdx.x; F.lane = F.tid & 63; F.wave = __builtin_amdgcn_readfirstlane(F.tid >> 6);
    F.G = gridDim.x; { const int bx = blockIdx.x; F.vcu = (F.G % 8 == 0) ? (bx % 8) * (F.G / 8) + bx / 8 : bx; }
    volatile LAS unsigned* MISC = (volatile LAS unsigned*)(F.lds + L_MISC);
    for (int u = F.tid; u < (LDS_BYTES - LCTL_OFF) / 4; u += NWAVES * 64) ((LAS unsigned*)(F.lds + LCTL_OFF))[u] = 0u;
    __syncthreads();
    XcdBarrier bar; bar.bar = (unsigned*)(F.ctl + CW_BAR); bar.x = 0; bar.st = nullptr;
#if MK_ONE_LAUNCH
    bar = xcd_barrier_post((unsigned*)(F.ctl + CW_BAR), MISC + 8);
#define GRID_BAR() xcd_barrier(bar)
#else
#define GRID_BAR() do { } while (0)
#endif
    const int lo = args.ph_lo, hi = args.ph_hi;
#ifndef PH_MASK
#define PH_MASK 0x3ff
#endif
#ifndef REP_MASK
#define REP_MASK 0x0
#endif
#define REPS(k) (1 + ((REP_MASK >> (k)) & 1))
#define IN(k) (((PH_MASK >> (k)) & 1) && lo <= (k) && (k) < hi)
#define BOTH(k) (IN(k) && IN((k) + 1))
    const float* x = args.in[0]; const float* cvec = args.in[1]; const float* w_ada = args.in[2]; const float* b_ada = args.in[3]; const float* w_in = args.in[4];
    const float* lq1 = args.in[5]; const float* lk1 = args.in[6]; const float* lq2 = args.in[7]; const float* lk2 = args.in[8]; const float* subln_g = args.in[9];
    const float* rel_bias = args.in[10]; const float* w_pool = args.in[11]; const float* b_pool = args.in[12]; const float* pool_scale = args.in[13]; const float* w_out = args.in[14];
    const float* ln1_g = args.in[15]; const float* ln1_b = args.in[16]; const float* w_router = args.in[17]; const float* b_router = args.in[18];
    const float* w_gu = args.in[19]; const float* b_gu = args.in[20]; const float* w_dn = args.in[21]; const float* b_dn = args.in[22]; const float* ln2_g = args.in[23]; const float* ln2_b = args.in[24];
    float* out = args.out; unsigned char* ws = args.ws;
    float* MOD = (float*)(ws + WS_MOD); bf16* WPOOL = (bf16*)(ws + WS_WPOOL); bf16* WIN = (bf16*)(ws + WS_WIN); bf16* WOUT = (bf16*)(ws + WS_WOUT);
    bf16* WGU = (bf16*)(ws + WS_WGU); bf16* WD = (bf16*)(ws + WS_WD); bf16* XN = (bf16*)(ws + WS_XN);
    bf16* QB = (bf16*)(ws + WS_Q); bf16* KB = (bf16*)(ws + WS_K); bf16* VB = (bf16*)(ws + WS_V); bf16* UB = (bf16*)(ws + WS_U);
    bf16* OA = (bf16*)(ws + WS_OA); bf16* MIX = (bf16*)(ws + WS_MIX); float* T1 = (float*)(ws + WS_T1); float* X1 = (float*)(ws + WS_X1); bf16* XN2 = (bf16*)(ws + WS_XN2);
    int* RE = (int*)(ws + WS_RE); int* RP = (int*)(ws + WS_RP); float* RG = (float*)(ws + WS_RG); int* ROWTOK = (int*)(ws + WS_ROWTOK);
    bf16* HB = (bf16*)(ws + WS_H); bf16* YB = (bf16*)(ws + WS_Y);
    const int gw = F.vcu * NWAVES + F.wave, NGW = F.G * NWAVES;
    unsigned long long dly_t0 = 0, dly_t1 = 0;

    if (DLY_PH == 0) dly_t0 = __builtin_amdgcn_s_memrealtime();
    if (IN(0)) _Pragma("unroll") for (int rep_ = 0; rep_ < REPS(0); ++rep_) {
        LAS float* sil = (LAS float*)(F.lds + 3 * 34816);
        for (int i = F.tid; i < NB * D; i += NWAVES * 64) { const float v = cvec[i]; sil[i] = v / (1.0f + __expf(-v)); }
        __syncthreads();
        constexpr int I_MOD = 6144 / 16, T_IN = (D / 128) * (NIN / 128), T_OUT = (D / 128) * (D / 128), T_POOL = 4, T_GU1 = (D / 128) * (2048 / 128), T_D1 = (FF / 128) * (D / 128);
        constexpr int NTR = T_IN + T_OUT + T_POOL + NE * T_GU1 + NE * T_D1;
        for (int r = NGW - 1 - gw; r < I_MOD; r += NGW) {
            const int kq = F.lane >> 4, col = r * 16 + (F.lane & 15); float a[NB];
#pragma unroll
            for (int b = 0; b < NB; ++b) a[b] = 0.f;
#pragma unroll 16
            for (int k = kq; k < D; k += 4) { const float w = ((const GAS float*)w_ada)[(size_t)k * 6144 + col];
#pragma unroll
                for (int b = 0; b < NB; ++b) a[b] += sil[b * D + k] * w; }
#pragma unroll
            for (int b = 0; b < NB; ++b) { a[b] += __shfl_xor(a[b], 16); a[b] += __shfl_xor(a[b], 32); }
            if (kq == 0) { const float bb = b_ada[col];
#pragma unroll
                for (int b = 0; b < NB; ++b) MOD[(size_t)b * 6144 + col] = a[b] + bb; }
        }
        for (int r0 = F.vcu; r0 < T_IN + T_OUT + T_POOL; r0 += F.G) {
            int r = r0; const float* W; bf16* WT; int K, N, item;
            if (r < T_IN) { W = w_in; WT = WIN; K = D; N = NIN; item = r; }
            else if ((r -= T_IN) < T_OUT) { W = w_out; WT = WOUT; K = D; N = D; item = r; }
            else { r -= T_OUT; W = w_pool + (size_t)r * 128 * 128; WT = WPOOL + (size_t)r * 128 * 128; K = 128; N = 128; item = 0; }
            const int nblk = N / 128, kb = item / nblk, nb = item - kb * nblk;
            TItem t; t.src = W + (size_t)(128 * kb) * N + 128 * nb; t.dst = WT + (size_t)(128 * nb) * K + 128 * kb; t.K = K; t.N = N;
            f32x4 bb[8]; p0_load(t, bb, F.wave, F.lane); p0_store(t, bb, F.lds, F.wave, F.lane);
            asm volatile("s_waitcnt lgkmcnt(0)\n\ts_barrier" ::: "memory");
        }
        auto pipe = [&](const float* W, bf16* WT, auto K_, auto N_, int ntiles) {
            constexpr int K = decltype(K_)::value, N = decltype(N_)::value, NBLK = N / 128, TPE = (K / 128) * NBLK;
            const int n_my = (ntiles - F.vcu + F.G - 1) / F.G;
            auto tile_of = [&](int q) -> TItem { const int qq = q < n_my ? q : n_my - 1; const int r = F.vcu + qq * F.G; const int e = r / TPE, item = r % TPE, kb = item / NBLK, nb = item % NBLK;
                TItem t; t.src = W + (size_t)e * K * N + (size_t)(128 * kb) * N + 128 * nb; t.dst = WT + (size_t)e * K * N + (size_t)(128 * nb) * K + 128 * kb; t.K = K; t.N = N; return t; };
            if (n_my > 0) {
                TItem t0 = tile_of(0), t1 = tile_of(1), t2; f32x4 b0[8], b1[8], b2[8];
                p0_load(t0, b0, F.wave, F.lane); p0_load(t1, b1, F.wave, F.lane);
                for (int q = 0; q < n_my; q += 3) {
                    t2 = tile_of(q + 2); p0_load(t2, b2, F.wave, F.lane); p0_store(t0, b0, F.lds, F.wave, F.lane);
                    t0 = tile_of(q + 3); p0_load(t0, b0, F.wave, F.lane); p0_store(t1, b1, F.lds + 34816, F.wave, F.lane);
                    t1 = tile_of(q + 4); p0_load(t1, b1, F.wave, F.lane); p0_store(t2, b2, F.lds + 2 * 34816, F.wave, F.lane);
                }
                asm volatile("s_waitcnt lgkmcnt(0)\n\ts_barrier" ::: "memory");
            }
        };
        pipe(w_gu, WGU, std::integral_constant<int, D>{}, std::integral_constant<int, 2048>{}, NE * T_GU1);
        pipe(w_dn, WD, std::integral_constant<int, FF>{}, std::integral_constant<int, D>{}, NE * T_D1);
        __syncthreads();
        if (BOTH(0) || rep_ + 1 < REPS(0)) GRID_BAR();
    }
    if (DLY_PH == 0) dly_t1 = __builtin_amdgcn_s_memrealtime();
    if (DLY_PH == 1) dly_t0 = __builtin_amdgcn_s_memrealtime();
    if (IN(1)) _Pragma("unroll") for (int rep_ = 0; rep_ < REPS(1); ++rep_) {
        for (int m = gw; m < M; m += NGW) {
            const int b = m >> 11; const float* sh = MOD + (size_t)b * 6144; const float* sc = sh + 1024;
            const GAS f32x4* xr = (const GAS f32x4*)(x + (size_t)m * D) + F.lane;
            f32x4 v[4]; float s = 0.f;
#pragma unroll
            for (int j = 0; j < 4; ++j) { v[j] = xr[64 * j]; s += (v[j].x + v[j].y) + (v[j].z + v[j].w); }
            const float mean = wave_sum(s) * (1.f / D); float s2 = 0.f;
#pragma unroll
            for (int j = 0; j < 4; ++j) { v[j] = v[j] - mean; s2 += (v[j].x * v[j].x + v[j].y * v[j].y) + (v[j].z * v[j].z + v[j].w * v[j].w); }
            const float rstd = 1.f / sqrtf(wave_sum(s2) * (1.f / D) + LN_EPS);
            GAS v2u* o8 = (GAS v2u*)(XN + (size_t)m * D) + F.lane;
#pragma unroll
            for (int j = 0; j < 4; ++j) { const f32x4 sv = *(const f32x4*)(sc + 4 * F.lane + 256 * j), hv = *(const f32x4*)(sh + 4 * F.lane + 256 * j);
                const f32x4 h = (v[j] * rstd) * (sv + 1.0f) + hv; v2u w; w.x = pk2(h.x, h.y); w.y = pk2(h.z, h.w); o8[64 * j] = w; }
        }
        if (BOTH(1) || rep_ + 1 < REPS(1)) GRID_BAR();
    }
    if (DLY_PH == 1) dly_t1 = __builtin_amdgcn_s_memrealtime();
    if (DLY_PH == 2) dly_t0 = __builtin_amdgcn_s_memrealtime();
    if (IN(2)) _Pragma("unroll") for (int rep_ = 0; rep_ < REPS(2); ++rep_) {
        DenseSched S; S.init(XN, WIN, M, NIN, F.G, (int)blockIdx.x);
        EpiQKVU E{QB, (size_t)(WS_K - WS_Q) / 2};
        pg8::gemm_phase<EpiQKVU, DenseSched, true>(F.lds, S, E);
        if (BOTH(2) || rep_ + 1 < REPS(2)) GRID_BAR();
    }
    if (DLY_PH == 2) dly_t1 = __builtin_amdgcn_s_memrealtime();
    if (DLY_PH == 3) dly_t0 = __builtin_amdgcn_s_memrealtime();
    if (IN(3)) _Pragma("unroll") for (int rep_ = 0; rep_ < REPS(3); ++rep_) {
        LAS float* tb = (LAS float*)(F.lds + L_TB);
        for (int i = F.tid; i < 4 * attn_body::TBN; i += NWAVES * 64) { const int h = i / attn_body::TBN, idx = i % attn_body::TBN; const int d = idx - attn_body::TBOFF;
            tb[i] = (d <= 63) ? (rel_bias[t5_bucket(d) * 4 + h] - rel_bias[15 * 4 + h]) * LOG2E : 0.f; }
        __syncthreads();
#if !NAIVE_ATTN
        for (int vv = F.vcu; vv < 256; vv += F.G) {
            const int bjm = vv >> 2, s = vv & 3, b = bjm >> 3, j = bjm & 7;
#pragma unroll 1
            for (int i = 0; i < 4; ++i) { const int vh = i >> 1, qb = (i & 1) ? 7 - s : s;
                attn_body::attn_unit<8>(b, j, vh, qb, (const attn_body::bf16*)QB, (const attn_body::bf16*)KB, (const attn_body::bf16*)VB, (attn_body::bf16*)OA, (char*)lds, tb + (j >> 1) * attn_body::TBN); }
        }
#else
        for (int idx = blockIdx.x * 512 + F.tid; idx < NB * 8 * 2 * SEQ; idx += F.G * 512) {
            const int q = idx & 2047, vh = (idx >> 11) & 1, j = (idx >> 12) & 7, b = idx >> 15, h = j >> 1;
            const bf16* qp = QB + (size_t)(b * SEQ + q) * 512 + j * 64; float qv[64];
#pragma unroll
            for (int d = 0; d < 64; ++d) qv[d] = pg8::bf2f(qp[d]);
            float o[64];
#pragma unroll
            for (int d = 0; d < 64; ++d) o[d] = 0.f;
            float mx = -INFINITY, l = 0.f; const int kend = ((q >> 6) + 1) << 6;
            for (int k = 0; k < kend; ++k) {
                const bf16* kp = KB + (size_t)(b * SEQ + k) * 512 + j * 64; float sdot = 0.f;
#pragma unroll
                for (int d = 0; d < 64; ++d) sdot += qv[d] * pg8::bf2f(kp[d]);
                const int dd = k - q; const int ti = dd + attn_body::TBOFF < 0 ? 0 : dd + attn_body::TBOFF; sdot += tb[h * attn_body::TBN + ti];
                const float mn = fmaxf(mx, sdot), f = exp2f(mx - mn), p = exp2f(sdot - mn); l = l * f + p; mx = mn;
                const bf16* vp = VB + (size_t)(b * SEQ + k) * 512 + h * 128 + vh * 64;
#pragma unroll
                for (int d = 0; d < 64; ++d) o[d] = o[d] * f + p * pg8::bf2f(vp[d]);
            }
            bf16* op = OA + (size_t)(b * SEQ + q) * 1024 + j * 128 + vh * 64; const float il = 1.0f / l;
#pragma unroll
            for (int d = 0; d < 64; ++d) op[d] = (bf16)f2bf(o[d] * il);
        }
#endif
        if (BOTH(3) || rep_ + 1 < REPS(3)) GRID_BAR();
    }
    if (DLY_PH == 3) dly_t1 = __builtin_amdgcn_s_memrealtime();
    if (DLY_PH == 4) dly_t0 = __builtin_amdgcn_s_memrealtime();
    if (IN(4)) _Pragma("unroll") for (int rep_ = 0; rep_ < REPS(4); ++rep_) {
        float lam;
        { const float a = lq1[F.lane] * lk1[F.lane], b2 = lq2[F.lane] * lk2[F.lane]; lam = __expf(wave_sum(a)) - __expf(wave_sum(b2)) + LAM_INIT; }
        for (int m0 = gw; m0 < M; m0 += 2 * NGW) {
            const int h = F.lane >> 4, e0 = (F.lane & 15) * 8; const bool two = m0 + NGW < M;
            v4u a[2], b2[2];
#pragma unroll
            for (int q = 0; q < 2; ++q) if (q == 0 || two) { const size_t m = (size_t)m0 + (size_t)q * NGW;
                a[q] = *(const GAS v4u*)(OA + m * 1024 + h * 256 + e0); b2[q] = *(const GAS v4u*)(OA + m * 1024 + h * 256 + 128 + e0); }
            const f32x4 g0 = *(const f32x4*)(subln_g + e0), g1v = *(const f32x4*)(subln_g + e0 + 4);
#pragma unroll
            for (int q = 0; q < 2; ++q) if (q == 0 || two) { const size_t m = (size_t)m0 + (size_t)q * NGW;
                float o[8];
                o[0] = bfl(a[q].x) - lam * bfl(b2[q].x); o[1] = bfh(a[q].x) - lam * bfh(b2[q].x); o[2] = bfl(a[q].y) - lam * bfl(b2[q].y); o[3] = bfh(a[q].y) - lam * bfh(b2[q].y);
                o[4] = bfl(a[q].z) - lam * bfl(b2[q].z); o[5] = bfh(a[q].z) - lam * bfh(b2[q].z); o[6] = bfl(a[q].w) - lam * bfl(b2[q].w); o[7] = bfh(a[q].w) - lam * bfh(b2[q].w);
                float ss = 0.f;
#pragma unroll
                for (int i = 0; i < 8; ++i) ss += o[i] * o[i];
                ss += __shfl_xor(ss, 1); ss += __shfl_xor(ss, 2); ss += __shfl_xor(ss, 4); ss += __shfl_xor(ss, 8);
                const float rs = (1.0f - LAM_INIT) / sqrtf(ss * (1.0f / 128.0f) + LN_EPS);
                v4u w; w.x = pk2(o[0] * rs * g0.x, o[1] * rs * g0.y); w.y = pk2(o[2] * rs * g0.z, o[3] * rs * g0.w); w.z = pk2(o[4] * rs * g1v.x, o[5] * rs * g1v.y); w.w = pk2(o[6] * rs * g1v.z, o[7] * rs * g1v.w);
                *(GAS v4u*)(MIX + m * 1024 + h * 128 + e0) = w; }
        }
        for (int it = gw; it < (M / 32) * 4; it += NGW) {
            const int g = it & 3, tile = it >> 2, row0 = tile * 32, r32 = F.lane & 31, hi = F.lane >> 5;
            const int row = row0 + r32, tpos = row & (SEQ - 1), tp0 = row0 & (SEQ - 1);
            LAS unsigned char* ut = F.lds + F.wave * 12800;
#pragma unroll
            for (int i = 0; i < 12; ++i) { const int pc = F.lane + 64 * i, rr = pc >> 4, c16 = pc & 15;
                if (rr < 47) { v4u v = (v4u){0u, 0u, 0u, 0u}; if (tp0 - 15 + rr >= 0) v = *(const GAS v4u*)(UB + (size_t)(row0 - 15 + rr) * 512 + g * 128 + c16 * 8); *(LAS v4u*)(ut + rr * 272 + c16 * 16) = v; } }
            LDS_WAIT(); asm volatile("" ::: "memory");
            bf16x8 pf[8];
            const LAS unsigned char* ub = ut + (r32 + 15) * 272 + hi * 16;
            auto pooled = [&](auto WIN_) {
                constexpr int WIN = decltype(WIN_)::value;
                const int nwin = tpos + 1 < WIN ? tpos + 1 : WIN; const float inv = 1.0f / (float)nwin;
#pragma unroll
                for (int s8 = 0; s8 < 8; ++s8) {
                    float sum[8];
#pragma unroll
                    for (int i = 0; i < 8; ++i) sum[i] = 0.f;
                    v4u self;
#pragma unroll
                    for (int k = 0; k < WIN; ++k) { const v4u u4 = *(const LAS v4u*)(ub - k * 272 + s8 * 32); if (k == 0) self = u4;
                        sum[0] += bfl(u4.x); sum[1] += bfh(u4.x); sum[2] += bfl(u4.y); sum[3] += bfh(u4.y); sum[4] += bfl(u4.z); sum[5] += bfh(u4.z); sum[6] += bfl(u4.w); sum[7] += bfh(u4.w); }
                    v4u w; w.x = pk2(sum[0] * inv - bfl(self.x), sum[1] * inv - bfh(self.x)); w.y = pk2(sum[2] * inv - bfl(self.y), sum[3] * inv - bfh(self.y));
                    w.z = pk2(sum[4] * inv - bfl(self.z), sum[5] * inv - bfh(self.z)); w.w = pk2(sum[6] * inv - bfl(self.w), sum[7] * inv - bfh(self.w));
                    pf[s8] = __builtin_bit_cast(bf16x8, w);
                }
            };
            if (g == 0) pooled(std::integral_constant<int, 2>{}); else if (g == 1) pooled(std::integral_constant<int, 4>{}); else if (g == 2) pooled(std::integral_constant<int, 8>{}); else pooled(std::integral_constant<int, 16>{});
            LDS_WAIT(); asm volatile("" ::: "memory");
#pragma unroll
            for (int db = 0; db < 4; ++db) {
                f32x16 acc = f32x16{};
                const bf16* wp = WPOOL + (size_t)g * 128 * 128 + (size_t)(db * 32 + r32) * 128 + hi * 8;
#pragma unroll
                for (int s8 = 0; s8 < 8; ++s8) { const bf16x8 wf = __builtin_bit_cast(bf16x8, *(const GAS v4u*)(wp + s8 * 16)); acc = __builtin_amdgcn_mfma_f32_32x32x16_bf16(wf, pf[s8], acc, 0, 0, 0); }
#pragma unroll
                for (int rq = 0; rq < 4; ++rq) { const int d0 = db * 32 + 8 * rq + 4 * hi; const int cg = g * 128 + d0;
                    const f32x4 bp = *(const f32x4*)(b_pool + cg), ps = *(const f32x4*)(pool_scale + cg);
                    v2u w; w.x = pk2((acc[4 * rq + 0] + bp.x) * ps.x, (acc[4 * rq + 1] + bp.y) * ps.y); w.y = pk2((acc[4 * rq + 2] + bp.z) * ps.z, (acc[4 * rq + 3] + bp.w) * ps.w);
                    *(GAS v2u*)(MIX + (size_t)row * 1024 + 512 + cg) = w; }
            }
        }
        if (BOTH(4) || rep_ + 1 < REPS(4)) GRID_BAR();
    }
    if (DLY_PH == 4) dly_t1 = __builtin_amdgcn_s_memrealtime();
    if (DLY_PH == 5) dly_t0 = __builtin_amdgcn_s_memrealtime();
    if (IN(5)) _Pragma("unroll") for (int rep_ = 0; rep_ < REPS(5); ++rep_) {
        DenseSched S; S.init(MIX, WOUT, M, D, F.G, (int)blockIdx.x);
        EpiT1 E{x, MOD, T1};
        pg8::gemm_phase<EpiT1, DenseSched, true>(F.lds, S, E);
        if (BOTH(5) || rep_ + 1 < REPS(5)) GRID_BAR();
    }
    if (DLY_PH == 5) dly_t1 = __builtin_amdgcn_s_memrealtime();
    if (DLY_PH == 6) dly_t0 = __builtin_amdgcn_s_memrealtime();
    if (IN(6)) _Pragma("unroll 1") for (int rep_ = 0; rep_ < REPS(6); ++rep_) {
        LAS float* H2 = (LAS float*)F.lds;
        LAS float* PART = (LAS float*)F.lds;
        LAS float* LOG = (LAS float*)(F.lds + 131200);
        LAS unsigned* hist = (LAS unsigned*)(F.lds + L_HIST); LAS unsigned* hbase = hist + 32;
        const int i32 = F.lane & 31, kh = F.lane >> 5, kb = F.wave * 128;
        float wreg[64];
#pragma unroll
        for (int kk = 0; kk < 64; ++kk) wreg[kk] = ((const GAS float*)w_router)[(size_t)(kb + 2 * kk + kh) * NE + i32];
        for (int tile = F.vcu; tile < M / 32; tile += F.G) {
            if (F.tid < 32) hist[F.tid] = 0u;
            const int b = (tile * 32) >> 11; const float* sh = MOD + (size_t)b * 6144 + 3072; const float* sc = sh + 1024;
#pragma unroll
            for (int pr = 0; pr < 2; ++pr) {
                f32x4 v[2][4];
#pragma unroll
                for (int r2 = 0; r2 < 2; ++r2) { const GAS f32x4* tr = (const GAS f32x4*)(T1 + (size_t)(tile * 32 + F.wave * 4 + 2 * pr + r2) * D) + F.lane;
#pragma unroll
                    for (int j = 0; j < 4; ++j) v[r2][j] = tr[64 * j]; }
#pragma unroll
                for (int r2 = 0; r2 < 2; ++r2) {
                    const int lr = F.wave * 4 + 2 * pr + r2, m = tile * 32 + lr;
                    float s = 0.f;
#pragma unroll
                    for (int j = 0; j < 4; ++j) s += (v[r2][j].x + v[r2][j].y) + (v[r2][j].z + v[r2][j].w);
                    float mean = wave_sum(s) * (1.f / D); float s2 = 0.f;
#pragma unroll
                    for (int j = 0; j < 4; ++j) { v[r2][j] = v[r2][j] - mean; s2 += (v[r2][j].x * v[r2][j].x + v[r2][j].y * v[r2][j].y) + (v[r2][j].z * v[r2][j].z + v[r2][j].w * v[r2][j].w); }
                    float rstd = 1.f / sqrtf(wave_sum(s2) * (1.f / D) + LN_EPS);
                    s = 0.f;
#pragma unroll
                    for (int j = 0; j < 4; ++j) { const f32x4 gvj = *(const f32x4*)(ln1_g + 4 * F.lane + 256 * j), bvj = *(const f32x4*)(ln1_b + 4 * F.lane + 256 * j);
                        v[r2][j] = (v[r2][j] * rstd) * gvj + bvj; ((GAS f32x4*)(X1 + (size_t)m * D) + F.lane)[64 * j] = v[r2][j]; s += (v[r2][j].x + v[r2][j].y) + (v[r2][j].z + v[r2][j].w); }
                    mean = wave_sum(s) * (1.f / D); s2 = 0.f;
#pragma unroll
                    for (int j = 0; j < 4; ++j) { v[r2][j] = v[r2][j] - mean; s2 += (v[r2][j].x * v[r2][j].x + v[r2][j].y * v[r2][j].y) + (v[r2][j].z * v[r2][j].z + v[r2][j].w * v[r2][j].w); }
                    rstd = 1.f / sqrtf(wave_sum(s2) * (1.f / D) + LN_EPS);
                    GAS v2u* o8 = (GAS v2u*)(XN2 + (size_t)m * D) + F.lane;
#pragma unroll
                    for (int j = 0; j < 4; ++j) { const f32x4 svj = *(const f32x4*)(sc + 4 * F.lane + 256 * j), hvj = *(const f32x4*)(sh + 4 * F.lane + 256 * j);
                        const f32x4 h = (v[r2][j] * rstd) * (svj + 1.0f) + hvj; v2u w; w.x = pk2(h.x, h.y); w.y = pk2(h.z, h.w); o8[64 * j] = w;
                        LAS float* hp = H2 + lr * 1025 + 4 * F.lane + 256 * j; hp[0] = h.x; hp[1] = h.y; hp[2] = h.z; hp[3] = h.w; }
                    asm volatile("" ::: "memory");
                }
            }
            __syncthreads();
            f32x16 acc = f32x16{};
#pragma unroll
            for (int kk = 0; kk < 64; ++kk) acc = __builtin_amdgcn_mfma_f32_32x32x2f32(H2[i32 * 1025 + kb + 2 * kk + kh], wreg[kk], acc, 0, 0, 0);
            __syncthreads();
#pragma unroll
            for (int r = 0; r < 16; ++r) PART[(F.wave * 32 + ((r & 3) + 8 * (r >> 2) + 4 * kh)) * 32 + i32] = acc[r];
            __syncthreads();
#pragma unroll
            for (int q = 0; q < 2; ++q) { const int idx = F.tid + 512 * q, i = idx >> 5, e = idx & 31; float sl = b_router[e];
#pragma unroll
                for (int w = 0; w < 8; ++w) sl += PART[(w * 32 + i) * 32 + e];
                LOG[i * 33 + e] = sl; }
            __syncthreads();
            int myk[2]; unsigned lrk[2]; float mygate[2];
#pragma unroll
            for (int it2 = 0; it2 < 2; ++it2) {
                const int rowl = F.wave * 4 + 2 * it2 + kh; float cur = LOG[rowl * 33 + i32]; float bvv[4]; myk[it2] = -1;
#pragma unroll
                for (int k = 0; k < 4; ++k) { float mv = cur; int me = i32;
#pragma unroll
                    for (int off = 1; off < 32; off <<= 1) { const float ov = __shfl_xor(mv, off); const int oe = __shfl_xor(me, off); if (ov > mv || (ov == mv && oe < me)) { mv = ov; me = oe; } }
                    bvv[k] = mv; if (me == i32) { cur = -INFINITY; myk[it2] = k; } }
                float ex[4], ssum = 0.f;
#pragma unroll
                for (int k = 0; k < 4; ++k) { ex[k] = __expf(bvv[k] - bvv[0]); ssum += ex[k]; }
                const float is = 1.0f / ssum; mygate[it2] = 0.f; lrk[it2] = 0u;
#pragma unroll
                for (int k = 0; k < 4; ++k) if (myk[it2] == k) mygate[it2] = ex[k] * is;
                if (myk[it2] >= 0) lrk[it2] = __hip_atomic_fetch_add(hist + i32, 1u, __ATOMIC_RELAXED, __HIP_MEMORY_SCOPE_WORKGROUP);
            }
            __syncthreads();
            if (F.tid < 32) { const unsigned n = hist[F.tid]; hbase[F.tid] = n ? __hip_atomic_fetch_add(F.ctl + (rep_ + 1 < REPS(6) ? CW_CNT + 4096 : CW_CNT) + 64 * F.tid, n, RLX_AGENT) : 0u; }
            __syncthreads();
#pragma unroll
            for (int it2 = 0; it2 < 2; ++it2) if (myk[it2] >= 0) { const int m = tile * 32 + F.wave * 4 + 2 * it2 + kh; const int pp = (int)(hbase[i32] + lrk[it2]);
                RE[m * 4 + myk[it2]] = i32; RP[m * 4 + myk[it2]] = pp; RG[m * 4 + myk[it2]] = mygate[it2]; if (pp < ECAP) ROWTOK[i32 * ECAP + pp] = m; }
            __syncthreads();
        }
        if (BOTH(6) || rep_ + 1 < REPS(6)) GRID_BAR();
    }
    if (DLY_PH == 6) dly_t1 = __builtin_amdgcn_s_memrealtime();
    if (DLY_PH == 7) dly_t0 = __builtin_amdgcn_s_memrealtime();
    if (IN(7)) _Pragma("unroll") for (int rep_ = 0; rep_ < REPS(7); ++rep_) {
        build_expert_tables(F);
        MoeSched S; S.A = XN2; S.W = WGU; S.rowtok = ROWTOK; S.pexp = (const LAS int*)(F.lds + L_PEXP); S.pfirst = (const LAS int*)(F.lds + L_PFIRST); S.cntl = (const LAS int*)(F.lds + L_CNT);
        S.NP = ((const LAS int*)(F.lds + L_PFIRST))[NE]; S.NT = 8; S.G = F.G; S.vcu = F.vcu; S.gather = true; S.wexp = (size_t)2048 * 1024 * 2; S.wtile = (size_t)128 * 1024 * 2; S.whalf = (size_t)1024 * 1024 * 2;
        EpiSwiglu E{b_gu, HB};
        pg8::gemm_phase<EpiSwiglu, MoeSched, true>(F.lds, S, E);
        if (BOTH(7) || rep_ + 1 < REPS(7)) GRID_BAR();
    }
    if (DLY_PH == 7) dly_t1 = __builtin_amdgcn_s_memrealtime();
    if (DLY_PH == 8) dly_t0 = __builtin_amdgcn_s_memrealtime();
    if (IN(8)) _Pragma("unroll") for (int rep_ = 0; rep_ < REPS(8); ++rep_) {
        build_expert_tables(F);
        MoeSched S; S.A = HB; S.W = WD; S.rowtok = ROWTOK; S.pexp = (const LAS int*)(F.lds + L_PEXP); S.pfirst = (const LAS int*)(F.lds + L_PFIRST); S.cntl = (const LAS int*)(F.lds + L_CNT);
        S.NP = ((const LAS int*)(F.lds + L_PFIRST))[NE]; S.NT = 4; S.G = F.G; S.vcu = F.vcu; S.gather = false; S.wexp = (size_t)1024 * 1024 * 2; S.wtile = (size_t)256 * 1024 * 2; S.whalf = (size_t)128 * 1024 * 2;
        EpiDown E{b_dn, YB};
        pg8::gemm_phase<EpiDown, MoeSched, true>(F.lds, S, E);
        if (BOTH(8) || rep_ + 1 < REPS(8)) GRID_BAR();
    }
    if (DLY_PH == 8) dly_t1 = __builtin_amdgcn_s_memrealtime();
    if (DLY_PH == 9) dly_t0 = __builtin_amdgcn_s_memrealtime();
    if (IN(9)) _Pragma("unroll") for (int rep_ = 0; rep_ < REPS(9); ++rep_) {
        build_expert_tables(F);
        const LAS int* pfirst = (const LAS int*)(F.lds + L_PFIRST);
        const unsigned bad = __hip_atomic_load(F.ctl + CW_BAR + XB_TMO, RLX_AGENT);
        for (int m = gw; m < M; m += NGW) {
            const int b = m >> 11; const float* g2 = MOD + (size_t)b * 6144 + 5120;
            f32x4 a[4];
#pragma unroll
            for (int j = 0; j < 4; ++j) a[j] = (f32x4){0.f, 0.f, 0.f, 0.f};
#pragma unroll
            for (int k = 0; k < 4; ++k) { const int e = __builtin_amdgcn_readfirstlane(RE[m * 4 + k]), p = __builtin_amdgcn_readfirstlane(RP[m * 4 + k]); const float gk = RG[m * 4 + k];
                const size_t yrow = (size_t)pfirst[e] * 256 + (size_t)p; const GAS v2u* yp = (const GAS v2u*)(YB + yrow * 1024) + F.lane;
#pragma unroll
                for (int j = 0; j < 4; ++j) { const v2u w = yp[64 * j]; a[j] += (f32x4){bfl(w.x), bfh(w.x), bfl(w.y), bfh(w.y)} * gk; } }
            f32x4 v[4]; float s = 0.f;
#pragma unroll
            for (int j = 0; j < 4; ++j) { const f32x4 xv = ((const GAS f32x4*)(X1 + (size_t)m * D) + F.lane)[64 * j]; const f32x4 gv = *(const f32x4*)(g2 + 4 * F.lane + 256 * j);
                v[j] = xv * DN_ALPHA + gv * a[j]; s += (v[j].x + v[j].y) + (v[j].z + v[j].w); }
            const float mean = wave_sum(s) * (1.f / D); float s2 = 0.f;
#pragma unroll
            for (int j = 0; j < 4; ++j) { v[j] = v[j] - mean; s2 += (v[j].x * v[j].x + v[j].y * v[j].y) + (v[j].z * v[j].z + v[j].w * v[j].w); }
            const float rstd = 1.f / sqrtf(wave_sum(s2) * (1.f / D) + LN_EPS);
#pragma unroll
            for (int j = 0; j < 4; ++j) { const f32x4 gv = *(const f32x4*)(ln2_g + 4 * F.lane + 256 * j), bv = *(const f32x4*)(ln2_b + 4 * F.lane + 256 * j);
                f32x4 o = (v[j] * rstd) * gv + bv; if (bad) { const float qn = __builtin_nanf(""); o = (f32x4){qn, qn, qn, qn}; }
                ((GAS f32x4*)(out + (size_t)m * D) + F.lane)[64 * j] = o; }
        }
    }
    if (DLY_PH >= 0) { if (DLY_PH == 9) dly_t1 = __builtin_amdgcn_s_memrealtime(); const unsigned long long te = __builtin_amdgcn_s_memrealtime(); while (__builtin_amdgcn_s_memrealtime() - te < dly_t1 - dly_t0) __builtin_amdgcn_s_sleep(8); }
#undef IN
#undef BOTH
}

extern "C" void kernel_launch(void* const* d_in, const int* in_sizes, int n_in, void* d_out, int out_size, void* d_ws, size_t ws_size, hipStream_t stream) {
    static int grid = 0;
    if (grid == 0) {
        if (n_in != 25 || in_sizes[0] != M * D || out_size != M * D || ws_size < WS_END) { fprintf(stderr, "kernel_launch: unexpected shapes (n_in %d, in0 %d, out %d, ws %zu); nothing launched\n", n_in, n_in > 0 ? in_sizes[0] : -1, out_size, ws_size); grid = -1; return; }
        int dev = 0, cus = 0, per_cu = 0;
        if (hipGetDevice(&dev) != hipSuccess || hipDeviceGetAttribute(&cus, hipDeviceAttributeMultiprocessorCount, dev) != hipSuccess) { grid = -1; return; }
        if (hipFuncSetAttribute((const void*)mk_fwd, hipFuncAttributeMaxDynamicSharedMemorySize, LDS_BYTES) != hipSuccess) { fprintf(stderr, "kernel_launch: hipFuncSetAttribute failed\n"); grid = -1; return; }
        if (hipOccupancyMaxActiveBlocksPerMultiprocessor(&per_cu, (const void*)mk_fwd, NWAVES * 64, LDS_BYTES) != hipSuccess || per_cu < 1) { fprintf(stderr, "kernel_launch: occupancy query reports %d workgroups per CU\n", per_cu); (void)hipGetLastError(); }
        grid = cus;
    }
    if (grid < 0) return;
    if (hipMemsetAsync((char*)d_ws + WS_CTL, 0, CTL_ZERO_BYTES, stream) != hipSuccess) return;
    Args a{};
    for (int i = 0; i < 25; ++i) a.in[i] = (const float*)d_in[i];
    a.out = (float*)d_out; a.ws = (unsigned char*)d_ws;
#if MK_ONE_LAUNCH
    a.ph_lo = 0; a.ph_hi = NPHASE;
    hipLaunchKernelGGL(mk_fwd, dim3(grid), dim3(NWAVES * 64), LDS_BYTES, stream, a);
#else
    for (int p = 0; p < NPHASE; ++p) { a.ph_lo = p; a.ph_hi = p + 1; hipLaunchKernelGGL(mk_fwd, dim3(grid), dim3(NWAVES * 64), LDS_BYTES, stream, a); }
#endif
}
```

```cpp
#include <hip/hip_runtime.h>
#include <hip/hip_bf16.h>
#include <cstdio>
#include <cstdint>
#include <cmath>
#include <type_traits>

#ifndef MK_ONE_LAUNCH
#define MK_ONE_LAUNCH 1
#endif
#ifndef NAIVE_GEMM
#define NAIVE_GEMM 0
#endif
#ifndef DLY_PH
#define DLY_PH (-1)
#endif
#ifndef NAIVE_ATTN
#define NAIVE_ATTN 0
#endif

#define GAS __attribute__((address_space(1)))
#define LAS __attribute__((address_space(3)))

constexpr int NB = 8, SEQ = 2048, D = 1024, M = NB * SEQ;
constexpr int AW = 512;
constexpr int NIN = 2048;
constexpr int NE = 32, TOPK = 4, FF = 1024;
constexpr int ECAP = 16384;
constexpr int PMAX = (M * TOPK) / 256 + NE;
constexpr float LN_EPS = 1e-5f;
constexpr float DN_ALPHA = 1.189207115002721f;
constexpr float LAM_INIT = 0.2f;
constexpr float LOG2E = 1.4426950408889634f;
constexpr float QSCALE = 0.125f * LOG2E;
constexpr int NWAVES = 8;

namespace pg8 {
#define PG8_LAS __attribute__((address_space(3)))
typedef unsigned short bf16_t;
typedef short bf16x8 __attribute__((ext_vector_type(8)));
typedef float f32x4 __attribute__((ext_vector_type(4)));
typedef unsigned u32x4 __attribute__((ext_vector_type(4)));
constexpr int BM = 256, BK = 64, HALF = 128, HTB = HALF * BK * 2, STAGE_BYTES = 8 * HTB, NXCD = 8, WGM = 8;
constexpr int GK = 1024;

__host__ __device__ __forceinline__ int lds_byte(int r, int c) { const int st = (r >> 4) * 2 + (c >> 5), rr = r & 15, cc = c & 31, ob = rr * 64 + cc * 2; return st * 1024 + (ob ^ (((ob >> 9) & 1) << 5)); }
__host__ __device__ __forceinline__ void stage_rc(int b, int& R, int& C) { const int st = b / 1024, sb = b % 1024, swz = sb ^ (((sb >> 9) & 1) << 5); R = (st >> 1) * 16 + swz / 64; C = (st & 1) * 32 + (swz % 64) / 2; }
__host__ __device__ __forceinline__ int perm32(int rho) { const int n = rho >> 4, i = rho & 15; return 8 * (i >> 2) + 4 * n + (i & 3); }

struct Unit { int pm, pn, e, lrow0, cnt; };

__device__ __forceinline__ unsigned cvt_pk_bf16(float lo, float hi) { unsigned r; asm volatile("v_cvt_pk_bf16_f32 %0, %1, %2" : "=v"(r) : "v"(lo), "v"(hi)); return r; }
__device__ __forceinline__ float bf2f(unsigned short v) { return __uint_as_float((unsigned)v << 16); }

#if !NAIVE_GEMM
typedef int v8i32 __attribute__((ext_vector_type(8)));
typedef int v4i32 __attribute__((ext_vector_type(4)));
template <class Epi, class Sched, bool ALIGN_EPI, bool FP8 = false>
__device__ __forceinline__ void gemm_phase(PG8_LAS unsigned char* lds, const Sched& S, const Epi& E) {
    constexpr int RB = FP8 ? 1024 : 2048, nt = RB / 128;
    const int tid = threadIdx.x, wid = __builtin_amdgcn_readfirstlane(tid >> 6), lane = tid & 63, wr = wid >> 2, wc = wid & 3, fr = lane & 15, fq = lane >> 4;
    int Rr[2], Cc[2]; unsigned voffB[2];
#pragma unroll
    for (int i = 0; i < 2; ++i) { int R, C; stage_rc(tid * 16 + i * 8192, R, C); Rr[i] = R; Cc[i] = C; const int Rb = Epi::PERM ? ((R & ~31) + perm32(R & 31)) : R; voffB[i] = (unsigned)(Rb * RB + C * 2); }
    const size_t kstep = (size_t)(BK * 2);
    const size_t hB = S.b_hstep();
    const unsigned ldsw = (unsigned)wid * 1024u;
    const int aoff = lds_byte(wr * 64 + fr, fq * 8), boff = lds_byte(wc * 32 + fr, fq * 8);
#define PG8_SA(b, h) (((b) * 2 + (h)) * HTB)
#define PG8_SB(b, h) ((4 + (b) * 2 + (h)) * HTB)
#define PG8_STAGE(bufoff, gbase, voff) do { _Pragma("unroll") for (int _i = 0; _i < 2; ++_i) \
        __builtin_amdgcn_global_load_lds((const unsigned*)((const char*)(gbase) + (voff)[_i]), (PG8_LAS unsigned*)(lds + (bufoff) + ldsw + _i * 8192), 16, 0, 0); } while (0)
#define PG8_LD32(p) __builtin_shufflevector(*(const PG8_LAS v4i32*)(p), *(const PG8_LAS v4i32*)((p) + 1024), 0, 1, 2, 3, 4, 5, 6, 7)
#define PG8_LDA(dst, b, h) do { if constexpr (FP8) { _Pragma("unroll") for (int m = 0; m < 4; ++m) dst##8[m] = PG8_LD32(lds + PG8_SA(b, h) + aoff + m * 2048); } \
        else { _Pragma("unroll") for (int m = 0; m < 4; ++m) _Pragma("unroll") for (int k = 0; k < 2; ++k) dst[m][k] = *(const PG8_LAS bf16x8*)(lds + PG8_SA(b, h) + aoff + m * 2048 + k * 1024); } } while (0)
#define PG8_LDB(dst, b, h) do { if constexpr (FP8) { _Pragma("unroll") for (int n = 0; n < 2; ++n) dst##8[n] = PG8_LD32(lds + PG8_SB(b, h) + boff + n * 2048); } \
        else { _Pragma("unroll") for (int n = 0; n < 2; ++n) _Pragma("unroll") for (int k = 0; k < 2; ++k) dst[n][k] = *(const PG8_LAS bf16x8*)(lds + PG8_SB(b, h) + boff + n * 2048 + k * 1024); } } while (0)
#define PG8_CAT(x) __builtin_shufflevector(__builtin_bit_cast(v4i32, (x)[0]), __builtin_bit_cast(v4i32, (x)[1]), 0, 1, 2, 3, 4, 5, 6, 7)
#define PG8_MMA(ai, bj, At, Bt) do { __builtin_amdgcn_s_setprio(1); \
        if constexpr (FP8) { _Pragma("unroll") for (int m = 0; m < 4; ++m) _Pragma("unroll") for (int n = 0; n < 2; ++n) \
            asm volatile("v_mfma_scale_f32_16x16x128_f8f6f4 %0, %1, %2, %0, %3, %3 op_sel_hi:[0,0,0]" : "+v"(acc[ai][bj][m][n]) : "v"(Bt##8[n]), "v"(At##8[m]), "v"(one8)); } \
        else { _Pragma("unroll") for (int m = 0; m < 4; ++m) _Pragma("unroll") for (int n = 0; n < 2; ++n) _Pragma("unroll") for (int k = 0; k < 2; ++k) \
            acc[ai][bj][m][n] = __builtin_amdgcn_mfma_f32_16x16x32_bf16(Bt[n][k], At[m][k], acc[ai][bj][m][n], 0, 0, 0); } \
        __builtin_amdgcn_s_setprio(0); } while (0)
#define PG8_WAIT_V(n) asm volatile("s_waitcnt vmcnt(" #n ")" ::: "memory")
#define PG8_WAIT_L(n) asm volatile("s_waitcnt lgkmcnt(" #n ")" ::: "memory")
#define PG8_BAR __builtin_amdgcn_s_barrier()
#define PG8_SCHED __builtin_amdgcn_sched_barrier(0)
    Unit cur, nxt; int ui = 0;
    if (!S.next(0, cur)) return;
    f32x4 acc[2][2][4][2];
#pragma unroll
    for (int a = 0; a < 2; ++a)
#pragma unroll
        for (int b = 0; b < 2; ++b)
#pragma unroll
            for (int m = 0; m < 4; ++m)
#pragma unroll
                for (int n = 0; n < 2; ++n) acc[a][b][m][n] = (f32x4){0.f, 0.f, 0.f, 0.f};
    const int one8 = 0x7f7f7f7f;
    bf16x8 At[4][2], B0[2][2], B1[2][2]; v8i32 At8[4], B08[2], B18[2];
    const char* cA = S.a_base(cur); const char* cB = S.b_base(cur);
    unsigned va0[2], va1[2];
    S.a_voff(cur, Rr, Cc, va0, va1);
    PG8_STAGE(PG8_SB(0, 0), cB, voffB); PG8_STAGE(PG8_SB(0, 1), cB + hB, voffB); PG8_STAGE(PG8_SA(0, 0), cA, va0); PG8_STAGE(PG8_SA(0, 1), cA, va1);
    if (wr == 1) PG8_BAR;
    PG8_WAIT_V(2); PG8_BAR;
    PG8_STAGE(PG8_SB(1, 0), cB + kstep, voffB); PG8_STAGE(PG8_SA(1, 0), cA + kstep, va0); PG8_STAGE(PG8_SB(1, 1), cB + hB + kstep, voffB);
    PG8_WAIT_V(6); PG8_BAR;
    for (;;) {
        const bool has_next = S.next(ui + 1, nxt);
        const char* nA = has_next ? S.a_base(nxt) : cA; const char* nB = has_next ? S.b_base(nxt) : cB;
        unsigned vn0[2], vn1[2];
        if (has_next) S.a_voff(nxt, Rr, Cc, vn0, vn1); else { vn0[0] = va0[0]; vn0[1] = va0[1]; vn1[0] = va1[0]; vn1[1] = va1[1]; }
#pragma unroll 1
        for (int t = 0; t < nt; t += 2) {
            const bool last = (t == nt - 2);
            const char* a1 = cA + (size_t)(t + 1) * kstep;
            const char* a2 = last ? nA : cA + (size_t)(t + 2) * kstep; const char* b2 = last ? nB : cB + (size_t)(t + 2) * kstep;
            const char* a3 = a2 + kstep; const char* b3 = b2 + kstep;
            asm volatile("" : "+v"(voffB[0]), "+v"(voffB[1]), "+v"(va0[0]), "+v"(va0[1]), "+v"(va1[0]), "+v"(va1[1]));
            unsigned v20[2], v21[2];
            v20[0] = last ? vn0[0] : va0[0]; v20[1] = last ? vn0[1] : va0[1]; v21[0] = last ? vn1[0] : va1[0]; v21[1] = last ? vn1[1] : va1[1];
            PG8_LDB(B0, 0, 0); PG8_LDB(B1, 0, 1); PG8_SCHED; PG8_LDA(At, 0, 0); PG8_STAGE(PG8_SA(1, 1), a1, va1);
            PG8_WAIT_V(8); PG8_WAIT_L(0); PG8_BAR; PG8_MMA(0, 0, At, B0); PG8_MMA(0, 1, At, B1); PG8_BAR; PG8_SCHED;
            PG8_LDA(At, 0, 1); PG8_STAGE(PG8_SB(0, 0), b2, voffB); PG8_STAGE(PG8_SB(0, 1), b2 + hB, voffB); PG8_STAGE(PG8_SA(0, 0), a2, v20);
            PG8_WAIT_V(8); PG8_WAIT_L(0); PG8_BAR; PG8_MMA(1, 0, At, B0); PG8_MMA(1, 1, At, B1); PG8_BAR; PG8_SCHED;
            PG8_LDB(B0, 1, 0); PG8_LDB(B1, 1, 1); PG8_SCHED; PG8_LDA(At, 1, 0); PG8_STAGE(PG8_SA(0, 1), a2, v21);
            PG8_WAIT_V(8); PG8_WAIT_L(0); PG8_BAR; PG8_MMA(0, 0, At, B0); PG8_MMA(0, 1, At, B1); PG8_BAR; PG8_SCHED;
            PG8_LDA(At, 1, 1); PG8_STAGE(PG8_SB(1, 0), b3, voffB); PG8_STAGE(PG8_SB(1, 1), b3 + hB, voffB); PG8_STAGE(PG8_SA(1, 0), a3, v20);
            PG8_WAIT_V(8); PG8_WAIT_L(0); PG8_BAR; PG8_MMA(1, 0, At, B0); PG8_MMA(1, 1, At, B1); PG8_BAR; PG8_SCHED;
        }
        if constexpr (ALIGN_EPI) { if (wr == 0) PG8_BAR; }
        if constexpr (FP8) asm volatile("s_nop 15\n\ts_nop 15" ::: "memory");
        { int fr_ = fr, fq_ = fq; asm volatile("" : "+v"(fr_), "+v"(fq_));
          E(acc, cur, wr, wc, fr_, fq_); }
        if (!has_next) break;
#pragma unroll
        for (int a = 0; a < 2; ++a)
#pragma unroll
            for (int b = 0; b < 2; ++b)
#pragma unroll
                for (int m = 0; m < 4; ++m)
#pragma unroll
                    for (int n = 0; n < 2; ++n) acc[a][b][m][n] = (f32x4){0.f, 0.f, 0.f, 0.f};
        cur = nxt; cA = nA; cB = nB; va0[0] = vn0[0]; va0[1] = vn0[1]; va1[0] = vn1[0]; va1[1] = vn1[1]; ++ui;
        if constexpr (ALIGN_EPI) { if (wr == 1) PG8_BAR; }
    }
    PG8_WAIT_V(0);
    if constexpr (!ALIGN_EPI) { if (wr == 0) PG8_BAR; }
    PG8_BAR;
#undef PG8_SA
#undef PG8_SB
#undef PG8_STAGE
#undef PG8_LDA
#undef PG8_LD32
#undef PG8_LDB
#undef PG8_MMA
#undef PG8_CAT
#undef PG8_WAIT_V
#undef PG8_WAIT_L
#undef PG8_BAR
#undef PG8_SCHED
}
#else
template <class Epi, class Sched, bool ALIGN_EPI, bool FP8 = false>
__device__ __forceinline__ void gemm_phase(PG8_LAS unsigned char*, const Sched& S, const Epi& E) {
    constexpr int K = GK;
    const int tid = threadIdx.x, wid = __builtin_amdgcn_readfirstlane(tid >> 6), lane = tid & 63, wr = wid >> 2, wc = wid & 3, fr = lane & 15, fq = lane >> 4;
    Unit u;
    for (int ui = 0; S.next(ui, u); ++ui) {
        f32x4 acc[2][2][4][2];
#pragma unroll
        for (int ai = 0; ai < 2; ++ai)
#pragma unroll
            for (int bj = 0; bj < 2; ++bj) {
                const bf16_t* ar[4]; const bf16_t* br[2][4];
#pragma unroll
                for (int m = 0; m < 4; ++m) ar[m] = S.a_row(u, ai * 128 + wr * 64 + m * 16 + fr);
#pragma unroll
                for (int n = 0; n < 2; ++n)
#pragma unroll
                    for (int x = 0; x < 4; ++x) br[n][x] = S.b_row(u, bj * 128 + wc * 32 + (Epi::PERM ? 8 * fq + 4 * n + x : 16 * n + 4 * fq + x));
                float s[4][2][4];
#pragma unroll
                for (int m = 0; m < 4; ++m)
#pragma unroll
                    for (int n = 0; n < 2; ++n)
#pragma unroll
                        for (int x = 0; x < 4; ++x) s[m][n][x] = 0.f;
                for (int k0 = 0; k0 < K; k0 += 8) {
                    bf16x8 av[4], bv[2][4];
#pragma unroll
                    for (int m = 0; m < 4; ++m) av[m] = *(const bf16x8*)(ar[m] + k0);
#pragma unroll
                    for (int n = 0; n < 2; ++n)
#pragma unroll
                        for (int x = 0; x < 4; ++x) bv[n][x] = *(const bf16x8*)(br[n][x] + k0);
#pragma unroll
                    for (int kk = 0; kk < 8; ++kk)
#pragma unroll
                        for (int m = 0; m < 4; ++m) { const float a = bf2f((unsigned short)av[m][kk]);
#pragma unroll
                            for (int n = 0; n < 2; ++n)
#pragma unroll
                                for (int x = 0; x < 4; ++x) s[m][n][x] += a * bf2f((unsigned short)bv[n][x][kk]); }
                }
#pragma unroll
                for (int m = 0; m < 4; ++m)
#pragma unroll
                    for (int n = 0; n < 2; ++n) acc[ai][bj][m][n] = (f32x4){s[m][n][0], s[m][n][1], s[m][n][2], s[m][n][3]};
            }
        E(acc, u, wr, wc, fr, fq);
    }
}
#endif
}

constexpr size_t MiB = 1u << 20;
constexpr size_t WS_CTL = 0, CTL_ZERO_BYTES = 1 * MiB;
constexpr size_t WS_MOD = 1 * MiB;
constexpr size_t WS_WPOOL = 1 * MiB + 512 * 1024;
constexpr size_t WS_WIN = 2 * MiB;
constexpr size_t WS_WOUT = 6 * MiB;
constexpr size_t WS_WGU = 8 * MiB;
constexpr size_t WS_WD = 136 * MiB;
constexpr size_t WS_XN = 200 * MiB;
constexpr size_t WS_Q = 232 * MiB, WS_K = 248 * MiB, WS_V = 264 * MiB, WS_U = 280 * MiB;
constexpr size_t WS_OA = 296 * MiB;
constexpr size_t WS_MIX = 328 * MiB;
constexpr size_t WS_T1 = 360 * MiB;
constexpr size_t WS_X1 = 424 * MiB;
constexpr size_t WS_XN2 = 488 * MiB;
constexpr size_t WS_RE = 520 * MiB, WS_RP = 521 * MiB, WS_RG = 522 * MiB;
constexpr size_t WS_ROWTOK = 524 * MiB;
constexpr size_t WS_H = 528 * MiB;
constexpr size_t WS_Y = 672 * MiB;
constexpr size_t WS_END = 816 * MiB;
static_assert((size_t)PMAX * 256 * 1024 * 2 == 144 * MiB, "H / Y size");
constexpr int CW_TMO = 0, CW_CODE = 1;
constexpr int CW_BAR = 4096;
constexpr int CW_CNT = 8192;

constexpr int RING_BYTES = 131072;
constexpr int LDS_BYTES = 147456;
constexpr int LCTL_OFF = 139264;
constexpr int L_MISC = LCTL_OFF;
constexpr int L_CNT = LCTL_OFF + 128;
constexpr int L_PFIRST = LCTL_OFF + 256;
constexpr int L_PEXP = LCTL_OFF + 512;
constexpr int L_HIST = LCTL_OFF + 512 + 4 * 320;
constexpr int L_TB = 90112;
static_assert(L_TB + 4 * 704 * 4 <= RING_BYTES && L_HIST + 256 <= LDS_BYTES && PMAX <= 320, "LDS map");

typedef unsigned short bf16;
typedef unsigned v4u __attribute__((ext_vector_type(4)));
typedef unsigned v2u __attribute__((ext_vector_type(2)));
typedef float f32x4 __attribute__((ext_vector_type(4)));
typedef float f32x16 __attribute__((ext_vector_type(16)));
typedef short bf16x8 __attribute__((ext_vector_type(8)));
typedef GAS unsigned gu32;
#define RLX_AGENT __ATOMIC_RELAXED, __HIP_MEMORY_SCOPE_AGENT
#define LDS_WAIT() asm volatile("s_waitcnt lgkmcnt(0)" ::: "memory")
#define VM_WAIT() asm volatile("s_waitcnt vmcnt(0)" ::: "memory")
__device__ __forceinline__ unsigned f2bf(float f) { unsigned u = __builtin_bit_cast(unsigned, f); return (u + 0x7fffu + ((u >> 16) & 1u)) >> 16; }
__device__ __forceinline__ unsigned pk2(float lo, float hi) { return f2bf(lo) | (f2bf(hi) << 16); }
__device__ __forceinline__ float bfl(unsigned w) { return __uint_as_float(w << 16); }
__device__ __forceinline__ float bfh(unsigned w) { return __uint_as_float(w & 0xffff0000u); }

namespace attn_body {
using bf16=__hip_bfloat16;
using bf16x8=__attribute__((ext_vector_type(8)))short;
using s16x4=__attribute__((ext_vector_type(4)))short;
using f32x16=__attribute__((ext_vector_type(16)))float;
using u32x4=__attribute__((ext_vector_type(4)))unsigned;
constexpr int SEQ=2048,DH=64,PQ=512,PO=1024;
constexpr int NW=8,QBLK=32,QB=QBLK*NW,KVBLK=64,NQB=SEQ/QB;
__device__ __forceinline__ int crow(int r,int hi){return (r&3)+8*(r>>2)+4*hi;}
#define SBAR() __builtin_amdgcn_sched_barrier(0)
constexpr int TBN=704, TBOFF=447;
__device__ __forceinline__ void bandinit(f32x16&p0,f32x16&p1,int t,int q0,int wid,int r32,int hi,const __attribute__((address_space(3))) float*tb){
  const __attribute__((address_space(3))) float*tp=tb+(64*t+4*hi-(q0+32*wid+r32)+TBOFF);
  #pragma unroll
  for(int r=0;r<16;++r){p0[r]=tp[(r&3)+8*(r>>2)]; p1[r]=tp[(r&3)+8*(r>>2)+32];}
}
__device__ __forceinline__ void bandpost(f32x16&p0,f32x16&p1,const f32x16&negm,int t,int q0,int wid){
  const float nm=(t>(q0>>6)+(wid>>1))?-INFINITY:negm[0];
  #pragma unroll
  for(int r=0;r<16;++r){p0[r]+=nm;p1[r]+=nm;}
}
constexpr int NSLOT=3, SLOTB=8192;
constexpr int LDS_K=0, LDS_V=NSLOT*SLOTB, LDS_WS=2*NSLOT*SLOTB, LDS_OST=LDS_WS+NW*64*4, LDS_BYTES=LDS_OST+NW*4096;
__device__ __forceinline__ void glds16(const void*gsrc,unsigned lds_dst){unsigned keep;
  asm volatile("s_mov_b32 %0, m0\n\ts_mov_b32 m0, %2\n\ts_nop 0\n\tglobal_load_lds_dwordx4 %1, off\n\ts_mov_b32 m0, %0":"=&s"(keep):"v"(gsrc),"s"(lds_dst):"memory");}
__device__ __forceinline__ float max3f(float a,float b,float c){float r;asm("v_max3_f32 %0, %1, %2, %3":"=v"(r):"v"(a),"v"(b),"v"(c));return r;}
__device__ __forceinline__ float max2f(float a,float b){float r;asm("v_max_f32_e32 %0, %1, %2":"=v"(r):"v"(a),"v"(b));return r;}
__device__ __forceinline__ float fadd_s(float a,float b){float r;asm("v_add_f32_e32 %0, %1, %2":"=v"(r):"v"(a),"v"(b));return r;}
__device__ __forceinline__ float fsub_s(float a,float b){float r;asm("v_sub_f32_e32 %0, %1, %2":"=v"(r):"v"(a),"v"(b));return r;}
typedef float f32x2_t __attribute__((ext_vector_type(2))); typedef __bf16 bf16x2_t __attribute__((ext_vector_type(2)));
__device__ __forceinline__ unsigned cvtpk_s(float lo,float hi){f32x2_t v={lo,hi};bf16x2_t b=__builtin_convertvector(v,bf16x2_t);return __builtin_bit_cast(unsigned,b);}
#define WAIT_BAR(N) asm volatile("s_waitcnt vmcnt(" #N ") lgkmcnt(0)\n\ts_barrier":::"memory")

__device__ __forceinline__ void qkt(f32x16&p0,f32x16&p1,const char*Kslot,const bf16x8*qr,int r32,int hi){
  const char*kb=Kslot+hi*1024+r32*16;
  #pragma unroll
  for(int d0=0;d0<4;++d0){
    const bf16x8 b0=*reinterpret_cast<const bf16x8*>(kb+d0*2048);
    const bf16x8 b1=*reinterpret_cast<const bf16x8*>(kb+d0*2048+512);
    p0=__builtin_amdgcn_mfma_f32_32x32x16_bf16(b0,qr[d0],p0,0,0,0);p1=__builtin_amdgcn_mfma_f32_32x32x16_bf16(b1,qr[d0],p1,0,0,0);}
}
typedef __attribute__((address_space(3))) const char* lds_cptr;
typedef short v4i16_t __attribute__((ext_vector_type(4)));
__device__ __forceinline__ void kload8(bf16x8*kf,lds_cptr kp){
  kf[0]=*(const __attribute__((address_space(3))) bf16x8*)(kp);      kf[1]=*(const __attribute__((address_space(3))) bf16x8*)(kp+512);
  kf[2]=*(const __attribute__((address_space(3))) bf16x8*)(kp+2048); kf[3]=*(const __attribute__((address_space(3))) bf16x8*)(kp+2560);
  kf[4]=*(const __attribute__((address_space(3))) bf16x8*)(kp+4096); kf[5]=*(const __attribute__((address_space(3))) bf16x8*)(kp+4608);
  kf[6]=*(const __attribute__((address_space(3))) bf16x8*)(kp+6144); kf[7]=*(const __attribute__((address_space(3))) bf16x8*)(kp+6656);
}
__device__ __forceinline__ void kload2(bf16x8*kf,lds_cptr kp,int j){ kf[2*j]=*(const __attribute__((address_space(3))) bf16x8*)(kp+j*2048); kf[2*j+1]=*(const __attribute__((address_space(3))) bf16x8*)(kp+j*2048+512); }
__device__ __forceinline__ s16x4 vtr(lds_cptr p){ return __builtin_bit_cast(s16x4,__builtin_amdgcn_ds_read_tr16_b64_v4i16((__attribute__((address_space(3))) v4i16_t*)p)); }
__device__ __forceinline__ float rowmax(const f32x16&p0,const f32x16&p1){
  float a=max3f(p0[0],p0[1],p1[0]),b=max3f(p0[2],p0[3],p1[1]);a=max3f(a,p1[2],p1[3]);
  #pragma unroll
  for(int r=4;r<16;r+=4){a=max3f(a,p0[r],p0[r+1]);b=max3f(b,p0[r+2],p0[r+3]);a=max3f(a,p1[r],p1[r+1]);b=max3f(b,p1[r+2],p1[r+3]);}
  const float m=max2f(a,b);
  auto rr=__builtin_amdgcn_permlane32_swap(__float_as_uint(m),__float_as_uint(m),false,false);
  return max2f(__uint_as_float(rr[0]),__uint_as_float(rr[1]));
}
__device__ __forceinline__ void pv(f32x16*o,int vb,bf16x8 pa0,bf16x8 pa1,bf16x8 pa2,bf16x8 pa3){
  #pragma unroll
  for(int d0=0;d0<2;++d0){s16x4 lo[4],hi[4];
    #pragma unroll
    for(int ks=0;ks<4;++ks){
      asm volatile("ds_read_b64_tr_b16 %0,%1 offset:%c2":"=&v"(lo[ks]):"v"(vb),"i"(d0*4096+ks*1024):"memory");
      asm volatile("ds_read_b64_tr_b16 %0,%1 offset:%c2":"=&v"(hi[ks]):"v"(vb),"i"(d0*4096+ks*1024+512):"memory");}
    asm volatile("s_waitcnt lgkmcnt(0)":::"memory");SBAR();
    #define PK(k) (bf16x8){lo[k][0],lo[k][1],lo[k][2],lo[k][3],hi[k][0],hi[k][1],hi[k][2],hi[k][3]}
    o[d0]=__builtin_amdgcn_mfma_f32_32x32x16_bf16(pa0,PK(0),o[d0],0,0,0);
    o[d0]=__builtin_amdgcn_mfma_f32_32x32x16_bf16(pa1,PK(1),o[d0],0,0,0);
    o[d0]=__builtin_amdgcn_mfma_f32_32x32x16_bf16(pa2,PK(2),o[d0],0,0,0);
    o[d0]=__builtin_amdgcn_mfma_f32_32x32x16_bf16(pa3,PK(3),o[d0],0,0,0);
    #undef PK
  }
}
#define ATTN_STORE16(p,v) (*(u32x4*)(p)=(v))
template<int THRL> __device__ __forceinline__ void attn_unit(int b,int j,int vh,int qb,const bf16*Q,const bf16*__restrict__ K,const bf16*__restrict__ V,bf16*O,char*shm,const __attribute__((address_space(3))) float*tbh){
  int tid_=threadIdx.x; asm volatile("":"+v"(tid_));
  const int tid=tid_,lane=tid&63,r32=lane&31,hi=lane>>5; const int wid=__builtin_amdgcn_readfirstlane(tid>>6);
  const long rowbase=(long)b*SEQ; const int q0=qb*QB;
  const bf16*Qw=Q+(rowbase+q0+wid*QBLK)*PQ+j*DH;
  const bf16*Kh=K+rowbase*PQ+j*DH,*Vh=V+rowbase*PQ+(j>>1)*128+vh*64;
  const unsigned lds0=(unsigned)(uintptr_t)shm;
  float*wsf=(float*)(shm+LDS_WS)+wid*64;
  const bf16*ksrc=Kh+(long)lane*PQ+wid*8;
  const bf16*vsrc=Vh+(long)(16*(wid&3)+(lane>>2))*PQ+(wid>>2)*32+(lane&3)*8;
  const unsigned kdst=lds0+LDS_K+wid*1024, vdst=lds0+LDS_V+wid*1024;
  #define DMA_K(t,slot) glds16(ksrc+(long)(t)*KVBLK*PQ,(unsigned)__builtin_amdgcn_readfirstlane(kdst+(slot)))
  #define DMA_V(t,slot) glds16(vsrc+(long)(t)*KVBLK*PQ,(unsigned)__builtin_amdgcn_readfirstlane(vdst+(slot)))
  const int vb0=(int)(lds0+LDS_V)+((lane>>4)&1)*32+(lane&3)*8+(4*hi+((lane&15)>>2))*64;
  const char*Kbase=shm+LDS_K; bf16x8 kf[8];
  const lds_cptr shm3=(lds_cptr)shm; const lds_cptr kp0=shm3+LDS_K+hi*1024+r32*16; const lds_cptr vp0=shm3+LDS_V+((lane>>4)&1)*32+(lane&3)*8+(4*hi+((lane&15)>>2))*64;
  const int NT=(q0+QB)/KVBLK;
  DMA_K(0,0);DMA_V(0,0);DMA_K(1,SLOTB);
  bf16x8 qr[4];
  #pragma unroll
  for(int d0=0;d0<4;++d0)qr[d0]=*reinterpret_cast<const bf16x8*>(&Qw[(long)r32*PQ+d0*16+hi*8]);
  float mhat=0.f,l_reg=0.f;f32x16 o[2];o[0]=f32x16{};o[1]=f32x16{};f32x16 negm=f32x16{};asm volatile("":"+v"(negm));
  #define BINIT(C0,C1,t) bandinit(C0,C1,(t),q0,wid,r32,hi,tbh)
  bool resc=false;
  #define START(P0,P1) do{ const float rm=rowmax(P0,P1); resc=false; \
    { const float dl=rm; mhat=fadd_s(mhat,dl); \
      _Pragma("unroll") for(int r=0;r<16;++r){P0[r]=fsub_s(P0[r],dl);P1[r]=fsub_s(P1[r],dl);} \
      _Pragma("unroll") for(int r=0;r<16;++r)negm[r]=-mhat; asm volatile("":"+v"(negm)); } \
    _Pragma("unroll") for(int r=0;r<16;++r)P0[r]=__builtin_amdgcn_exp2f(P0[r]); }while(0)
  #define RESC() do{ if(resc){ asm volatile("s_waitcnt lgkmcnt(0)":::"memory"); \
      _Pragma("unroll") for(int d_=0;d_<2;++d_) _Pragma("unroll") for(int r=0;r<16;++r)o[d_][r]*=wsf[crow(r,hi)]; } }while(0)
  f32x16 pA0,pA1,pB0,pB1;
  int sl_prev=0,sl_cur=0,sl_next=SLOTB;
  #define ROT() do{sl_prev=sl_cur;sl_cur=sl_next;sl_next=(sl_next==(NSLOT-1)*SLOTB)?0:sl_next+SLOTB;}while(0)
  DMA_K(2,2*SLOTB);
  WAIT_BAR(3);
  if(NT<=7){BINIT(pA0,pA1,0);}else{pA0=f32x16{};pA1=f32x16{};}
  qkt(pA0,pA1,Kbase,qr,r32,hi);asm volatile("s_nop 15\n\ts_nop 7":"+v"(pA0),"+v"(pA1));
  START(pA0,pA1);
  _Pragma("unroll") for(int r=0;r<16;++r)pA1[r]=__builtin_amdgcn_exp2f(pA1[r]);
  WAIT_BAR(0);
  DMA_K(3,0);DMA_V(1,SLOTB);
  ROT();
  kload8(kf,kp0+sl_cur);
  WAIT_BAR(2);
  s16x4 vlo[8],vhi[8]; u32x4 pw0,pw1,pw2,pw3;
  #define PKW(P,B) cvtpk_s(P[B],P[B+1])
  #define PAF(k) __builtin_bit_cast(bf16x8,pw##k)
  #define VFR(i) (bf16x8){vlo[i][0],vlo[i][1],vlo[i][2],vlo[i][3],vhi[i][0],vhi[i][1],vhi[i][2],vhi[i][3]}
  #define PIN(x) asm volatile("":"+v"(x))
  #define MX3(a,b,c) __builtin_fmaxf(__builtin_fmaxf((a),(b)),(c))
  #define GAPA(MF,A0,A1,A2,A3,W0,W1,PW) do{ MF; sacc+=A0; sacc+=A1; sacc+=A2; sacc+=A3; PIN(sacc); W0; W1; PIN(PW); SBAR(); }while(0)
  #define EX(v) __builtin_amdgcn_exp2f(v)
  #define GAPB(MF,X,B) do{ MF; X[B]=EX(X[B]); X[B+1]=EX(X[B+1]); X[B+2]=EX(X[B+2]); X[B+3]=EX(X[B+3]); PIN(X); SBAR(); }while(0)
  #define VRD(i) do{ vlo[i]=vtr(vp_+(((i)>>2)*4096+((i)&3)*1024)); vhi[i]=vtr(vp_+(((i)>>2)*4096+((i)&3)*1024+512)); }while(0)
  #define KRD(G,j) do{ if(G){ kload2(kf,kp0+sl_next,j); SBAR(); } }while(0)
  #define STEP(C0,C1,P0,P1,t,GK,GV,GL,PRE,I0,I1,POST) do{ SBAR(); PRE; SBAR(); \
    const lds_cptr vp_=vp0+sl_prev; \
    VRD(0); SBAR(); float sacc=(P0[0]+P0[1]); \
    GAPA(C0=__builtin_amdgcn_mfma_f32_32x32x16_bf16(kf[0],qr[0],I0,0,0,0), P0[2],P0[3],P0[4],P0[5],     pw0[0]=PKW(P0,0), pw0[1]=PKW(P0,2), pw0); \
    VRD(4); SBAR(); GAPA(C1=__builtin_amdgcn_mfma_f32_32x32x16_bf16(kf[1],qr[0],I1,0,0,0), P0[6],P0[7],P0[8],P0[9],     pw0[2]=PKW(P0,4), pw0[3]=PKW(P0,6), pw0); \
    VRD(1); SBAR(); GAPA(C0=__builtin_amdgcn_mfma_f32_32x32x16_bf16(kf[2],qr[1],C0,0,0,0),   P0[10],P0[11],P0[12],P0[13], pw1[0]=PKW(P0,8), pw1[1]=PKW(P0,10), pw1); \
    VRD(5); SBAR(); GAPA(C1=__builtin_amdgcn_mfma_f32_32x32x16_bf16(kf[3],qr[1],C1,0,0,0),   P0[14],P0[15],P1[0],P1[1],   pw1[2]=PKW(P0,12),pw1[3]=PKW(P0,14), pw1); \
    VRD(2); SBAR(); GAPA(C0=__builtin_amdgcn_mfma_f32_32x32x16_bf16(kf[4],qr[2],C0,0,0,0),   P1[2],P1[3],P1[4],P1[5],     pw2[0]=PKW(P1,0), pw2[1]=PKW(P1,2), pw2); \
    VRD(6); SBAR(); GAPA(C1=__builtin_amdgcn_mfma_f32_32x32x16_bf16(kf[5],qr[2],C1,0,0,0),   P1[6],P1[7],P1[8],P1[9],     pw2[2]=PKW(P1,4), pw2[3]=PKW(P1,6), pw2); \
    VRD(3); SBAR(); GAPA(C0=__builtin_amdgcn_mfma_f32_32x32x16_bf16(kf[6],qr[3],C0,0,0,0),   P1[10],P1[11],P1[12],P1[13], pw3[0]=PKW(P1,8), pw3[1]=PKW(P1,10), pw3); \
    VRD(7); SBAR(); GAPA(C1=__builtin_amdgcn_mfma_f32_32x32x16_bf16(kf[7],qr[3],C1,0,0,0),   P1[14],P1[15],0.f,0.f,       pw3[2]=PKW(P1,12),pw3[3]=PKW(P1,14), pw3); \
    l_reg+=sacc; \
    if(GK){DMA_K((t)+3,sl_cur);} if(GV){DMA_V((t)+1,sl_next);} \
    POST; \
    { float a=MX3(C0[0],C0[1],C1[0]),b=MX3(C0[2],C0[3],C1[1]); a=MX3(a,C1[2],C1[3]); \
      _Pragma("unroll") for(int r=4;r<16;r+=4){a=MX3(a,C0[r],C0[r+1]);b=MX3(b,C0[r+2],C0[r+3]);a=MX3(a,C1[r],C1[r+1]);b=MX3(b,C1[r+2],C1[r+3]);} \
      float rm=__builtin_fmaxf(a,b); { auto rr=__builtin_amdgcn_permlane32_swap(__float_as_uint(rm),__float_as_uint(rm),false,false); rm=__builtin_fmaxf(__uint_as_float(rr[0]),__uint_as_float(rr[1])); } \
      resc=false; \
      if(__builtin_expect(__any(rm>(float)THRL),0)){ const float dl=__builtin_fmaxf(rm,0.f); mhat+=dl; \
        _Pragma("unroll") for(int r=0;r<16;++r){C0[r]-=dl;C1[r]-=dl;} \
        _Pragma("unroll") for(int r=0;r<16;++r)negm[r]=-mhat; asm volatile("":"+v"(negm)); \
        const float f=__builtin_amdgcn_exp2f(-dl); l_reg*=f; if(hi==0)wsf[r32]=f; resc=true; } } \
    SBAR(); \
    GAPB(o[0]=__builtin_amdgcn_mfma_f32_32x32x16_bf16(PAF(0),VFR(0),o[0],0,0,0), C0,0); \
    GAPB(o[1]=__builtin_amdgcn_mfma_f32_32x32x16_bf16(PAF(0),VFR(4),o[1],0,0,0), C0,4); \
    KRD(GL,0); GAPB(o[0]=__builtin_amdgcn_mfma_f32_32x32x16_bf16(PAF(1),VFR(1),o[0],0,0,0), C0,8); \
    KRD(GL,1); GAPB(o[1]=__builtin_amdgcn_mfma_f32_32x32x16_bf16(PAF(1),VFR(5),o[1],0,0,0), C0,12); \
    KRD(GL,2); GAPB(o[0]=__builtin_amdgcn_mfma_f32_32x32x16_bf16(PAF(2),VFR(2),o[0],0,0,0), C1,0); \
    KRD(GL,3); GAPB(o[1]=__builtin_amdgcn_mfma_f32_32x32x16_bf16(PAF(2),VFR(6),o[1],0,0,0), C1,4); \
    GAPB(o[0]=__builtin_amdgcn_mfma_f32_32x32x16_bf16(PAF(3),VFR(3),o[0],0,0,0), C1,8); \
    GAPB(o[1]=__builtin_amdgcn_mfma_f32_32x32x16_bf16(PAF(3),VFR(7),o[1],0,0,0), C1,12); \
    }while(0)
  int t=1;
  for(;t+7<NT;t+=2){
    STEP(pB0,pB1,pA0,pA1,t,true,true,true,,negm,negm,);     WAIT_BAR(2); RESC(); ROT();
    STEP(pA0,pA1,pB0,pB1,t+1,true,true,true,,negm,negm,);   WAIT_BAR(2); RESC(); ROT();
  }
  #define ENDW(tt) do{ if((tt)+3<NT){WAIT_BAR(2);} else if((tt)+2<NT){WAIT_BAR(1);} else {WAIT_BAR(0);} }while(0)
  for(;t+1<NT;t+=2){
    STEP(pB0,pB1,pA0,pA1,t,(t+3<NT),(t+1<NT),(t+1<NT),BINIT(pB0,pB1,t),pB0,pB1,bandpost(pB0,pB1,negm,t,q0,wid));           ENDW(t);   RESC(); ROT();
    STEP(pA0,pA1,pB0,pB1,t+1,(t+4<NT),(t+2<NT),(t+2<NT),BINIT(pA0,pA1,t+1),pA0,pA1,bandpost(pA0,pA1,negm,t+1,q0,wid));       ENDW(t+1); RESC(); ROT();
  }
  STEP(pB0,pB1,pA0,pA1,NT-1,false,false,false,BINIT(pB0,pB1,NT-1),pB0,pB1,bandpost(pB0,pB1,negm,NT-1,q0,wid)); RESC();
  { float sacc=pB0[0]+pB0[1]; _Pragma("unroll") for(int r=2;r<16;++r)sacc+=pB0[r]; _Pragma("unroll") for(int r=0;r<16;++r)sacc+=pB1[r]; l_reg+=sacc;
    pw0=(u32x4){PKW(pB0,0),PKW(pB0,2),PKW(pB0,4),PKW(pB0,6)};pw1=(u32x4){PKW(pB0,8),PKW(pB0,10),PKW(pB0,12),PKW(pB0,14)};pw2=(u32x4){PKW(pB1,0),PKW(pB1,2),PKW(pB1,4),PKW(pB1,6)};pw3=(u32x4){PKW(pB1,8),PKW(pB1,10),PKW(pB1,12),PKW(pB1,14)};
    SBAR(); pv(o,vb0+sl_cur,PAF(0),PAF(1),PAF(2),PAF(3)); }
  #undef PKW
  #undef PAF
  #undef VFR
  #undef PIN
  #undef MX3
  #undef GAPA
  #undef GAPB
  #undef EX
  #undef VRD
  #undef KRD
  #undef STEP
  #undef ENDW
  {auto rr=__builtin_amdgcn_permlane32_swap(__float_as_uint(l_reg),__float_as_uint(l_reg),false,false);l_reg=__uint_as_float(rr[0])+__uint_as_float(rr[1]);}
  if(hi==0)wsf[32+r32]=l_reg;asm volatile("s_waitcnt lgkmcnt(0)":::"memory");
  float rli[16];
  #pragma unroll
  for(int r=0;r<16;++r)rli[r]=__builtin_amdgcn_rcpf(wsf[32+crow(r,hi)]);
  bf16*Ow=O+(rowbase+q0+wid*QBLK)*PO+j*128+vh*64;
  { bf16*stg=(bf16*)(shm+LDS_OST)+wid*2048;
    #pragma unroll
    for(int r=0;r<16;++r){const int orow=crow(r,hi);
      #pragma unroll
      for(int d0=0;d0<2;++d0)stg[orow*64+d0*32+r32]=__float2bfloat16(o[d0][r]*rli[r]);}
    asm volatile("s_waitcnt lgkmcnt(0)":::"memory");
    #pragma unroll
    for(int i=0;i<4;++i){const int row=i*8+(lane>>3),ch=lane&7; const u32x4 v=*(const u32x4*)(stg+row*64+ch*8); ATTN_STORE16(Ow+(long)row*PO+ch*8,v);} }
  asm volatile("s_waitcnt lgkmcnt(0)\n\ts_barrier":::"memory");
  #undef DMA_K
  #undef DMA_V
  #undef BINIT
  #undef START
  #undef RESC
  #undef ROT
}
constexpr int ATTN_LDS_BYTES=LDS_BYTES;
#undef SBAR
#undef WAIT_BAR
}

#define XB_TMO      128
#define XB_XCNT(j)  (256  + 64 * (j))
#define XB_XSUB(j)  (1280 + 64 * (j))
#define XB_XGEN(j)  (2304 + 64 * (j))
#define XB_TOP      3328
#define XB_TOPGEN   3392
#define XCD_BAR_WORDS 3456
#define XB_SPIN_CAP (1u << 18)
__device__ __forceinline__ unsigned xb_ld(unsigned* p)              { return __hip_atomic_load(p, __ATOMIC_RELAXED, __HIP_MEMORY_SCOPE_AGENT); }
__device__ __forceinline__ unsigned xb_add(unsigned* p, unsigned v) { return __hip_atomic_fetch_add(p, v, __ATOMIC_RELAXED, __HIP_MEMORY_SCOPE_AGENT); }
__device__ __forceinline__ unsigned xb_xcc_id() { return (unsigned)__builtin_amdgcn_s_getreg((3 << 11) | 20) & 0xFu; }
#define XB_SPIN(cond, bar) do { unsigned _sp = 0; while (cond) { __builtin_amdgcn_s_sleep(1); \
    if ((++_sp & 255u) == 0u) { if (xb_ld(&(bar)[XB_TMO])) break; if (_sp > XB_SPIN_CAP) { atomicAdd(&(bar)[XB_TMO], 1u); break; } } } } while (0)
struct XcdBarrier { unsigned* bar; unsigned x; volatile LAS unsigned* st; };
__device__ __forceinline__ XcdBarrier xcd_barrier_post(unsigned* bar, volatile LAS unsigned* st) {
    XcdBarrier b; b.bar = bar; b.x = xb_xcc_id(); b.st = st;
    if (threadIdx.x == 0) (void)xb_add(&bar[XB_XCNT(b.x)], 1u);
    return b;
}
__device__ __forceinline__ void xcd_barrier_complete(unsigned* bar, unsigned x, unsigned& nloc, unsigned& nx) {
    const unsigned G = gridDim.x * gridDim.y * gridDim.z;
    unsigned sum, cnt, mine, sp = 0u;
    for (;;) {
        sum = 0u; cnt = 0u; mine = 0u;
#pragma unroll
        for (unsigned j = 0; j < 16; ++j) { const unsigned c = xb_ld(&bar[XB_XCNT(j)]); sum += c; cnt += (c > 0u) ? 1u : 0u; mine = (j == x) ? c : mine; }
        if (sum == G) break;
        __builtin_amdgcn_s_sleep(1);
        if ((++sp & 255u) == 0u) { if (xb_ld(&bar[XB_TMO])) break; if (sp > XB_SPIN_CAP) { atomicAdd(&bar[XB_TMO], 1u); break; } }
    }
    nloc = mine > 0u ? mine : 1u; nx = cnt > 0u ? cnt : 1u;
}
__device__ __forceinline__ void xcd_barrier(const XcdBarrier& b) {
    asm volatile("s_waitcnt vmcnt(0)" ::: "memory");
    __syncthreads();
    if (threadIdx.x == 0) {
        unsigned* bar = b.bar;
        __builtin_amdgcn_s_waitcnt(0);
        unsigned nloc = b.st[0], nx = b.st[1];
        if (nloc == 0u) { xcd_barrier_complete(bar, b.x, nloc, nx); b.st[0] = nloc; b.st[1] = nx; }
        const unsigned old = xb_add(&bar[XB_XSUB(b.x)], 1u);
        const unsigned gen = old / nloc;
        if (old + 1u == (gen + 1u) * nloc) {
            __builtin_amdgcn_fence(__ATOMIC_RELEASE, "agent");
            asm volatile("s_waitcnt vmcnt(0)" ::: "memory");
            const unsigned og = xb_add(&bar[XB_TOP], 1u);
            const unsigned tg = og / nx;
            if (og + 1u == (tg + 1u) * nx) xb_add(&bar[XB_TOPGEN], 1u);
            else XB_SPIN(xb_ld(&bar[XB_TOPGEN]) == tg, bar);
            __builtin_amdgcn_fence(__ATOMIC_ACQUIRE, "agent");
            xb_add(&bar[XB_XGEN(b.x)], 1u);
            asm volatile("s_waitcnt vmcnt(0)" ::: "memory");
        } else {
            XB_SPIN(xb_ld(&bar[XB_XGEN(b.x)]) == gen, bar);
            __builtin_amdgcn_fence(__ATOMIC_ACQUIRE, "agent");
            asm volatile("s_waitcnt vmcnt(0)" ::: "memory");
        }
    }
    __syncthreads();
}

struct Frame {
    LAS unsigned char* lds;
    unsigned char* ws;
    gu32* ctl;
    int tid, lane, wave;
    int vcu, G;
};
__device__ __forceinline__ float wave_sum(float v) {
#pragma unroll
    for (int o = 1; o < 64; o <<= 1) v += __shfl_xor(v, o);
    return v;
}
struct TItem { const float* src; bf16* dst; int K, N; };
__device__ __forceinline__ unsigned pk4_fp8(float a, float b, float c, float d) {
    int w = __builtin_amdgcn_cvt_pk_fp8_f32(a, b, 0, false); w = __builtin_amdgcn_cvt_pk_fp8_f32(c, d, w, true); return (unsigned)w; }
constexpr float W8_SCALE = 64.0f, W8_INV = 1.0f / 64.0f;
__device__ __forceinline__ void p0_load(const TItem& t, f32x4 (&v)[8], int wave, int lane) {
    const GAS float* sp = (const GAS float*)t.src + (size_t)(8 * (2 * wave + (lane >> 5))) * t.N + 4 * (lane & 31);
#pragma unroll
    for (int i = 0; i < 8; ++i) v[i] = *(const GAS f32x4*)(sp + (size_t)i * t.N);
}
__device__ __forceinline__ void p0_store(const TItem& t, const f32x4 (&v)[8], LAS unsigned char* img, int wave, int lane) {
    const int kg = 2 * wave + (lane >> 5), n4 = lane & 31;
#pragma unroll
    for (int x = 0; x < 4; ++x) { v4u w; w.x = pg8::cvt_pk_bf16(v[0][x], v[1][x]); w.y = pg8::cvt_pk_bf16(v[2][x], v[3][x]); w.z = pg8::cvt_pk_bf16(v[4][x], v[5][x]); w.w = pg8::cvt_pk_bf16(v[6][x], v[7][x]);
        *(LAS v4u*)(img + (4 * n4 + x) * 272 + kg * 16) = w; }
    asm volatile("s_waitcnt lgkmcnt(0)\n\ts_barrier" ::: "memory");
#pragma unroll
    for (int j = 0; j < 4; ++j) { const int n = 16 * wave + 4 * j + (lane >> 4), kc = lane & 15;
        const v4u o = *(const LAS v4u*)(img + n * 272 + kc * 16);
        *(GAS v4u*)(t.dst + (size_t)n * t.K + 8 * kc) = o; }
}
__device__ __forceinline__ void p0_store8(const TItem& t, const f32x4 (&v)[8], LAS unsigned char* img, int wave, int lane) {
    const int kg = 2 * wave + (lane >> 5), n4 = lane & 31;
#pragma unroll
    for (int x = 0; x < 4; ++x) { v2u w; w.x = pk4_fp8(v[0][x] * W8_SCALE, v[1][x] * W8_SCALE, v[2][x] * W8_SCALE, v[3][x] * W8_SCALE); w.y = pk4_fp8(v[4][x] * W8_SCALE, v[5][x] * W8_SCALE, v[6][x] * W8_SCALE, v[7][x] * W8_SCALE);
        *(LAS v2u*)(img + (4 * n4 + x) * 144 + kg * 8) = w; }
    asm volatile("s_waitcnt lgkmcnt(0)\n\ts_barrier" ::: "memory");
    unsigned char* dst = (unsigned char*)t.dst;
#pragma unroll
    for (int j = 0; j < 2; ++j) { const int n = 16 * wave + 8 * j + (lane >> 3), kc = lane & 7;
        const v4u o = *(const LAS v4u*)(img + n * 144 + kc * 16);
        *(GAS v4u*)(dst + (size_t)n * t.K + 16 * kc) = o; }
}
__device__ __forceinline__ int t5_bucket(int rel) {
    const int n = rel < 0 ? -rel : rel; int b;
    if (n < 8) b = n; else if (n < 12) b = 8; else if (n < 16) b = 9; else if (n < 23) b = 10; else if (n < 32) b = 11; else if (n < 46) b = 12; else if (n < 64) b = 13; else if (n < 91) b = 14; else b = 15;
    return b + (rel > 0 ? 16 : 0);
}

struct DenseSched {
    const bf16* A; const bf16* Bt; int nM, nN, nwg, G, c;
    __device__ __forceinline__ void init(const bf16* A_, const bf16* Bt_, int M_, int N_, int G_, int c_) { A = A_; Bt = Bt_; nM = M_ / 256; nN = N_ / 256; nwg = nM * nN; G = G_; c = c_; }
    __device__ __forceinline__ bool next(int i, pg8::Unit& u) const {
        const long L = (long)i * G + c; if (L >= nwg) return false;
        int wgid = (int)L; { const int q = nwg / 8, r = nwg % 8, xcd = wgid % 8, off = wgid / 8; wgid = (xcd < r ? xcd * (q + 1) : r * (q + 1) + (xcd - r) * q) + off; }
        const int nig = 8 * nN, gid = wgid / nig, fm = gid * 8, gsz = (nM - fm) < 8 ? (nM - fm) : 8;
        u.pm = fm + ((wgid % nig) % gsz); u.pn = (wgid % nig) / gsz; u.e = 0; u.lrow0 = 0; u.cnt = 0; return true;
    }
    __device__ __forceinline__ const char* a_base(const pg8::Unit& u) const { return (const char*)A + (size_t)u.pm * (256 * 1024 * 2); }
    __device__ __forceinline__ const char* b_base(const pg8::Unit& u) const { return (const char*)Bt + (size_t)u.pn * (256 * 1024 * 2); }
    __device__ __forceinline__ size_t b_hstep() const { return (size_t)128 * 1024 * 2; }
    __device__ __forceinline__ void a_voff(const pg8::Unit&, const int (&R)[2], const int (&C)[2], unsigned (&v0)[2], unsigned (&v1)[2]) const {
#pragma unroll
        for (int i = 0; i < 2; ++i) { v0[i] = (unsigned)(R[i] * 1024 + C[i]) * 2u; v1[i] = v0[i] + 128u * 1024u * 2u; } }
    __device__ __forceinline__ const bf16* a_row(const pg8::Unit& u, int r) const { return A + (size_t)(u.pm * 256 + r) * 1024; }
    __device__ __forceinline__ const bf16* b_row(const pg8::Unit& u, int c_) const { return Bt + (size_t)(u.pn * 256 + c_) * 1024; }
};
struct MoeSched {
    const bf16* A; const bf16* W; const int* rowtok; const LAS int* pexp; const LAS int* pfirst; const LAS int* cntl;
    int NP, NT, G, vcu; bool gather; int rowb  ; size_t wexp  , wtile  , whalf;
    __device__ __forceinline__ bool next(int i, pg8::Unit& u) const {
        const int L = i * G + vcu; if (L >= NP * NT) return false;
        const int pi = L / NT; const int e = __builtin_amdgcn_readfirstlane(pexp[pi]);
        u.pm = pi; u.pn = L - pi * NT; u.e = e; u.lrow0 = (pi - __builtin_amdgcn_readfirstlane(pfirst[e])) * 256; u.cnt = __builtin_amdgcn_readfirstlane(cntl[e]); return true;
    }
    __device__ __forceinline__ const char* a_base(const pg8::Unit& u) const { return gather ? (const char*)A : (const char*)A + (size_t)u.pm * 256 * (size_t)rowb; }
    __device__ __forceinline__ const char* b_base(const pg8::Unit& u) const { return (const char*)W + (size_t)u.e * wexp + (size_t)u.pn * wtile; }
    __device__ __forceinline__ size_t b_hstep() const { return whalf; }
    __device__ __forceinline__ int tok_of(const pg8::Unit& u, int r) const { const int lr = u.lrow0 + r; return lr < u.cnt ? ((const GAS int*)rowtok)[u.e * ECAP + lr] : 0; }
    __device__ __forceinline__ void a_voff(const pg8::Unit& u, const int (&R)[2], const int (&C)[2], unsigned (&v0)[2], unsigned (&v1)[2]) const {
        if (gather) {
#pragma unroll
            for (int i = 0; i < 2; ++i) { v0[i] = (unsigned)(tok_of(u, R[i]) * rowb + C[i] * 2); v1[i] = (unsigned)(tok_of(u, 128 + R[i]) * rowb + C[i] * 2); }
        } else {
#pragma unroll
            for (int i = 0; i < 2; ++i) { v0[i] = (unsigned)(R[i] * rowb + C[i] * 2); v1[i] = v0[i] + 128u * (unsigned)rowb; }
        }
    }
    __device__ __forceinline__ const bf16* a_row(const pg8::Unit& u, int r) const { return gather ? A + (size_t)tok_of(u, r) * 1024 : A + (size_t)(u.pm * 256 + r) * 1024; }
    __device__ __forceinline__ const bf16* b_row(const pg8::Unit& u, int c_) const { return (const bf16*)((const char*)W + (size_t)u.e * wexp + (size_t)u.pn * wtile + (c_ >= 128 ? whalf : 0) + (size_t)(c_ & 127) * 2048); }
};

struct EpiQKVU {
    static constexpr bool PERM = true;
    bf16* O; size_t stride;
    __device__ __forceinline__ void operator()(const pg8::f32x4 (&acc)[2][2][4][2], const pg8::Unit& u, int wr, int wc, int fr, int fq) const {
        const int t = u.pn >> 1; const float sc = t == 0 ? QSCALE : 1.f;
        bf16* base = O + (size_t)t * stride; const int col0 = (u.pn & 1) * 256 + wc * 32 + 8 * fq; const int row0 = u.pm * 256 + wr * 64 + fr;
#pragma unroll
        for (int ai = 0; ai < 2; ++ai)
#pragma unroll
            for (int m = 0; m < 4; ++m) { bf16* rowp = base + (size_t)(row0 + ai * 128 + m * 16) * 512 + col0;
#pragma unroll
                for (int bj = 0; bj < 2; ++bj) { const pg8::f32x4 v0 = acc[ai][bj][m][0] * sc, v1 = acc[ai][bj][m][1] * sc;
                    pg8::u32x4 w; w.x = pg8::cvt_pk_bf16(v0[0], v0[1]); w.y = pg8::cvt_pk_bf16(v0[2], v0[3]); w.z = pg8::cvt_pk_bf16(v1[0], v1[1]); w.w = pg8::cvt_pk_bf16(v1[2], v1[3]);
                    *(pg8::u32x4*)(rowp + bj * 128) = w; } }
    }
};
struct EpiT1 {
    static constexpr bool PERM = false;
    const float* x; const float* mod; float* T1;
    __device__ __forceinline__ void operator()(const pg8::f32x4 (&acc)[2][2][4][2], const pg8::Unit& u, int wr, int wc, int fr, int fq) const {
        const int b = u.pm >> 3; const float* g1 = mod + (size_t)b * 6144 + 2048;
        const int col0 = u.pn * 256 + wc * 32 + 4 * fq;
        pg8::f32x4 gv[2][2];
#pragma unroll
        for (int bj = 0; bj < 2; ++bj)
#pragma unroll
            for (int n = 0; n < 2; ++n) gv[bj][n] = *(const pg8::f32x4*)(g1 + col0 + bj * 128 + n * 16);
#pragma unroll
        for (int ai = 0; ai < 2; ++ai)
#pragma unroll
            for (int m = 0; m < 4; ++m) { const size_t off = (size_t)(u.pm * 256 + ai * 128 + wr * 64 + m * 16 + fr) * 1024 + col0;
#pragma unroll
                for (int bj = 0; bj < 2; ++bj)
#pragma unroll
                    for (int n = 0; n < 2; ++n) { const pg8::f32x4 xv = *(const pg8::f32x4*)(x + off + bj * 128 + n * 16);
                        *(pg8::f32x4*)(T1 + off + bj * 128 + n * 16) = xv * DN_ALPHA + gv[bj][n] * acc[ai][bj][m][n]; } }
    }
};
struct EpiSwiglu {
    static constexpr bool PERM = true;
    const float* bgu; unsigned char* H;
    __device__ __forceinline__ void operator()(const pg8::f32x4 (&acc)[2][2][4][2], const pg8::Unit& u, int wr, int wc, int fr, int fq) const {
        const int c0 = u.pn * 128 + wc * 32 + 8 * fq; const float* bg = bgu + (size_t)u.e * 2048 + c0;
        pg8::f32x4 bgv[2], buv[2];
#pragma unroll
        for (int n = 0; n < 2; ++n) { bgv[n] = *(const pg8::f32x4*)(bg + 4 * n); buv[n] = *(const pg8::f32x4*)(bg + 1024 + 4 * n); }
#pragma unroll
        for (int ai = 0; ai < 2; ++ai)
#pragma unroll
            for (int m = 0; m < 4; ++m) { float r[8];
#pragma unroll
                for (int n = 0; n < 2; ++n)
#pragma unroll
                    for (int x = 0; x < 4; ++x) { const float g = fminf(acc[ai][0][m][n][x] * W8_INV + bgv[n][x], 7.0f); const float up = fminf(fmaxf(acc[ai][1][m][n][x] * W8_INV + buv[n][x], -7.0f), 7.0f);
                        const float sg = __builtin_amdgcn_rcpf(1.0f + __builtin_amdgcn_exp2f(-1.702f * LOG2E * g)); r[4 * n + x] = (up + 1.0f) * (g * sg); }
                v2u w; w.x = pk4_fp8(r[0], r[1], r[2], r[3]); w.y = pk4_fp8(r[4], r[5], r[6], r[7]);
                *(v2u*)(H + (size_t)(u.pm * 256 + ai * 128 + wr * 64 + m * 16 + fr) * 1024 + c0) = w; }
    }
};
struct EpiDown {
    static constexpr bool PERM = true;
    const float* bd; bf16* Y;
    __device__ __forceinline__ void operator()(const pg8::f32x4 (&acc)[2][2][4][2], const pg8::Unit& u, int wr, int wc, int fr, int fq) const {
        const int c0 = u.pn * 256 + wc * 32 + 8 * fq; const float* bp = bd + (size_t)u.e * 1024 + c0;
        pg8::f32x4 bv[2][2];
#pragma unroll
        for (int bj = 0; bj < 2; ++bj)
#pragma unroll
            for (int n = 0; n < 2; ++n) bv[bj][n] = *(const pg8::f32x4*)(bp + bj * 128 + 4 * n);
#pragma unroll
        for (int ai = 0; ai < 2; ++ai)
#pragma unroll
            for (int m = 0; m < 4; ++m) { bf16* rowp = Y + (size_t)(u.pm * 256 + ai * 128 + wr * 64 + m * 16 + fr) * 1024 + c0;
#pragma unroll
                for (int bj = 0; bj < 2; ++bj) { const pg8::f32x4 v0 = acc[ai][bj][m][0] * W8_INV + bv[bj][0], v1 = acc[ai][bj][m][1] * W8_INV + bv[bj][1];
                    pg8::u32x4 w; w.x = pg8::cvt_pk_bf16(v0[0], v0[1]); w.y = pg8::cvt_pk_bf16(v0[2], v0[3]); w.z = pg8::cvt_pk_bf16(v1[0], v1[1]); w.w = pg8::cvt_pk_bf16(v1[2], v1[3]);
                    *(pg8::u32x4*)(rowp + bj * 128) = w; } }
    }
};

__device__ __forceinline__ void build_expert_tables(Frame& F) {
    LAS int* cntl = (LAS int*)(F.lds + L_CNT); LAS int* pfirst = (LAS int*)(F.lds + L_PFIRST); LAS int* pexp = (LAS int*)(F.lds + L_PEXP);
    __syncthreads();
    if (F.tid < NE) { int c = (int)__hip_atomic_load(F.ctl + CW_CNT + 64 * F.tid, RLX_AGENT); c = c < 0 ? 0 : (c > ECAP ? ECAP : c); cntl[F.tid] = c; }
    __syncthreads();
    if (F.tid == 0) { int p = 0; for (int e = 0; e < NE; ++e) { pfirst[e] = p; const int np = (cntl[e] + 255) >> 8; for (int k = 0; k < np; ++k) if (p + k < PMAX) pexp[p + k] = e; p += np; if (p > PMAX) p = PMAX; } pfirst[NE] = p; }
    __syncthreads();
}

struct Args { const float* in[25]; float* out; unsigned char* ws; int ph_lo, ph_hi; };
constexpr int NPHASE = 10;

__global__ void __launch_bounds__(NWAVES * 64, 2) mk_fwd(Args args) {
    extern __shared__ __attribute__((aligned(16))) unsigned char lds[];
    Frame F;
    F.lds = (LAS unsigned char*)lds; F.ws = args.ws; F.ctl = (gu32*)(args.ws + WS_CTL);
    F.tid = threadIdx.x; F.lane = F.tid & 63; F.wave = __builtin_amdgcn_readfirstlane(F.tid >> 6);
    F.G = gridDim.x; { const int bx = blockIdx.x; F.vcu = (F.G % 8 == 0) ? (bx % 8) * (F.G / 8) + bx / 8 : bx; }
    volatile LAS unsigned* MISC = (volatile LAS unsigned*)(F.lds + L_MISC);
    for (int u = F.tid; u < (LDS_BYTES - LCTL_OFF) / 4; u += NWAVES * 64) ((LAS unsigned*)(F.lds + LCTL_OFF))[u] = 0u;
    __syncthreads();
    XcdBarrier bar; bar.bar = (unsigned*)(F.ctl + CW_BAR); bar.x = 0; bar.st = nullptr;
#if MK_ONE_LAUNCH
    bar = xcd_barrier_post((unsigned*)(F.ctl + CW_BAR), MISC + 8);
#define GRID_BAR() xcd_barrier(bar)
#else
#define GRID_BAR() do { } while (0)
#endif
    const int lo = args.ph_lo, hi = args.ph_hi;
#ifndef PH_MASK
#define PH_MASK 0x3ff
#endif
#ifndef REP_MASK
#define REP_MASK 0x0
#endif
#define REPS(k) (1 + ((REP_MASK >> (k)) & 1))
#define IN(k) (((PH_MASK >> (k)) & 1) && lo <= (k) && (k) < hi)
#define BOTH(k) (IN(k) && IN((k) + 1))
    const float* x = args.in[0]; const float* cvec = args.in[1]; const float* w_ada = args.in[2]; const float* b_ada = args.in[3]; const float* w_in = args.in[4];
    const float* lq1 = args.in[5]; const float* lk1 = args.in[6]; const float* lq2 = args.in[7]; const float* lk2 = args.in[8]; const float* subln_g = args.in[9];
    const float* rel_bias = args.in[10]; const float* w_pool = args.in[11]; const float* b_pool = args.in[12]; const float* pool_scale = args.in[13]; const float* w_out = args.in[14];
    const float* ln1_g = args.in[15]; const float* ln1_b = args.in[16]; const float* w_router = args.in[17]; const float* b_router = args.in[18];
    const float* w_gu = args.in[19]; const float* b_gu = args.in[20]; const float* w_dn = args.in[21]; const float* b_dn = args.in[22]; const float* ln2_g = args.in[23]; const float* ln2_b = args.in[24];
    float* out = args.out; unsigned char* ws = args.ws;
    float* MOD = (float*)(ws + WS_MOD); bf16* WPOOL = (bf16*)(ws + WS_WPOOL); bf16* WIN = (bf16*)(ws + WS_WIN); bf16* WOUT = (bf16*)(ws + WS_WOUT);
    bf16* WGU = (bf16*)(ws + WS_WGU); bf16* WD = (bf16*)(ws + WS_WD); bf16* XN = (bf16*)(ws + WS_XN);
    bf16* QB = (bf16*)(ws + WS_Q); bf16* KB = (bf16*)(ws + WS_K); bf16* VB = (bf16*)(ws + WS_V); bf16* UB = (bf16*)(ws + WS_U);
    bf16* OA = (bf16*)(ws + WS_OA); bf16* MIX = (bf16*)(ws + WS_MIX); float* T1 = (float*)(ws + WS_T1); float* X1 = (float*)(ws + WS_X1); bf16* XN2 = (bf16*)(ws + WS_XN2);
    int* RE = (int*)(ws + WS_RE); int* RP = (int*)(ws + WS_RP); float* RG = (float*)(ws + WS_RG); int* ROWTOK = (int*)(ws + WS_ROWTOK);
    bf16* HB = (bf16*)(ws + WS_H); bf16* YB = (bf16*)(ws + WS_Y);
    const int gw = F.vcu * NWAVES + F.wave, NGW = F.G * NWAVES;
    unsigned long long dly_t0 = 0, dly_t1 = 0;

    if (DLY_PH == 0) dly_t0 = __builtin_amdgcn_s_memrealtime();
    if (IN(0)) _Pragma("unroll") for (int rep_ = 0; rep_ < REPS(0); ++rep_) {
        LAS float* sil = (LAS float*)(F.lds + 3 * 34816);
        for (int i = F.tid; i < NB * D; i += NWAVES * 64) { const float v = cvec[i]; sil[i] = v / (1.0f + __expf(-v)); }
        __syncthreads();
        constexpr int I_MOD = 6144 / 16, T_IN = (D / 128) * (NIN / 128), T_OUT = (D / 128) * (D / 128), T_POOL = 4, T_GU1 = (D / 128) * (2048 / 128), T_D1 = (FF / 128) * (D / 128);
        constexpr int NTR = T_IN + T_OUT + T_POOL + NE * T_GU1 + NE * T_D1;
        for (int r = NGW - 1 - gw; r < I_MOD; r += NGW) {
            const int kq = F.lane >> 4, col = r * 16 + (F.lane & 15); float a[NB];
#pragma unroll
            for (int b = 0; b < NB; ++b) a[b] = 0.f;
#pragma unroll 16
            for (int k = kq; k < D; k += 4) { const float w = ((const GAS float*)w_ada)[(size_t)k * 6144 + col];
#pragma unroll
                for (int b = 0; b < NB; ++b) a[b] += sil[b * D + k] * w; }
#pragma unroll
            for (int b = 0; b < NB; ++b) { a[b] += __shfl_xor(a[b], 16); a[b] += __shfl_xor(a[b], 32); }
            if (kq == 0) { const float bb = b_ada[col];
#pragma unroll
                for (int b = 0; b < NB; ++b) MOD[(size_t)b * 6144 + col] = a[b] + bb; }
        }
        for (int r0 = F.vcu; r0 < T_IN + T_OUT + T_POOL; r0 += F.G) {
            int r = r0; const float* W; bf16* WT; int K, N, item;
            if (r < T_IN) { W = w_in; WT = WIN; K = D; N = NIN; item = r; }
            else if ((r -= T_IN) < T_OUT) { W = w_out; WT = WOUT; K = D; N = D; item = r; }
            else { r -= T_OUT; W = w_pool + (size_t)r * 128 * 128; WT = WPOOL + (size_t)r * 128 * 128; K = 128; N = 128; item = 0; }
            const int nblk = N / 128, kb = item / nblk, nb = item - kb * nblk;
            TItem t; t.src = W + (size_t)(128 * kb) * N + 128 * nb; t.dst = WT + (size_t)(128 * nb) * K + 128 * kb; t.K = K; t.N = N;
            f32x4 bb[8]; p0_load(t, bb, F.wave, F.lane); p0_store(t, bb, F.lds, F.wave, F.lane);
            asm volatile("s_waitcnt lgkmcnt(0)\n\ts_barrier" ::: "memory");
        }
        auto pipe = [&](const float* W, bf16* WT, auto K_, auto N_, int ntiles) {
            constexpr int K = decltype(K_)::value, N = decltype(N_)::value, NBLK = N / 128, TPE = (K / 128) * NBLK;
            const int n_my = (ntiles - F.vcu + F.G - 1) / F.G;
            auto tile_of = [&](int q) -> TItem { const int qq = q < n_my ? q : n_my - 1; const int r = F.vcu + qq * F.G; const int e = r / TPE, item = r % TPE, kb = item / NBLK, nb = item % NBLK;
                TItem t; t.src = W + (size_t)e * K * N + (size_t)(128 * kb) * N + 128 * nb; t.dst = (bf16*)((unsigned char*)WT + (size_t)e * K * N + (size_t)(128 * nb) * K + 128 * kb);     t.K = K; t.N = N; return t; };
            if (n_my > 0) {
                TItem t0 = tile_of(0), t1 = tile_of(1), t2; f32x4 b0[8], b1[8], b2[8];
                p0_load(t0, b0, F.wave, F.lane); p0_load(t1, b1, F.wave, F.lane);
                for (int q = 0; q < n_my; q += 3) {
                    t2 = tile_of(q + 2); p0_load(t2, b2, F.wave, F.lane); p0_store8(t0, b0, F.lds, F.wave, F.lane);
                    t0 = tile_of(q + 3); p0_load(t0, b0, F.wave, F.lane); p0_store8(t1, b1, F.lds + 34816, F.wave, F.lane);
                    t1 = tile_of(q + 4); p0_load(t1, b1, F.wave, F.lane); p0_store8(t2, b2, F.lds + 2 * 34816, F.wave, F.lane);
                }
                asm volatile("s_waitcnt lgkmcnt(0)\n\ts_barrier" ::: "memory");
            }
        };
        pipe(w_gu, WGU, std::integral_constant<int, D>{}, std::integral_constant<int, 2048>{}, NE * T_GU1);
        pipe(w_dn, WD, std::integral_constant<int, FF>{}, std::integral_constant<int, D>{}, NE * T_D1);
        __syncthreads();
        if (BOTH(0) || rep_ + 1 < REPS(0)) GRID_BAR();
    }
    if (DLY_PH == 0) dly_t1 = __builtin_amdgcn_s_memrealtime();
    if (DLY_PH == 1) dly_t0 = __builtin_amdgcn_s_memrealtime();
    if (IN(1)) _Pragma("unroll") for (int rep_ = 0; rep_ < REPS(1); ++rep_) {
        for (int m = gw; m < M; m += NGW) {
            const int b = m >> 11; const float* sh = MOD + (size_t)b * 6144; const float* sc = sh + 1024;
            const GAS f32x4* xr = (const GAS f32x4*)(x + (size_t)m * D) + F.lane;
            f32x4 v[4]; float s = 0.f;
#pragma unroll
            for (int j = 0; j < 4; ++j) { v[j] = xr[64 * j]; s += (v[j].x + v[j].y) + (v[j].z + v[j].w); }
            const float mean = wave_sum(s) * (1.f / D); float s2 = 0.f;
#pragma unroll
            for (int j = 0; j < 4; ++j) { v[j] = v[j] - mean; s2 += (v[j].x * v[j].x + v[j].y * v[j].y) + (v[j].z * v[j].z + v[j].w * v[j].w); }
            const float rstd = 1.f / sqrtf(wave_sum(s2) * (1.f / D) + LN_EPS);
            GAS v2u* o8 = (GAS v2u*)(XN + (size_t)m * D) + F.lane;
#pragma unroll
            for (int j = 0; j < 4; ++j) { const f32x4 sv = *(const f32x4*)(sc + 4 * F.lane + 256 * j), hv = *(const f32x4*)(sh + 4 * F.lane + 256 * j);
                const f32x4 h = (v[j] * rstd) * (sv + 1.0f) + hv; v2u w; w.x = pk2(h.x, h.y); w.y = pk2(h.z, h.w); o8[64 * j] = w; }
        }
        if (BOTH(1) || rep_ + 1 < REPS(1)) GRID_BAR();
    }
    if (DLY_PH == 1) dly_t1 = __builtin_amdgcn_s_memrealtime();
    if (DLY_PH == 2) dly_t0 = __builtin_amdgcn_s_memrealtime();
    if (IN(2)) _Pragma("unroll") for (int rep_ = 0; rep_ < REPS(2); ++rep_) {
        DenseSched S; S.init(XN, WIN, M, NIN, F.G, (int)blockIdx.x);
        EpiQKVU E{QB, (size_t)(WS_K - WS_Q) / 2};
        pg8::gemm_phase<EpiQKVU, DenseSched, true>(F.lds, S, E);
        if (BOTH(2) || rep_ + 1 < REPS(2)) GRID_BAR();
    }
    if (DLY_PH == 2) dly_t1 = __builtin_amdgcn_s_memrealtime();
    if (DLY_PH == 3) dly_t0 = __builtin_amdgcn_s_memrealtime();
    if (IN(3)) _Pragma("unroll") for (int rep_ = 0; rep_ < REPS(3); ++rep_) {
        LAS float* tb = (LAS float*)(F.lds + L_TB);
        for (int i = F.tid; i < 4 * attn_body::TBN; i += NWAVES * 64) { const int h = i / attn_body::TBN, idx = i % attn_body::TBN; const int d = idx - attn_body::TBOFF;
            tb[i] = (d <= 63) ? (rel_bias[t5_bucket(d) * 4 + h] - rel_bias[15 * 4 + h]) * LOG2E : 0.f; }
        __syncthreads();
#if !NAIVE_ATTN
        for (int vv = F.vcu; vv < 256; vv += F.G) {
            const int bjm = vv >> 2, s = vv & 3, b = bjm >> 3, j = bjm & 7;
#pragma unroll 1
            for (int i = 0; i < 4; ++i) { const int vh = i >> 1, qb = (i & 1) ? 7 - s : s;
                attn_body::attn_unit<8>(b, j, vh, qb, (const attn_body::bf16*)QB, (const attn_body::bf16*)KB, (const attn_body::bf16*)VB, (attn_body::bf16*)OA, (char*)lds, tb + (j >> 1) * attn_body::TBN); }
        }
#else
        for (int idx = blockIdx.x * 512 + F.tid; idx < NB * 8 * 2 * SEQ; idx += F.G * 512) {
            const int q = idx & 2047, vh = (idx >> 11) & 1, j = (idx >> 12) & 7, b = idx >> 15, h = j >> 1;
            const bf16* qp = QB + (size_t)(b * SEQ + q) * 512 + j * 64; float qv[64];
#pragma unroll
            for (int d = 0; d < 64; ++d) qv[d] = pg8::bf2f(qp[d]);
            float o[64];
#pragma unroll
            for (int d = 0; d < 64; ++d) o[d] = 0.f;
            float mx = -INFINITY, l = 0.f; const int kend = ((q >> 6) + 1) << 6;
            for (int k = 0; k < kend; ++k) {
                const bf16* kp = KB + (size_t)(b * SEQ + k) * 512 + j * 64; float sdot = 0.f;
#pragma unroll
                for (int d = 0; d < 64; ++d) sdot += qv[d] * pg8::bf2f(kp[d]);
                const int dd = k - q; const int ti = dd + attn_body::TBOFF < 0 ? 0 : dd + attn_body::TBOFF; sdot += tb[h * attn_body::TBN + ti];
                const float mn = fmaxf(mx, sdot), f = exp2f(mx - mn), p = exp2f(sdot - mn); l = l * f + p; mx = mn;
                const bf16* vp = VB + (size_t)(b * SEQ + k) * 512 + h * 128 + vh * 64;
#pragma unroll
                for (int d = 0; d < 64; ++d) o[d] = o[d] * f + p * pg8::bf2f(vp[d]);
            }
            bf16* op = OA + (size_t)(b * SEQ + q) * 1024 + j * 128 + vh * 64; const float il = 1.0f / l;
#pragma unroll
            for (int d = 0; d < 64; ++d) op[d] = (bf16)f2bf(o[d] * il);
        }
#endif
        if (BOTH(3) || rep_ + 1 < REPS(3)) GRID_BAR();
    }
    if (DLY_PH == 3) dly_t1 = __builtin_amdgcn_s_memrealtime();
    if (DLY_PH == 4) dly_t0 = __builtin_amdgcn_s_memrealtime();
    if (IN(4)) _Pragma("unroll") for (int rep_ = 0; rep_ < REPS(4); ++rep_) {
        float lam;
        { const float a = lq1[F.lane] * lk1[F.lane], b2 = lq2[F.lane] * lk2[F.lane]; lam = __expf(wave_sum(a)) - __expf(wave_sum(b2)) + LAM_INIT; }
        for (int m0 = gw; m0 < M; m0 += 2 * NGW) {
            const int h = F.lane >> 4, e0 = (F.lane & 15) * 8; const bool two = m0 + NGW < M;
            v4u a[2], b2[2];
#pragma unroll
            for (int q = 0; q < 2; ++q) if (q == 0 || two) { const size_t m = (size_t)m0 + (size_t)q * NGW;
                a[q] = *(const GAS v4u*)(OA + m * 1024 + h * 256 + e0); b2[q] = *(const GAS v4u*)(OA + m * 1024 + h * 256 + 128 + e0); }
            const f32x4 g0 = *(const f32x4*)(subln_g + e0), g1v = *(const f32x4*)(subln_g + e0 + 4);
#pragma unroll
            for (int q = 0; q < 2; ++q) if (q == 0 || two) { const size_t m = (size_t)m0 + (size_t)q * NGW;
                float o[8];
                o[0] = bfl(a[q].x) - lam * bfl(b2[q].x); o[1] = bfh(a[q].x) - lam * bfh(b2[q].x); o[2] = bfl(a[q].y) - lam * bfl(b2[q].y); o[3] = bfh(a[q].y) - lam * bfh(b2[q].y);
                o[4] = bfl(a[q].z) - lam * bfl(b2[q].z); o[5] = bfh(a[q].z) - lam * bfh(b2[q].z); o[6] = bfl(a[q].w) - lam * bfl(b2[q].w); o[7] = bfh(a[q].w) - lam * bfh(b2[q].w);
                float ss = 0.f;
#pragma unroll
                for (int i = 0; i < 8; ++i) ss += o[i] * o[i];
                ss += __shfl_xor(ss, 1); ss += __shfl_xor(ss, 2); ss += __shfl_xor(ss, 4); ss += __shfl_xor(ss, 8);
                const float rs = (1.0f - LAM_INIT) / sqrtf(ss * (1.0f / 128.0f) + LN_EPS);
                v4u w; w.x = pk2(o[0] * rs * g0.x, o[1] * rs * g0.y); w.y = pk2(o[2] * rs * g0.z, o[3] * rs * g0.w); w.z = pk2(o[4] * rs * g1v.x, o[5] * rs * g1v.y); w.w = pk2(o[6] * rs * g1v.z, o[7] * rs * g1v.w);
                *(GAS v4u*)(MIX + m * 1024 + h * 128 + e0) = w; }
        }
        for (int it = gw; it < (M / 32) * 4; it += NGW) {
            const int g = it & 3, tile = it >> 2, row0 = tile * 32, r32 = F.lane & 31, hi = F.lane >> 5;
            const int row = row0 + r32, tpos = row & (SEQ - 1), tp0 = row0 & (SEQ - 1);
            LAS unsigned char* ut = F.lds + F.wave * 12800;
#pragma unroll
            for (int i = 0; i < 12; ++i) { const int pc = F.lane + 64 * i, rr = pc >> 4, c16 = pc & 15;
                if (rr < 47) { v4u v = (v4u){0u, 0u, 0u, 0u}; if (tp0 - 15 + rr >= 0) v = *(const GAS v4u*)(UB + (size_t)(row0 - 15 + rr) * 512 + g * 128 + c16 * 8); *(LAS v4u*)(ut + rr * 272 + c16 * 16) = v; } }
            LDS_WAIT(); asm volatile("" ::: "memory");
            bf16x8 pf[8];
            const LAS unsigned char* ub = ut + (r32 + 15) * 272 + hi * 16;
            auto pooled = [&](auto WIN_) {
                constexpr int WIN = decltype(WIN_)::value;
                const int nwin = tpos + 1 < WIN ? tpos + 1 : WIN; const float inv = 1.0f / (float)nwin;
#pragma unroll
                for (int s8 = 0; s8 < 8; ++s8) {
                    float sum[8];
#pragma unroll
                    for (int i = 0; i < 8; ++i) sum[i] = 0.f;
                    v4u self;
#pragma unroll
                    for (int k = 0; k < WIN; ++k) { const v4u u4 = *(const LAS v4u*)(ub - k * 272 + s8 * 32); if (k == 0) self = u4;
                        sum[0] += bfl(u4.x); sum[1] += bfh(u4.x); sum[2] += bfl(u4.y); sum[3] += bfh(u4.y); sum[4] += bfl(u4.z); sum[5] += bfh(u4.z); sum[6] += bfl(u4.w); sum[7] += bfh(u4.w); }
                    v4u w; w.x = pk2(sum[0] * inv - bfl(self.x), sum[1] * inv - bfh(self.x)); w.y = pk2(sum[2] * inv - bfl(self.y), sum[3] * inv - bfh(self.y));
                    w.z = pk2(sum[4] * inv - bfl(self.z), sum[5] * inv - bfh(self.z)); w.w = pk2(sum[6] * inv - bfl(self.w), sum[7] * inv - bfh(self.w));
                    pf[s8] = __builtin_bit_cast(bf16x8, w);
                }
            };
            if (g == 0) pooled(std::integral_constant<int, 2>{}); else if (g == 1) pooled(std::integral_constant<int, 4>{}); else if (g == 2) pooled(std::integral_constant<int, 8>{}); else pooled(std::integral_constant<int, 16>{});
            LDS_WAIT(); asm volatile("" ::: "memory");
#pragma unroll
            for (int db = 0; db < 4; ++db) {
                f32x16 acc = f32x16{};
                const bf16* wp = WPOOL + (size_t)g * 128 * 128 + (size_t)(db * 32 + r32) * 128 + hi * 8;
#pragma unroll
                for (int s8 = 0; s8 < 8; ++s8) { const bf16x8 wf = __builtin_bit_cast(bf16x8, *(const GAS v4u*)(wp + s8 * 16)); acc = __builtin_amdgcn_mfma_f32_32x32x16_bf16(wf, pf[s8], acc, 0, 0, 0); }
#pragma unroll
                for (int rq = 0; rq < 4; ++rq) { const int d0 = db * 32 + 8 * rq + 4 * hi; const int cg = g * 128 + d0;
                    const f32x4 bp = *(const f32x4*)(b_pool + cg), ps = *(const f32x4*)(pool_scale + cg);
                    v2u w; w.x = pk2((acc[4 * rq + 0] + bp.x) * ps.x, (acc[4 * rq + 1] + bp.y) * ps.y); w.y = pk2((acc[4 * rq + 2] + bp.z) * ps.z, (acc[4 * rq + 3] + bp.w) * ps.w);
                    *(GAS v2u*)(MIX + (size_t)row * 1024 + 512 + cg) = w; }
            }
        }
        if (BOTH(4) || rep_ + 1 < REPS(4)) GRID_BAR();
    }
    if (DLY_PH == 4) dly_t1 = __builtin_amdgcn_s_memrealtime();
    if (DLY_PH == 5) dly_t0 = __builtin_amdgcn_s_memrealtime();
    if (IN(5)) _Pragma("unroll") for (int rep_ = 0; rep_ < REPS(5); ++rep_) {
        DenseSched S; S.init(MIX, WOUT, M, D, F.G, (int)blockIdx.x);
        EpiT1 E{x, MOD, T1};
        pg8::gemm_phase<EpiT1, DenseSched, true>(F.lds, S, E);
        if (BOTH(5) || rep_ + 1 < REPS(5)) GRID_BAR();
    }
    if (DLY_PH == 5) dly_t1 = __builtin_amdgcn_s_memrealtime();
    if (DLY_PH == 6) dly_t0 = __builtin_amdgcn_s_memrealtime();
    if (IN(6)) _Pragma("unroll 1") for (int rep_ = 0; rep_ < REPS(6); ++rep_) {
        LAS float* H2 = (LAS float*)F.lds;
        LAS float* PART = (LAS float*)F.lds;
        LAS float* LOG = (LAS float*)(F.lds + 131200);
        LAS unsigned* hist = (LAS unsigned*)(F.lds + L_HIST); LAS unsigned* hbase = hist + 32;
        const int i32 = F.lane & 31, kh = F.lane >> 5, kb = F.wave * 128;
        float wreg[64];
#pragma unroll
        for (int kk = 0; kk < 64; ++kk) wreg[kk] = ((const GAS float*)w_router)[(size_t)(kb + 2 * kk + kh) * NE + i32];
        for (int tile = F.vcu; tile < M / 32; tile += F.G) {
            if (F.tid < 32) hist[F.tid] = 0u;
            const int b = (tile * 32) >> 11; const float* sh = MOD + (size_t)b * 6144 + 3072; const float* sc = sh + 1024;
#pragma unroll
            for (int pr = 0; pr < 2; ++pr) {
                f32x4 v[2][4];
#pragma unroll
                for (int r2 = 0; r2 < 2; ++r2) { const GAS f32x4* tr = (const GAS f32x4*)(T1 + (size_t)(tile * 32 + F.wave * 4 + 2 * pr + r2) * D) + F.lane;
#pragma unroll
                    for (int j = 0; j < 4; ++j) v[r2][j] = tr[64 * j]; }
#pragma unroll
                for (int r2 = 0; r2 < 2; ++r2) {
                    const int lr = F.wave * 4 + 2 * pr + r2, m = tile * 32 + lr;
                    float s = 0.f;
#pragma unroll
                    for (int j = 0; j < 4; ++j) s += (v[r2][j].x + v[r2][j].y) + (v[r2][j].z + v[r2][j].w);
                    float mean = wave_sum(s) * (1.f / D); float s2 = 0.f;
#pragma unroll
                    for (int j = 0; j < 4; ++j) { v[r2][j] = v[r2][j] - mean; s2 += (v[r2][j].x * v[r2][j].x + v[r2][j].y * v[r2][j].y) + (v[r2][j].z * v[r2][j].z + v[r2][j].w * v[r2][j].w); }
                    float rstd = 1.f / sqrtf(wave_sum(s2) * (1.f / D) + LN_EPS);
                    s = 0.f;
#pragma unroll
                    for (int j = 0; j < 4; ++j) { const f32x4 gvj = *(const f32x4*)(ln1_g + 4 * F.lane + 256 * j), bvj = *(const f32x4*)(ln1_b + 4 * F.lane + 256 * j);
                        v[r2][j] = (v[r2][j] * rstd) * gvj + bvj; ((GAS f32x4*)(X1 + (size_t)m * D) + F.lane)[64 * j] = v[r2][j]; s += (v[r2][j].x + v[r2][j].y) + (v[r2][j].z + v[r2][j].w); }
                    mean = wave_sum(s) * (1.f / D); s2 = 0.f;
#pragma unroll
                    for (int j = 0; j < 4; ++j) { v[r2][j] = v[r2][j] - mean; s2 += (v[r2][j].x * v[r2][j].x + v[r2][j].y * v[r2][j].y) + (v[r2][j].z * v[r2][j].z + v[r2][j].w * v[r2][j].w); }
                    rstd = 1.f / sqrtf(wave_sum(s2) * (1.f / D) + LN_EPS);
                    GAS unsigned* o8 = (GAS unsigned*)((unsigned char*)XN2 + (size_t)m * D) + F.lane;
#pragma unroll
                    for (int j = 0; j < 4; ++j) { const f32x4 svj = *(const f32x4*)(sc + 4 * F.lane + 256 * j), hvj = *(const f32x4*)(sh + 4 * F.lane + 256 * j);
                        const f32x4 h = (v[r2][j] * rstd) * (svj + 1.0f) + hvj; o8[64 * j] = pk4_fp8(h.x, h.y, h.z, h.w);
                        LAS float* hp = H2 + lr * 1025 + 4 * F.lane + 256 * j; hp[0] = h.x; hp[1] = h.y; hp[2] = h.z; hp[3] = h.w; }
                    asm volatile("" ::: "memory");
                }
            }
            __syncthreads();
            f32x16 acc = f32x16{};
#pragma unroll
            for (int kk = 0; kk < 64; ++kk) acc = __builtin_amdgcn_mfma_f32_32x32x2f32(H2[i32 * 1025 + kb + 2 * kk + kh], wreg[kk], acc, 0, 0, 0);
            __syncthreads();
#pragma unroll
            for (int r = 0; r < 16; ++r) PART[(F.wave * 32 + ((r & 3) + 8 * (r >> 2) + 4 * kh)) * 32 + i32] = acc[r];
            __syncthreads();
#pragma unroll
            for (int q = 0; q < 2; ++q) { const int idx = F.tid + 512 * q, i = idx >> 5, e = idx & 31; float sl = b_router[e];
#pragma unroll
                for (int w = 0; w < 8; ++w) sl += PART[(w * 32 + i) * 32 + e];
                LOG[i * 33 + e] = sl; }
            __syncthreads();
            int myk[2]; unsigned lrk[2]; float mygate[2];
#pragma unroll
            for (int it2 = 0; it2 < 2; ++it2) {
                const int rowl = F.wave * 4 + 2 * it2 + kh; float cur = LOG[rowl * 33 + i32]; float bvv[4]; myk[it2] = -1;
#pragma unroll
                for (int k = 0; k < 4; ++k) { float mv = cur; int me = i32;
#pragma unroll
                    for (int off = 1; off < 32; off <<= 1) { const float ov = __shfl_xor(mv, off); const int oe = __shfl_xor(me, off); if (ov > mv || (ov == mv && oe < me)) { mv = ov; me = oe; } }
                    bvv[k] = mv; if (me == i32) { cur = -INFINITY; myk[it2] = k; } }
                float ex[4], ssum = 0.f;
#pragma unroll
                for (int k = 0; k < 4; ++k) { ex[k] = __expf(bvv[k] - bvv[0]); ssum += ex[k]; }
                const float is = 1.0f / ssum; mygate[it2] = 0.f; lrk[it2] = 0u;
#pragma unroll
                for (int k = 0; k < 4; ++k) if (myk[it2] == k) mygate[it2] = ex[k] * is;
                if (myk[it2] >= 0) lrk[it2] = __hip_atomic_fetch_add(hist + i32, 1u, __ATOMIC_RELAXED, __HIP_MEMORY_SCOPE_WORKGROUP);
            }
            __syncthreads();
            if (F.tid < 32) { const unsigned n = hist[F.tid]; hbase[F.tid] = n ? __hip_atomic_fetch_add(F.ctl + (rep_ + 1 < REPS(6) ? CW_CNT + 4096 : CW_CNT) + 64 * F.tid, n, RLX_AGENT) : 0u; }
            __syncthreads();
#pragma unroll
            for (int it2 = 0; it2 < 2; ++it2) if (myk[it2] >= 0) { const int m = tile * 32 + F.wave * 4 + 2 * it2 + kh; const int pp = (int)(hbase[i32] + lrk[it2]);
                RE[m * 4 + myk[it2]] = i32; RP[m * 4 + myk[it2]] = pp; RG[m * 4 + myk[it2]] = mygate[it2]; if (pp < ECAP) ROWTOK[i32 * ECAP + pp] = m; }
            __syncthreads();
        }
        if (BOTH(6) || rep_ + 1 < REPS(6)) GRID_BAR();
    }
    if (DLY_PH == 6) dly_t1 = __builtin_amdgcn_s_memrealtime();
    if (DLY_PH == 7) dly_t0 = __builtin_amdgcn_s_memrealtime();
    if (IN(7)) _Pragma("unroll") for (int rep_ = 0; rep_ < REPS(7); ++rep_) {
        build_expert_tables(F);
        MoeSched S; S.A = XN2; S.W = WGU; S.rowtok = ROWTOK; S.pexp = (const LAS int*)(F.lds + L_PEXP); S.pfirst = (const LAS int*)(F.lds + L_PFIRST); S.cntl = (const LAS int*)(F.lds + L_CNT);
        S.NP = ((const LAS int*)(F.lds + L_PFIRST))[NE]; S.NT = 8; S.G = F.G; S.vcu = F.vcu; S.gather = true; S.rowb = 1024; S.wexp = (size_t)2048 * 1024; S.wtile = (size_t)128 * 1024; S.whalf = (size_t)1024 * 1024;
        EpiSwiglu E{b_gu, (unsigned char*)HB};
        pg8::gemm_phase<EpiSwiglu, MoeSched, true, true>(F.lds, S, E);
        if (BOTH(7) || rep_ + 1 < REPS(7)) GRID_BAR();
    }
    if (DLY_PH == 7) dly_t1 = __builtin_amdgcn_s_memrealtime();
    if (DLY_PH == 8) dly_t0 = __builtin_amdgcn_s_memrealtime();
    if (IN(8)) _Pragma("unroll") for (int rep_ = 0; rep_ < REPS(8); ++rep_) {
        build_expert_tables(F);
        MoeSched S; S.A = HB; S.W = WD; S.rowtok = ROWTOK; S.pexp = (const LAS int*)(F.lds + L_PEXP); S.pfirst = (const LAS int*)(F.lds + L_PFIRST); S.cntl = (const LAS int*)(F.lds + L_CNT);
        S.NP = ((const LAS int*)(F.lds + L_PFIRST))[NE]; S.NT = 4; S.G = F.G; S.vcu = F.vcu; S.gather = false; S.rowb = 1024; S.wexp = (size_t)1024 * 1024; S.wtile = (size_t)256 * 1024; S.whalf = (size_t)128 * 1024;
        EpiDown E{b_dn, YB};
        pg8::gemm_phase<EpiDown, MoeSched, true, true>(F.lds, S, E);
        if (BOTH(8) || rep_ + 1 < REPS(8)) GRID_BAR();
    }
    if (DLY_PH == 8) dly_t1 = __builtin_amdgcn_s_memrealtime();
    if (DLY_PH == 9) dly_t0 = __builtin_amdgcn_s_memrealtime();
    if (IN(9)) _Pragma("unroll") for (int rep_ = 0; rep_ < REPS(9); ++rep_) {
        build_expert_tables(F);
        const LAS int* pfirst = (const LAS int*)(F.lds + L_PFIRST);
        const unsigned bad = __hip_atomic_load(F.ctl + CW_BAR + XB_TMO, RLX_AGENT);
        for (int m = gw; m < M; m += NGW) {
            const int b = m >> 11; const float* g2 = MOD + (size_t)b * 6144 + 5120;
            f32x4 a[4];
#pragma unroll
            for (int j = 0; j < 4; ++j) a[j] = (f32x4){0.f, 0.f, 0.f, 0.f};
#pragma unroll
            for (int k = 0; k < 4; ++k) { const int e = __builtin_amdgcn_readfirstlane(RE[m * 4 + k]), p = __builtin_amdgcn_readfirstlane(RP[m * 4 + k]); const float gk = RG[m * 4 + k];
                const size_t yrow = (size_t)pfirst[e] * 256 + (size_t)p; const GAS v2u* yp = (const GAS v2u*)(YB + yrow * 1024) + F.lane;
#pragma unroll
                for (int j = 0; j < 4; ++j) { const v2u w = yp[64 * j]; a[j] += (f32x4){bfl(w.x), bfh(w.x), bfl(w.y), bfh(w.y)} * gk; } }
            f32x4 v[4]; float s = 0.f;
#pragma unroll
            for (int j = 0; j < 4; ++j) { const f32x4 xv = ((const GAS f32x4*)(X1 + (size_t)m * D) + F.lane)[64 * j]; const f32x4 gv = *(const f32x4*)(g2 + 4 * F.lane + 256 * j);
                v[j] = xv * DN_ALPHA + gv * a[j]; s += (v[j].x + v[j].y) + (v[j].z + v[j].w); }
            const float mean = wave_sum(s) * (1.f / D); float s2 = 0.f;
#pragma unroll
            for (int j = 0; j < 4; ++j) { v[j] = v[j] - mean; s2 += (v[j].x * v[j].x + v[j].y * v[j].y) + (v[j].z * v[j].z + v[j].w * v[j].w); }
            const float rstd = 1.f / sqrtf(wave_sum(s2) * (1.f / D) + LN_EPS);
#pragma unroll
            for (int j = 0; j < 4; ++j) { const f32x4 gv = *(const f32x4*)(ln2_g + 4 * F.lane + 256 * j), bv = *(const f32x4*)(ln2_b + 4 * F.lane + 256 * j);
                f32x4 o = (v[j] * rstd) * gv + bv; if (bad) { const float qn = __builtin_nanf(""); o = (f32x4){qn, qn, qn, qn}; }
                ((GAS f32x4*)(out + (size_t)m * D) + F.lane)[64 * j] = o; }
        }
    }
    if (DLY_PH >= 0) { if (DLY_PH == 9) dly_t1 = __builtin_amdgcn_s_memrealtime(); const unsigned long long te = __builtin_amdgcn_s_memrealtime(); while (__builtin_amdgcn_s_memrealtime() - te < dly_t1 - dly_t0) __builtin_amdgcn_s_sleep(8); }
#undef IN
#undef BOTH
}

extern "C" void kernel_launch(void* const* d_in, const int* in_sizes, int n_in, void* d_out, int out_size, void* d_ws, size_t ws_size, hipStream_t stream) {
    static int grid = 0;
    if (grid == 0) {
        if (n_in != 25 || in_sizes[0] != M * D || out_size != M * D || ws_size < WS_END) { fprintf(stderr, "kernel_launch: unexpected shapes (n_in %d, in0 %d, out %d, ws %zu); nothing launched\n", n_in, n_in > 0 ? in_sizes[0] : -1, out_size, ws_size); grid = -1; return; }
        int dev = 0, cus = 0, per_cu = 0;
        if (hipGetDevice(&dev) != hipSuccess || hipDeviceGetAttribute(&cus, hipDeviceAttributeMultiprocessorCount, dev) != hipSuccess) { grid = -1; return; }
        if (hipFuncSetAttribute((const void*)mk_fwd, hipFuncAttributeMaxDynamicSharedMemorySize, LDS_BYTES) != hipSuccess) { fprintf(stderr, "kernel_launch: hipFuncSetAttribute failed\n"); grid = -1; return; }
        if (hipOccupancyMaxActiveBlocksPerMultiprocessor(&per_cu, (const void*)mk_fwd, NWAVES * 64, LDS_BYTES) != hipSuccess || per_cu < 1) { fprintf(stderr, "kernel_launch: occupancy query reports %d workgroups per CU\n", per_cu); (void)hipGetLastError(); }
        grid = cus;
    }
    if (grid < 0) return;
    if (hipMemsetAsync((char*)d_ws + WS_CTL, 0, CTL_ZERO_BYTES, stream) != hipSuccess) return;
    Args a{};
    for (int i = 0; i < 25; ++i) a.in[i] = (const float*)d_in[i];
    a.out = (float*)d_out; a.ws = (unsigned char*)d_ws;
#if MK_ONE_LAUNCH
    a.ph_lo = 0; a.ph_hi = NPHASE;
    hipLaunchKernelGGL(mk_fwd, dim3(grid), dim3(NWAVES * 64), LDS_BYTES, stream, a);
#else
    for (int p = 0; p < NPHASE; ++p) { a.ph_lo = p; a.ph_hi = p + 1; hipLaunchKernelGGL(mk_fwd, dim3(grid), dim3(NWAVES * 64), LDS_BYTES, stream, a); }
#endif
}
```

```cpp
#include <hip/hip_runtime.h>
#include <hip/hip_bf16.h>
#include <cstdio>
#include <cstdint>
#include <cmath>
#include <type_traits>

#ifndef MK_ONE_LAUNCH
#define MK_ONE_LAUNCH 1
#endif
#ifndef NAIVE_GEMM
#define NAIVE_GEMM 0
#endif
#ifndef DLY_PH
#define DLY_PH (-1)
#endif
#ifndef NAIVE_ATTN
#define NAIVE_ATTN 0
#endif

#define GAS __attribute__((address_space(1)))
#define LAS __attribute__((address_space(3)))

constexpr int NB = 8, SEQ = 2048, D = 1024, M = NB * SEQ;
constexpr int AW = 512;
constexpr int NIN = 2048;
constexpr int NE = 32, TOPK = 4, FF = 1024;
constexpr int ECAP = 16384;
constexpr int PMAX = (M * TOPK) / 256 + NE;
constexpr float LN_EPS = 1e-5f;
constexpr float DN_ALPHA = 1.189207115002721f;
constexpr float LAM_INIT = 0.2f;
constexpr float LOG2E = 1.4426950408889634f;
constexpr float QSCALE = 0.125f * LOG2E;
constexpr int NWAVES = 8;

namespace pg8 {
#define PG8_LAS __attribute__((address_space(3)))
typedef unsigned short bf16_t;
typedef short bf16x8 __attribute__((ext_vector_type(8)));
typedef float f32x4 __attribute__((ext_vector_type(4)));
typedef unsigned u32x4 __attribute__((ext_vector_type(4)));
constexpr int BM = 256, BK = 64, HALF = 128, HTB = HALF * BK * 2, STAGE_BYTES = 8 * HTB, NXCD = 8, WGM = 8;
constexpr int GK = 1024;

__host__ __device__ __forceinline__ int lds_byte(int r, int c) { const int st = (r >> 4) * 2 + (c >> 5), rr = r & 15, cc = c & 31, ob = rr * 64 + cc * 2; return st * 1024 + (ob ^ (((ob >> 9) & 1) << 5)); }
__host__ __device__ __forceinline__ void stage_rc(int b, int& R, int& C) { const int st = b / 1024, sb = b % 1024, swz = sb ^ (((sb >> 9) & 1) << 5); R = (st >> 1) * 16 + swz / 64; C = (st & 1) * 32 + (swz % 64) / 2; }
__host__ __device__ __forceinline__ int perm32(int rho) { const int n = rho >> 4, i = rho & 15; return 8 * (i >> 2) + 4 * n + (i & 3); }

struct Unit { int pm, pn, e, lrow0, cnt; };

__device__ __forceinline__ unsigned cvt_pk_bf16(float lo, float hi) { unsigned r; asm volatile("v_cvt_pk_bf16_f32 %0, %1, %2" : "=v"(r) : "v"(lo), "v"(hi)); return r; }
__device__ __forceinline__ float bf2f(unsigned short v) { return __uint_as_float((unsigned)v << 16); }

#if !NAIVE_GEMM
typedef int v8i32 __attribute__((ext_vector_type(8)));
typedef int v4i32 __attribute__((ext_vector_type(4)));
template <class Epi, class Sched, bool ALIGN_EPI, bool FP8 = false>
__device__ __forceinline__ void gemm_phase(PG8_LAS unsigned char* lds, const Sched& S, const Epi& E) {
    constexpr int RB = FP8 ? 1024 : 2048, nt = RB / 128;
    const int tid = threadIdx.x, wid = __builtin_amdgcn_readfirstlane(tid >> 6), lane = tid & 63, wr = wid >> 2, wc = wid & 3, fr = lane & 15, fq = lane >> 4;
    int Rr[2], Cc[2]; unsigned voffB[2];
#pragma unroll
    for (int i = 0; i < 2; ++i) { int R, C; stage_rc(tid * 16 + i * 8192, R, C); Rr[i] = R; Cc[i] = C; const int Rb = Epi::PERM ? ((R & ~31) + perm32(R & 31)) : R; voffB[i] = (unsigned)(Rb * RB + C * 2); }
    const size_t kstep = (size_t)(BK * 2);
    const size_t hB = S.b_hstep();
    const unsigned ldsw = (unsigned)wid * 1024u;
    const int aoff = lds_byte(wr * 64 + fr, fq * 8), boff = lds_byte(wc * 32 + fr, fq * 8);
#define PG8_SA(b, h) (((b) * 2 + (h)) * HTB)
#define PG8_SB(b, h) ((4 + (b) * 2 + (h)) * HTB)
#define PG8_STAGE(bufoff, gbase, voff) do { _Pragma("unroll") for (int _i = 0; _i < 2; ++_i) \
        __builtin_amdgcn_global_load_lds((const unsigned*)((const char*)(gbase) + (voff)[_i]), (PG8_LAS unsigned*)(lds + (bufoff) + ldsw + _i * 8192), 16, 0, 0); } while (0)
#define PG8_LD32(p) __builtin_shufflevector(*(const PG8_LAS v4i32*)(p), *(const PG8_LAS v4i32*)((p) + 1024), 0, 1, 2, 3, 4, 5, 6, 7)
#define PG8_LDA(dst, b, h) do { if constexpr (FP8) { _Pragma("unroll") for (int m = 0; m < 4; ++m) dst##8[m] = PG8_LD32(lds + PG8_SA(b, h) + aoff + m * 2048); } \
        else { _Pragma("unroll") for (int m = 0; m < 4; ++m) _Pragma("unroll") for (int k = 0; k < 2; ++k) dst[m][k] = *(const PG8_LAS bf16x8*)(lds + PG8_SA(b, h) + aoff + m * 2048 + k * 1024); } } while (0)
#define PG8_LDB(dst, b, h) do { if constexpr (FP8) { _Pragma("unroll") for (int n = 0; n < 2; ++n) dst##8[n] = PG8_LD32(lds + PG8_SB(b, h) + boff + n * 2048); } \
        else { _Pragma("unroll") for (int n = 0; n < 2; ++n) _Pragma("unroll") for (int k = 0; k < 2; ++k) dst[n][k] = *(const PG8_LAS bf16x8*)(lds + PG8_SB(b, h) + boff + n * 2048 + k * 1024); } } while (0)
#define PG8_CAT(x) __builtin_shufflevector(__builtin_bit_cast(v4i32, (x)[0]), __builtin_bit_cast(v4i32, (x)[1]), 0, 1, 2, 3, 4, 5, 6, 7)
#define PG8_MMA(ai, bj, At, Bt) do { __builtin_amdgcn_s_setprio(1); \
        if constexpr (FP8) { _Pragma("unroll") for (int m = 0; m < 4; ++m) _Pragma("unroll") for (int n = 0; n < 2; ++n) \
            asm volatile("v_mfma_scale_f32_16x16x128_f8f6f4 %0, %1, %2, %0, %3, %3 op_sel_hi:[0,0,0]" : "+v"(acc[ai][bj][m][n]) : "v"(Bt##8[n]), "v"(At##8[m]), "v"(one8)); } \
        else { _Pragma("unroll") for (int m = 0; m < 4; ++m) _Pragma("unroll") for (int n = 0; n < 2; ++n) _Pragma("unroll") for (int k = 0; k < 2; ++k) \
            acc[ai][bj][m][n] = __builtin_amdgcn_mfma_f32_16x16x32_bf16(Bt[n][k], At[m][k], acc[ai][bj][m][n], 0, 0, 0); } \
        __builtin_amdgcn_s_setprio(0); } while (0)
#define PG8_WAIT_V(n) asm volatile("s_waitcnt vmcnt(" #n ")" ::: "memory")
#define PG8_WAIT_L(n) asm volatile("s_waitcnt lgkmcnt(" #n ")" ::: "memory")
#define PG8_BAR __builtin_amdgcn_s_barrier()
#define PG8_SCHED __builtin_amdgcn_sched_barrier(0)
    Unit cur, nxt; int ui = 0;
    if (!S.next(0, cur)) return;
    f32x4 acc[2][2][4][2];
#pragma unroll
    for (int a = 0; a < 2; ++a)
#pragma unroll
        for (int b = 0; b < 2; ++b)
#pragma unroll
            for (int m = 0; m < 4; ++m)
#pragma unroll
                for (int n = 0; n < 2; ++n) acc[a][b][m][n] = (f32x4){0.f, 0.f, 0.f, 0.f};
    const int one8 = 0x7f7f7f7f;
    bf16x8 At[4][2], B0[2][2], B1[2][2]; v8i32 At8[4], B08[2], B18[2];
    const char* cA = S.a_base(cur); const char* cB = S.b_base(cur);
    unsigned va0[2], va1[2];
    S.a_voff(cur, Rr, Cc, va0, va1);
    PG8_STAGE(PG8_SB(0, 0), cB, voffB); PG8_STAGE(PG8_SB(0, 1), cB + hB, voffB); PG8_STAGE(PG8_SA(0, 0), cA, va0); PG8_STAGE(PG8_SA(0, 1), cA, va1);
    if (wr == 1) PG8_BAR;
    PG8_WAIT_V(2); PG8_BAR;
    PG8_STAGE(PG8_SB(1, 0), cB + kstep, voffB); PG8_STAGE(PG8_SA(1, 0), cA + kstep, va0); PG8_STAGE(PG8_SB(1, 1), cB + hB + kstep, voffB);
    PG8_WAIT_V(6); PG8_BAR;
    for (;;) {
        const bool has_next = S.next(ui + 1, nxt);
        const char* nA = has_next ? S.a_base(nxt) : cA; const char* nB = has_next ? S.b_base(nxt) : cB;
        unsigned vn0[2], vn1[2];
        if (has_next) S.a_voff(nxt, Rr, Cc, vn0, vn1); else { vn0[0] = va0[0]; vn0[1] = va0[1]; vn1[0] = va1[0]; vn1[1] = va1[1]; }
#pragma unroll 1
        for (int t = 0; t < nt; t += 2) {
            const bool last = (t == nt - 2);
            const char* a1 = cA + (size_t)(t + 1) * kstep;
            const char* a2 = last ? nA : cA + (size_t)(t + 2) * kstep; const char* b2 = last ? nB : cB + (size_t)(t + 2) * kstep;
            const char* a3 = a2 + kstep; const char* b3 = b2 + kstep;
            asm volatile("" : "+v"(voffB[0]), "+v"(voffB[1]), "+v"(va0[0]), "+v"(va0[1]), "+v"(va1[0]), "+v"(va1[1]));
            unsigned v20[2], v21[2];
            v20[0] = last ? vn0[0] : va0[0]; v20[1] = last ? vn0[1] : va0[1]; v21[0] = last ? vn1[0] : va1[0]; v21[1] = last ? vn1[1] : va1[1];
            PG8_LDB(B0, 0, 0); PG8_LDB(B1, 0, 1); PG8_SCHED; PG8_LDA(At, 0, 0); PG8_STAGE(PG8_SA(1, 1), a1, va1);
            PG8_WAIT_V(8); PG8_WAIT_L(0); PG8_BAR; PG8_MMA(0, 0, At, B0); PG8_MMA(0, 1, At, B1); PG8_BAR; PG8_SCHED;
            PG8_LDA(At, 0, 1); PG8_STAGE(PG8_SB(0, 0), b2, voffB); PG8_STAGE(PG8_SB(0, 1), b2 + hB, voffB); PG8_STAGE(PG8_SA(0, 0), a2, v20);
            PG8_WAIT_V(8); PG8_WAIT_L(0); PG8_BAR; PG8_MMA(1, 0, At, B0); PG8_MMA(1, 1, At, B1); PG8_BAR; PG8_SCHED;
            PG8_LDB(B0, 1, 0); PG8_LDB(B1, 1, 1); PG8_SCHED; PG8_LDA(At, 1, 0); PG8_STAGE(PG8_SA(0, 1), a2, v21);
            PG8_WAIT_V(8); PG8_WAIT_L(0); PG8_BAR; PG8_MMA(0, 0, At, B0); PG8_MMA(0, 1, At, B1); PG8_BAR; PG8_SCHED;
            PG8_LDA(At, 1, 1); PG8_STAGE(PG8_SB(1, 0), b3, voffB); PG8_STAGE(PG8_SB(1, 1), b3 + hB, voffB); PG8_STAGE(PG8_SA(1, 0), a3, v20);
            PG8_WAIT_V(8); PG8_WAIT_L(0); PG8_BAR; PG8_MMA(1, 0, At, B0); PG8_MMA(1, 1, At, B1); PG8_BAR; PG8_SCHED;
        }
        if constexpr (ALIGN_EPI) { if (wr == 0) PG8_BAR; }
        if constexpr (FP8) asm volatile("s_nop 15\n\ts_nop 15" ::: "memory");
        { int fr_ = fr, fq_ = fq; asm volatile("" : "+v"(fr_), "+v"(fq_));
          E(acc, cur, wr, wc, fr_, fq_); }
        if (!has_next) break;
#pragma unroll
        for (int a = 0; a < 2; ++a)
#pragma unroll
            for (int b = 0; b < 2; ++b)
#pragma unroll
                for (int m = 0; m < 4; ++m)
#pragma unroll
                    for (int n = 0; n < 2; ++n) acc[a][b][m][n] = (f32x4){0.f, 0.f, 0.f, 0.f};
        cur = nxt; cA = nA; cB = nB; va0[0] = vn0[0]; va0[1] = vn0[1]; va1[0] = vn1[0]; va1[1] = vn1[1]; ++ui;
        if constexpr (ALIGN_EPI) { if (wr == 1) PG8_BAR; }
    }
    PG8_WAIT_V(0);
    if constexpr (!ALIGN_EPI) { if (wr == 0) PG8_BAR; }
    PG8_BAR;
#undef PG8_SA
#undef PG8_SB
#undef PG8_STAGE
#undef PG8_LDA
#undef PG8_LD32
#undef PG8_LDB
#undef PG8_MMA
#undef PG8_CAT
#undef PG8_WAIT_V
#undef PG8_WAIT_L
#undef PG8_BAR
#undef PG8_SCHED
}
#else
template <class Epi, class Sched, bool ALIGN_EPI, bool FP8 = false>
__device__ __forceinline__ void gemm_phase(PG8_LAS unsigned char*, const Sched& S, const Epi& E) {
    constexpr int K = GK;
    const int tid = threadIdx.x, wid = __builtin_amdgcn_readfirstlane(tid >> 6), lane = tid & 63, wr = wid >> 2, wc = wid & 3, fr = lane & 15, fq = lane >> 4;
    Unit u;
    for (int ui = 0; S.next(ui, u); ++ui) {
        f32x4 acc[2][2][4][2];
#pragma unroll
        for (int ai = 0; ai < 2; ++ai)
#pragma unroll
            for (int bj = 0; bj < 2; ++bj) {
                const bf16_t* ar[4]; const bf16_t* br[2][4];
#pragma unroll
                for (int m = 0; m < 4; ++m) ar[m] = S.a_row(u, ai * 128 + wr * 64 + m * 16 + fr);
#pragma unroll
                for (int n = 0; n < 2; ++n)
#pragma unroll
                    for (int x = 0; x < 4; ++x) br[n][x] = S.b_row(u, bj * 128 + wc * 32 + (Epi::PERM ? 8 * fq + 4 * n + x : 16 * n + 4 * fq + x));
                float s[4][2][4];
#pragma unroll
                for (int m = 0; m < 4; ++m)
#pragma unroll
                    for (int n = 0; n < 2; ++n)
#pragma unroll
                        for (int x = 0; x < 4; ++x) s[m][n][x] = 0.f;
                for (int k0 = 0; k0 < K; k0 += 8) {
                    bf16x8 av[4], bv[2][4];
#pragma unroll
                    for (int m = 0; m < 4; ++m) av[m] = *(const bf16x8*)(ar[m] + k0);
#pragma unroll
                    for (int n = 0; n < 2; ++n)
#pragma unroll
                        for (int x = 0; x < 4; ++x) bv[n][x] = *(const bf16x8*)(br[n][x] + k0);
#pragma unroll
                    for (int kk = 0; kk < 8; ++kk)
#pragma unroll
                        for (int m = 0; m < 4; ++m) { const float a = bf2f((unsigned short)av[m][kk]);
#pragma unroll
                            for (int n = 0; n < 2; ++n)
#pragma unroll
                                for (int x = 0; x < 4; ++x) s[m][n][x] += a * bf2f((unsigned short)bv[n][x][kk]); }
                }
#pragma unroll
                for (int m = 0; m < 4; ++m)
#pragma unroll
                    for (int n = 0; n < 2; ++n) acc[ai][bj][m][n] = (f32x4){s[m][n][0], s[m][n][1], s[m][n][2], s[m][n][3]};
            }
        E(acc, u, wr, wc, fr, fq);
    }
}
#endif
}

constexpr size_t MiB = 1u << 20;
constexpr size_t WS_CTL = 0, CTL_ZERO_BYTES = 1 * MiB;
constexpr size_t WS_MOD = 1 * MiB;
constexpr size_t WS_WPOOL = 1 * MiB + 512 * 1024;
constexpr size_t WS_WIN = 2 * MiB;
constexpr size_t WS_WOUT = 6 * MiB;
constexpr size_t WS_WGU = 8 * MiB;
constexpr size_t WS_WD = 136 * MiB;
constexpr size_t WS_XN = 200 * MiB;
constexpr size_t WS_Q = 232 * MiB, WS_K = 248 * MiB, WS_V = 264 * MiB, WS_U = 280 * MiB;
constexpr size_t WS_OA = 296 * MiB;
constexpr size_t WS_MIX = 328 * MiB;
constexpr size_t WS_T1 = 360 * MiB;
constexpr size_t WS_X1 = 424 * MiB;
constexpr size_t WS_XN2 = 488 * MiB;
constexpr size_t WS_RE = 520 * MiB, WS_RP = 521 * MiB, WS_RG = 522 * MiB;
constexpr size_t WS_ROWTOK = 524 * MiB;
constexpr size_t WS_H = 528 * MiB;
constexpr size_t WS_Y = 672 * MiB;
constexpr size_t WS_END = 816 * MiB;
static_assert((size_t)PMAX * 256 * 1024 * 2 == 144 * MiB, "H / Y size");
constexpr int CW_TMO = 0, CW_CODE = 1;
constexpr int CW_BAR = 4096;
constexpr int CW_AQ = 6144;
constexpr int CW_CNT = 8192;

constexpr int RING_BYTES = 131072;
constexpr int LDS_BYTES = 147456;
constexpr int LCTL_OFF = 139264;
constexpr int L_MISC = LCTL_OFF;
constexpr int L_CNT = LCTL_OFF + 128;
constexpr int L_PFIRST = LCTL_OFF + 256;
constexpr int L_PEXP = LCTL_OFF + 512;
constexpr int L_HIST = LCTL_OFF + 512 + 4 * 320;
constexpr int L_TB = 106496;
static_assert(L_TB + 4 * 704 * 4 <= RING_BYTES && L_HIST + 256 <= LDS_BYTES && PMAX <= 320, "LDS map");

typedef unsigned short bf16;
typedef unsigned v4u __attribute__((ext_vector_type(4)));
typedef unsigned v2u __attribute__((ext_vector_type(2)));
typedef float f32x4 __attribute__((ext_vector_type(4)));
typedef float f32x16 __attribute__((ext_vector_type(16)));
typedef short bf16x8 __attribute__((ext_vector_type(8)));
typedef GAS unsigned gu32;
#define RLX_AGENT __ATOMIC_RELAXED, __HIP_MEMORY_SCOPE_AGENT
#define LDS_WAIT() asm volatile("s_waitcnt lgkmcnt(0)" ::: "memory")
#define VM_WAIT() asm volatile("s_waitcnt vmcnt(0)" ::: "memory")
__device__ __forceinline__ unsigned f2bf(float f) { unsigned u = __builtin_bit_cast(unsigned, f); return (u + 0x7fffu + ((u >> 16) & 1u)) >> 16; }
__device__ __forceinline__ unsigned pk2(float lo, float hi) { return f2bf(lo) | (f2bf(hi) << 16); }
__device__ __forceinline__ float bfl(unsigned w) { return __uint_as_float(w << 16); }
__device__ __forceinline__ float bfh(unsigned w) { return __uint_as_float(w & 0xffff0000u); }

namespace attn_body {
using bf16=__hip_bfloat16;
using bf16x8=__attribute__((ext_vector_type(8)))short;
using s16x4=__attribute__((ext_vector_type(4)))short;
using f32x16=__attribute__((ext_vector_type(16)))float;
using u32x4=__attribute__((ext_vector_type(4)))unsigned;
constexpr int SEQ=2048,DH=64,PQ=512,PO=1024;
constexpr int NW=8,QBLK=32,QB=QBLK*NW,KVBLK=64,NQB=SEQ/QB;
__device__ __forceinline__ int crow(int r,int hi){return (r&3)+8*(r>>2)+4*hi;}
#define SBAR() __builtin_amdgcn_sched_barrier(0)
constexpr int TBN=704, TBOFF=447;
__device__ __forceinline__ void bandinit(f32x16&p0,f32x16&p1,int t,int q0,int wid,int r32,int hi,const __attribute__((address_space(3))) float*tb){
  const __attribute__((address_space(3))) float*tp=tb+(64*t+4*hi-(q0+32*wid+r32)+TBOFF);
  #pragma unroll
  for(int r=0;r<16;++r){p0[r]=tp[(r&3)+8*(r>>2)]; p1[r]=tp[(r&3)+8*(r>>2)+32];}
}
__device__ __forceinline__ void bandpost(f32x16&p0,f32x16&p1,const f32x16&negm,int t,int q0,int wid){
  const float nm=(t>(q0>>6)+(wid>>1))?-INFINITY:negm[0];
  #pragma unroll
  for(int r=0;r<16;++r){p0[r]+=nm;p1[r]+=nm;}
}
constexpr int NSLOT=3, SLOTB=8192;
constexpr int LDS_K=0, LDS_V=NSLOT*SLOTB, LDS_WS=2*NSLOT*SLOTB, LDS_OST=LDS_WS+NW*64*4, LDS_BYTES=LDS_OST+NW*4096;
__device__ __forceinline__ void glds16(const void*gsrc,unsigned lds_dst){unsigned keep;
  asm volatile("s_mov_b32 %0, m0\n\ts_mov_b32 m0, %2\n\ts_nop 0\n\tglobal_load_lds_dwordx4 %1, off\n\ts_mov_b32 m0, %0":"=&s"(keep):"v"(gsrc),"s"(lds_dst):"memory");}
__device__ __forceinline__ float max3f(float a,float b,float c){float r;asm("v_max3_f32 %0, %1, %2, %3":"=v"(r):"v"(a),"v"(b),"v"(c));return r;}
__device__ __forceinline__ float max2f(float a,float b){float r;asm("v_max_f32_e32 %0, %1, %2":"=v"(r):"v"(a),"v"(b));return r;}
__device__ __forceinline__ float fadd_s(float a,float b){float r;asm("v_add_f32_e32 %0, %1, %2":"=v"(r):"v"(a),"v"(b));return r;}
__device__ __forceinline__ float fsub_s(float a,float b){float r;asm("v_sub_f32_e32 %0, %1, %2":"=v"(r):"v"(a),"v"(b));return r;}
typedef float f32x2_t __attribute__((ext_vector_type(2))); typedef __bf16 bf16x2_t __attribute__((ext_vector_type(2)));
__device__ __forceinline__ unsigned cvtpk_s(float lo,float hi){f32x2_t v={lo,hi};bf16x2_t b=__builtin_convertvector(v,bf16x2_t);return __builtin_bit_cast(unsigned,b);}
#define WAIT_BAR(N) asm volatile("s_waitcnt vmcnt(" #N ") lgkmcnt(0)\n\ts_barrier":::"memory")

__device__ __forceinline__ void qkt(f32x16&p0,f32x16&p1,const char*Kslot,const bf16x8*qr,int r32,int hi){
  const char*kb=Kslot+hi*1024+r32*16;
  #pragma unroll
  for(int d0=0;d0<4;++d0){
    const bf16x8 b0=*reinterpret_cast<const bf16x8*>(kb+d0*2048);
    const bf16x8 b1=*reinterpret_cast<const bf16x8*>(kb+d0*2048+512);
    p0=__builtin_amdgcn_mfma_f32_32x32x16_bf16(b0,qr[d0],p0,0,0,0);p1=__builtin_amdgcn_mfma_f32_32x32x16_bf16(b1,qr[d0],p1,0,0,0);}
}
typedef __attribute__((address_space(3))) const char* lds_cptr;
typedef short v4i16_t __attribute__((ext_vector_type(4)));
__device__ __forceinline__ void kload8(bf16x8*kf,lds_cptr kp){
  kf[0]=*(const __attribute__((address_space(3))) bf16x8*)(kp);      kf[1]=*(const __attribute__((address_space(3))) bf16x8*)(kp+512);
  kf[2]=*(const __attribute__((address_space(3))) bf16x8*)(kp+2048); kf[3]=*(const __attribute__((address_space(3))) bf16x8*)(kp+2560);
  kf[4]=*(const __attribute__((address_space(3))) bf16x8*)(kp+4096); kf[5]=*(const __attribute__((address_space(3))) bf16x8*)(kp+4608);
  kf[6]=*(const __attribute__((address_space(3))) bf16x8*)(kp+6144); kf[7]=*(const __attribute__((address_space(3))) bf16x8*)(kp+6656);
}
__device__ __forceinline__ void kload2(bf16x8*kf,lds_cptr kp,int j){ kf[2*j]=*(const __attribute__((address_space(3))) bf16x8*)(kp+j*2048); kf[2*j+1]=*(const __attribute__((address_space(3))) bf16x8*)(kp+j*2048+512); }
__device__ __forceinline__ s16x4 vtr(lds_cptr p){ return __builtin_bit_cast(s16x4,__builtin_amdgcn_ds_read_tr16_b64_v4i16((__attribute__((address_space(3))) v4i16_t*)p)); }
__device__ __forceinline__ float rowmax(const f32x16&p0,const f32x16&p1){
  float a=max3f(p0[0],p0[1],p1[0]),b=max3f(p0[2],p0[3],p1[1]);a=max3f(a,p1[2],p1[3]);
  #pragma unroll
  for(int r=4;r<16;r+=4){a=max3f(a,p0[r],p0[r+1]);b=max3f(b,p0[r+2],p0[r+3]);a=max3f(a,p1[r],p1[r+1]);b=max3f(b,p1[r+2],p1[r+3]);}
  const float m=max2f(a,b);
  auto rr=__builtin_amdgcn_permlane32_swap(__float_as_uint(m),__float_as_uint(m),false,false);
  return max2f(__uint_as_float(rr[0]),__uint_as_float(rr[1]));
}
__device__ __forceinline__ void pv(f32x16*o,int vb,bf16x8 pa0,bf16x8 pa1,bf16x8 pa2,bf16x8 pa3){
  #pragma unroll
  for(int d0=0;d0<2;++d0){s16x4 lo[4],hi[4];
    #pragma unroll
    for(int ks=0;ks<4;++ks){
      asm volatile("ds_read_b64_tr_b16 %0,%1 offset:%c2":"=&v"(lo[ks]):"v"(vb),"i"(d0*4096+ks*1024):"memory");
      asm volatile("ds_read_b64_tr_b16 %0,%1 offset:%c2":"=&v"(hi[ks]):"v"(vb),"i"(d0*4096+ks*1024+512):"memory");}
    asm volatile("s_waitcnt lgkmcnt(0)":::"memory");SBAR();
    #define PK(k) (bf16x8){lo[k][0],lo[k][1],lo[k][2],lo[k][3],hi[k][0],hi[k][1],hi[k][2],hi[k][3]}
    o[d0]=__builtin_amdgcn_mfma_f32_32x32x16_bf16(pa0,PK(0),o[d0],0,0,0);
    o[d0]=__builtin_amdgcn_mfma_f32_32x32x16_bf16(pa1,PK(1),o[d0],0,0,0);
    o[d0]=__builtin_amdgcn_mfma_f32_32x32x16_bf16(pa2,PK(2),o[d0],0,0,0);
    o[d0]=__builtin_amdgcn_mfma_f32_32x32x16_bf16(pa3,PK(3),o[d0],0,0,0);
    #undef PK
  }
}
#define ATTN_STORE16(p,v) (*(u32x4*)(p)=(v))
template<int THRL> __device__ __forceinline__ void attn_unit(int b,int j,int vh,int qb,const bf16*Q,const bf16*__restrict__ K,const bf16*__restrict__ V,bf16*O,char*shm,const __attribute__((address_space(3))) float*tbh){
  int tid_=threadIdx.x; asm volatile("":"+v"(tid_));
  const int tid=tid_,lane=tid&63,r32=lane&31,hi=lane>>5; const int wid=__builtin_amdgcn_readfirstlane(tid>>6);
  const long rowbase=(long)b*SEQ; const int q0=qb*QB;
  const bf16*Qw=Q+(rowbase+q0+wid*QBLK)*PQ+j*DH;
  const bf16*Kh=K+rowbase*PQ+j*DH,*Vh=V+rowbase*PQ+(j>>1)*128+vh*64;
  const unsigned lds0=(unsigned)(uintptr_t)shm;
  float*wsf=(float*)(shm+LDS_WS)+wid*64;
  const bf16*ksrc=Kh+(long)lane*PQ+wid*8;
  const bf16*vsrc=Vh+(long)(16*(wid&3)+(lane>>2))*PQ+(wid>>2)*32+(lane&3)*8;
  const unsigned kdst=lds0+LDS_K+wid*1024, vdst=lds0+LDS_V+wid*1024;
  #define DMA_K(t,slot) glds16(ksrc+(long)(t)*KVBLK*PQ,(unsigned)__builtin_amdgcn_readfirstlane(kdst+(slot)))
  #define DMA_V(t,slot) glds16(vsrc+(long)(t)*KVBLK*PQ,(unsigned)__builtin_amdgcn_readfirstlane(vdst+(slot)))
  const int vb0=(int)(lds0+LDS_V)+((lane>>4)&1)*32+(lane&3)*8+(4*hi+((lane&15)>>2))*64;
  const char*Kbase=shm+LDS_K; bf16x8 kf[8];
  const lds_cptr shm3=(lds_cptr)shm; const lds_cptr kp0=shm3+LDS_K+hi*1024+r32*16; const lds_cptr vp0=shm3+LDS_V+((lane>>4)&1)*32+(lane&3)*8+(4*hi+((lane&15)>>2))*64;
  const int NT=(q0+QB)/KVBLK;
  DMA_K(0,0);DMA_V(0,0);DMA_K(1,SLOTB);
  bf16x8 qr[4];
  #pragma unroll
  for(int d0=0;d0<4;++d0)qr[d0]=*reinterpret_cast<const bf16x8*>(&Qw[(long)r32*PQ+d0*16+hi*8]);
  float mhat=0.f,l_reg=0.f;f32x16 o[2];o[0]=f32x16{};o[1]=f32x16{};f32x16 negm=f32x16{};asm volatile("":"+v"(negm));
  #define BINIT(C0,C1,t) bandinit(C0,C1,(t),q0,wid,r32,hi,tbh)
  bool resc=false;
  #define START(P0,P1) do{ const float rm=rowmax(P0,P1); resc=false; \
    { const float dl=rm; mhat=fadd_s(mhat,dl); \
      _Pragma("unroll") for(int r=0;r<16;++r){P0[r]=fsub_s(P0[r],dl);P1[r]=fsub_s(P1[r],dl);} \
      _Pragma("unroll") for(int r=0;r<16;++r)negm[r]=-mhat; asm volatile("":"+v"(negm)); } \
    _Pragma("unroll") for(int r=0;r<16;++r)P0[r]=__builtin_amdgcn_exp2f(P0[r]); }while(0)
  #define RESC() do{ if(resc){ asm volatile("s_waitcnt lgkmcnt(0)":::"memory"); \
      _Pragma("unroll") for(int d_=0;d_<2;++d_) _Pragma("unroll") for(int r=0;r<16;++r)o[d_][r]*=wsf[crow(r,hi)]; } }while(0)
  f32x16 pA0,pA1,pB0,pB1;
  int sl_prev=0,sl_cur=0,sl_next=SLOTB;
  #define ROT() do{sl_prev=sl_cur;sl_cur=sl_next;sl_next=(sl_next==(NSLOT-1)*SLOTB)?0:sl_next+SLOTB;}while(0)
  DMA_K(2,2*SLOTB);
  WAIT_BAR(3);
  if(NT<=7){BINIT(pA0,pA1,0);}else{pA0=f32x16{};pA1=f32x16{};}
  qkt(pA0,pA1,Kbase,qr,r32,hi);asm volatile("s_nop 15\n\ts_nop 7":"+v"(pA0),"+v"(pA1));
  START(pA0,pA1);
  _Pragma("unroll") for(int r=0;r<16;++r)pA1[r]=__builtin_amdgcn_exp2f(pA1[r]);
  WAIT_BAR(0);
  DMA_K(3,0);DMA_V(1,SLOTB);
  ROT();
  kload8(kf,kp0+sl_cur);
  WAIT_BAR(2);
  s16x4 vlo[8],vhi[8]; u32x4 pw0,pw1,pw2,pw3;
  #define PKW(P,B) cvtpk_s(P[B],P[B+1])
  #define PAF(k) __builtin_bit_cast(bf16x8,pw##k)
  #define VFR(i) (bf16x8){vlo[i][0],vlo[i][1],vlo[i][2],vlo[i][3],vhi[i][0],vhi[i][1],vhi[i][2],vhi[i][3]}
  #define PIN(x) asm volatile("":"+v"(x))
  #define MX3(a,b,c) __builtin_fmaxf(__builtin_fmaxf((a),(b)),(c))
  #define GAPA(MF,A0,A1,A2,A3,W0,W1,PW) do{ MF; sacc+=A0; sacc+=A1; sacc+=A2; sacc+=A3; PIN(sacc); W0; W1; PIN(PW); SBAR(); }while(0)
  #define EX(v) __builtin_amdgcn_exp2f(v)
  #define GAPB(MF,X,B) do{ MF; X[B]=EX(X[B]); X[B+1]=EX(X[B+1]); X[B+2]=EX(X[B+2]); X[B+3]=EX(X[B+3]); PIN(X); SBAR(); }while(0)
  #define VRD(i) do{ vlo[i]=vtr(vp_+(((i)>>2)*4096+((i)&3)*1024)); vhi[i]=vtr(vp_+(((i)>>2)*4096+((i)&3)*1024+512)); }while(0)
  #define KRD(G,j) do{ if(G){ kload2(kf,kp0+sl_next,j); SBAR(); } }while(0)
  #define STEP(C0,C1,P0,P1,t,GK,GV,GL,PRE,I0,I1,POST) do{ SBAR(); PRE; SBAR(); \
    const lds_cptr vp_=vp0+sl_prev; \
    VRD(0); SBAR(); float sacc=(P0[0]+P0[1]); \
    GAPA(C0=__builtin_amdgcn_mfma_f32_32x32x16_bf16(kf[0],qr[0],I0,0,0,0), P0[2],P0[3],P0[4],P0[5],     pw0[0]=PKW(P0,0), pw0[1]=PKW(P0,2), pw0); \
    VRD(4); SBAR(); GAPA(C1=__builtin_amdgcn_mfma_f32_32x32x16_bf16(kf[1],qr[0],I1,0,0,0), P0[6],P0[7],P0[8],P0[9],     pw0[2]=PKW(P0,4), pw0[3]=PKW(P0,6), pw0); \
    VRD(1); SBAR(); GAPA(C0=__builtin_amdgcn_mfma_f32_32x32x16_bf16(kf[2],qr[1],C0,0,0,0),   P0[10],P0[11],P0[12],P0[13], pw1[0]=PKW(P0,8), pw1[1]=PKW(P0,10), pw1); \
    VRD(5); SBAR(); GAPA(C1=__builtin_amdgcn_mfma_f32_32x32x16_bf16(kf[3],qr[1],C1,0,0,0),   P0[14],P0[15],P1[0],P1[1],   pw1[2]=PKW(P0,12),pw1[3]=PKW(P0,14), pw1); \
    VRD(2); SBAR(); GAPA(C0=__builtin_amdgcn_mfma_f32_32x32x16_bf16(kf[4],qr[2],C0,0,0,0),   P1[2],P1[3],P1[4],P1[5],     pw2[0]=PKW(P1,0), pw2[1]=PKW(P1,2), pw2); \
    VRD(6); SBAR(); GAPA(C1=__builtin_amdgcn_mfma_f32_32x32x16_bf16(kf[5],qr[2],C1,0,0,0),   P1[6],P1[7],P1[8],P1[9],     pw2[2]=PKW(P1,4), pw2[3]=PKW(P1,6), pw2); \
    VRD(3); SBAR(); GAPA(C0=__builtin_amdgcn_mfma_f32_32x32x16_bf16(kf[6],qr[3],C0,0,0,0),   P1[10],P1[11],P1[12],P1[13], pw3[0]=PKW(P1,8), pw3[1]=PKW(P1,10), pw3); \
    VRD(7); SBAR(); GAPA(C1=__builtin_amdgcn_mfma_f32_32x32x16_bf16(kf[7],qr[3],C1,0,0,0),   P1[14],P1[15],0.f,0.f,       pw3[2]=PKW(P1,12),pw3[3]=PKW(P1,14), pw3); \
    l_reg+=sacc; \
    if(GK){DMA_K((t)+3,sl_cur);} if(GV){DMA_V((t)+1,sl_next);} \
    POST; \
    { float a=MX3(C0[0],C0[1],C1[0]),b=MX3(C0[2],C0[3],C1[1]); a=MX3(a,C1[2],C1[3]); \
      _Pragma("unroll") for(int r=4;r<16;r+=4){a=MX3(a,C0[r],C0[r+1]);b=MX3(b,C0[r+2],C0[r+3]);a=MX3(a,C1[r],C1[r+1]);b=MX3(b,C1[r+2],C1[r+3]);} \
      float rm=__builtin_fmaxf(a,b); { auto rr=__builtin_amdgcn_permlane32_swap(__float_as_uint(rm),__float_as_uint(rm),false,false); rm=__builtin_fmaxf(__uint_as_float(rr[0]),__uint_as_float(rr[1])); } \
      resc=false; \
      if(__builtin_expect(__any(rm>(float)THRL),0)){ const float dl=__builtin_fmaxf(rm,0.f); mhat+=dl; \
        _Pragma("unroll") for(int r=0;r<16;++r){C0[r]-=dl;C1[r]-=dl;} \
        _Pragma("unroll") for(int r=0;r<16;++r)negm[r]=-mhat; asm volatile("":"+v"(negm)); \
        const float f=__builtin_amdgcn_exp2f(-dl); l_reg*=f; if(hi==0)wsf[r32]=f; resc=true; } } \
    SBAR(); \
    GAPB(o[0]=__builtin_amdgcn_mfma_f32_32x32x16_bf16(PAF(0),VFR(0),o[0],0,0,0), C0,0); \
    GAPB(o[1]=__builtin_amdgcn_mfma_f32_32x32x16_bf16(PAF(0),VFR(4),o[1],0,0,0), C0,4); \
    KRD(GL,0); GAPB(o[0]=__builtin_amdgcn_mfma_f32_32x32x16_bf16(PAF(1),VFR(1),o[0],0,0,0), C0,8); \
    KRD(GL,1); GAPB(o[1]=__builtin_amdgcn_mfma_f32_32x32x16_bf16(PAF(1),VFR(5),o[1],0,0,0), C0,12); \
    KRD(GL,2); GAPB(o[0]=__builtin_amdgcn_mfma_f32_32x32x16_bf16(PAF(2),VFR(2),o[0],0,0,0), C1,0); \
    KRD(GL,3); GAPB(o[1]=__builtin_amdgcn_mfma_f32_32x32x16_bf16(PAF(2),VFR(6),o[1],0,0,0), C1,4); \
    GAPB(o[0]=__builtin_amdgcn_mfma_f32_32x32x16_bf16(PAF(3),VFR(3),o[0],0,0,0), C1,8); \
    GAPB(o[1]=__builtin_amdgcn_mfma_f32_32x32x16_bf16(PAF(3),VFR(7),o[1],0,0,0), C1,12); \
    }while(0)
  int t=1;
  for(;t+7<NT;t+=2){
    STEP(pB0,pB1,pA0,pA1,t,true,true,true,,negm,negm,);     WAIT_BAR(2); RESC(); ROT();
    STEP(pA0,pA1,pB0,pB1,t+1,true,true,true,,negm,negm,);   WAIT_BAR(2); RESC(); ROT();
  }
  #define ENDW(tt) do{ if((tt)+3<NT){WAIT_BAR(2);} else if((tt)+2<NT){WAIT_BAR(1);} else {WAIT_BAR(0);} }while(0)
  for(;t+1<NT;t+=2){
    STEP(pB0,pB1,pA0,pA1,t,(t+3<NT),(t+1<NT),(t+1<NT),BINIT(pB0,pB1,t),pB0,pB1,bandpost(pB0,pB1,negm,t,q0,wid));           ENDW(t);   RESC(); ROT();
    STEP(pA0,pA1,pB0,pB1,t+1,(t+4<NT),(t+2<NT),(t+2<NT),BINIT(pA0,pA1,t+1),pA0,pA1,bandpost(pA0,pA1,negm,t+1,q0,wid));       ENDW(t+1); RESC(); ROT();
  }
  STEP(pB0,pB1,pA0,pA1,NT-1,false,false,false,BINIT(pB0,pB1,NT-1),pB0,pB1,bandpost(pB0,pB1,negm,NT-1,q0,wid)); RESC();
  { float sacc=pB0[0]+pB0[1]; _Pragma("unroll") for(int r=2;r<16;++r)sacc+=pB0[r]; _Pragma("unroll") for(int r=0;r<16;++r)sacc+=pB1[r]; l_reg+=sacc;
    pw0=(u32x4){PKW(pB0,0),PKW(pB0,2),PKW(pB0,4),PKW(pB0,6)};pw1=(u32x4){PKW(pB0,8),PKW(pB0,10),PKW(pB0,12),PKW(pB0,14)};pw2=(u32x4){PKW(pB1,0),PKW(pB1,2),PKW(pB1,4),PKW(pB1,6)};pw3=(u32x4){PKW(pB1,8),PKW(pB1,10),PKW(pB1,12),PKW(pB1,14)};
    SBAR(); pv(o,vb0+sl_cur,PAF(0),PAF(1),PAF(2),PAF(3)); }
  #undef PKW
  #undef PAF
  #undef VFR
  #undef PIN
  #undef MX3
  #undef GAPA
  #undef GAPB
  #undef EX
  #undef VRD
  #undef KRD
  #undef STEP
  #undef ENDW
  {auto rr=__builtin_amdgcn_permlane32_swap(__float_as_uint(l_reg),__float_as_uint(l_reg),false,false);l_reg=__uint_as_float(rr[0])+__uint_as_float(rr[1]);}
  if(hi==0)wsf[32+r32]=l_reg;asm volatile("s_waitcnt lgkmcnt(0)":::"memory");
  float rli[16];
  #pragma unroll
  for(int r=0;r<16;++r)rli[r]=__builtin_amdgcn_rcpf(wsf[32+crow(r,hi)]);
  bf16*Ow=O+(rowbase+q0+wid*QBLK)*PO+j*128+vh*64;
  { bf16*stg=(bf16*)(shm+LDS_OST)+wid*2048;
    #pragma unroll
    for(int r=0;r<16;++r){const int orow=crow(r,hi);
      #pragma unroll
      for(int d0=0;d0<2;++d0)stg[orow*64+d0*32+r32]=__float2bfloat16(o[d0][r]*rli[r]);}
    asm volatile("s_waitcnt lgkmcnt(0)":::"memory");
    #pragma unroll
    for(int i=0;i<4;++i){const int row=i*8+(lane>>3),ch=lane&7; const u32x4 v=*(const u32x4*)(stg+row*64+ch*8); ATTN_STORE16(Ow+(long)row*PO+ch*8,v);} }
  asm volatile("s_waitcnt lgkmcnt(0)\n\ts_barrier":::"memory");
  #undef DMA_K
  #undef DMA_V
  #undef BINIT
  #undef START
  #undef RESC
  #undef ROT
}
constexpr int ATTN_LDS_BYTES=LDS_BYTES;
#undef SBAR
#undef WAIT_BAR
}

#define XB_TMO      128
#define XB_XCNT(j)  (256  + 64 * (j))
#define XB_XSUB(j)  (1280 + 64 * (j))
#define XB_XGEN(j)  (2304 + 64 * (j))
#define XB_TOP      3328
#define XB_TOPGEN   3392
#define XCD_BAR_WORDS 3456
#define XB_SPIN_CAP (1u << 18)
__device__ __forceinline__ unsigned xb_ld(unsigned* p)              { return __hip_atomic_load(p, __ATOMIC_RELAXED, __HIP_MEMORY_SCOPE_AGENT); }
__device__ __forceinline__ unsigned xb_add(unsigned* p, unsigned v) { return __hip_atomic_fetch_add(p, v, __ATOMIC_RELAXED, __HIP_MEMORY_SCOPE_AGENT); }
__device__ __forceinline__ unsigned xb_xcc_id() { return (unsigned)__builtin_amdgcn_s_getreg((3 << 11) | 20) & 0xFu; }
#define XB_SPIN(cond, bar) do { unsigned _sp = 0; while (cond) { __builtin_amdgcn_s_sleep(1); \
    if ((++_sp & 255u) == 0u) { if (xb_ld(&(bar)[XB_TMO])) break; if (_sp > XB_SPIN_CAP) { atomicAdd(&(bar)[XB_TMO], 1u); break; } } } } while (0)
struct XcdBarrier { unsigned* bar; unsigned x; volatile LAS unsigned* st; };
__device__ __forceinline__ XcdBarrier xcd_barrier_post(unsigned* bar, volatile LAS unsigned* st) {
    XcdBarrier b; b.bar = bar; b.x = xb_xcc_id(); b.st = st;
    if (threadIdx.x == 0) (void)xb_add(&bar[XB_XCNT(b.x)], 1u);
    return b;
}
__device__ __forceinline__ void xcd_barrier_complete(unsigned* bar, unsigned x, unsigned& nloc, unsigned& nx) {
    const unsigned G = gridDim.x * gridDim.y * gridDim.z;
    unsigned sum, cnt, mine, sp = 0u;
    for (;;) {
        sum = 0u; cnt = 0u; mine = 0u;
#pragma unroll
        for (unsigned j = 0; j < 16; ++j) { const unsigned c = xb_ld(&bar[XB_XCNT(j)]); sum += c; cnt += (c > 0u) ? 1u : 0u; mine = (j == x) ? c : mine; }
        if (sum == G) break;
        __builtin_amdgcn_s_sleep(1);
        if ((++sp & 255u) == 0u) { if (xb_ld(&bar[XB_TMO])) break; if (sp > XB_SPIN_CAP) { atomicAdd(&bar[XB_TMO], 1u); break; } }
    }
    nloc = mine > 0u ? mine : 1u; nx = cnt > 0u ? cnt : 1u;
}
__device__ __forceinline__ void xcd_barrier(const XcdBarrier& b) {
    asm volatile("s_waitcnt vmcnt(0)" ::: "memory");
    __syncthreads();
    if (threadIdx.x == 0) {
        unsigned* bar = b.bar;
        __builtin_amdgcn_s_waitcnt(0);
        unsigned nloc = b.st[0], nx = b.st[1];
        if (nloc == 0u) { xcd_barrier_complete(bar, b.x, nloc, nx); b.st[0] = nloc; b.st[1] = nx; }
        const unsigned old = xb_add(&bar[XB_XSUB(b.x)], 1u);
        const unsigned gen = old / nloc;
        if (old + 1u == (gen + 1u) * nloc) {
            __builtin_amdgcn_fence(__ATOMIC_RELEASE, "agent");
            asm volatile("s_waitcnt vmcnt(0)" ::: "memory");
            const unsigned og = xb_add(&bar[XB_TOP], 1u);
            const unsigned tg = og / nx;
            if (og + 1u == (tg + 1u) * nx) xb_add(&bar[XB_TOPGEN], 1u);
            else XB_SPIN(xb_ld(&bar[XB_TOPGEN]) == tg, bar);
            __builtin_amdgcn_fence(__ATOMIC_ACQUIRE, "agent");
            xb_add(&bar[XB_XGEN(b.x)], 1u);
            asm volatile("s_waitcnt vmcnt(0)" ::: "memory");
        } else {
            XB_SPIN(xb_ld(&bar[XB_XGEN(b.x)]) == gen, bar);
            __builtin_amdgcn_fence(__ATOMIC_ACQUIRE, "agent");
            asm volatile("s_waitcnt vmcnt(0)" ::: "memory");
        }
    }
    __syncthreads();
}

struct Frame {
    LAS unsigned char* lds;
    unsigned char* ws;
    gu32* ctl;
    int tid, lane, wave;
    int vcu, G;
};
__device__ __forceinline__ float wave_sum(float v) {
#pragma unroll
    for (int o = 1; o < 64; o <<= 1) v += __shfl_xor(v, o);
    return v;
}
struct TItem { const float* src; bf16* dst; int K, N; };
__device__ __forceinline__ unsigned pk4_fp8(float a, float b, float c, float d) {
    int w = __builtin_amdgcn_cvt_pk_fp8_f32(a, b, 0, false); w = __builtin_amdgcn_cvt_pk_fp8_f32(c, d, w, true); return (unsigned)w; }
constexpr float W8_SCALE = 64.0f, W8_INV = 1.0f / 64.0f;
__device__ __forceinline__ void p0_load(const TItem& t, f32x4 (&v)[8], int wave, int lane) {
    const GAS float* sp = (const GAS float*)t.src + (size_t)(8 * (2 * wave + (lane >> 5))) * t.N + 4 * (lane & 31);
#pragma unroll
    for (int i = 0; i < 8; ++i) v[i] = __builtin_nontemporal_load((const GAS f32x4*)(sp + (size_t)i * t.N));
}
__device__ __forceinline__ void p0_store(const TItem& t, const f32x4 (&v)[8], LAS unsigned char* img, int wave, int lane) {
    const int kg = 2 * wave + (lane >> 5), n4 = lane & 31;
#pragma unroll
    for (int x = 0; x < 4; ++x) { v4u w; w.x = pg8::cvt_pk_bf16(v[0][x], v[1][x]); w.y = pg8::cvt_pk_bf16(v[2][x], v[3][x]); w.z = pg8::cvt_pk_bf16(v[4][x], v[5][x]); w.w = pg8::cvt_pk_bf16(v[6][x], v[7][x]);
        *(LAS v4u*)(img + (4 * n4 + x) * 272 + kg * 16) = w; }
    asm volatile("s_waitcnt lgkmcnt(0)\n\ts_barrier" ::: "memory");
#pragma unroll
    for (int j = 0; j < 4; ++j) { const int n = 16 * wave + 4 * j + (lane >> 4), kc = lane & 15;
        const v4u o = *(const LAS v4u*)(img + n * 272 + kc * 16);
        *(GAS v4u*)(t.dst + (size_t)n * t.K + 8 * kc) = o; }
}
__device__ __forceinline__ void p0_store8(const TItem& t, const f32x4 (&v)[8], LAS unsigned char* img, int wave, int lane) {
    const int kg = 2 * wave + (lane >> 5), n4 = lane & 31;
#pragma unroll
    for (int x = 0; x < 4; ++x) { v2u w; w.x = pk4_fp8(v[0][x] * W8_SCALE, v[1][x] * W8_SCALE, v[2][x] * W8_SCALE, v[3][x] * W8_SCALE); w.y = pk4_fp8(v[4][x] * W8_SCALE, v[5][x] * W8_SCALE, v[6][x] * W8_SCALE, v[7][x] * W8_SCALE);
        *(LAS v2u*)(img + (4 * n4 + x) * 144 + kg * 8) = w; }
    asm volatile("s_waitcnt lgkmcnt(0)\n\ts_barrier" ::: "memory");
    unsigned char* dst = (unsigned char*)t.dst;
#pragma unroll
    for (int j = 0; j < 2; ++j) { const int n = 16 * wave + 8 * j + (lane >> 3), kc = lane & 7;
        const v4u o = *(const LAS v4u*)(img + n * 144 + kc * 16);
        *(GAS v4u*)(dst + (size_t)n * t.K + 16 * kc) = o; }
}
__device__ __forceinline__ int t5_bucket(int rel) {
    const int n = rel < 0 ? -rel : rel; int b;
    if (n < 8) b = n; else if (n < 12) b = 8; else if (n < 16) b = 9; else if (n < 23) b = 10; else if (n < 32) b = 11; else if (n < 46) b = 12; else if (n < 64) b = 13; else if (n < 91) b = 14; else b = 15;
    return b + (rel > 0 ? 16 : 0);
}

struct DenseSched {
    const bf16* A; const bf16* Bt; int nM, nN, nwg, G, c;
    __device__ __forceinline__ void init(const bf16* A_, const bf16* Bt_, int M_, int N_, int G_, int c_) { A = A_; Bt = Bt_; nM = M_ / 256; nN = N_ / 256; nwg = nM * nN; G = G_; c = c_; }
    __device__ __forceinline__ bool next(int i, pg8::Unit& u) const {
        const long L = (long)i * G + c; if (L >= nwg) return false;
        int wgid = (int)L; { const int q = nwg / 8, r = nwg % 8, xcd = wgid % 8, off = wgid / 8; wgid = (xcd < r ? xcd * (q + 1) : r * (q + 1) + (xcd - r) * q) + off; }
        const int nig = 8 * nN, gid = wgid / nig, fm = gid * 8, gsz = (nM - fm) < 8 ? (nM - fm) : 8;
        u.pm = fm + ((wgid % nig) % gsz); u.pn = (wgid % nig) / gsz; u.e = 0; u.lrow0 = 0; u.cnt = 0; return true;
    }
    __device__ __forceinline__ const char* a_base(const pg8::Unit& u) const { return (const char*)A + (size_t)u.pm * (256 * 1024 * 2); }
    __device__ __forceinline__ const char* b_base(const pg8::Unit& u) const { return (const char*)Bt + (size_t)u.pn * (256 * 1024 * 2); }
    __device__ __forceinline__ size_t b_hstep() const { return (size_t)128 * 1024 * 2; }
    __device__ __forceinline__ void a_voff(const pg8::Unit&, const int (&R)[2], const int (&C)[2], unsigned (&v0)[2], unsigned (&v1)[2]) const {
#pragma unroll
        for (int i = 0; i < 2; ++i) { v0[i] = (unsigned)(R[i] * 1024 + C[i]) * 2u; v1[i] = v0[i] + 128u * 1024u * 2u; } }
    __device__ __forceinline__ const bf16* a_row(const pg8::Unit& u, int r) const { return A + (size_t)(u.pm * 256 + r) * 1024; }
    __device__ __forceinline__ const bf16* b_row(const pg8::Unit& u, int c_) const { return Bt + (size_t)(u.pn * 256 + c_) * 1024; }
};
struct MoeSched {
    const bf16* A; const bf16* W; const int* rowtok; const LAS int* pexp; const LAS int* pfirst; const LAS int* cntl;
    int NP, NT, G, vcu; bool gather; int rowb  ; size_t wexp  , wtile  , whalf;
    __device__ __forceinline__ bool next(int i, pg8::Unit& u) const {
        const int L = i * G + vcu; if (L >= NP * NT) return false;
        const int pi = L / NT; const int e = __builtin_amdgcn_readfirstlane(pexp[pi]);
        u.pm = pi; u.pn = L - pi * NT; u.e = e; u.lrow0 = (pi - __builtin_amdgcn_readfirstlane(pfirst[e])) * 256; u.cnt = __builtin_amdgcn_readfirstlane(cntl[e]); return true;
    }
    __device__ __forceinline__ const char* a_base(const pg8::Unit& u) const { return gather ? (const char*)A : (const char*)A + (size_t)u.pm * 256 * (size_t)rowb; }
    __device__ __forceinline__ const char* b_base(const pg8::Unit& u) const { return (const char*)W + (size_t)u.e * wexp + (size_t)u.pn * wtile; }
    __device__ __forceinline__ size_t b_hstep() const { return whalf; }
    __device__ __forceinline__ int tok_of(const pg8::Unit& u, int r) const { const int lr = u.lrow0 + r; return lr < u.cnt ? ((const GAS int*)rowtok)[u.e * ECAP + lr] : 0; }
    __device__ __forceinline__ void a_voff(const pg8::Unit& u, const int (&R)[2], const int (&C)[2], unsigned (&v0)[2], unsigned (&v1)[2]) const {
        if (gather) {
#pragma unroll
            for (int i = 0; i < 2; ++i) { v0[i] = (unsigned)(tok_of(u, R[i]) * rowb + C[i] * 2); v1[i] = (unsigned)(tok_of(u, 128 + R[i]) * rowb + C[i] * 2); }
        } else {
#pragma unroll
            for (int i = 0; i < 2; ++i) { v0[i] = (unsigned)(R[i] * rowb + C[i] * 2); v1[i] = v0[i] + 128u * (unsigned)rowb; }
        }
    }
    __device__ __forceinline__ const bf16* a_row(const pg8::Unit& u, int r) const { return gather ? A + (size_t)tok_of(u, r) * 1024 : A + (size_t)(u.pm * 256 + r) * 1024; }
    __device__ __forceinline__ const bf16* b_row(const pg8::Unit& u, int c_) const { return (const bf16*)((const char*)W + (size_t)u.e * wexp + (size_t)u.pn * wtile + (c_ >= 128 ? whalf : 0) + (size_t)(c_ & 127) * 2048); }
};

struct EpiQKVU {
    static constexpr bool PERM = true;
    bf16* O; size_t stride;
    __device__ __forceinline__ void operator()(const pg8::f32x4 (&acc)[2][2][4][2], const pg8::Unit& u, int wr, int wc, int fr, int fq) const {
        const int t = u.pn >> 1; const float sc = t == 0 ? QSCALE : 1.f;
        bf16* base = O + (size_t)t * stride; const int col0 = (u.pn & 1) * 256 + wc * 32 + 8 * fq; const int row0 = u.pm * 256 + wr * 64 + fr;
#pragma unroll
        for (int ai = 0; ai < 2; ++ai)
#pragma unroll
            for (int m = 0; m < 4; ++m) { bf16* rowp = base + (size_t)(row0 + ai * 128 + m * 16) * 512 + col0;
#pragma unroll
                for (int bj = 0; bj < 2; ++bj) { const pg8::f32x4 v0 = acc[ai][bj][m][0] * sc, v1 = acc[ai][bj][m][1] * sc;
                    pg8::u32x4 w; w.x = pg8::cvt_pk_bf16(v0[0], v0[1]); w.y = pg8::cvt_pk_bf16(v0[2], v0[3]); w.z = pg8::cvt_pk_bf16(v1[0], v1[1]); w.w = pg8::cvt_pk_bf16(v1[2], v1[3]);
                    *(pg8::u32x4*)(rowp + bj * 128) = w; } }
    }
};
struct EpiT1 {
    static constexpr bool PERM = false;
    const float* x; const float* mod; float* T1;
    __device__ __forceinline__ void operator()(const pg8::f32x4 (&acc)[2][2][4][2], const pg8::Unit& u, int wr, int wc, int fr, int fq) const {
        const int b = u.pm >> 3; const float* g1 = mod + (size_t)b * 6144 + 2048;
        const int col0 = u.pn * 256 + wc * 32 + 4 * fq;
        pg8::f32x4 gv[2][2];
#pragma unroll
        for (int bj = 0; bj < 2; ++bj)
#pragma unroll
            for (int n = 0; n < 2; ++n) gv[bj][n] = *(const pg8::f32x4*)(g1 + col0 + bj * 128 + n * 16);
#pragma unroll
        for (int ai = 0; ai < 2; ++ai)
#pragma unroll
            for (int m = 0; m < 4; ++m) { const size_t off = (size_t)(u.pm * 256 + ai * 128 + wr * 64 + m * 16 + fr) * 1024 + col0;
#pragma unroll
                for (int bj = 0; bj < 2; ++bj)
#pragma unroll
                    for (int n = 0; n < 2; ++n) { const pg8::f32x4 xv = *(const pg8::f32x4*)(x + off + bj * 128 + n * 16);
                        *(pg8::f32x4*)(T1 + off + bj * 128 + n * 16) = xv * DN_ALPHA + gv[bj][n] * acc[ai][bj][m][n]; } }
    }
};
struct EpiSwiglu {
    static constexpr bool PERM = true;
    const float* bgu; unsigned char* H;
    __device__ __forceinline__ void operator()(const pg8::f32x4 (&acc)[2][2][4][2], const pg8::Unit& u, int wr, int wc, int fr, int fq) const {
        const int c0 = u.pn * 128 + wc * 32 + 8 * fq; const float* bg = bgu + (size_t)u.e * 2048 + c0;
        pg8::f32x4 bgv[2], buv[2];
#pragma unroll
        for (int n = 0; n < 2; ++n) { bgv[n] = *(const pg8::f32x4*)(bg + 4 * n); buv[n] = *(const pg8::f32x4*)(bg + 1024 + 4 * n); }
#pragma unroll
        for (int ai = 0; ai < 2; ++ai)
#pragma unroll
            for (int m = 0; m < 4; ++m) { float r[8];
#pragma unroll
                for (int n = 0; n < 2; ++n)
#pragma unroll
                    for (int x = 0; x < 4; ++x) { const float g = fminf(acc[ai][0][m][n][x] * W8_INV + bgv[n][x], 7.0f); const float up = fminf(fmaxf(acc[ai][1][m][n][x] * W8_INV + buv[n][x], -7.0f), 7.0f);
                        const float sg = __builtin_amdgcn_rcpf(1.0f + __builtin_amdgcn_exp2f(-1.702f * LOG2E * g)); r[4 * n + x] = (up + 1.0f) * (g * sg); }
                v2u w; w.x = pk4_fp8(r[0], r[1], r[2], r[3]); w.y = pk4_fp8(r[4], r[5], r[6], r[7]);
                *(v2u*)(H + (size_t)(u.pm * 256 + ai * 128 + wr * 64 + m * 16 + fr) * 1024 + c0) = w; }
    }
};
struct EpiDown {
    static constexpr bool PERM = true;
    const float* bd; bf16* Y;
    __device__ __forceinline__ void operator()(const pg8::f32x4 (&acc)[2][2][4][2], const pg8::Unit& u, int wr, int wc, int fr, int fq) const {
        const int c0 = u.pn * 256 + wc * 32 + 8 * fq; const float* bp = bd + (size_t)u.e * 1024 + c0;
        pg8::f32x4 bv[2][2];
#pragma unroll
        for (int bj = 0; bj < 2; ++bj)
#pragma unroll
            for (int n = 0; n < 2; ++n) bv[bj][n] = *(const pg8::f32x4*)(bp + bj * 128 + 4 * n);
#pragma unroll
        for (int ai = 0; ai < 2; ++ai)
#pragma unroll
            for (int m = 0; m < 4; ++m) { bf16* rowp = Y + (size_t)(u.pm * 256 + ai * 128 + wr * 64 + m * 16 + fr) * 1024 + c0;
#pragma unroll
                for (int bj = 0; bj < 2; ++bj) { const pg8::f32x4 v0 = acc[ai][bj][m][0] * W8_INV + bv[bj][0], v1 = acc[ai][bj][m][1] * W8_INV + bv[bj][1];
                    pg8::u32x4 w; w.x = pg8::cvt_pk_bf16(v0[0], v0[1]); w.y = pg8::cvt_pk_bf16(v0[2], v0[3]); w.z = pg8::cvt_pk_bf16(v1[0], v1[1]); w.w = pg8::cvt_pk_bf16(v1[2], v1[3]);
                    *(pg8::u32x4*)(rowp + bj * 128) = w; } }
    }
};

__device__ __forceinline__ void build_expert_tables(Frame& F) {
    LAS int* cntl = (LAS int*)(F.lds + L_CNT); LAS int* pfirst = (LAS int*)(F.lds + L_PFIRST); LAS int* pexp = (LAS int*)(F.lds + L_PEXP);
    __syncthreads();
    if (F.tid < NE) { int c = (int)__hip_atomic_load(F.ctl + CW_CNT + 64 * F.tid, RLX_AGENT); c = c < 0 ? 0 : (c > ECAP ? ECAP : c); cntl[F.tid] = c; }
    __syncthreads();
    if (F.tid == 0) { int p = 0; for (int e = 0; e < NE; ++e) { pfirst[e] = p; const int np = (cntl[e] + 255) >> 8; for (int k = 0; k < np; ++k) if (p + k < PMAX) pexp[p + k] = e; p += np; if (p > PMAX) p = PMAX; } pfirst[NE] = p; }
    __syncthreads();
}

struct Args { const float* in[25]; float* out; unsigned char* ws; int ph_lo, ph_hi; };
constexpr int NPHASE = 10;

__global__ void __launch_bounds__(NWAVES * 64, 2) mk_fwd(Args args) {
    extern __shared__ __attribute__((aligned(16))) unsigned char lds[];
    Frame F;
    F.lds = (LAS unsigned char*)lds; F.ws = args.ws; F.ctl = (gu32*)(args.ws + WS_CTL);
    F.tid = threadIdx.x; F.lane = F.tid & 63; F.wave = __builtin_amdgcn_readfirstlane(F.tid >> 6);
    F.G = gridDim.x; { const int bx = blockIdx.x; F.vcu = (F.G % 8 == 0) ? (bx % 8) * (F.G / 8) + bx / 8 : bx; }
    volatile LAS unsigned* MISC = (volatile LAS unsigned*)(F.lds + L_MISC);
    for (int u = F.tid; u < (LDS_BYTES - LCTL_OFF) / 4; u += NWAVES * 64) ((LAS unsigned*)(F.lds + LCTL_OFF))[u] = 0u;
    __syncthreads();
    XcdBarrier bar; bar.bar = (unsigned*)(F.ctl + CW_BAR); bar.x = 0; bar.st = nullptr;
#if MK_ONE_LAUNCH
    bar = xcd_barrier_post((unsigned*)(F.ctl + CW_BAR), MISC + 8);
#define GRID_BAR() xcd_barrier(bar)
#else
#define GRID_BAR() do { } while (0)
#endif
    const int lo = args.ph_lo, hi = args.ph_hi;
#ifndef PH_MASK
#define PH_MASK 0x3ff
#endif
#ifndef REP_MASK
#define REP_MASK 0x0
#endif
#define REPS(k) (1 + ((REP_MASK >> (k)) & 1))
#define IN(k) (((PH_MASK >> (k)) & 1) && lo <= (k) && (k) < hi)
#define BOTH(k) (IN(k) && IN((k) + 1))
    const float* x = args.in[0]; const float* cvec = args.in[1]; const float* w_ada = args.in[2]; const float* b_ada = args.in[3]; const float* w_in = args.in[4];
    const float* lq1 = args.in[5]; const float* lk1 = args.in[6]; const float* lq2 = args.in[7]; const float* lk2 = args.in[8]; const float* subln_g = args.in[9];
    const float* rel_bias = args.in[10]; const float* w_pool = args.in[11]; const float* b_pool = args.in[12]; const float* pool_scale = args.in[13]; const float* w_out = args.in[14];
    const float* ln1_g = args.in[15]; const float* ln1_b = args.in[16]; const float* w_router = args.in[17]; const float* b_router = args.in[18];
    const float* w_gu = args.in[19]; const float* b_gu = args.in[20]; const float* w_dn = args.in[21]; const float* b_dn = args.in[22]; const float* ln2_g = args.in[23]; const float* ln2_b = args.in[24];
    float* out = args.out; unsigned char* ws = args.ws;
    float* MOD = (float*)(ws + WS_MOD); bf16* WPOOL = (bf16*)(ws + WS_WPOOL); bf16* WIN = (bf16*)(ws + WS_WIN); bf16* WOUT = (bf16*)(ws + WS_WOUT);
    bf16* WGU = (bf16*)(ws + WS_WGU); bf16* WD = (bf16*)(ws + WS_WD); bf16* XN = (bf16*)(ws + WS_XN);
    bf16* QB = (bf16*)(ws + WS_Q); bf16* KB = (bf16*)(ws + WS_K); bf16* VB = (bf16*)(ws + WS_V); bf16* UB = (bf16*)(ws + WS_U);
    bf16* OA = (bf16*)(ws + WS_OA); bf16* MIX = (bf16*)(ws + WS_MIX); float* T1 = (float*)(ws + WS_T1); float* X1 = (float*)(ws + WS_X1); bf16* XN2 = (bf16*)(ws + WS_XN2);
    int* RE = (int*)(ws + WS_RE); int* RP = (int*)(ws + WS_RP); float* RG = (float*)(ws + WS_RG); int* ROWTOK = (int*)(ws + WS_ROWTOK);
    bf16* HB = (bf16*)(ws + WS_H); bf16* YB = (bf16*)(ws + WS_Y);
    const int gw = F.vcu * NWAVES + F.wave, NGW = F.G * NWAVES;
    unsigned long long dly_t0 = 0, dly_t1 = 0;

    if (DLY_PH == 0) dly_t0 = __builtin_amdgcn_s_memrealtime();
    if (IN(0)) _Pragma("unroll") for (int rep_ = 0; rep_ < REPS(0); ++rep_) {
        LAS float* sil = (LAS float*)(F.lds + 3 * 34816);
        for (int i = F.tid; i < NB * D; i += NWAVES * 64) { const float v = cvec[i]; sil[i] = v / (1.0f + __expf(-v)); }
        __syncthreads();
        constexpr int I_MOD = 6144 / 16, T_IN = (D / 128) * (NIN / 128), T_OUT = (D / 128) * (D / 128), T_POOL = 4, T_GU1 = (D / 128) * (2048 / 128), T_D1 = (FF / 128) * (D / 128);
        constexpr int NTR = T_IN + T_OUT + T_POOL + NE * T_GU1 + NE * T_D1;
        for (int r = NGW - 1 - gw; r < I_MOD; r += NGW) {
            const int kq = F.lane >> 4, col = r * 16 + (F.lane & 15); float a[NB];
#pragma unroll
            for (int b = 0; b < NB; ++b) a[b] = 0.f;
#pragma unroll 16
            for (int k = kq; k < D; k += 4) { const float w = ((const GAS float*)w_ada)[(size_t)k * 6144 + col];
#pragma unroll
                for (int b = 0; b < NB; ++b) a[b] += sil[b * D + k] * w; }
#pragma unroll
            for (int b = 0; b < NB; ++b) { a[b] += __shfl_xor(a[b], 16); a[b] += __shfl_xor(a[b], 32); }
            if (kq == 0) { const float bb = b_ada[col];
#pragma unroll
                for (int b = 0; b < NB; ++b) MOD[(size_t)b * 6144 + col] = a[b] + bb; }
        }
        for (int r0 = F.vcu; r0 < T_IN + T_OUT + T_POOL; r0 += F.G) {
            int r = r0; const float* W; bf16* WT; int K, N, item;
            if (r < T_IN) { W = w_in; WT = WIN; K = D; N = NIN; item = r; }
            else if ((r -= T_IN) < T_OUT) { W = w_out; WT = WOUT; K = D; N = D; item = r; }
            else { r -= T_OUT; W = w_pool + (size_t)r * 128 * 128; WT = WPOOL + (size_t)r * 128 * 128; K = 128; N = 128; item = 0; }
            const int nblk = N / 128, kb = item / nblk, nb = item - kb * nblk;
            TItem t; t.src = W + (size_t)(128 * kb) * N + 128 * nb; t.dst = WT + (size_t)(128 * nb) * K + 128 * kb; t.K = K; t.N = N;
            f32x4 bb[8]; p0_load(t, bb, F.wave, F.lane); p0_store(t, bb, F.lds, F.wave, F.lane);
            asm volatile("s_waitcnt lgkmcnt(0)\n\ts_barrier" ::: "memory");
        }
        __syncthreads();
        if (BOTH(0) || rep_ + 1 < REPS(0)) GRID_BAR();
    }
    if (DLY_PH == 0) dly_t1 = __builtin_amdgcn_s_memrealtime();
    if (DLY_PH == 1) dly_t0 = __builtin_amdgcn_s_memrealtime();
    if (IN(1)) _Pragma("unroll") for (int rep_ = 0; rep_ < REPS(1); ++rep_) {
        for (int m = gw; m < M; m += NGW) {
            const int b = m >> 11; const float* sh = MOD + (size_t)b * 6144; const float* sc = sh + 1024;
            const GAS f32x4* xr = (const GAS f32x4*)(x + (size_t)m * D) + F.lane;
            f32x4 v[4]; float s = 0.f;
#pragma unroll
            for (int j = 0; j < 4; ++j) { v[j] = xr[64 * j]; s += (v[j].x + v[j].y) + (v[j].z + v[j].w); }
            const float mean = wave_sum(s) * (1.f / D); float s2 = 0.f;
#pragma unroll
            for (int j = 0; j < 4; ++j) { v[j] = v[j] - mean; s2 += (v[j].x * v[j].x + v[j].y * v[j].y) + (v[j].z * v[j].z + v[j].w * v[j].w); }
            const float rstd = 1.f / sqrtf(wave_sum(s2) * (1.f / D) + LN_EPS);
            GAS v2u* o8 = (GAS v2u*)(XN + (size_t)m * D) + F.lane;
#pragma unroll
            for (int j = 0; j < 4; ++j) { const f32x4 sv = *(const f32x4*)(sc + 4 * F.lane + 256 * j), hv = *(const f32x4*)(sh + 4 * F.lane + 256 * j);
                const f32x4 h = (v[j] * rstd) * (sv + 1.0f) + hv; v2u w; w.x = pk2(h.x, h.y); w.y = pk2(h.z, h.w); o8[64 * j] = w; }
        }
        if (BOTH(1) || rep_ + 1 < REPS(1)) GRID_BAR();
    }
    if (DLY_PH == 1) dly_t1 = __builtin_amdgcn_s_memrealtime();
    if (DLY_PH == 2) dly_t0 = __builtin_amdgcn_s_memrealtime();
    if (IN(2)) _Pragma("unroll") for (int rep_ = 0; rep_ < REPS(2); ++rep_) {
        DenseSched S; S.init(XN, WIN, M, NIN, F.G, (int)blockIdx.x);
        EpiQKVU E{QB, (size_t)(WS_K - WS_Q) / 2};
        pg8::gemm_phase<EpiQKVU, DenseSched, true>(F.lds, S, E);
        if (BOTH(2) || rep_ + 1 < REPS(2)) GRID_BAR();
    }
    if (DLY_PH == 2) dly_t1 = __builtin_amdgcn_s_memrealtime();
    if (DLY_PH == 3) dly_t0 = __builtin_amdgcn_s_memrealtime();
    if (IN(3)) _Pragma("unroll") for (int rep_ = 0; rep_ < REPS(3); ++rep_) {
        const bool g8 = (F.G % 8 == 0); const bool conv_cu = g8 ? (F.vcu & 7) < 3 : true; const int cG = g8 ? (F.G / 8) * 3 : F.G, cv = g8 ? (F.vcu >> 3) * 3 + (F.vcu & 7) : F.vcu;
        if (conv_cu) {
            __syncthreads();
            constexpr int T_GU1 = (D / 128) * (2048 / 128), T_D1 = (FF / 128) * (D / 128);
        auto pipe = [&](const float* W, bf16* WT, auto K_, auto N_, int ntiles) {
            constexpr int K = decltype(K_)::value, N = decltype(N_)::value, NBLK = N / 128, TPE = (K / 128) * NBLK;
            const int n_my = (ntiles - cv + cG - 1) / cG;
            auto tile_of = [&](int q) -> TItem { const int qq = q < n_my ? q : n_my - 1; const int r = cv + qq * cG; const int e = r / TPE, item = r % TPE, kb = item / NBLK, nb = item % NBLK;
                TItem t; t.src = W + (size_t)e * K * N + (size_t)(128 * kb) * N + 128 * nb; t.dst = (bf16*)((unsigned char*)WT + (size_t)e * K * N + (size_t)(128 * nb) * K + 128 * kb);     t.K = K; t.N = N; return t; };
            if (n_my > 0) {
                TItem t0 = tile_of(0), t1 = tile_of(1), t2; f32x4 b0[8], b1[8], b2[8];
                p0_load(t0, b0, F.wave, F.lane); p0_load(t1, b1, F.wave, F.lane);
                for (int q = 0; q < n_my; q += 3) {
                    t2 = tile_of(q + 2); p0_load(t2, b2, F.wave, F.lane); p0_store8(t0, b0, F.lds, F.wave, F.lane);
                    t0 = tile_of(q + 3); p0_load(t0, b0, F.wave, F.lane); p0_store8(t1, b1, F.lds + 34816, F.wave, F.lane);
                    t1 = tile_of(q + 4); p0_load(t1, b1, F.wave, F.lane); p0_store8(t2, b2, F.lds + 2 * 34816, F.wave, F.lane);
                }
                asm volatile("s_waitcnt lgkmcnt(0)\n\ts_barrier" ::: "memory");
            }
        };
        pipe(w_gu, WGU, std::integral_constant<int, D>{}, std::integral_constant<int, 2048>{}, NE * T_GU1);
        pipe(w_dn, WD, std::integral_constant<int, FF>{}, std::integral_constant<int, D>{}, NE * T_D1);
            __syncthreads();
        }
        LAS float* tb = (LAS float*)(F.lds + L_TB);
        for (int i = F.tid; i < 4 * attn_body::TBN; i += NWAVES * 64) { const int h = i / attn_body::TBN, idx = i % attn_body::TBN; const int d = idx - attn_body::TBOFF;
            tb[i] = (d <= 63) ? (rel_bias[t5_bucket(d) * 4 + h] - rel_bias[15 * 4 + h]) * LOG2E : 0.f; }
        __syncthreads();
#if !NAIVE_ATTN
        {
            volatile LAS int* qslot = (volatile LAS int*)(F.lds + L_MISC + 64);
            for (;;) {
                __syncthreads();
                if (F.tid == 0) *qslot = (int)__hip_atomic_fetch_add(F.ctl + CW_AQ + 64 * rep_, 1u, RLX_AGENT);
                __syncthreads();
                const int ui = __builtin_amdgcn_readfirstlane(*qslot);
                if (ui >= 1024) break;
                const int qb = 7 - (ui >> 7), c7 = ui & 127, b = c7 >> 4, j = (c7 >> 1) & 7, vh = c7 & 1;
                attn_body::attn_unit<8>(b, j, vh, qb, (const attn_body::bf16*)QB, (const attn_body::bf16*)KB, (const attn_body::bf16*)VB, (attn_body::bf16*)OA, (char*)lds, tb + (j >> 1) * attn_body::TBN);
            }
        }
#else
        for (int idx = blockIdx.x * 512 + F.tid; idx < NB * 8 * 2 * SEQ; idx += F.G * 512) {
            const int q = idx & 2047, vh = (idx >> 11) & 1, j = (idx >> 12) & 7, b = idx >> 15, h = j >> 1;
            const bf16* qp = QB + (size_t)(b * SEQ + q) * 512 + j * 64; float qv[64];
#pragma unroll
            for (int d = 0; d < 64; ++d) qv[d] = pg8::bf2f(qp[d]);
            float o[64];
#pragma unroll
            for (int d = 0; d < 64; ++d) o[d] = 0.f;
            float mx = -INFINITY, l = 0.f; const int kend = ((q >> 6) + 1) << 6;
            for (int k = 0; k < kend; ++k) {
                const bf16* kp = KB + (size_t)(b * SEQ + k) * 512 + j * 64; float sdot = 0.f;
#pragma unroll
                for (int d = 0; d < 64; ++d) sdot += qv[d] * pg8::bf2f(kp[d]);
                const int dd = k - q; const int ti = dd + attn_body::TBOFF < 0 ? 0 : dd + attn_body::TBOFF; sdot += tb[h * attn_body::TBN + ti];
                const float mn = fmaxf(mx, sdot), f = exp2f(mx - mn), p = exp2f(sdot - mn); l = l * f + p; mx = mn;
                const bf16* vp = VB + (size_t)(b * SEQ + k) * 512 + h * 128 + vh * 64;
#pragma unroll
                for (int d = 0; d < 64; ++d) o[d] = o[d] * f + p * pg8::bf2f(vp[d]);
            }
            bf16* op = OA + (size_t)(b * SEQ + q) * 1024 + j * 128 + vh * 64; const float il = 1.0f / l;
#pragma unroll
            for (int d = 0; d < 64; ++d) op[d] = (bf16)f2bf(o[d] * il);
        }
#endif
        if (BOTH(3) || rep_ + 1 < REPS(3)) GRID_BAR();
    }
    if (DLY_PH == 3) dly_t1 = __builtin_amdgcn_s_memrealtime();
    if (DLY_PH == 4) dly_t0 = __builtin_amdgcn_s_memrealtime();
    if (IN(4)) _Pragma("unroll") for (int rep_ = 0; rep_ < REPS(4); ++rep_) {
        float lam;
        { const float a = lq1[F.lane] * lk1[F.lane], b2 = lq2[F.lane] * lk2[F.lane]; lam = __expf(wave_sum(a)) - __expf(wave_sum(b2)) + LAM_INIT; }
        for (int m0 = gw; m0 < M; m0 += 2 * NGW) {
            const int h = F.lane >> 4, e0 = (F.lane & 15) * 8; const bool two = m0 + NGW < M;
            v4u a[2], b2[2];
#pragma unroll
            for (int q = 0; q < 2; ++q) if (q == 0 || two) { const size_t m = (size_t)m0 + (size_t)q * NGW;
                a[q] = *(const GAS v4u*)(OA + m * 1024 + h * 256 + e0); b2[q] = *(const GAS v4u*)(OA + m * 1024 + h * 256 + 128 + e0); }
            const f32x4 g0 = *(const f32x4*)(subln_g + e0), g1v = *(const f32x4*)(subln_g + e0 + 4);
#pragma unroll
            for (int q = 0; q < 2; ++q) if (q == 0 || two) { const size_t m = (size_t)m0 + (size_t)q * NGW;
                float o[8];
                o[0] = bfl(a[q].x) - lam * bfl(b2[q].x); o[1] = bfh(a[q].x) - lam * bfh(b2[q].x); o[2] = bfl(a[q].y) - lam * bfl(b2[q].y); o[3] = bfh(a[q].y) - lam * bfh(b2[q].y);
                o[4] = bfl(a[q].z) - lam * bfl(b2[q].z); o[5] = bfh(a[q].z) - lam * bfh(b2[q].z); o[6] = bfl(a[q].w) - lam * bfl(b2[q].w); o[7] = bfh(a[q].w) - lam * bfh(b2[q].w);
                float ss = 0.f;
#pragma unroll
                for (int i = 0; i < 8; ++i) ss += o[i] * o[i];
                ss += __shfl_xor(ss, 1); ss += __shfl_xor(ss, 2); ss += __shfl_xor(ss, 4); ss += __shfl_xor(ss, 8);
                const float rs = (1.0f - LAM_INIT) / sqrtf(ss * (1.0f / 128.0f) + LN_EPS);
                v4u w; w.x = pk2(o[0] * rs * g0.x, o[1] * rs * g0.y); w.y = pk2(o[2] * rs * g0.z, o[3] * rs * g0.w); w.z = pk2(o[4] * rs * g1v.x, o[5] * rs * g1v.y); w.w = pk2(o[6] * rs * g1v.z, o[7] * rs * g1v.w);
                *(GAS v4u*)(MIX + m * 1024 + h * 128 + e0) = w; }
        }
        for (int it = gw; it < (M / 32) * 4; it += NGW) {
            const int g = it & 3, tile = it >> 2, row0 = tile * 32, r32 = F.lane & 31, hi = F.lane >> 5;
            const int row = row0 + r32, tpos = row & (SEQ - 1), tp0 = row0 & (SEQ - 1);
            LAS unsigned char* ut = F.lds + F.wave * 12800;
#pragma unroll
            for (int i = 0; i < 12; ++i) { const int pc = F.lane + 64 * i, rr = pc >> 4, c16 = pc & 15;
                if (rr < 47) { v4u v = (v4u){0u, 0u, 0u, 0u}; if (tp0 - 15 + rr >= 0) v = *(const GAS v4u*)(UB + (size_t)(row0 - 15 + rr) * 512 + g * 128 + c16 * 8); *(LAS v4u*)(ut + rr * 272 + c16 * 16) = v; } }
            LDS_WAIT(); asm volatile("" ::: "memory");
            bf16x8 pf[8];
            const LAS unsigned char* ub = ut + (r32 + 15) * 272 + hi * 16;
            auto pooled = [&](auto WIN_) {
                constexpr int WIN = decltype(WIN_)::value;
                const int nwin = tpos + 1 < WIN ? tpos + 1 : WIN; const float inv = 1.0f / (float)nwin;
#pragma unroll
                for (int s8 = 0; s8 < 8; ++s8) {
                    float sum[8];
#pragma unroll
                    for (int i = 0; i < 8; ++i) sum[i] = 0.f;
                    v4u self;
#pragma unroll
                    for (int k = 0; k < WIN; ++k) { const v4u u4 = *(const LAS v4u*)(ub - k * 272 + s8 * 32); if (k == 0) self = u4;
                        sum[0] += bfl(u4.x); sum[1] += bfh(u4.x); sum[2] += bfl(u4.y); sum[3] += bfh(u4.y); sum[4] += bfl(u4.z); sum[5] += bfh(u4.z); sum[6] += bfl(u4.w); sum[7] += bfh(u4.w); }
                    v4u w; w.x = pk2(sum[0] * inv - bfl(self.x), sum[1] * inv - bfh(self.x)); w.y = pk2(sum[2] * inv - bfl(self.y), sum[3] * inv - bfh(self.y));
                    w.z = pk2(sum[4] * inv - bfl(self.z), sum[5] * inv - bfh(self.z)); w.w = pk2(sum[6] * inv - bfl(self.w), sum[7] * inv - bfh(self.w));
                    pf[s8] = __builtin_bit_cast(bf16x8, w);
                }
            };
            if (g == 0) pooled(std::integral_constant<int, 2>{}); else if (g == 1) pooled(std::integral_constant<int, 4>{}); else if (g == 2) pooled(std::integral_constant<int, 8>{}); else pooled(std::integral_constant<int, 16>{});
            LDS_WAIT(); asm volatile("" ::: "memory");
#pragma unroll
            for (int db = 0; db < 4; ++db) {
                f32x16 acc = f32x16{};
                const bf16* wp = WPOOL + (size_t)g * 128 * 128 + (size_t)(db * 32 + r32) * 128 + hi * 8;
#pragma unroll
                for (int s8 = 0; s8 < 8; ++s8) { const bf16x8 wf = __builtin_bit_cast(bf16x8, *(const GAS v4u*)(wp + s8 * 16)); acc = __builtin_amdgcn_mfma_f32_32x32x16_bf16(wf, pf[s8], acc, 0, 0, 0); }
#pragma unroll
                for (int rq = 0; rq < 4; ++rq) { const int d0 = db * 32 + 8 * rq + 4 * hi; const int cg = g * 128 + d0;
                    const f32x4 bp = *(const f32x4*)(b_pool + cg), ps = *(const f32x4*)(pool_scale + cg);
                    v2u w; w.x = pk2((acc[4 * rq + 0] + bp.x) * ps.x, (acc[4 * rq + 1] + bp.y) * ps.y); w.y = pk2((acc[4 * rq + 2] + bp.z) * ps.z, (acc[4 * rq + 3] + bp.w) * ps.w);
                    *(GAS v2u*)(MIX + (size_t)row * 1024 + 512 + cg) = w; }
            }
        }
        if (BOTH(4) || rep_ + 1 < REPS(4)) GRID_BAR();
    }
    if (DLY_PH == 4) dly_t1 = __builtin_amdgcn_s_memrealtime();
    if (DLY_PH == 5) dly_t0 = __builtin_amdgcn_s_memrealtime();
    if (IN(5)) _Pragma("unroll") for (int rep_ = 0; rep_ < REPS(5); ++rep_) {
        DenseSched S; S.init(MIX, WOUT, M, D, F.G, (int)blockIdx.x);
        EpiT1 E{x, MOD, T1};
        pg8::gemm_phase<EpiT1, DenseSched, true>(F.lds, S, E);
        if (BOTH(5) || rep_ + 1 < REPS(5)) GRID_BAR();
    }
    if (DLY_PH == 5) dly_t1 = __builtin_amdgcn_s_memrealtime();
    if (DLY_PH == 6) dly_t0 = __builtin_amdgcn_s_memrealtime();
    if (IN(6)) _Pragma("unroll 1") for (int rep_ = 0; rep_ < REPS(6); ++rep_) {
        LAS float* H2 = (LAS float*)F.lds;
        LAS float* PART = (LAS float*)F.lds;
        LAS float* LOG = (LAS float*)(F.lds + 131200);
        LAS unsigned* hist = (LAS unsigned*)(F.lds + L_HIST); LAS unsigned* hbase = hist + 32;
        const int i32 = F.lane & 31, kh = F.lane >> 5, kb = F.wave * 128;
        float wreg[64];
#pragma unroll
        for (int kk = 0; kk < 64; ++kk) wreg[kk] = ((const GAS float*)w_router)[(size_t)(kb + 2 * kk + kh) * NE + i32];
        for (int tile = F.vcu; tile < M / 32; tile += F.G) {
            if (F.tid < 32) hist[F.tid] = 0u;
            const int b = (tile * 32) >> 11; const float* sh = MOD + (size_t)b * 6144 + 3072; const float* sc = sh + 1024;
#pragma unroll
            for (int pr = 0; pr < 2; ++pr) {
                f32x4 v[2][4];
#pragma unroll
                for (int r2 = 0; r2 < 2; ++r2) { const GAS f32x4* tr = (const GAS f32x4*)(T1 + (size_t)(tile * 32 + F.wave * 4 + 2 * pr + r2) * D) + F.lane;
#pragma unroll
                    for (int j = 0; j < 4; ++j) v[r2][j] = tr[64 * j]; }
#pragma unroll
                for (int r2 = 0; r2 < 2; ++r2) {
                    const int lr = F.wave * 4 + 2 * pr + r2, m = tile * 32 + lr;
                    float s = 0.f;
#pragma unroll
                    for (int j = 0; j < 4; ++j) s += (v[r2][j].x + v[r2][j].y) + (v[r2][j].z + v[r2][j].w);
                    float mean = wave_sum(s) * (1.f / D); float s2 = 0.f;
#pragma unroll
                    for (int j = 0; j < 4; ++j) { v[r2][j] = v[r2][j] - mean; s2 += (v[r2][j].x * v[r2][j].x + v[r2][j].y * v[r2][j].y) + (v[r2][j].z * v[r2][j].z + v[r2][j].w * v[r2][j].w); }
                    float rstd = 1.f / sqrtf(wave_sum(s2) * (1.f / D) + LN_EPS);
                    s = 0.f;
#pragma unroll
                    for (int j = 0; j < 4; ++j) { const f32x4 gvj = *(const f32x4*)(ln1_g + 4 * F.lane + 256 * j), bvj = *(const f32x4*)(ln1_b + 4 * F.lane + 256 * j);
                        v[r2][j] = (v[r2][j] * rstd) * gvj + bvj; ((GAS f32x4*)(X1 + (size_t)m * D) + F.lane)[64 * j] = v[r2][j]; s += (v[r2][j].x + v[r2][j].y) + (v[r2][j].z + v[r2][j].w); }
                    mean = wave_sum(s) * (1.f / D); s2 = 0.f;
#pragma unroll
                    for (int j = 0; j < 4; ++j) { v[r2][j] = v[r2][j] - mean; s2 += (v[r2][j].x * v[r2][j].x + v[r2][j].y * v[r2][j].y) + (v[r2][j].z * v[r2][j].z + v[r2][j].w * v[r2][j].w); }
                    rstd = 1.f / sqrtf(wave_sum(s2) * (1.f / D) + LN_EPS);
                    GAS unsigned* o8 = (GAS unsigned*)((unsigned char*)XN2 + (size_t)m * D) + F.lane;
#pragma unroll
                    for (int j = 0; j < 4; ++j) { const f32x4 svj = *(const f32x4*)(sc + 4 * F.lane + 256 * j), hvj = *(const f32x4*)(sh + 4 * F.lane + 256 * j);
                        const f32x4 h = (v[r2][j] * rstd) * (svj + 1.0f) + hvj; o8[64 * j] = pk4_fp8(h.x, h.y, h.z, h.w);
                        LAS float* hp = H2 + lr * 1025 + 4 * F.lane + 256 * j; hp[0] = h.x; hp[1] = h.y; hp[2] = h.z; hp[3] = h.w; }
                    asm volatile("" ::: "memory");
                }
            }
            __syncthreads();
            f32x16 acc = f32x16{};
#pragma unroll
            for (int kk = 0; kk < 64; ++kk) acc = __builtin_amdgcn_mfma_f32_32x32x2f32(H2[i32 * 1025 + kb + 2 * kk + kh], wreg[kk], acc, 0, 0, 0);
            __syncthreads();
#pragma unroll
            for (int r = 0; r < 16; ++r) PART[(F.wave * 32 + ((r & 3) + 8 * (r >> 2) + 4 * kh)) * 32 + i32] = acc[r];
            __syncthreads();
#pragma unroll
            for (int q = 0; q < 2; ++q) { const int idx = F.tid + 512 * q, i = idx >> 5, e = idx & 31; float sl = b_router[e];
#pragma unroll
                for (int w = 0; w < 8; ++w) sl += PART[(w * 32 + i) * 32 + e];
                LOG[i * 33 + e] = sl; }
            __syncthreads();
            int myk[2]; unsigned lrk[2]; float mygate[2];
#pragma unroll
            for (int it2 = 0; it2 < 2; ++it2) {
                const int rowl = F.wave * 4 + 2 * it2 + kh; float cur = LOG[rowl * 33 + i32]; float bvv[4]; myk[it2] = -1;
#pragma unroll
                for (int k = 0; k < 4; ++k) { float mv = cur; int me = i32;
#pragma unroll
                    for (int off = 1; off < 32; off <<= 1) { const float ov = __shfl_xor(mv, off); const int oe = __shfl_xor(me, off); if (ov > mv || (ov == mv && oe < me)) { mv = ov; me = oe; } }
                    bvv[k] = mv; if (me == i32) { cur = -INFINITY; myk[it2] = k; } }
                float ex[4], ssum = 0.f;
#pragma unroll
                for (int k = 0; k < 4; ++k) { ex[k] = __expf(bvv[k] - bvv[0]); ssum += ex[k]; }
                const float is = 1.0f / ssum; mygate[it2] = 0.f; lrk[it2] = 0u;
#pragma unroll
                for (int k = 0; k < 4; ++k) if (myk[it2] == k) mygate[it2] = ex[k] * is;
                if (myk[it2] >= 0) lrk[it2] = __hip_atomic_fetch_add(hist + i32, 1u, __ATOMIC_RELAXED, __HIP_MEMORY_SCOPE_WORKGROUP);
            }
            __syncthreads();
            if (F.tid < 32) { const unsigned n = hist[F.tid]; hbase[F.tid] = n ? __hip_atomic_fetch_add(F.ctl + (rep_ + 1 < REPS(6) ? CW_CNT + 4096 : CW_CNT) + 64 * F.tid, n, RLX_AGENT) : 0u; }
            __syncthreads();
#pragma unroll
            for (int it2 = 0; it2 < 2; ++it2) if (myk[it2] >= 0) { const int m = tile * 32 + F.wave * 4 + 2 * it2 + kh; const int pp = (int)(hbase[i32] + lrk[it2]);
                RE[m * 4 + myk[it2]] = i32; RP[m * 4 + myk[it2]] = pp; RG[m * 4 + myk[it2]] = mygate[it2]; if (pp < ECAP) ROWTOK[i32 * ECAP + pp] = m; }
            __syncthreads();
        }
        if (BOTH(6) || rep_ + 1 < REPS(6)) GRID_BAR();
    }
    if (DLY_PH == 6) dly_t1 = __builtin_amdgcn_s_memrealtime();
    if (DLY_PH == 7) dly_t0 = __builtin_amdgcn_s_memrealtime();
    if (IN(7)) _Pragma("unroll") for (int rep_ = 0; rep_ < REPS(7); ++rep_) {
        build_expert_tables(F);
        MoeSched S; S.A = XN2; S.W = WGU; S.rowtok = ROWTOK; S.pexp = (const LAS int*)(F.lds + L_PEXP); S.pfirst = (const LAS int*)(F.lds + L_PFIRST); S.cntl = (const LAS int*)(F.lds + L_CNT);
        S.NP = ((const LAS int*)(F.lds + L_PFIRST))[NE]; S.NT = 8; S.G = F.G; S.vcu = F.vcu; S.gather = true; S.rowb = 1024; S.wexp = (size_t)2048 * 1024; S.wtile = (size_t)128 * 1024; S.whalf = (size_t)1024 * 1024;
        EpiSwiglu E{b_gu, (unsigned char*)HB};
        pg8::gemm_phase<EpiSwiglu, MoeSched, true, true>(F.lds, S, E);
        if (BOTH(7) || rep_ + 1 < REPS(7)) GRID_BAR();
    }
    if (DLY_PH == 7) dly_t1 = __builtin_amdgcn_s_memrealtime();
    if (DLY_PH == 8) dly_t0 = __builtin_amdgcn_s_memrealtime();
    if (IN(8)) _Pragma("unroll") for (int rep_ = 0; rep_ < REPS(8); ++rep_) {
        build_expert_tables(F);
        MoeSched S; S.A = HB; S.W = WD; S.rowtok = ROWTOK; S.pexp = (const LAS int*)(F.lds + L_PEXP); S.pfirst = (const LAS int*)(F.lds + L_PFIRST); S.cntl = (const LAS int*)(F.lds + L_CNT);
        S.NP = ((const LAS int*)(F.lds + L_PFIRST))[NE]; S.NT = 4; S.G = F.G; S.vcu = F.vcu; S.gather = false; S.rowb = 1024; S.wexp = (size_t)1024 * 1024; S.wtile = (size_t)256 * 1024; S.whalf = (size_t)128 * 1024;
        EpiDown E{b_dn, YB};
        pg8::gemm_phase<EpiDown, MoeSched, true, true>(F.lds, S, E);
        if (BOTH(8) || rep_ + 1 < REPS(8)) GRID_BAR();
    }
    if (DLY_PH == 8) dly_t1 = __builtin_amdgcn_s_memrealtime();
    if (DLY_PH == 9) dly_t0 = __builtin_amdgcn_s_memrealtime();
    if (IN(9)) _Pragma("unroll") for (int rep_ = 0; rep_ < REPS(9); ++rep_) {
        build_expert_tables(F);
        const LAS int* pfirst = (const LAS int*)(F.lds + L_PFIRST);
        const unsigned bad = __hip_atomic_load(F.ctl + CW_BAR + XB_TMO, RLX_AGENT);
        for (int m = gw; m < M; m += NGW) {
            const int b = m >> 11; const float* g2 = MOD + (size_t)b * 6144 + 5120;
            f32x4 a[4];
#pragma unroll
            for (int j = 0; j < 4; ++j) a[j] = (f32x4){0.f, 0.f, 0.f, 0.f};
#pragma unroll
            for (int k = 0; k < 4; ++k) { const int e = __builtin_amdgcn_readfirstlane(RE[m * 4 + k]), p = __builtin_amdgcn_readfirstlane(RP[m * 4 + k]); const float gk = RG[m * 4 + k];
                const size_t yrow = (size_t)pfirst[e] * 256 + (size_t)p; const GAS v2u* yp = (const GAS v2u*)(YB + yrow * 1024) + F.lane;
#pragma unroll
                for (int j = 0; j < 4; ++j) { const v2u w = yp[64 * j]; a[j] += (f32x4){bfl(w.x), bfh(w.x), bfl(w.y), bfh(w.y)} * gk; } }
            f32x4 v[4]; float s = 0.f;
#pragma unroll
            for (int j = 0; j < 4; ++j) { const f32x4 xv = ((const GAS f32x4*)(X1 + (size_t)m * D) + F.lane)[64 * j]; const f32x4 gv = *(const f32x4*)(g2 + 4 * F.lane + 256 * j);
                v[j] = xv * DN_ALPHA + gv * a[j]; s += (v[j].x + v[j].y) + (v[j].z + v[j].w); }
            const float mean = wave_sum(s) * (1.f / D); float s2 = 0.f;
#pragma unroll
            for (int j = 0; j < 4; ++j) { v[j] = v[j] - mean; s2 += (v[j].x * v[j].x + v[j].y * v[j].y) + (v[j].z * v[j].z + v[j].w * v[j].w); }
            const float rstd = 1.f / sqrtf(wave_sum(s2) * (1.f / D) + LN_EPS);
#pragma unroll
            for (int j = 0; j < 4; ++j) { const f32x4 gv = *(const f32x4*)(ln2_g + 4 * F.lane + 256 * j), bv = *(const f32x4*)(ln2_b + 4 * F.lane + 256 * j);
                f32x4 o = (v[j] * rstd) * gv + bv; if (bad) { const float qn = __builtin_nanf(""); o = (f32x4){qn, qn, qn, qn}; }
                ((GAS f32x4*)(out + (size_t)m * D) + F.lane)[64 * j] = o; }
        }
    }
    if (DLY_PH >= 0) { if (DLY_PH == 9) dly_t1 = __builtin_amdgcn_s_memrealtime(); const unsigned long long te = __builtin_amdgcn_s_memrealtime(); while (__builtin_amdgcn_s_memrealtime() - te < dly_t1 - dly_t0) __builtin_amdgcn_s_sleep(8); }
#undef IN
#undef BOTH
}

extern "C" void kernel_launch(void* const* d_in, const int* in_sizes, int n_in, void* d_out, int out_size, void* d_ws, size_t ws_size, hipStream_t stream) {
    static int grid = 0;
    if (grid == 0) {
        if (n_in != 25 || in_sizes[0] != M * D || out_size != M * D || ws_size < WS_END) { fprintf(stderr, "kernel_launch: unexpected shapes (n_in %d, in0 %d, out %d, ws %zu); nothing launched\n", n_in, n_in > 0 ? in_sizes[0] : -1, out_size, ws_size); grid = -1; return; }
        int dev = 0, cus = 0, per_cu = 0;
        if (hipGetDevice(&dev) != hipSuccess || hipDeviceGetAttribute(&cus, hipDeviceAttributeMultiprocessorCount, dev) != hipSuccess) { grid = -1; return; }
        if (hipFuncSetAttribute((const void*)mk_fwd, hipFuncAttributeMaxDynamicSharedMemorySize, LDS_BYTES) != hipSuccess) { fprintf(stderr, "kernel_launch: hipFuncSetAttribute failed\n"); grid = -1; return; }
        if (hipOccupancyMaxActiveBlocksPerMultiprocessor(&per_cu, (const void*)mk_fwd, NWAVES * 64, LDS_BYTES) != hipSuccess || per_cu < 1) { fprintf(stderr, "kernel_launch: occupancy query reports %d workgroups per CU\n", per_cu); (void)hipGetLastError(); }
        grid = cus;
    }
    if (grid < 0) return;
    if (hipMemsetAsync((char*)d_ws + WS_CTL, 0, CTL_ZERO_BYTES, stream) != hipSuccess) return;
    Args a{};
    for (int i = 0; i < 25; ++i) a.in[i] = (const float*)d_in[i];
    a.out = (float*)d_out; a.ws = (unsigned char*)d_ws;
#if MK_ONE_LAUNCH
    a.ph_lo = 0; a.ph_hi = NPHASE;
    hipLaunchKernelGGL(mk_fwd, dim3(grid), dim3(NWAVES * 64), LDS_BYTES, stream, a);
#else
    for (int p = 0; p < NPHASE; ++p) { a.ph_lo = p; a.ph_hi = p + 1; hipLaunchKernelGGL(mk_fwd, dim3(grid), dim3(NWAVES * 64), LDS_BYTES, stream, a); }
#endif
}
```

```cpp
#include <hip/hip_runtime.h>
#include <hip/hip_bf16.h>
#include <cstdio>
#include <cstdint>
#include <cmath>
#include <type_traits>

#ifndef MK_ONE_LAUNCH
#define MK_ONE_LAUNCH 1
#endif
#ifndef NAIVE_GEMM
#define NAIVE_GEMM 0
#endif
#ifndef DLY_PH
#define DLY_PH (-1)
#endif
#ifndef NAIVE_ATTN
#define NAIVE_ATTN 0
#endif

#define GAS __attribute__((address_space(1)))
#define LAS __attribute__((address_space(3)))

constexpr int NB = 8, SEQ = 2048, D = 1024, M = NB * SEQ;
constexpr int AW = 512;
constexpr int NIN = 2048;
constexpr int NE = 32, TOPK = 4, FF = 1024;
constexpr int ECAP = 16384;
constexpr int PMAX = (M * TOPK) / 256 + NE;
constexpr float LN_EPS = 1e-5f;
constexpr float DN_ALPHA = 1.189207115002721f;
constexpr float LAM_INIT = 0.2f;
constexpr float LOG2E = 1.4426950408889634f;
constexpr float QSCALE = 0.125f * LOG2E;
constexpr int NWAVES = 8;

namespace pg8 {
#define PG8_LAS __attribute__((address_space(3)))
typedef unsigned short bf16_t;
typedef short bf16x8 __attribute__((ext_vector_type(8)));
typedef float f32x4 __attribute__((ext_vector_type(4)));
typedef unsigned u32x4 __attribute__((ext_vector_type(4)));
constexpr int BM = 256, BK = 64, HALF = 128, HTB = HALF * BK * 2, STAGE_BYTES = 8 * HTB, NXCD = 8, WGM = 8;
constexpr int GK = 1024;

__host__ __device__ __forceinline__ int lds_byte(int r, int c) { const int st = (r >> 4) * 2 + (c >> 5), rr = r & 15, cc = c & 31, ob = rr * 64 + cc * 2; return st * 1024 + (ob ^ (((ob >> 9) & 1) << 5)); }
__host__ __device__ __forceinline__ void stage_rc(int b, int& R, int& C) { const int st = b / 1024, sb = b % 1024, swz = sb ^ (((sb >> 9) & 1) << 5); R = (st >> 1) * 16 + swz / 64; C = (st & 1) * 32 + (swz % 64) / 2; }
__host__ __device__ __forceinline__ int perm32(int rho) { const int n = rho >> 4, i = rho & 15; return 8 * (i >> 2) + 4 * n + (i & 3); }

struct Unit { int pm, pn, e, lrow0, cnt; };
struct Pre { f32x4 v[4]; };
__device__ __forceinline__ void asm_ld16(f32x4& d, const float* p) { asm volatile("global_load_dwordx4 %0, %1, off" : "=v"(d) : "v"((const __attribute__((address_space(1))) float*)p) : "memory"); }

__device__ __forceinline__ unsigned cvt_pk_bf16(float lo, float hi) { unsigned r; asm volatile("v_cvt_pk_bf16_f32 %0, %1, %2" : "=v"(r) : "v"(lo), "v"(hi)); return r; }
__device__ __forceinline__ float bf2f(unsigned short v) { return __uint_as_float((unsigned)v << 16); }

#if !NAIVE_GEMM
typedef int v8i32 __attribute__((ext_vector_type(8)));
typedef int v4i32 __attribute__((ext_vector_type(4)));
template <class Epi, class Sched, bool ALIGN_EPI, bool FP8 = false>
__device__ __forceinline__ void gemm_phase(PG8_LAS unsigned char* lds, const Sched& S, const Epi& E) {
    constexpr int RB = FP8 ? 1024 : 2048, nt = RB / 128;
    const int tid = threadIdx.x, wid = __builtin_amdgcn_readfirstlane(tid >> 6), lane = tid & 63, wr = wid >> 2, wc = wid & 3, fr = lane & 15, fq = lane >> 4;
    int Rr[2], Cc[2]; unsigned voffB[2];
#pragma unroll
    for (int i = 0; i < 2; ++i) { int R, C; stage_rc(tid * 16 + i * 8192, R, C); Rr[i] = R; Cc[i] = C; const int Rb = Epi::PERM ? ((R & ~31) + perm32(R & 31)) : R; voffB[i] = (unsigned)(Rb * RB + C * 2); }
    const size_t kstep = (size_t)(BK * 2);
    const size_t hB = S.b_hstep();
    const unsigned ldsw = (unsigned)wid * 1024u;
    const int aoff = lds_byte(wr * 64 + fr, fq * 8), boff = lds_byte(wc * 32 + fr, fq * 8);
#define PG8_SA(b, h) (((b) * 2 + (h)) * HTB)
#define PG8_SB(b, h) ((4 + (b) * 2 + (h)) * HTB)
#define PG8_STAGE(bufoff, gbase, voff) do { _Pragma("unroll") for (int _i = 0; _i < 2; ++_i) \
        __builtin_amdgcn_global_load_lds((const unsigned*)((const char*)(gbase) + (voff)[_i]), (PG8_LAS unsigned*)(lds + (bufoff) + ldsw + _i * 8192), 16, 0, 0); } while (0)
#define PG8_LD32(p) __builtin_shufflevector(*(const PG8_LAS v4i32*)(p), *(const PG8_LAS v4i32*)((p) + 1024), 0, 1, 2, 3, 4, 5, 6, 7)
#define PG8_LDA(dst, b, h) do { if constexpr (FP8) { _Pragma("unroll") for (int m = 0; m < 4; ++m) dst##8[m] = PG8_LD32(lds + PG8_SA(b, h) + aoff + m * 2048); } \
        else { _Pragma("unroll") for (int m = 0; m < 4; ++m) _Pragma("unroll") for (int k = 0; k < 2; ++k) dst[m][k] = *(const PG8_LAS bf16x8*)(lds + PG8_SA(b, h) + aoff + m * 2048 + k * 1024); } } while (0)
#define PG8_LDB(dst, b, h) do { if constexpr (FP8) { _Pragma("unroll") for (int n = 0; n < 2; ++n) dst##8[n] = PG8_LD32(lds + PG8_SB(b, h) + boff + n * 2048); } \
        else { _Pragma("unroll") for (int n = 0; n < 2; ++n) _Pragma("unroll") for (int k = 0; k < 2; ++k) dst[n][k] = *(const PG8_LAS bf16x8*)(lds + PG8_SB(b, h) + boff + n * 2048 + k * 1024); } } while (0)
#define PG8_CAT(x) __builtin_shufflevector(__builtin_bit_cast(v4i32, (x)[0]), __builtin_bit_cast(v4i32, (x)[1]), 0, 1, 2, 3, 4, 5, 6, 7)
#define PG8_MMA(ai, bj, At, Bt) do { __builtin_amdgcn_s_setprio(1); \
        if constexpr (FP8) { _Pragma("unroll") for (int m = 0; m < 4; ++m) _Pragma("unroll") for (int n = 0; n < 2; ++n) \
            asm volatile("v_mfma_scale_f32_16x16x128_f8f6f4 %0, %1, %2, %0, %3, %3 op_sel_hi:[0,0,0]" : "+v"(acc[ai][bj][m][n]) : "v"(Bt##8[n]), "v"(At##8[m]), "v"(one8)); } \
        else { _Pragma("unroll") for (int m = 0; m < 4; ++m) _Pragma("unroll") for (int n = 0; n < 2; ++n) _Pragma("unroll") for (int k = 0; k < 2; ++k) \
            acc[ai][bj][m][n] = __builtin_amdgcn_mfma_f32_16x16x32_bf16(Bt[n][k], At[m][k], acc[ai][bj][m][n], 0, 0, 0); } \
        __builtin_amdgcn_s_setprio(0); } while (0)
#define PG8_WAIT_V(n) asm volatile("s_waitcnt vmcnt(" #n ")" ::: "memory")
#define PG8_WAIT_L(n) asm volatile("s_waitcnt lgkmcnt(" #n ")" ::: "memory")
#define PG8_BAR __builtin_amdgcn_s_barrier()
#define PG8_SCHED __builtin_amdgcn_sched_barrier(0)
    Unit cur, nxt; int ui = 0; Pre pre;
    if (!S.next(0, cur)) return;
    f32x4 acc[2][2][4][2];
#pragma unroll
    for (int a = 0; a < 2; ++a)
#pragma unroll
        for (int b = 0; b < 2; ++b)
#pragma unroll
            for (int m = 0; m < 4; ++m)
#pragma unroll
                for (int n = 0; n < 2; ++n) acc[a][b][m][n] = (f32x4){0.f, 0.f, 0.f, 0.f};
    const int one8 = 0x7f7f7f7f;
    bf16x8 At[4][2], B0[2][2], B1[2][2]; v8i32 At8[4], B08[2], B18[2];
    const char* cA = S.a_base(cur); const char* cB = S.b_base(cur);
    unsigned va0[2], va1[2];
    S.a_voff(cur, Rr, Cc, va0, va1);
    PG8_STAGE(PG8_SB(0, 0), cB, voffB); PG8_STAGE(PG8_SB(0, 1), cB + hB, voffB); PG8_STAGE(PG8_SA(0, 0), cA, va0); PG8_STAGE(PG8_SA(0, 1), cA, va1);
    if (wr == 1) PG8_BAR;
    PG8_WAIT_V(2); PG8_BAR;
    PG8_STAGE(PG8_SB(1, 0), cB + kstep, voffB); PG8_STAGE(PG8_SA(1, 0), cA + kstep, va0); PG8_STAGE(PG8_SB(1, 1), cB + hB + kstep, voffB);
    PG8_WAIT_V(6); PG8_BAR;
    for (;;) {
        const bool has_next = S.next(ui + 1, nxt);
        const char* nA = has_next ? S.a_base(nxt) : cA; const char* nB = has_next ? S.b_base(nxt) : cB;
        unsigned vn0[2] = {va0[0], va0[1]}, vn1[2] = {va1[0], va1[1]}, tkn[4];
        { Unit tu = cur; if (has_next) tu = nxt; S.a_tok(tu, Rr, tkn); }
#define PG8_TRIP(LAST, t) do { \
            const char* a1 = cA + (size_t)((t) + 1) * kstep; \
            const char* a2 = (LAST) ? nA : cA + (size_t)((t) + 2) * kstep; const char* b2 = (LAST) ? nB : cB + (size_t)((t) + 2) * kstep; \
            const char* a3 = a2 + kstep; const char* b3 = b2 + kstep; \
            asm volatile("" : "+v"(voffB[0]), "+v"(voffB[1]), "+v"(va0[0]), "+v"(va0[1]), "+v"(va1[0]), "+v"(va1[1])); \
            unsigned v20[2] = {va0[0], va0[1]}, v21[2] = {va1[0], va1[1]}; \
            if (LAST) { E.pre(cur, wr, wc, fr, fq, pre); if (has_next) { S.a_voff_tok(tkn, Rr, Cc, vn0, vn1); v20[0] = vn0[0]; v20[1] = vn0[1]; v21[0] = vn1[0]; v21[1] = vn1[1]; } } \
            PG8_LDB(B0, 0, 0); PG8_LDB(B1, 0, 1); PG8_SCHED; PG8_LDA(At, 0, 0); PG8_STAGE(PG8_SA(1, 1), a1, va1); \
            PG8_WAIT_V(8); PG8_WAIT_L(0); PG8_BAR; PG8_MMA(0, 0, At, B0); PG8_MMA(0, 1, At, B1); PG8_BAR; PG8_SCHED; \
            PG8_LDA(At, 0, 1); PG8_STAGE(PG8_SB(0, 0), b2, voffB); PG8_STAGE(PG8_SB(0, 1), b2 + hB, voffB); PG8_STAGE(PG8_SA(0, 0), a2, v20); \
            PG8_WAIT_V(8); PG8_WAIT_L(0); PG8_BAR; PG8_MMA(1, 0, At, B0); PG8_MMA(1, 1, At, B1); PG8_BAR; PG8_SCHED; \
            PG8_LDB(B0, 1, 0); PG8_LDB(B1, 1, 1); PG8_SCHED; PG8_LDA(At, 1, 0); PG8_STAGE(PG8_SA(0, 1), a2, v21); \
            PG8_WAIT_V(8); PG8_WAIT_L(0); PG8_BAR; PG8_MMA(0, 0, At, B0); PG8_MMA(0, 1, At, B1); PG8_BAR; PG8_SCHED; \
            PG8_LDA(At, 1, 1); PG8_STAGE(PG8_SB(1, 0), b3, voffB); PG8_STAGE(PG8_SB(1, 1), b3 + hB, voffB); PG8_STAGE(PG8_SA(1, 0), a3, v20); \
            PG8_WAIT_V(8); PG8_WAIT_L(0); PG8_BAR; PG8_MMA(1, 0, At, B0); PG8_MMA(1, 1, At, B1); PG8_BAR; PG8_SCHED; \
        } while (0)
#pragma unroll 1
        for (int t = 0; t < nt - 2; t += 2) PG8_TRIP(0, t);
        PG8_TRIP(1, nt - 2);
#undef PG8_TRIP
        if constexpr (ALIGN_EPI) { if (wr == 0) PG8_BAR; }
        if constexpr (FP8) asm volatile("s_nop 15\n\ts_nop 15" ::: "memory");
        { int fr_ = fr, fq_ = fq; asm volatile("" : "+v"(fr_), "+v"(fq_));
          E(acc, cur, wr, wc, fr_, fq_, pre); }
        if (!has_next) break;
#pragma unroll
        for (int a = 0; a < 2; ++a)
#pragma unroll
            for (int b = 0; b < 2; ++b)
#pragma unroll
                for (int m = 0; m < 4; ++m)
#pragma unroll
                    for (int n = 0; n < 2; ++n) acc[a][b][m][n] = (f32x4){0.f, 0.f, 0.f, 0.f};
        cur = nxt; cA = nA; cB = nB; va0[0] = vn0[0]; va0[1] = vn0[1]; va1[0] = vn1[0]; va1[1] = vn1[1]; ++ui;
        if constexpr (ALIGN_EPI) { if (wr == 1) PG8_BAR; }
    }
    PG8_WAIT_V(0);
    if constexpr (!ALIGN_EPI) { if (wr == 0) PG8_BAR; }
    PG8_BAR;
#undef PG8_SA
#undef PG8_SB
#undef PG8_STAGE
#undef PG8_LDA
#undef PG8_LD32
#undef PG8_LDB
#undef PG8_MMA
#undef PG8_CAT
#undef PG8_WAIT_V
#undef PG8_WAIT_L
#undef PG8_BAR
#undef PG8_SCHED
}
#else
template <class Epi, class Sched, bool ALIGN_EPI, bool FP8 = false>
__device__ __forceinline__ void gemm_phase(PG8_LAS unsigned char*, const Sched& S, const Epi& E) {
    constexpr int K = GK;
    const int tid = threadIdx.x, wid = __builtin_amdgcn_readfirstlane(tid >> 6), lane = tid & 63, wr = wid >> 2, wc = wid & 3, fr = lane & 15, fq = lane >> 4;
    Unit u;
    for (int ui = 0; S.next(ui, u); ++ui) {
        f32x4 acc[2][2][4][2];
#pragma unroll
        for (int ai = 0; ai < 2; ++ai)
#pragma unroll
            for (int bj = 0; bj < 2; ++bj) {
                const bf16_t* ar[4]; const bf16_t* br[2][4];
#pragma unroll
                for (int m = 0; m < 4; ++m) ar[m] = S.a_row(u, ai * 128 + wr * 64 + m * 16 + fr);
#pragma unroll
                for (int n = 0; n < 2; ++n)
#pragma unroll
                    for (int x = 0; x < 4; ++x) br[n][x] = S.b_row(u, bj * 128 + wc * 32 + (Epi::PERM ? 8 * fq + 4 * n + x : 16 * n + 4 * fq + x));
                float s[4][2][4];
#pragma unroll
                for (int m = 0; m < 4; ++m)
#pragma unroll
                    for (int n = 0; n < 2; ++n)
#pragma unroll
                        for (int x = 0; x < 4; ++x) s[m][n][x] = 0.f;
                for (int k0 = 0; k0 < K; k0 += 8) {
                    bf16x8 av[4], bv[2][4];
#pragma unroll
                    for (int m = 0; m < 4; ++m) av[m] = *(const bf16x8*)(ar[m] + k0);
#pragma unroll
                    for (int n = 0; n < 2; ++n)
#pragma unroll
                        for (int x = 0; x < 4; ++x) bv[n][x] = *(const bf16x8*)(br[n][x] + k0);
#pragma unroll
                    for (int kk = 0; kk < 8; ++kk)
#pragma unroll
                        for (int m = 0; m < 4; ++m) { const float a = bf2f((unsigned short)av[m][kk]);
#pragma unroll
                            for (int n = 0; n < 2; ++n)
#pragma unroll
                                for (int x = 0; x < 4; ++x) s[m][n][x] += a * bf2f((unsigned short)bv[n][x][kk]); }
                }
#pragma unroll
                for (int m = 0; m < 4; ++m)
#pragma unroll
                    for (int n = 0; n < 2; ++n) acc[ai][bj][m][n] = (f32x4){s[m][n][0], s[m][n][1], s[m][n][2], s[m][n][3]};
            }
        Pre pre; E.pre(u, wr, wc, fr, fq, pre); asm volatile("s_waitcnt vmcnt(0)" ::: "memory"); E(acc, u, wr, wc, fr, fq, pre);
    }
}
#endif
}

constexpr size_t MiB = 1u << 20;
constexpr size_t WS_CTL = 0, CTL_ZERO_BYTES = 1 * MiB;
constexpr size_t WS_MOD = 1 * MiB;
constexpr size_t WS_WPOOL = 1 * MiB + 512 * 1024;
constexpr size_t WS_WIN = 2 * MiB;
constexpr size_t WS_WOUT = 6 * MiB;
constexpr size_t WS_WGU = 8 * MiB;
constexpr size_t WS_WD = 136 * MiB;
constexpr size_t WS_XN = 200 * MiB;
constexpr size_t WS_Q = 232 * MiB, WS_K = 248 * MiB, WS_V = 264 * MiB, WS_U = 280 * MiB;
constexpr size_t WS_OA = 296 * MiB;
constexpr size_t WS_MIX = 328 * MiB;
constexpr size_t WS_T1 = 360 * MiB;
constexpr size_t WS_X1 = 424 * MiB;
constexpr size_t WS_XN2 = 488 * MiB;
constexpr size_t WS_RE = 520 * MiB, WS_RP = 521 * MiB, WS_RG = 522 * MiB;
constexpr size_t WS_ROWTOK = 524 * MiB;
constexpr size_t WS_H = 528 * MiB;
constexpr size_t WS_Y = 672 * MiB;
constexpr size_t WS_MODP = 816 * MiB;
constexpr size_t WS_END = 818 * MiB;
static_assert((size_t)PMAX * 256 * 1024 * 2 == 144 * MiB, "H / Y size");
constexpr int CW_TMO = 0, CW_CODE = 1;
constexpr int CW_BAR = 4096;
constexpr int CW_AQ = 6144;
constexpr int CW_CNT = 8192;

constexpr int RING_BYTES = 131072;
constexpr int LDS_BYTES = 147456;
constexpr int LCTL_OFF = 139264;
constexpr int L_MISC = LCTL_OFF;
constexpr int L_CNT = LCTL_OFF + 128;
constexpr int L_PFIRST = LCTL_OFF + 256;
constexpr int L_PEXP = LCTL_OFF + 512;
constexpr int L_HIST = LCTL_OFF + 512 + 4 * 320;
constexpr int L_TB = 106496;
static_assert(L_TB + 4 * 704 * 4 <= RING_BYTES && L_HIST + 256 <= LDS_BYTES && PMAX <= 320, "LDS map");

typedef unsigned short bf16;
typedef unsigned v4u __attribute__((ext_vector_type(4)));
typedef unsigned v2u __attribute__((ext_vector_type(2)));
typedef float f32x4 __attribute__((ext_vector_type(4)));
typedef float f32x16 __attribute__((ext_vector_type(16)));
typedef short bf16x8 __attribute__((ext_vector_type(8)));
typedef GAS unsigned gu32;
#define RLX_AGENT __ATOMIC_RELAXED, __HIP_MEMORY_SCOPE_AGENT
#define LDS_WAIT() asm volatile("s_waitcnt lgkmcnt(0)" ::: "memory")
#define VM_WAIT() asm volatile("s_waitcnt vmcnt(0)" ::: "memory")
__device__ __forceinline__ unsigned f2bf(float f) { unsigned u = __builtin_bit_cast(unsigned, f); return (u + 0x7fffu + ((u >> 16) & 1u)) >> 16; }
__device__ __forceinline__ unsigned pk2(float lo, float hi) { return f2bf(lo) | (f2bf(hi) << 16); }
__device__ __forceinline__ float bfl(unsigned w) { return __uint_as_float(w << 16); }
__device__ __forceinline__ float bfh(unsigned w) { return __uint_as_float(w & 0xffff0000u); }

namespace attn_body {
using bf16=__hip_bfloat16;
using bf16x8=__attribute__((ext_vector_type(8)))short;
using s16x4=__attribute__((ext_vector_type(4)))short;
using f32x16=__attribute__((ext_vector_type(16)))float;
using u32x4=__attribute__((ext_vector_type(4)))unsigned;
constexpr int SEQ=2048,DH=64,PQ=512,PO=1024;
constexpr int NW=8,QBLK=32,QB=QBLK*NW,KVBLK=64,NQB=SEQ/QB;
__device__ __forceinline__ int crow(int r,int hi){return (r&3)+8*(r>>2)+4*hi;}
#define SBAR() __builtin_amdgcn_sched_barrier(0)
constexpr int TBN=704, TBOFF=447;
__device__ __forceinline__ void bandinit(f32x16&p0,f32x16&p1,int t,int q0,int wid,int r32,int hi,const __attribute__((address_space(3))) float*tb){
  const __attribute__((address_space(3))) float*tp=tb+(64*t+4*hi-(q0+32*wid+r32)+TBOFF);
  #pragma unroll
  for(int r=0;r<16;++r){p0[r]=tp[(r&3)+8*(r>>2)]; p1[r]=tp[(r&3)+8*(r>>2)+32];}
}
__device__ __forceinline__ void bandpost(f32x16&p0,f32x16&p1,const f32x16&negm,int t,int q0,int wid){
  const float nm=(t>(q0>>6)+(wid>>1))?-INFINITY:negm[0];
  #pragma unroll
  for(int r=0;r<16;++r){p0[r]+=nm;p1[r]+=nm;}
}
constexpr int NSLOT=3, SLOTB=8192;
constexpr int LDS_K=0, LDS_V=NSLOT*SLOTB, LDS_WS=2*NSLOT*SLOTB, LDS_OST=LDS_WS+NW*64*4, LDS_BYTES=LDS_OST+NW*4096;
__device__ __forceinline__ void glds16(const void*gsrc,unsigned lds_dst){unsigned keep;
  asm volatile("s_mov_b32 %0, m0\n\ts_mov_b32 m0, %2\n\ts_nop 0\n\tglobal_load_lds_dwordx4 %1, off\n\ts_mov_b32 m0, %0":"=&s"(keep):"v"(gsrc),"s"(lds_dst):"memory");}
__device__ __forceinline__ float max3f(float a,float b,float c){float r;asm("v_max3_f32 %0, %1, %2, %3":"=v"(r):"v"(a),"v"(b),"v"(c));return r;}
__device__ __forceinline__ float max2f(float a,float b){float r;asm("v_max_f32_e32 %0, %1, %2":"=v"(r):"v"(a),"v"(b));return r;}
__device__ __forceinline__ float fadd_s(float a,float b){float r;asm("v_add_f32_e32 %0, %1, %2":"=v"(r):"v"(a),"v"(b));return r;}
__device__ __forceinline__ float fsub_s(float a,float b){float r;asm("v_sub_f32_e32 %0, %1, %2":"=v"(r):"v"(a),"v"(b));return r;}
typedef float f32x2_t __attribute__((ext_vector_type(2))); typedef __bf16 bf16x2_t __attribute__((ext_vector_type(2)));
__device__ __forceinline__ unsigned cvtpk_s(float lo,float hi){f32x2_t v={lo,hi};bf16x2_t b=__builtin_convertvector(v,bf16x2_t);return __builtin_bit_cast(unsigned,b);}
#define WAIT_BAR(N) asm volatile("s_waitcnt vmcnt(" #N ") lgkmcnt(0)\n\ts_barrier":::"memory")

__device__ __forceinline__ void qkt(f32x16&p0,f32x16&p1,const char*Kslot,const bf16x8*qr,int r32,int hi){
  const char*kb=Kslot+hi*1024+r32*16;
  #pragma unroll
  for(int d0=0;d0<4;++d0){
    const bf16x8 b0=*reinterpret_cast<const bf16x8*>(kb+d0*2048);
    const bf16x8 b1=*reinterpret_cast<const bf16x8*>(kb+d0*2048+512);
    p0=__builtin_amdgcn_mfma_f32_32x32x16_bf16(b0,qr[d0],p0,0,0,0);p1=__builtin_amdgcn_mfma_f32_32x32x16_bf16(b1,qr[d0],p1,0,0,0);}
}
typedef __attribute__((address_space(3))) const char* lds_cptr;
typedef short v4i16_t __attribute__((ext_vector_type(4)));
__device__ __forceinline__ void kload8(bf16x8*kf,lds_cptr kp){
  kf[0]=*(const __attribute__((address_space(3))) bf16x8*)(kp);      kf[1]=*(const __attribute__((address_space(3))) bf16x8*)(kp+512);
  kf[2]=*(const __attribute__((address_space(3))) bf16x8*)(kp+2048); kf[3]=*(const __attribute__((address_space(3))) bf16x8*)(kp+2560);
  kf[4]=*(const __attribute__((address_space(3))) bf16x8*)(kp+4096); kf[5]=*(const __attribute__((address_space(3))) bf16x8*)(kp+4608);
  kf[6]=*(const __attribute__((address_space(3))) bf16x8*)(kp+6144); kf[7]=*(const __attribute__((address_space(3))) bf16x8*)(kp+6656);
}
__device__ __forceinline__ void kload2(bf16x8*kf,lds_cptr kp,int j){ kf[2*j]=*(const __attribute__((address_space(3))) bf16x8*)(kp+j*2048); kf[2*j+1]=*(const __attribute__((address_space(3))) bf16x8*)(kp+j*2048+512); }
__device__ __forceinline__ s16x4 vtr(lds_cptr p){ return __builtin_bit_cast(s16x4,__builtin_amdgcn_ds_read_tr16_b64_v4i16((__attribute__((address_space(3))) v4i16_t*)p)); }
__device__ __forceinline__ float rowmax(const f32x16&p0,const f32x16&p1){
  float a=max3f(p0[0],p0[1],p1[0]),b=max3f(p0[2],p0[3],p1[1]);a=max3f(a,p1[2],p1[3]);
  #pragma unroll
  for(int r=4;r<16;r+=4){a=max3f(a,p0[r],p0[r+1]);b=max3f(b,p0[r+2],p0[r+3]);a=max3f(a,p1[r],p1[r+1]);b=max3f(b,p1[r+2],p1[r+3]);}
  const float m=max2f(a,b);
  auto rr=__builtin_amdgcn_permlane32_swap(__float_as_uint(m),__float_as_uint(m),false,false);
  return max2f(__uint_as_float(rr[0]),__uint_as_float(rr[1]));
}
__device__ __forceinline__ void pv(f32x16*o,int vb,bf16x8 pa0,bf16x8 pa1,bf16x8 pa2,bf16x8 pa3){
  #pragma unroll
  for(int d0=0;d0<2;++d0){s16x4 lo[4],hi[4];
    #pragma unroll
    for(int ks=0;ks<4;++ks){
      asm volatile("ds_read_b64_tr_b16 %0,%1 offset:%c2":"=&v"(lo[ks]):"v"(vb),"i"(d0*4096+ks*1024):"memory");
      asm volatile("ds_read_b64_tr_b16 %0,%1 offset:%c2":"=&v"(hi[ks]):"v"(vb),"i"(d0*4096+ks*1024+512):"memory");}
    asm volatile("s_waitcnt lgkmcnt(0)":::"memory");SBAR();
    #define PK(k) (bf16x8){lo[k][0],lo[k][1],lo[k][2],lo[k][3],hi[k][0],hi[k][1],hi[k][2],hi[k][3]}
    o[d0]=__builtin_amdgcn_mfma_f32_32x32x16_bf16(pa0,PK(0),o[d0],0,0,0);
    o[d0]=__builtin_amdgcn_mfma_f32_32x32x16_bf16(pa1,PK(1),o[d0],0,0,0);
    o[d0]=__builtin_amdgcn_mfma_f32_32x32x16_bf16(pa2,PK(2),o[d0],0,0,0);
    o[d0]=__builtin_amdgcn_mfma_f32_32x32x16_bf16(pa3,PK(3),o[d0],0,0,0);
    #undef PK
  }
}
#define ATTN_STORE16(p,v) (*(u32x4*)(p)=(v))
template<int THRL> __device__ __forceinline__ void attn_unit(int b,int j,int vh,int qb,const bf16*Q,const bf16*__restrict__ K,const bf16*__restrict__ V,bf16*O,char*shm,const __attribute__((address_space(3))) float*tbh){
  int tid_=threadIdx.x; asm volatile("":"+v"(tid_));
  const int tid=tid_,lane=tid&63,r32=lane&31,hi=lane>>5; const int wid=__builtin_amdgcn_readfirstlane(tid>>6);
  const long rowbase=(long)b*SEQ; const int q0=qb*QB;
  const bf16*Qw=Q+(rowbase+q0+wid*QBLK)*PQ+j*DH;
  const bf16*Kh=K+rowbase*PQ+j*DH,*Vh=V+rowbase*PQ+(j>>1)*128+vh*64;
  const unsigned lds0=(unsigned)(uintptr_t)shm;
  float*wsf=(float*)(shm+LDS_WS)+wid*64;
  const bf16*ksrc=Kh+(long)lane*PQ+wid*8;
  const bf16*vsrc=Vh+(long)(16*(wid&3)+(lane>>2))*PQ+(wid>>2)*32+(lane&3)*8;
  const unsigned kdst=lds0+LDS_K+wid*1024, vdst=lds0+LDS_V+wid*1024;
  #define DMA_K(t,slot) glds16(ksrc+(long)(t)*KVBLK*PQ,(unsigned)__builtin_amdgcn_readfirstlane(kdst+(slot)))
  #define DMA_V(t,slot) glds16(vsrc+(long)(t)*KVBLK*PQ,(unsigned)__builtin_amdgcn_readfirstlane(vdst+(slot)))
  const int vb0=(int)(lds0+LDS_V)+((lane>>4)&1)*32+(lane&3)*8+(4*hi+((lane&15)>>2))*64;
  const char*Kbase=shm+LDS_K; bf16x8 kf[8];
  const lds_cptr shm3=(lds_cptr)shm; const lds_cptr kp0=shm3+LDS_K+hi*1024+r32*16; const lds_cptr vp0=shm3+LDS_V+((lane>>4)&1)*32+(lane&3)*8+(4*hi+((lane&15)>>2))*64;
  const int NT=(q0+QB)/KVBLK;
  DMA_K(0,0);DMA_V(0,0);DMA_K(1,SLOTB);
  bf16x8 qr[4];
  #pragma unroll
  for(int d0=0;d0<4;++d0)qr[d0]=*reinterpret_cast<const bf16x8*>(&Qw[(long)r32*PQ+d0*16+hi*8]);
  float mhat=0.f,l_reg=0.f;f32x16 o[2];o[0]=f32x16{};o[1]=f32x16{};f32x16 negm=f32x16{};asm volatile("":"+v"(negm));
  #define BINIT(C0,C1,t) bandinit(C0,C1,(t),q0,wid,r32,hi,tbh)
  bool resc=false;
  #define START(P0,P1) do{ const float rm=rowmax(P0,P1); resc=false; \
    { const float dl=rm; mhat=fadd_s(mhat,dl); \
      _Pragma("unroll") for(int r=0;r<16;++r){P0[r]=fsub_s(P0[r],dl);P1[r]=fsub_s(P1[r],dl);} \
      _Pragma("unroll") for(int r=0;r<16;++r)negm[r]=-mhat; asm volatile("":"+v"(negm)); } \
    _Pragma("unroll") for(int r=0;r<16;++r)P0[r]=__builtin_amdgcn_exp2f(P0[r]); }while(0)
  #define RESC() do{ if(resc){ asm volatile("s_waitcnt lgkmcnt(0)":::"memory"); \
      _Pragma("unroll") for(int d_=0;d_<2;++d_) _Pragma("unroll") for(int r=0;r<16;++r)o[d_][r]*=wsf[crow(r,hi)]; } }while(0)
  f32x16 pA0,pA1,pB0,pB1;
  int sl_prev=0,sl_cur=0,sl_next=SLOTB;
  #define ROT() do{sl_prev=sl_cur;sl_cur=sl_next;sl_next=(sl_next==(NSLOT-1)*SLOTB)?0:sl_next+SLOTB;}while(0)
  DMA_K(2,2*SLOTB);
  WAIT_BAR(3);
  if(NT<=7){BINIT(pA0,pA1,0);}else{pA0=f32x16{};pA1=f32x16{};}
  qkt(pA0,pA1,Kbase,qr,r32,hi);asm volatile("s_nop 15\n\ts_nop 7":"+v"(pA0),"+v"(pA1));
  START(pA0,pA1);
  _Pragma("unroll") for(int r=0;r<16;++r)pA1[r]=__builtin_amdgcn_exp2f(pA1[r]);
  WAIT_BAR(0);
  DMA_K(3,0);DMA_V(1,SLOTB);
  ROT();
  kload8(kf,kp0+sl_cur);
  WAIT_BAR(2);
  s16x4 vlo[8],vhi[8]; u32x4 pw0,pw1,pw2,pw3;
  #define PKW(P,B) cvtpk_s(P[B],P[B+1])
  #define PAF(k) __builtin_bit_cast(bf16x8,pw##k)
  #define VFR(i) (bf16x8){vlo[i][0],vlo[i][1],vlo[i][2],vlo[i][3],vhi[i][0],vhi[i][1],vhi[i][2],vhi[i][3]}
  #define PIN(x) asm volatile("":"+v"(x))
  #define MX3(a,b,c) __builtin_fmaxf(__builtin_fmaxf((a),(b)),(c))
  #define GAPA(MF,A0,A1,A2,A3,W0,W1,PW) do{ MF; sacc+=A0; sacc+=A1; sacc+=A2; sacc+=A3; PIN(sacc); W0; W1; PIN(PW); SBAR(); }while(0)
  #define EX(v) __builtin_amdgcn_exp2f(v)
  #define GAPB(MF,X,B) do{ MF; X[B]=EX(X[B]); X[B+1]=EX(X[B+1]); X[B+2]=EX(X[B+2]); X[B+3]=EX(X[B+3]); PIN(X); SBAR(); }while(0)
  #define VRD(i) do{ vlo[i]=vtr(vp_+(((i)>>2)*4096+((i)&3)*1024)); vhi[i]=vtr(vp_+(((i)>>2)*4096+((i)&3)*1024+512)); }while(0)
  #define KRD(G,j) do{ if(G){ kload2(kf,kp0+sl_next,j); SBAR(); } }while(0)
  #define STEP(C0,C1,P0,P1,t,GK,GV,GL,PRE,I0,I1,POST) do{ SBAR(); PRE; SBAR(); \
    const lds_cptr vp_=vp0+sl_prev; \
    VRD(0); SBAR(); float sacc=(P0[0]+P0[1]); \
    GAPA(C0=__builtin_amdgcn_mfma_f32_32x32x16_bf16(kf[0],qr[0],I0,0,0,0), P0[2],P0[3],P0[4],P0[5],     pw0[0]=PKW(P0,0), pw0[1]=PKW(P0,2), pw0); \
    VRD(4); SBAR(); GAPA(C1=__builtin_amdgcn_mfma_f32_32x32x16_bf16(kf[1],qr[0],I1,0,0,0), P0[6],P0[7],P0[8],P0[9],     pw0[2]=PKW(P0,4), pw0[3]=PKW(P0,6), pw0); \
    VRD(1); SBAR(); GAPA(C0=__builtin_amdgcn_mfma_f32_32x32x16_bf16(kf[2],qr[1],C0,0,0,0),   P0[10],P0[11],P0[12],P0[13], pw1[0]=PKW(P0,8), pw1[1]=PKW(P0,10), pw1); \
    VRD(5); SBAR(); GAPA(C1=__builtin_amdgcn_mfma_f32_32x32x16_bf16(kf[3],qr[1],C1,0,0,0),   P0[14],P0[15],P1[0],P1[1],   pw1[2]=PKW(P0,12),pw1[3]=PKW(P0,14), pw1); \
    VRD(2); SBAR(); GAPA(C0=__builtin_amdgcn_mfma_f32_32x32x16_bf16(kf[4],qr[2],C0,0,0,0),   P1[2],P1[3],P1[4],P1[5],     pw2[0]=PKW(P1,0), pw2[1]=PKW(P1,2), pw2); \
    VRD(6); SBAR(); GAPA(C1=__builtin_amdgcn_mfma_f32_32x32x16_bf16(kf[5],qr[2],C1,0,0,0),   P1[6],P1[7],P1[8],P1[9],     pw2[2]=PKW(P1,4), pw2[3]=PKW(P1,6), pw2); \
    VRD(3); SBAR(); GAPA(C0=__builtin_amdgcn_mfma_f32_32x32x16_bf16(kf[6],qr[3],C0,0,0,0),   P1[10],P1[11],P1[12],P1[13], pw3[0]=PKW(P1,8), pw3[1]=PKW(P1,10), pw3); \
    VRD(7); SBAR(); GAPA(C1=__builtin_amdgcn_mfma_f32_32x32x16_bf16(kf[7],qr[3],C1,0,0,0),   P1[14],P1[15],0.f,0.f,       pw3[2]=PKW(P1,12),pw3[3]=PKW(P1,14), pw3); \
    l_reg+=sacc; \
    if(GK){DMA_K((t)+3,sl_cur);} if(GV){DMA_V((t)+1,sl_next);} \
    POST; \
    { float a=MX3(C0[0],C0[1],C1[0]),b=MX3(C0[2],C0[3],C1[1]); a=MX3(a,C1[2],C1[3]); \
      _Pragma("unroll") for(int r=4;r<16;r+=4){a=MX3(a,C0[r],C0[r+1]);b=MX3(b,C0[r+2],C0[r+3]);a=MX3(a,C1[r],C1[r+1]);b=MX3(b,C1[r+2],C1[r+3]);} \
      float rm=__builtin_fmaxf(a,b); { auto rr=__builtin_amdgcn_permlane32_swap(__float_as_uint(rm),__float_as_uint(rm),false,false); rm=__builtin_fmaxf(__uint_as_float(rr[0]),__uint_as_float(rr[1])); } \
      resc=false; \
      if(__builtin_expect(__any(rm>(float)THRL),0)){ const float dl=__builtin_fmaxf(rm,0.f); mhat+=dl; \
        _Pragma("unroll") for(int r=0;r<16;++r){C0[r]-=dl;C1[r]-=dl;} \
        _Pragma("unroll") for(int r=0;r<16;++r)negm[r]=-mhat; asm volatile("":"+v"(negm)); \
        const float f=__builtin_amdgcn_exp2f(-dl); l_reg*=f; if(hi==0)wsf[r32]=f; resc=true; } } \
    SBAR(); \
    GAPB(o[0]=__builtin_amdgcn_mfma_f32_32x32x16_bf16(PAF(0),VFR(0),o[0],0,0,0), C0,0); \
    GAPB(o[1]=__builtin_amdgcn_mfma_f32_32x32x16_bf16(PAF(0),VFR(4),o[1],0,0,0), C0,4); \
    KRD(GL,0); GAPB(o[0]=__builtin_amdgcn_mfma_f32_32x32x16_bf16(PAF(1),VFR(1),o[0],0,0,0), C0,8); \
    KRD(GL,1); GAPB(o[1]=__builtin_amdgcn_mfma_f32_32x32x16_bf16(PAF(1),VFR(5),o[1],0,0,0), C0,12); \
    KRD(GL,2); GAPB(o[0]=__builtin_amdgcn_mfma_f32_32x32x16_bf16(PAF(2),VFR(2),o[0],0,0,0), C1,0); \
    KRD(GL,3); GAPB(o[1]=__builtin_amdgcn_mfma_f32_32x32x16_bf16(PAF(2),VFR(6),o[1],0,0,0), C1,4); \
    GAPB(o[0]=__builtin_amdgcn_mfma_f32_32x32x16_bf16(PAF(3),VFR(3),o[0],0,0,0), C1,8); \
    GAPB(o[1]=__builtin_amdgcn_mfma_f32_32x32x16_bf16(PAF(3),VFR(7),o[1],0,0,0), C1,12); \
    }while(0)
  int t=1;
  for(;t+7<NT;t+=2){
    STEP(pB0,pB1,pA0,pA1,t,true,true,true,,negm,negm,);     WAIT_BAR(2); RESC(); ROT();
    STEP(pA0,pA1,pB0,pB1,t+1,true,true,true,,negm,negm,);   WAIT_BAR(2); RESC(); ROT();
  }
  #define ENDW(tt) do{ if((tt)+3<NT){WAIT_BAR(2);} else if((tt)+2<NT){WAIT_BAR(1);} else {WAIT_BAR(0);} }while(0)
  for(;t+1<NT;t+=2){
    STEP(pB0,pB1,pA0,pA1,t,(t+3<NT),(t+1<NT),(t+1<NT),BINIT(pB0,pB1,t),pB0,pB1,bandpost(pB0,pB1,negm,t,q0,wid));           ENDW(t);   RESC(); ROT();
    STEP(pA0,pA1,pB0,pB1,t+1,(t+4<NT),(t+2<NT),(t+2<NT),BINIT(pA0,pA1,t+1),pA0,pA1,bandpost(pA0,pA1,negm,t+1,q0,wid));       ENDW(t+1); RESC(); ROT();
  }
  STEP(pB0,pB1,pA0,pA1,NT-1,false,false,false,BINIT(pB0,pB1,NT-1),pB0,pB1,bandpost(pB0,pB1,negm,NT-1,q0,wid)); RESC();
  { float sacc=pB0[0]+pB0[1]; _Pragma("unroll") for(int r=2;r<16;++r)sacc+=pB0[r]; _Pragma("unroll") for(int r=0;r<16;++r)sacc+=pB1[r]; l_reg+=sacc;
    pw0=(u32x4){PKW(pB0,0),PKW(pB0,2),PKW(pB0,4),PKW(pB0,6)};pw1=(u32x4){PKW(pB0,8),PKW(pB0,10),PKW(pB0,12),PKW(pB0,14)};pw2=(u32x4){PKW(pB1,0),PKW(pB1,2),PKW(pB1,4),PKW(pB1,6)};pw3=(u32x4){PKW(pB1,8),PKW(pB1,10),PKW(pB1,12),PKW(pB1,14)};
    SBAR(); pv(o,vb0+sl_cur,PAF(0),PAF(1),PAF(2),PAF(3)); }
  #undef PKW
  #undef PAF
  #undef VFR
  #undef PIN
  #undef MX3
  #undef GAPA
  #undef GAPB
  #undef EX
  #undef VRD
  #undef KRD
  #undef STEP
  #undef ENDW
  {auto rr=__builtin_amdgcn_permlane32_swap(__float_as_uint(l_reg),__float_as_uint(l_reg),false,false);l_reg=__uint_as_float(rr[0])+__uint_as_float(rr[1]);}
  if(hi==0)wsf[32+r32]=l_reg;asm volatile("s_waitcnt lgkmcnt(0)":::"memory");
  float rli[16];
  #pragma unroll
  for(int r=0;r<16;++r)rli[r]=__builtin_amdgcn_rcpf(wsf[32+crow(r,hi)]);
  bf16*Ow=O+(rowbase+q0+wid*QBLK)*PO+j*128+vh*64;
  { bf16*stg=(bf16*)(shm+LDS_OST)+wid*2048;
    #pragma unroll
    for(int r=0;r<16;++r){const int orow=crow(r,hi);
      #pragma unroll
      for(int d0=0;d0<2;++d0)stg[orow*64+d0*32+r32]=__float2bfloat16(o[d0][r]*rli[r]);}
    asm volatile("s_waitcnt lgkmcnt(0)":::"memory");
    #pragma unroll
    for(int i=0;i<4;++i){const int row=i*8+(lane>>3),ch=lane&7; const u32x4 v=*(const u32x4*)(stg+row*64+ch*8); ATTN_STORE16(Ow+(long)row*PO+ch*8,v);} }
  asm volatile("s_waitcnt lgkmcnt(0)\n\ts_barrier":::"memory");
  #undef DMA_K
  #undef DMA_V
  #undef BINIT
  #undef START
  #undef RESC
  #undef ROT
}
constexpr int ATTN_LDS_BYTES=LDS_BYTES;
#undef SBAR
#undef WAIT_BAR
}

#define XB_TMO      128
#define XB_XCNT(j)  (256  + 64 * (j))
#define XB_XSUB(j)  (1280 + 64 * (j))
#define XB_XGEN(j)  (2304 + 64 * (j))
#define XB_TOP      3328
#define XB_TOPGEN   3392
#define XCD_BAR_WORDS 3456
#define XB_SPIN_CAP (1u << 18)
__device__ __forceinline__ unsigned xb_ld(unsigned* p)              { return __hip_atomic_load(p, __ATOMIC_RELAXED, __HIP_MEMORY_SCOPE_AGENT); }
__device__ __forceinline__ unsigned xb_add(unsigned* p, unsigned v) { return __hip_atomic_fetch_add(p, v, __ATOMIC_RELAXED, __HIP_MEMORY_SCOPE_AGENT); }
__device__ __forceinline__ unsigned xb_xcc_id() { return (unsigned)__builtin_amdgcn_s_getreg((3 << 11) | 20) & 0xFu; }
#define XB_SPIN(cond, bar) do { unsigned _sp = 0; while (cond) { __builtin_amdgcn_s_sleep(1); \
    if ((++_sp & 255u) == 0u) { if (xb_ld(&(bar)[XB_TMO])) break; if (_sp > XB_SPIN_CAP) { atomicAdd(&(bar)[XB_TMO], 1u); break; } } } } while (0)
struct XcdBarrier { unsigned* bar; unsigned x; volatile LAS unsigned* st; };
__device__ __forceinline__ XcdBarrier xcd_barrier_post(unsigned* bar, volatile LAS unsigned* st) {
    XcdBarrier b; b.bar = bar; b.x = xb_xcc_id(); b.st = st;
    if (threadIdx.x == 0) (void)xb_add(&bar[XB_XCNT(b.x)], 1u);
    return b;
}
__device__ __forceinline__ void xcd_barrier_complete(unsigned* bar, unsigned x, unsigned& nloc, unsigned& nx) {
    const unsigned G = gridDim.x * gridDim.y * gridDim.z;
    unsigned sum, cnt, mine, sp = 0u;
    for (;;) {
        sum = 0u; cnt = 0u; mine = 0u;
#pragma unroll
        for (unsigned j = 0; j < 16; ++j) { const unsigned c = xb_ld(&bar[XB_XCNT(j)]); sum += c; cnt += (c > 0u) ? 1u : 0u; mine = (j == x) ? c : mine; }
        if (sum == G) break;
        __builtin_amdgcn_s_sleep(1);
        if ((++sp & 255u) == 0u) { if (xb_ld(&bar[XB_TMO])) break; if (sp > XB_SPIN_CAP) { atomicAdd(&bar[XB_TMO], 1u); break; } }
    }
    nloc = mine > 0u ? mine : 1u; nx = cnt > 0u ? cnt : 1u;
}
__device__ __forceinline__ void xcd_barrier(const XcdBarrier& b) {
    asm volatile("s_waitcnt vmcnt(0)" ::: "memory");
    __syncthreads();
    if (threadIdx.x == 0) {
        unsigned* bar = b.bar;
        __builtin_amdgcn_s_waitcnt(0);
        unsigned nloc = b.st[0], nx = b.st[1];
        if (nloc == 0u) { xcd_barrier_complete(bar, b.x, nloc, nx); b.st[0] = nloc; b.st[1] = nx; }
        const unsigned old = xb_add(&bar[XB_XSUB(b.x)], 1u);
        const unsigned gen = old / nloc;
        if (old + 1u == (gen + 1u) * nloc) {
            __builtin_amdgcn_fence(__ATOMIC_RELEASE, "agent");
            asm volatile("s_waitcnt vmcnt(0)" ::: "memory");
            const unsigned og = xb_add(&bar[XB_TOP], 1u);
            const unsigned tg = og / nx;
            if (og + 1u == (tg + 1u) * nx) xb_add(&bar[XB_TOPGEN], 1u);
            else XB_SPIN(xb_ld(&bar[XB_TOPGEN]) == tg, bar);
            __builtin_amdgcn_fence(__ATOMIC_ACQUIRE, "agent");
            xb_add(&bar[XB_XGEN(b.x)], 1u);
            asm volatile("s_waitcnt vmcnt(0)" ::: "memory");
        } else {
            XB_SPIN(xb_ld(&bar[XB_XGEN(b.x)]) == gen, bar);
            __builtin_amdgcn_fence(__ATOMIC_ACQUIRE, "agent");
            asm volatile("s_waitcnt vmcnt(0)" ::: "memory");
        }
    }
    __syncthreads();
}

struct Frame {
    LAS unsigned char* lds;
    unsigned char* ws;
    gu32* ctl;
    int tid, lane, wave;
    int vcu, G;
};
__device__ __forceinline__ float wave_sum(float v) {
#pragma unroll
    for (int o = 1; o < 64; o <<= 1) v += __shfl_xor(v, o);
    return v;
}
struct TItem { const float* src; bf16* dst; int K, N; };
__device__ __forceinline__ unsigned pk4_fp8(float a, float b, float c, float d) {
    int w = __builtin_amdgcn_cvt_pk_fp8_f32(a, b, 0, false); w = __builtin_amdgcn_cvt_pk_fp8_f32(c, d, w, true); return (unsigned)w; }
constexpr float W8_SCALE = 64.0f, W8_INV = 1.0f / 64.0f;
__device__ __forceinline__ void p0_load(const TItem& t, f32x4 (&v)[8], int wave, int lane) {
    const GAS float* sp = (const GAS float*)t.src + (size_t)(8 * (2 * wave + (lane >> 5))) * t.N + 4 * (lane & 31);
#pragma unroll
    for (int i = 0; i < 8; ++i) v[i] = __builtin_nontemporal_load((const GAS f32x4*)(sp + (size_t)i * t.N));
}
__device__ __forceinline__ void p0_store(const TItem& t, const f32x4 (&v)[8], LAS unsigned char* img, int wave, int lane) {
    const int kg = 2 * wave + (lane >> 5), n4 = lane & 31;
#pragma unroll
    for (int x = 0; x < 4; ++x) { v4u w; w.x = pg8::cvt_pk_bf16(v[0][x], v[1][x]); w.y = pg8::cvt_pk_bf16(v[2][x], v[3][x]); w.z = pg8::cvt_pk_bf16(v[4][x], v[5][x]); w.w = pg8::cvt_pk_bf16(v[6][x], v[7][x]);
        *(LAS v4u*)(img + (4 * n4 + x) * 272 + kg * 16) = w; }
    asm volatile("s_waitcnt lgkmcnt(0)\n\ts_barrier" ::: "memory");
#pragma unroll
    for (int j = 0; j < 4; ++j) { const int n = 16 * wave + 4 * j + (lane >> 4), kc = lane & 15;
        const v4u o = *(const LAS v4u*)(img + n * 272 + kc * 16);
        *(GAS v4u*)(t.dst + (size_t)n * t.K + 8 * kc) = o; }
}
__device__ __forceinline__ void p0_store8(const TItem& t, const f32x4 (&v)[8], LAS unsigned char* img, int wave, int lane) {
    const int kg = 2 * wave + (lane >> 5), n4 = lane & 31;
#pragma unroll
    for (int x = 0; x < 4; ++x) { v2u w; w.x = pk4_fp8(v[0][x] * W8_SCALE, v[1][x] * W8_SCALE, v[2][x] * W8_SCALE, v[3][x] * W8_SCALE); w.y = pk4_fp8(v[4][x] * W8_SCALE, v[5][x] * W8_SCALE, v[6][x] * W8_SCALE, v[7][x] * W8_SCALE);
        *(LAS v2u*)(img + (4 * n4 + x) * 144 + kg * 8) = w; }
    asm volatile("s_waitcnt lgkmcnt(0)\n\ts_barrier" ::: "memory");
    unsigned char* dst = (unsigned char*)t.dst;
#pragma unroll
    for (int j = 0; j < 2; ++j) { const int n = 16 * wave + 8 * j + (lane >> 3), kc = lane & 7;
        const v4u o = *(const LAS v4u*)(img + n * 144 + kc * 16);
        *(GAS v4u*)(dst + (size_t)n * t.K + 16 * kc) = o; }
}
__device__ __forceinline__ int t5_bucket(int rel) {
    const int n = rel < 0 ? -rel : rel; int b;
    if (n < 8) b = n; else if (n < 12) b = 8; else if (n < 16) b = 9; else if (n < 23) b = 10; else if (n < 32) b = 11; else if (n < 46) b = 12; else if (n < 64) b = 13; else if (n < 91) b = 14; else b = 15;
    return b + (rel > 0 ? 16 : 0);
}

struct DenseSched {
    const bf16* A; const bf16* Bt; int nM, nN, nwg, G, c;
    __device__ __forceinline__ void init(const bf16* A_, const bf16* Bt_, int M_, int N_, int G_, int c_) { A = A_; Bt = Bt_; nM = M_ / 256; nN = N_ / 256; nwg = nM * nN; G = G_; c = c_; }
    __device__ __forceinline__ bool next(int i, pg8::Unit& u) const {
        const long L = (long)i * G + c; if (L >= nwg) return false;
        int wgid = (int)L; { const int q = nwg / 8, r = nwg % 8, xcd = wgid % 8, off = wgid / 8; wgid = (xcd < r ? xcd * (q + 1) : r * (q + 1) + (xcd - r) * q) + off; }
        const int nig = 8 * nN, gid = wgid / nig, fm = gid * 8, gsz = (nM - fm) < 8 ? (nM - fm) : 8;
        u.pm = fm + ((wgid % nig) % gsz); u.pn = (wgid % nig) / gsz; u.e = 0; u.lrow0 = 0; u.cnt = 0; return true;
    }
    __device__ __forceinline__ const char* a_base(const pg8::Unit& u) const { return (const char*)A + (size_t)u.pm * (256 * 1024 * 2); }
    __device__ __forceinline__ const char* b_base(const pg8::Unit& u) const { return (const char*)Bt + (size_t)u.pn * (256 * 1024 * 2); }
    __device__ __forceinline__ size_t b_hstep() const { return (size_t)128 * 1024 * 2; }
    __device__ __forceinline__ void a_voff(const pg8::Unit&, const int (&R)[2], const int (&C)[2], unsigned (&v0)[2], unsigned (&v1)[2]) const {
#pragma unroll
        for (int i = 0; i < 2; ++i) { v0[i] = (unsigned)(R[i] * 1024 + C[i]) * 2u; v1[i] = v0[i] + 128u * 1024u * 2u; } }
    __device__ __forceinline__ const bf16* a_row(const pg8::Unit& u, int r) const { return A + (size_t)(u.pm * 256 + r) * 1024; }
    __device__ __forceinline__ const bf16* b_row(const pg8::Unit& u, int c_) const { return Bt + (size_t)(u.pn * 256 + c_) * 1024; }
    __device__ __forceinline__ void a_tok(const pg8::Unit&, const int (&)[2], unsigned (&tk)[4]) const { tk[0] = tk[1] = tk[2] = tk[3] = 0u; }
    __device__ __forceinline__ void a_voff_tok(const unsigned (&)[4], const int (&R)[2], const int (&C)[2], unsigned (&v0)[2], unsigned (&v1)[2]) const {
#pragma unroll
        for (int i = 0; i < 2; ++i) { v0[i] = (unsigned)(R[i] * 1024 + C[i]) * 2u; v1[i] = v0[i] + 128u * 1024u * 2u; } }
};
struct MoeSched {
    const bf16* A; const bf16* W; const int* rowtok; const LAS int* pexp; const LAS int* pfirst; const LAS int* cntl;
    int NP, NT, G, vcu; bool gather; int rowb  ; size_t wexp  , wtile  , whalf;
    __device__ __forceinline__ bool next(int i, pg8::Unit& u) const {
        const int L = i * G + vcu; if (L >= NP * NT) return false;
        const int pi = L / NT; const int e = __builtin_amdgcn_readfirstlane(pexp[pi]);
        u.pm = pi; u.pn = L - pi * NT; u.e = e; u.lrow0 = (pi - __builtin_amdgcn_readfirstlane(pfirst[e])) * 256; u.cnt = __builtin_amdgcn_readfirstlane(cntl[e]); return true;
    }
    __device__ __forceinline__ const char* a_base(const pg8::Unit& u) const { return gather ? (const char*)A : (const char*)A + (size_t)u.pm * 256 * (size_t)rowb; }
    __device__ __forceinline__ const char* b_base(const pg8::Unit& u) const { return (const char*)W + (size_t)u.e * wexp + (size_t)u.pn * wtile; }
    __device__ __forceinline__ size_t b_hstep() const { return whalf; }
    __device__ __forceinline__ int tok_of(const pg8::Unit& u, int r) const { int lr = u.lrow0 + r; lr = lr < u.cnt ? lr : u.cnt - 1; return ((const GAS int*)rowtok)[u.e * ECAP + lr]; }
    __device__ __forceinline__ void a_tok(const pg8::Unit& u, const int (&R)[2], unsigned (&tk)[4]) const {
        if (gather) {
#pragma unroll
            for (int q = 0; q < 4; ++q) { int lr = u.lrow0 + (q >> 1) * 128 + R[q & 1]; lr = lr < u.cnt ? lr : u.cnt - 1; const GAS int* ap = (const GAS int*)rowtok + (u.e * ECAP + lr);
                asm volatile("global_load_dword %0, %1, off" : "=v"(tk[q]) : "v"(ap) : "memory"); }
        } else { tk[0] = tk[1] = tk[2] = tk[3] = 0u; } }
    __device__ __forceinline__ void a_voff_tok(const unsigned (&tk)[4], const int (&R)[2], const int (&C)[2], unsigned (&v0)[2], unsigned (&v1)[2]) const {
        if (gather) {
#pragma unroll
            for (int i = 0; i < 2; ++i) { v0[i] = tk[i] * (unsigned)rowb + (unsigned)(C[i] * 2); v1[i] = tk[2 + i] * (unsigned)rowb + (unsigned)(C[i] * 2); }
        } else {
#pragma unroll
            for (int i = 0; i < 2; ++i) { v0[i] = (unsigned)(R[i] * rowb + C[i] * 2); v1[i] = v0[i] + 128u * (unsigned)rowb; }
        } }
    __device__ __forceinline__ void a_voff(const pg8::Unit& u, const int (&R)[2], const int (&C)[2], unsigned (&v0)[2], unsigned (&v1)[2]) const {
        if (gather) {
#pragma unroll
            for (int i = 0; i < 2; ++i) { v0[i] = (unsigned)(tok_of(u, R[i]) * rowb + C[i] * 2); v1[i] = (unsigned)(tok_of(u, 128 + R[i]) * rowb + C[i] * 2); }
        } else {
#pragma unroll
            for (int i = 0; i < 2; ++i) { v0[i] = (unsigned)(R[i] * rowb + C[i] * 2); v1[i] = v0[i] + 128u * (unsigned)rowb; }
        }
    }
    __device__ __forceinline__ const bf16* a_row(const pg8::Unit& u, int r) const { return gather ? A + (size_t)tok_of(u, r) * 1024 : A + (size_t)(u.pm * 256 + r) * 1024; }
    __device__ __forceinline__ const bf16* b_row(const pg8::Unit& u, int c_) const { return (const bf16*)((const char*)W + (size_t)u.e * wexp + (size_t)u.pn * wtile + (c_ >= 128 ? whalf : 0) + (size_t)(c_ & 127) * 2048); }
};

struct EpiQKVU {
    static constexpr bool PERM = true;
    bf16* O; size_t stride;
    __device__ __forceinline__ void pre(const pg8::Unit&, int, int, int, int, pg8::Pre&) const {}
    __device__ __forceinline__ void operator()(const pg8::f32x4 (&acc)[2][2][4][2], const pg8::Unit& u, int wr, int wc, int fr, int fq, const pg8::Pre&) const {
        const int t = u.pn >> 1; const float sc = t == 0 ? QSCALE : 1.f;
        bf16* base = O + (size_t)t * stride; const int col0 = (u.pn & 1) * 256 + wc * 32 + 8 * fq; const int row0 = u.pm * 256 + wr * 64 + fr;
#pragma unroll
        for (int ai = 0; ai < 2; ++ai)
#pragma unroll
            for (int m = 0; m < 4; ++m) { bf16* rowp = base + (size_t)(row0 + ai * 128 + m * 16) * 512 + col0;
#pragma unroll
                for (int bj = 0; bj < 2; ++bj) { const pg8::f32x4 v0 = acc[ai][bj][m][0] * sc, v1 = acc[ai][bj][m][1] * sc;
                    pg8::u32x4 w; w.x = pg8::cvt_pk_bf16(v0[0], v0[1]); w.y = pg8::cvt_pk_bf16(v0[2], v0[3]); w.z = pg8::cvt_pk_bf16(v1[0], v1[1]); w.w = pg8::cvt_pk_bf16(v1[2], v1[3]);
                    *(pg8::u32x4*)(rowp + bj * 128) = w; } }
    }
};
struct EpiT1 {
    static constexpr bool PERM = false;
    const float* x; const float* mod; float* T1;
    __device__ __forceinline__ void pre(const pg8::Unit&, int, int, int, int, pg8::Pre&) const {}
    __device__ __forceinline__ void operator()(const pg8::f32x4 (&acc)[2][2][4][2], const pg8::Unit& u, int wr, int wc, int fr, int fq, const pg8::Pre&) const {
        const int b = u.pm >> 3; const float* g1 = mod + (size_t)b * 6144 + 2048;
        const int col0 = u.pn * 256 + wc * 32 + 4 * fq;
        pg8::f32x4 gv[2][2];
#pragma unroll
        for (int bj = 0; bj < 2; ++bj)
#pragma unroll
            for (int n = 0; n < 2; ++n) gv[bj][n] = *(const pg8::f32x4*)(g1 + col0 + bj * 128 + n * 16);
#pragma unroll
        for (int ai = 0; ai < 2; ++ai)
#pragma unroll
            for (int m = 0; m < 4; ++m) { const size_t off = (size_t)(u.pm * 256 + ai * 128 + wr * 64 + m * 16 + fr) * 1024 + col0;
#pragma unroll
                for (int bj = 0; bj < 2; ++bj)
#pragma unroll
                    for (int n = 0; n < 2; ++n) { const pg8::f32x4 xv = *(const pg8::f32x4*)(x + off + bj * 128 + n * 16);
                        *(pg8::f32x4*)(T1 + off + bj * 128 + n * 16) = xv * DN_ALPHA + gv[bj][n] * acc[ai][bj][m][n]; } }
    }
};
struct EpiSwiglu {
    static constexpr bool PERM = true;
    const float* bgu; unsigned char* H;
    __device__ __forceinline__ void pre(const pg8::Unit& u, int, int wc, int, int fq, pg8::Pre& P) const {
        const float* bg = bgu + (size_t)u.e * 2048 + u.pn * 128 + wc * 32 + 8 * fq;
        pg8::asm_ld16(P.v[0], bg); pg8::asm_ld16(P.v[1], bg + 4); pg8::asm_ld16(P.v[2], bg + 1024); pg8::asm_ld16(P.v[3], bg + 1028); }
    __device__ __forceinline__ void operator()(const pg8::f32x4 (&acc)[2][2][4][2], const pg8::Unit& u, int wr, int wc, int fr, int fq, const pg8::Pre& P) const {
        const int c0 = u.pn * 128 + wc * 32 + 8 * fq;
        const pg8::f32x4 bgv[2] = {P.v[0], P.v[1]}, buv[2] = {P.v[2], P.v[3]};
#pragma unroll
        for (int ai = 0; ai < 2; ++ai)
#pragma unroll
            for (int m = 0; m < 4; ++m) { float r[8];
#pragma unroll
                for (int n = 0; n < 2; ++n)
#pragma unroll
                    for (int x = 0; x < 4; ++x) { const float g = fminf(acc[ai][0][m][n][x] * W8_INV + bgv[n][x], 7.0f); const float up = fminf(fmaxf(acc[ai][1][m][n][x] * W8_INV + buv[n][x], -7.0f), 7.0f);
                        const float sg = __builtin_amdgcn_rcpf(1.0f + __builtin_amdgcn_exp2f(-1.702f * LOG2E * g)); r[4 * n + x] = (up + 1.0f) * (g * sg); }
                v2u w; w.x = pk4_fp8(r[0], r[1], r[2], r[3]); w.y = pk4_fp8(r[4], r[5], r[6], r[7]);
                *(v2u*)(H + (size_t)(u.pm * 256 + ai * 128 + wr * 64 + m * 16 + fr) * 1024 + c0) = w; }
    }
};
struct EpiDown {
    static constexpr bool PERM = true;
    const float* bd; bf16* Y;
    __device__ __forceinline__ void pre(const pg8::Unit& u, int, int wc, int, int fq, pg8::Pre& P) const {
        const float* bp = bd + (size_t)u.e * 1024 + u.pn * 256 + wc * 32 + 8 * fq;
        pg8::asm_ld16(P.v[0], bp); pg8::asm_ld16(P.v[1], bp + 4); pg8::asm_ld16(P.v[2], bp + 128); pg8::asm_ld16(P.v[3], bp + 132); }
    __device__ __forceinline__ void operator()(const pg8::f32x4 (&acc)[2][2][4][2], const pg8::Unit& u, int wr, int wc, int fr, int fq, const pg8::Pre& P) const {
        const int c0 = u.pn * 256 + wc * 32 + 8 * fq;
        const pg8::f32x4 bv[2][2] = {{P.v[0], P.v[1]}, {P.v[2], P.v[3]}};
#pragma unroll
        for (int ai = 0; ai < 2; ++ai)
#pragma unroll
            for (int m = 0; m < 4; ++m) { bf16* rowp = Y + (size_t)(u.pm * 256 + ai * 128 + wr * 64 + m * 16 + fr) * 1024 + c0;
#pragma unroll
                for (int bj = 0; bj < 2; ++bj) { const pg8::f32x4 v0 = acc[ai][bj][m][0] * W8_INV + bv[bj][0], v1 = acc[ai][bj][m][1] * W8_INV + bv[bj][1];
                    pg8::u32x4 w; w.x = pg8::cvt_pk_bf16(v0[0], v0[1]); w.y = pg8::cvt_pk_bf16(v0[2], v0[3]); w.z = pg8::cvt_pk_bf16(v1[0], v1[1]); w.w = pg8::cvt_pk_bf16(v1[2], v1[3]);
                    *(pg8::u32x4*)(rowp + bj * 128) = w; } }
    }
};

__device__ __forceinline__ void build_expert_tables(Frame& F) {
    LAS int* cntl = (LAS int*)(F.lds + L_CNT); LAS int* pfirst = (LAS int*)(F.lds + L_PFIRST); LAS int* pexp = (LAS int*)(F.lds + L_PEXP);
    __syncthreads();
    if (F.tid < NE) { int c = (int)__hip_atomic_load(F.ctl + CW_CNT + 64 * F.tid, RLX_AGENT); c = c < 0 ? 0 : (c > ECAP ? ECAP : c); cntl[F.tid] = c; }
    __syncthreads();
    if (F.tid == 0) { int p = 0; for (int e = 0; e < NE; ++e) { pfirst[e] = p; const int np = (cntl[e] + 255) >> 8; for (int k = 0; k < np; ++k) if (p + k < PMAX) pexp[p + k] = e; p += np; if (p > PMAX) p = PMAX; } pfirst[NE] = p; }
    __syncthreads();
}

struct Args { const float* in[25]; float* out; unsigned char* ws; int ph_lo, ph_hi; };
constexpr int NPHASE = 10;

__global__ void __launch_bounds__(NWAVES * 64, 2) mk_fwd(Args args) {
    extern __shared__ __attribute__((aligned(16))) unsigned char lds[];
    Frame F;
    F.lds = (LAS unsigned char*)lds; F.ws = args.ws; F.ctl = (gu32*)(args.ws + WS_CTL);
    F.tid = threadIdx.x; F.lane = F.tid & 63; F.wave = __builtin_amdgcn_readfirstlane(F.tid >> 6);
    F.G = gridDim.x; { const int bx = blockIdx.x; F.vcu = (F.G % 8 == 0) ? (bx % 8) * (F.G / 8) + bx / 8 : bx; }
    volatile LAS unsigned* MISC = (volatile LAS unsigned*)(F.lds + L_MISC);
    for (int u = F.tid; u < (LDS_BYTES - LCTL_OFF) / 4; u += NWAVES * 64) ((LAS unsigned*)(F.lds + LCTL_OFF))[u] = 0u;
    __syncthreads();
    XcdBarrier bar; bar.bar = (unsigned*)(F.ctl + CW_BAR); bar.x = 0; bar.st = nullptr;
#if MK_ONE_LAUNCH
    bar = xcd_barrier_post((unsigned*)(F.ctl + CW_BAR), MISC + 8);
#define GRID_BAR() xcd_barrier(bar)
#else
#define GRID_BAR() do { } while (0)
#endif
#define PHASE_ENTRY() do { int t_ = threadIdx.x; asm volatile("" : "+v"(t_)); F.tid = t_; F.lane = t_ & 63; } while (0)
    const int lo = args.ph_lo, hi = args.ph_hi;
#ifndef PH_MASK
#define PH_MASK 0x3ff
#endif
#ifndef REP_MASK
#define REP_MASK 0x0
#endif
#define REPS(k) (1 + ((REP_MASK >> (k)) & 1))
#define IN(k) (((PH_MASK >> (k)) & 1) && lo <= (k) && (k) < hi)
#define BOTH(k) (IN(k) && IN((k) + 1))
    const float* x = args.in[0]; const float* cvec = args.in[1]; const float* w_ada = args.in[2]; const float* b_ada = args.in[3]; const float* w_in = args.in[4];
    const float* lq1 = args.in[5]; const float* lk1 = args.in[6]; const float* lq2 = args.in[7]; const float* lk2 = args.in[8]; const float* subln_g = args.in[9];
    const float* rel_bias = args.in[10]; const float* w_pool = args.in[11]; const float* b_pool = args.in[12]; const float* pool_scale = args.in[13]; const float* w_out = args.in[14];
    const float* ln1_g = args.in[15]; const float* ln1_b = args.in[16]; const float* w_router = args.in[17]; const float* b_router = args.in[18];
    const float* w_gu = args.in[19]; const float* b_gu = args.in[20]; const float* w_dn = args.in[21]; const float* b_dn = args.in[22]; const float* ln2_g = args.in[23]; const float* ln2_b = args.in[24];
    float* out = args.out; unsigned char* ws = args.ws;
    float* MOD = (float*)(ws + WS_MOD); float* MODP = (float*)(ws + WS_MODP); bf16* WPOOL = (bf16*)(ws + WS_WPOOL); bf16* WIN = (bf16*)(ws + WS_WIN); bf16* WOUT = (bf16*)(ws + WS_WOUT);
    bf16* WGU = (bf16*)(ws + WS_WGU); bf16* WD = (bf16*)(ws + WS_WD); bf16* XN = (bf16*)(ws + WS_XN);
    bf16* QB = (bf16*)(ws + WS_Q); bf16* KB = (bf16*)(ws + WS_K); bf16* VB = (bf16*)(ws + WS_V); bf16* UB = (bf16*)(ws + WS_U);
    bf16* OA = (bf16*)(ws + WS_OA); bf16* MIX = (bf16*)(ws + WS_MIX); float* T1 = (float*)(ws + WS_T1); float* X1 = (float*)(ws + WS_X1); bf16* XN2 = (bf16*)(ws + WS_XN2);
    int* RE = (int*)(ws + WS_RE); int* RP = (int*)(ws + WS_RP); float* RG = (float*)(ws + WS_RG); int* ROWTOK = (int*)(ws + WS_ROWTOK);
    bf16* HB = (bf16*)(ws + WS_H); bf16* YB = (bf16*)(ws + WS_Y);
    const int gw = F.vcu * NWAVES + F.wave, NGW = F.G * NWAVES;
    unsigned long long dly_t0 = 0, dly_t1 = 0;

    if (DLY_PH == 0) dly_t0 = __builtin_amdgcn_s_memrealtime();
    if (IN(0)) _Pragma("unroll") for (int rep_ = 0; rep_ < REPS(0); ++rep_) {
        PHASE_ENTRY();
        LAS float* sil = (LAS float*)(F.lds + 3 * 34816);
        for (int i = F.tid; i < NB * D; i += NWAVES * 64) { const float v = cvec[i]; sil[i] = v / (1.0f + __expf(-v)); }
        __syncthreads();
        constexpr int I_MOD = 6144 / 16, T_IN = (D / 128) * (NIN / 128), T_OUT = (D / 128) * (D / 128), T_POOL = 4, T_GU1 = (D / 128) * (2048 / 128), T_D1 = (FF / 128) * (D / 128);
        constexpr int NTR = T_IN + T_OUT + T_POOL + NE * T_GU1 + NE * T_D1;
        for (int r = gw; r < 8 * I_MOD; r += NGW) {
            const int cgp = r % I_MOD, kc = r / I_MOD, kq = F.lane >> 4, col = cgp * 16 + (F.lane & 15); float a[NB];
#pragma unroll
            for (int b = 0; b < NB; ++b) a[b] = 0.f;
#pragma unroll 16
            for (int i = 0; i < 32; ++i) { const int k = kc * 128 + kq + 4 * i; const float w = ((const GAS float*)w_ada)[(size_t)k * 6144 + col];
#pragma unroll
                for (int b = 0; b < NB; ++b) a[b] += sil[b * D + k] * w; }
#pragma unroll
            for (int b = 0; b < NB; ++b) { a[b] += __shfl_xor(a[b], 16); a[b] += __shfl_xor(a[b], 32); }
            if (kq == 0) {
#pragma unroll
                for (int b = 0; b < NB; ++b) MODP[((size_t)kc * NB + b) * 6144 + col] = a[b]; }
        }
        for (int r0 = F.vcu; r0 < T_IN + T_OUT + T_POOL; r0 += F.G) {
            int r = r0; const float* W; bf16* WT; int K, N, item;
            if (r < T_IN) { W = w_in; WT = WIN; K = D; N = NIN; item = r; }
            else if ((r -= T_IN) < T_OUT) { W = w_out; WT = WOUT; K = D; N = D; item = r; }
            else { r -= T_OUT; W = w_pool + (size_t)r * 128 * 128; WT = WPOOL + (size_t)r * 128 * 128; K = 128; N = 128; item = 0; }
            const int nblk = N / 128, kb = item / nblk, nb = item - kb * nblk;
            TItem t; t.src = W + (size_t)(128 * kb) * N + 128 * nb; t.dst = WT + (size_t)(128 * nb) * K + 128 * kb; t.K = K; t.N = N;
            f32x4 bb[8]; p0_load(t, bb, F.wave, F.lane); p0_store(t, bb, F.lds, F.wave, F.lane);
            asm volatile("s_waitcnt lgkmcnt(0)\n\ts_barrier" ::: "memory");
        }
        __syncthreads();
        if (BOTH(0) || rep_ + 1 < REPS(0)) GRID_BAR();
    }
    if (DLY_PH == 0) dly_t1 = __builtin_amdgcn_s_memrealtime();
    if (DLY_PH == 1) dly_t0 = __builtin_amdgcn_s_memrealtime();
    if (IN(1)) _Pragma("unroll") for (int rep_ = 0; rep_ < REPS(1); ++rep_) {
        PHASE_ENTRY();
        LAS float* modl = (LAS float*)F.lds;
        for (int blk = F.vcu; blk < M / 64; blk += F.G) {
            const int b = blk >> 5; const bool first = (blk & 31) == 0;
            __syncthreads();
            for (int c = F.tid; c < (first ? 6144 : 2048); c += NWAVES * 64) { float a = b_ada[c];
#pragma unroll
                for (int kc = 0; kc < 8; ++kc) a += ((const GAS float*)MODP)[((size_t)kc * NB + b) * 6144 + c];
                if (c < 2048) modl[c] = a; if (first) MOD[(size_t)b * 6144 + c] = a; }
            __syncthreads();
            {
                f32x4 v[8][4];
#pragma unroll
                for (int r8 = 0; r8 < 8; ++r8) { const GAS f32x4* xr = (const GAS f32x4*)(x + (size_t)(blk * 64 + F.wave * 8 + r8) * D) + F.lane;
#pragma unroll
                    for (int j = 0; j < 4; ++j) v[r8][j] = xr[64 * j]; }
#pragma unroll
                for (int r8 = 0; r8 < 8; ++r8) { const int m = blk * 64 + F.wave * 8 + r8; float s = 0.f;
#pragma unroll
                    for (int j = 0; j < 4; ++j) s += (v[r8][j].x + v[r8][j].y) + (v[r8][j].z + v[r8][j].w);
                    const float mean = wave_sum(s) * (1.f / D); float s2 = 0.f;
#pragma unroll
                    for (int j = 0; j < 4; ++j) { v[r8][j] = v[r8][j] - mean; s2 += (v[r8][j].x * v[r8][j].x + v[r8][j].y * v[r8][j].y) + (v[r8][j].z * v[r8][j].z + v[r8][j].w * v[r8][j].w); }
                    const float rstd = 1.f / sqrtf(wave_sum(s2) * (1.f / D) + LN_EPS);
                    GAS v2u* o8 = (GAS v2u*)(XN + (size_t)m * D) + F.lane;
#pragma unroll
                    for (int j = 0; j < 4; ++j) { const f32x4 hv = *(const LAS f32x4*)(modl + 4 * F.lane + 256 * j), sv = *(const LAS f32x4*)(modl + 1024 + 4 * F.lane + 256 * j);
                        const f32x4 h = (v[r8][j] * rstd) * (sv + 1.0f) + hv; v2u w; w.x = pk2(h.x, h.y); w.y = pk2(h.z, h.w); o8[64 * j] = w; } }
            }
        }
        if (BOTH(1) || rep_ + 1 < REPS(1)) GRID_BAR();
    }
    if (DLY_PH == 1) dly_t1 = __builtin_amdgcn_s_memrealtime();
    if (DLY_PH == 2) dly_t0 = __builtin_amdgcn_s_memrealtime();
    if (IN(2)) _Pragma("unroll") for (int rep_ = 0; rep_ < REPS(2); ++rep_) {
        PHASE_ENTRY();
        DenseSched S; S.init(XN, WIN, M, NIN, F.G, (int)blockIdx.x);
        EpiQKVU E{QB, (size_t)(WS_K - WS_Q) / 2};
        pg8::gemm_phase<EpiQKVU, DenseSched, true>(F.lds, S, E);
        if (BOTH(2) || rep_ + 1 < REPS(2)) GRID_BAR();
    }
    if (DLY_PH == 2) dly_t1 = __builtin_amdgcn_s_memrealtime();
    if (DLY_PH == 3) dly_t0 = __builtin_amdgcn_s_memrealtime();
    if (IN(3)) _Pragma("unroll") for (int rep_ = 0; rep_ < REPS(3); ++rep_) {
        PHASE_ENTRY();
        const bool g8 = (F.G % 8 == 0); const bool conv_cu = g8 ? (F.vcu & 7) < 3 : true; const int cG = g8 ? (F.G / 8) * 3 : F.G, cv = g8 ? (F.vcu >> 3) * 3 + (F.vcu & 7) : F.vcu;
        if (conv_cu) {
            __syncthreads();
            constexpr int T_GU1 = (D / 128) * (2048 / 128), T_D1 = (FF / 128) * (D / 128);
        auto pipe = [&](const float* W, bf16* WT, auto K_, auto N_, int ntiles) {
            constexpr int K = decltype(K_)::value, N = decltype(N_)::value, NBLK = N / 128, TPE = (K / 128) * NBLK;
            const int n_my = (ntiles - cv + cG - 1) / cG;
            auto tile_of = [&](int q) -> TItem { const int qq = q < n_my ? q : n_my - 1; const int r = cv + qq * cG; const int e = r / TPE, item = r % TPE, kb = item / NBLK, nb = item % NBLK;
                TItem t; t.src = W + (size_t)e * K * N + (size_t)(128 * kb) * N + 128 * nb; t.dst = (bf16*)((unsigned char*)WT + (size_t)e * K * N + (size_t)(128 * nb) * K + 128 * kb);     t.K = K; t.N = N; return t; };
            if (n_my > 0) {
                TItem t0 = tile_of(0), t1 = tile_of(1), t2; f32x4 b0[8], b1[8], b2[8];
                p0_load(t0, b0, F.wave, F.lane); p0_load(t1, b1, F.wave, F.lane);
                for (int q = 0; q < n_my; q += 3) {
                    t2 = tile_of(q + 2); p0_load(t2, b2, F.wave, F.lane); p0_store8(t0, b0, F.lds, F.wave, F.lane);
                    t0 = tile_of(q + 3); p0_load(t0, b0, F.wave, F.lane); p0_store8(t1, b1, F.lds + 34816, F.wave, F.lane);
                    t1 = tile_of(q + 4); p0_load(t1, b1, F.wave, F.lane); p0_store8(t2, b2, F.lds + 2 * 34816, F.wave, F.lane);
                }
                asm volatile("s_waitcnt lgkmcnt(0)\n\ts_barrier" ::: "memory");
            }
        };
        pipe(w_gu, WGU, std::integral_constant<int, D>{}, std::integral_constant<int, 2048>{}, NE * T_GU1);
        pipe(w_dn, WD, std::integral_constant<int, FF>{}, std::integral_constant<int, D>{}, NE * T_D1);
            __syncthreads();
        }
        LAS float* tb = (LAS float*)(F.lds + L_TB);
        for (int i = F.tid; i < 4 * attn_body::TBN; i += NWAVES * 64) { const int h = i / attn_body::TBN, idx = i % attn_body::TBN; const int d = idx - attn_body::TBOFF;
            tb[i] = (d <= 63) ? (rel_bias[t5_bucket(d) * 4 + h] - rel_bias[15 * 4 + h]) * LOG2E : 0.f; }
        __syncthreads();
#if !NAIVE_ATTN
        {
            volatile LAS int* qslot = (volatile LAS int*)(F.lds + L_MISC + 64);
            for (;;) {
                __syncthreads();
                if (F.tid == 0) *qslot = (int)__hip_atomic_fetch_add(F.ctl + CW_AQ + 64 * rep_, 1u, RLX_AGENT);
                __syncthreads();
                const int ui = __builtin_amdgcn_readfirstlane(*qslot);
                if (ui >= 1024) break;
                const int qb = 7 - (ui >> 7), c7 = ui & 127, b = c7 >> 4, j = (c7 >> 1) & 7, vh = c7 & 1;
                attn_body::attn_unit<8>(b, j, vh, qb, (const attn_body::bf16*)QB, (const attn_body::bf16*)KB, (const attn_body::bf16*)VB, (attn_body::bf16*)OA, (char*)lds, tb + (j >> 1) * attn_body::TBN);
            }
        }
#else
        for (int idx = blockIdx.x * 512 + F.tid; idx < NB * 8 * 2 * SEQ; idx += F.G * 512) {
            const int q = idx & 2047, vh = (idx >> 11) & 1, j = (idx >> 12) & 7, b = idx >> 15, h = j >> 1;
            const bf16* qp = QB + (size_t)(b * SEQ + q) * 512 + j * 64; float qv[64];
#pragma unroll
            for (int d = 0; d < 64; ++d) qv[d] = pg8::bf2f(qp[d]);
            float o[64];
#pragma unroll
            for (int d = 0; d < 64; ++d) o[d] = 0.f;
            float mx = -INFINITY, l = 0.f; const int kend = ((q >> 6) + 1) << 6;
            for (int k = 0; k < kend; ++k) {
                const bf16* kp = KB + (size_t)(b * SEQ + k) * 512 + j * 64; float sdot = 0.f;
#pragma unroll
                for (int d = 0; d < 64; ++d) sdot += qv[d] * pg8::bf2f(kp[d]);
                const int dd = k - q; const int ti = dd + attn_body::TBOFF < 0 ? 0 : dd + attn_body::TBOFF; sdot += tb[h * attn_body::TBN + ti];
                const float mn = fmaxf(mx, sdot), f = exp2f(mx - mn), p = exp2f(sdot - mn); l = l * f + p; mx = mn;
                const bf16* vp = VB + (size_t)(b * SEQ + k) * 512 + h * 128 + vh * 64;
#pragma unroll
                for (int d = 0; d < 64; ++d) o[d] = o[d] * f + p * pg8::bf2f(vp[d]);
            }
            bf16* op = OA + (size_t)(b * SEQ + q) * 1024 + j * 128 + vh * 64; const float il = 1.0f / l;
#pragma unroll
            for (int d = 0; d < 64; ++d) op[d] = (bf16)f2bf(o[d] * il);
        }
#endif
        if (BOTH(3) || rep_ + 1 < REPS(3)) GRID_BAR();
    }
    if (DLY_PH == 3) dly_t1 = __builtin_amdgcn_s_memrealtime();
    if (DLY_PH == 4) dly_t0 = __builtin_amdgcn_s_memrealtime();
    if (IN(4)) _Pragma("unroll") for (int rep_ = 0; rep_ < REPS(4); ++rep_) {
        PHASE_ENTRY();
        float lam;
        { const float a = lq1[F.lane] * lk1[F.lane], b2 = lq2[F.lane] * lk2[F.lane]; lam = __expf(wave_sum(a)) - __expf(wave_sum(b2)) + LAM_INIT; }
        for (int m0 = gw; m0 < M; m0 += 2 * NGW) {
            const int h = F.lane >> 4, e0 = (F.lane & 15) * 8; const bool two = m0 + NGW < M;
            v4u a[2], b2[2];
#pragma unroll
            for (int q = 0; q < 2; ++q) if (q == 0 || two) { const size_t m = (size_t)m0 + (size_t)q * NGW;
                a[q] = *(const GAS v4u*)(OA + m * 1024 + h * 256 + e0); b2[q] = *(const GAS v4u*)(OA + m * 1024 + h * 256 + 128 + e0); }
            const f32x4 g0 = *(const f32x4*)(subln_g + e0), g1v = *(const f32x4*)(subln_g + e0 + 4);
#pragma unroll
            for (int q = 0; q < 2; ++q) if (q == 0 || two) { const size_t m = (size_t)m0 + (size_t)q * NGW;
                float o[8];
                o[0] = bfl(a[q].x) - lam * bfl(b2[q].x); o[1] = bfh(a[q].x) - lam * bfh(b2[q].x); o[2] = bfl(a[q].y) - lam * bfl(b2[q].y); o[3] = bfh(a[q].y) - lam * bfh(b2[q].y);
                o[4] = bfl(a[q].z) - lam * bfl(b2[q].z); o[5] = bfh(a[q].z) - lam * bfh(b2[q].z); o[6] = bfl(a[q].w) - lam * bfl(b2[q].w); o[7] = bfh(a[q].w) - lam * bfh(b2[q].w);
                float ss = 0.f;
#pragma unroll
                for (int i = 0; i < 8; ++i) ss += o[i] * o[i];
                ss += __shfl_xor(ss, 1); ss += __shfl_xor(ss, 2); ss += __shfl_xor(ss, 4); ss += __shfl_xor(ss, 8);
                const float rs = (1.0f - LAM_INIT) / sqrtf(ss * (1.0f / 128.0f) + LN_EPS);
                v4u w; w.x = pk2(o[0] * rs * g0.x, o[1] * rs * g0.y); w.y = pk2(o[2] * rs * g0.z, o[3] * rs * g0.w); w.z = pk2(o[4] * rs * g1v.x, o[5] * rs * g1v.y); w.w = pk2(o[6] * rs * g1v.z, o[7] * rs * g1v.w);
                *(GAS v4u*)(MIX + m * 1024 + h * 128 + e0) = w; }
        }
        for (int it = gw; it < (M / 32) * 4; it += NGW) {
            const int g = it & 3, tile = it >> 2, row0 = tile * 32, r32 = F.lane & 31, hi = F.lane >> 5;
            const int row = row0 + r32, tpos = row & (SEQ - 1), tp0 = row0 & (SEQ - 1);
            LAS unsigned char* ut = F.lds + F.wave * 12800;
#pragma unroll
            for (int i = 0; i < 12; ++i) { const int pc = F.lane + 64 * i, rr = pc >> 4, c16 = pc & 15;
                if (rr < 47) { v4u v = (v4u){0u, 0u, 0u, 0u}; if (tp0 - 15 + rr >= 0) v = *(const GAS v4u*)(UB + (size_t)(row0 - 15 + rr) * 512 + g * 128 + c16 * 8); *(LAS v4u*)(ut + rr * 272 + c16 * 16) = v; } }
            LDS_WAIT(); asm volatile("" ::: "memory");
            bf16x8 pf[8];
            const LAS unsigned char* ub = ut + (r32 + 15) * 272 + hi * 16;
            auto pooled = [&](auto WIN_) {
                constexpr int WIN = decltype(WIN_)::value;
                const int nwin = tpos + 1 < WIN ? tpos + 1 : WIN; const float inv = 1.0f / (float)nwin;
#pragma unroll
                for (int s8 = 0; s8 < 8; ++s8) {
                    float sum[8];
#pragma unroll
                    for (int i = 0; i < 8; ++i) sum[i] = 0.f;
                    v4u self;
#pragma unroll
                    for (int k = 0; k < WIN; ++k) { const v4u u4 = *(const LAS v4u*)(ub - k * 272 + s8 * 32); if (k == 0) self = u4;
                        sum[0] += bfl(u4.x); sum[1] += bfh(u4.x); sum[2] += bfl(u4.y); sum[3] += bfh(u4.y); sum[4] += bfl(u4.z); sum[5] += bfh(u4.z); sum[6] += bfl(u4.w); sum[7] += bfh(u4.w); }
                    v4u w; w.x = pk2(sum[0] * inv - bfl(self.x), sum[1] * inv - bfh(self.x)); w.y = pk2(sum[2] * inv - bfl(self.y), sum[3] * inv - bfh(self.y));
                    w.z = pk2(sum[4] * inv - bfl(self.z), sum[5] * inv - bfh(self.z)); w.w = pk2(sum[6] * inv - bfl(self.w), sum[7] * inv - bfh(self.w));
                    pf[s8] = __builtin_bit_cast(bf16x8, w);
                }
            };
            if (g == 0) pooled(std::integral_constant<int, 2>{}); else if (g == 1) pooled(std::integral_constant<int, 4>{}); else if (g == 2) pooled(std::integral_constant<int, 8>{}); else pooled(std::integral_constant<int, 16>{});
            LDS_WAIT(); asm volatile("" ::: "memory");
#pragma unroll
            for (int db = 0; db < 4; ++db) {
                f32x16 acc = f32x16{};
                const bf16* wp = WPOOL + (size_t)g * 128 * 128 + (size_t)(db * 32 + r32) * 128 + hi * 8;
#pragma unroll
                for (int s8 = 0; s8 < 8; ++s8) { const bf16x8 wf = __builtin_bit_cast(bf16x8, *(const GAS v4u*)(wp + s8 * 16)); acc = __builtin_amdgcn_mfma_f32_32x32x16_bf16(wf, pf[s8], acc, 0, 0, 0); }
#pragma unroll
                for (int rq = 0; rq < 4; ++rq) { const int d0 = db * 32 + 8 * rq + 4 * hi; const int cg = g * 128 + d0;
                    const f32x4 bp = *(const f32x4*)(b_pool + cg), ps = *(const f32x4*)(pool_scale + cg);
                    v2u w; w.x = pk2((acc[4 * rq + 0] + bp.x) * ps.x, (acc[4 * rq + 1] + bp.y) * ps.y); w.y = pk2((acc[4 * rq + 2] + bp.z) * ps.z, (acc[4 * rq + 3] + bp.w) * ps.w);
                    *(GAS v2u*)(MIX + (size_t)row * 1024 + 512 + cg) = w; }
            }
        }
        if (BOTH(4) || rep_ + 1 < REPS(4)) GRID_BAR();
    }
    if (DLY_PH == 4) dly_t1 = __builtin_amdgcn_s_memrealtime();
    if (DLY_PH == 5) dly_t0 = __builtin_amdgcn_s_memrealtime();
    if (IN(5)) _Pragma("unroll") for (int rep_ = 0; rep_ < REPS(5); ++rep_) {
        PHASE_ENTRY();
        DenseSched S; S.init(MIX, WOUT, M, D, F.G, (int)blockIdx.x);
        EpiT1 E{x, MOD, T1};
        pg8::gemm_phase<EpiT1, DenseSched, true>(F.lds, S, E);
        if (BOTH(5) || rep_ + 1 < REPS(5)) GRID_BAR();
    }
    if (DLY_PH == 5) dly_t1 = __builtin_amdgcn_s_memrealtime();
    if (DLY_PH == 6) dly_t0 = __builtin_amdgcn_s_memrealtime();
    if (IN(6)) _Pragma("unroll 1") for (int rep_ = 0; rep_ < REPS(6); ++rep_) {
        PHASE_ENTRY();
        LAS float* H2 = (LAS float*)F.lds;
        LAS float* PART = (LAS float*)F.lds;
        LAS float* LOG = (LAS float*)(F.lds + 131200);
        LAS unsigned* hist = (LAS unsigned*)(F.lds + L_HIST); LAS unsigned* hbase = hist + 32;
        const int i32 = F.lane & 31, kh = F.lane >> 5, kb = F.wave * 128;
        float wreg[64];
#pragma unroll
        for (int kk = 0; kk < 64; ++kk) wreg[kk] = ((const GAS float*)w_router)[(size_t)(kb + 2 * kk + kh) * NE + i32];
        for (int tile = F.vcu; tile < M / 32; tile += F.G) {
            if (F.tid < 32) hist[F.tid] = 0u;
            const int b = (tile * 32) >> 11; const float* sh = MOD + (size_t)b * 6144 + 3072; const float* sc = sh + 1024;
#pragma unroll
            for (int pr = 0; pr < 2; ++pr) {
                f32x4 v[2][4];
#pragma unroll
                for (int r2 = 0; r2 < 2; ++r2) { const GAS f32x4* tr = (const GAS f32x4*)(T1 + (size_t)(tile * 32 + F.wave * 4 + 2 * pr + r2) * D) + F.lane;
#pragma unroll
                    for (int j = 0; j < 4; ++j) v[r2][j] = tr[64 * j]; }
#pragma unroll
                for (int r2 = 0; r2 < 2; ++r2) {
                    const int lr = F.wave * 4 + 2 * pr + r2, m = tile * 32 + lr;
                    float s = 0.f;
#pragma unroll
                    for (int j = 0; j < 4; ++j) s += (v[r2][j].x + v[r2][j].y) + (v[r2][j].z + v[r2][j].w);
                    float mean = wave_sum(s) * (1.f / D); float s2 = 0.f;
#pragma unroll
                    for (int j = 0; j < 4; ++j) { v[r2][j] = v[r2][j] - mean; s2 += (v[r2][j].x * v[r2][j].x + v[r2][j].y * v[r2][j].y) + (v[r2][j].z * v[r2][j].z + v[r2][j].w * v[r2][j].w); }
                    float rstd = 1.f / sqrtf(wave_sum(s2) * (1.f / D) + LN_EPS);
                    s = 0.f;
#pragma unroll
                    for (int j = 0; j < 4; ++j) { const f32x4 gvj = *(const f32x4*)(ln1_g + 4 * F.lane + 256 * j), bvj = *(const f32x4*)(ln1_b + 4 * F.lane + 256 * j);
                        v[r2][j] = (v[r2][j] * rstd) * gvj + bvj; ((GAS f32x4*)(X1 + (size_t)m * D) + F.lane)[64 * j] = v[r2][j]; s += (v[r2][j].x + v[r2][j].y) + (v[r2][j].z + v[r2][j].w); }
                    mean = wave_sum(s) * (1.f / D); s2 = 0.f;
#pragma unroll
                    for (int j = 0; j < 4; ++j) { v[r2][j] = v[r2][j] - mean; s2 += (v[r2][j].x * v[r2][j].x + v[r2][j].y * v[r2][j].y) + (v[r2][j].z * v[r2][j].z + v[r2][j].w * v[r2][j].w); }
                    rstd = 1.f / sqrtf(wave_sum(s2) * (1.f / D) + LN_EPS);
                    GAS unsigned* o8 = (GAS unsigned*)((unsigned char*)XN2 + (size_t)m * D) + F.lane;
#pragma unroll
                    for (int j = 0; j < 4; ++j) { const f32x4 svj = *(const f32x4*)(sc + 4 * F.lane + 256 * j), hvj = *(const f32x4*)(sh + 4 * F.lane + 256 * j);
                        const f32x4 h = (v[r2][j] * rstd) * (svj + 1.0f) + hvj; o8[64 * j] = pk4_fp8(h.x, h.y, h.z, h.w);
                        LAS float* hp = H2 + lr * 1025 + 4 * F.lane + 256 * j; hp[0] = h.x; hp[1] = h.y; hp[2] = h.z; hp[3] = h.w; }
                    asm volatile("" ::: "memory");
                }
            }
            __syncthreads();
            f32x16 acc = f32x16{};
#pragma unroll
            for (int kk = 0; kk < 64; ++kk) acc = __builtin_amdgcn_mfma_f32_32x32x2f32(H2[i32 * 1025 + kb + 2 * kk + kh], wreg[kk], acc, 0, 0, 0);
            __syncthreads();
#pragma unroll
            for (int r = 0; r < 16; ++r) PART[(F.wave * 32 + ((r & 3) + 8 * (r >> 2) + 4 * kh)) * 32 + i32] = acc[r];
            __syncthreads();
#pragma unroll
            for (int q = 0; q < 2; ++q) { const int idx = F.tid + 512 * q, i = idx >> 5, e = idx & 31; float sl = b_router[e];
#pragma unroll
                for (int w = 0; w < 8; ++w) sl += PART[(w * 32 + i) * 32 + e];
                LOG[i * 33 + e] = sl; }
            __syncthreads();
            int myk[2]; unsigned lrk[2]; float mygate[2];
#pragma unroll
            for (int it2 = 0; it2 < 2; ++it2) {
                const int rowl = F.wave * 4 + 2 * it2 + kh; float cur = LOG[rowl * 33 + i32]; float bvv[4]; myk[it2] = -1;
#pragma unroll
                for (int k = 0; k < 4; ++k) { float mv = cur; int me = i32;
#pragma unroll
                    for (int off = 1; off < 32; off <<= 1) { const float ov = __shfl_xor(mv, off); const int oe = __shfl_xor(me, off); if (ov > mv || (ov == mv && oe < me)) { mv = ov; me = oe; } }
                    bvv[k] = mv; if (me == i32) { cur = -INFINITY; myk[it2] = k; } }
                float ex[4], ssum = 0.f;
#pragma unroll
                for (int k = 0; k < 4; ++k) { ex[k] = __expf(bvv[k] - bvv[0]); ssum += ex[k]; }
                const float is = 1.0f / ssum; mygate[it2] = 0.f; lrk[it2] = 0u;
#pragma unroll
                for (int k = 0; k < 4; ++k) if (myk[it2] == k) mygate[it2] = ex[k] * is;
                if (myk[it2] >= 0) lrk[it2] = __hip_atomic_fetch_add(hist + i32, 1u, __ATOMIC_RELAXED, __HIP_MEMORY_SCOPE_WORKGROUP);
            }
            __syncthreads();
            if (F.tid < 32) { const unsigned n = hist[F.tid]; hbase[F.tid] = n ? __hip_atomic_fetch_add(F.ctl + (rep_ + 1 < REPS(6) ? CW_CNT + 4096 : CW_CNT) + 64 * F.tid, n, RLX_AGENT) : 0u; }
            __syncthreads();
#pragma unroll
            for (int it2 = 0; it2 < 2; ++it2) if (myk[it2] >= 0) { const int m = tile * 32 + F.wave * 4 + 2 * it2 + kh; const int pp = (int)(hbase[i32] + lrk[it2]);
                RE[m * 4 + myk[it2]] = i32; RP[m * 4 + myk[it2]] = pp; RG[m * 4 + myk[it2]] = mygate[it2]; if (pp < ECAP) ROWTOK[i32 * ECAP + pp] = m; }
            __syncthreads();
        }
        if (BOTH(6) || rep_ + 1 < REPS(6)) GRID_BAR();
    }
    if (DLY_PH == 6) dly_t1 = __builtin_amdgcn_s_memrealtime();
    if (DLY_PH == 7) dly_t0 = __builtin_amdgcn_s_memrealtime();
    if (IN(7)) _Pragma("unroll") for (int rep_ = 0; rep_ < REPS(7); ++rep_) {
        PHASE_ENTRY();
        build_expert_tables(F);
        MoeSched S; S.A = XN2; S.W = WGU; S.rowtok = ROWTOK; S.pexp = (const LAS int*)(F.lds + L_PEXP); S.pfirst = (const LAS int*)(F.lds + L_PFIRST); S.cntl = (const LAS int*)(F.lds + L_CNT);
        S.NP = ((const LAS int*)(F.lds + L_PFIRST))[NE]; S.NT = 8; S.G = F.G; S.vcu = F.vcu; S.gather = true; S.rowb = 1024; S.wexp = (size_t)2048 * 1024; S.wtile = (size_t)128 * 1024; S.whalf = (size_t)1024 * 1024;
        EpiSwiglu E{b_gu, (unsigned char*)HB};
        pg8::gemm_phase<EpiSwiglu, MoeSched, true, true>(F.lds, S, E);
        if (BOTH(7) || rep_ + 1 < REPS(7)) GRID_BAR();
    }
    if (DLY_PH == 7) dly_t1 = __builtin_amdgcn_s_memrealtime();
    if (DLY_PH == 8) dly_t0 = __builtin_amdgcn_s_memrealtime();
    if (IN(8)) _Pragma("unroll") for (int rep_ = 0; rep_ < REPS(8); ++rep_) {
        PHASE_ENTRY();
        build_expert_tables(F);
        MoeSched S; S.A = HB; S.W = WD; S.rowtok = ROWTOK; S.pexp = (const LAS int*)(F.lds + L_PEXP); S.pfirst = (const LAS int*)(F.lds + L_PFIRST); S.cntl = (const LAS int*)(F.lds + L_CNT);
        S.NP = ((const LAS int*)(F.lds + L_PFIRST))[NE]; S.NT = 4; S.G = F.G; S.vcu = F.vcu; S.gather = false; S.rowb = 1024; S.wexp = (size_t)1024 * 1024; S.wtile = (size_t)256 * 1024; S.whalf = (size_t)128 * 1024;
        EpiDown E{b_dn, YB};
        pg8::gemm_phase<EpiDown, MoeSched, true, true>(F.lds, S, E);
        if (BOTH(8) || rep_ + 1 < REPS(8)) GRID_BAR();
    }
    if (DLY_PH == 8) dly_t1 = __builtin_amdgcn_s_memrealtime();
    if (DLY_PH == 9) dly_t0 = __builtin_amdgcn_s_memrealtime();
    if (IN(9)) _Pragma("unroll") for (int rep_ = 0; rep_ < REPS(9); ++rep_) {
        PHASE_ENTRY();
        build_expert_tables(F);
        const LAS int* pfirst = (const LAS int*)(F.lds + L_PFIRST);
        const unsigned bad = __hip_atomic_load(F.ctl + CW_BAR + XB_TMO, RLX_AGENT);
        for (int m = gw; m < M; m += NGW) {
            const int b = m >> 11; const float* g2 = MOD + (size_t)b * 6144 + 5120;
            f32x4 a[4];
#pragma unroll
            for (int j = 0; j < 4; ++j) a[j] = (f32x4){0.f, 0.f, 0.f, 0.f};
#pragma unroll
            for (int k = 0; k < 4; ++k) { const int e = __builtin_amdgcn_readfirstlane(RE[m * 4 + k]), p = __builtin_amdgcn_readfirstlane(RP[m * 4 + k]); const float gk = RG[m * 4 + k];
                const size_t yrow = (size_t)pfirst[e] * 256 + (size_t)p; const GAS v2u* yp = (const GAS v2u*)(YB + yrow * 1024) + F.lane;
#pragma unroll
                for (int j = 0; j < 4; ++j) { const v2u w = yp[64 * j]; a[j] += (f32x4){bfl(w.x), bfh(w.x), bfl(w.y), bfh(w.y)} * gk; } }
            f32x4 v[4]; float s = 0.f;
#pragma unroll
            for (int j = 0; j < 4; ++j) { const f32x4 xv = ((const GAS f32x4*)(X1 + (size_t)m * D) + F.lane)[64 * j]; const f32x4 gv = *(const f32x4*)(g2 + 4 * F.lane + 256 * j);
                v[j] = xv * DN_ALPHA + gv * a[j]; s += (v[j].x + v[j].y) + (v[j].z + v[j].w); }
            const float mean = wave_sum(s) * (1.f / D); float s2 = 0.f;
#pragma unroll
            for (int j = 0; j < 4; ++j) { v[j] = v[j] - mean; s2 += (v[j].x * v[j].x + v[j].y * v[j].y) + (v[j].z * v[j].z + v[j].w * v[j].w); }
            const float rstd = 1.f / sqrtf(wave_sum(s2) * (1.f / D) + LN_EPS);
#pragma unroll
            for (int j = 0; j < 4; ++j) { const f32x4 gv = *(const f32x4*)(ln2_g + 4 * F.lane + 256 * j), bv = *(const f32x4*)(ln2_b + 4 * F.lane + 256 * j);
                f32x4 o = (v[j] * rstd) * gv + bv; if (bad) { const float qn = __builtin_nanf(""); o = (f32x4){qn, qn, qn, qn}; }
                ((GAS f32x4*)(out + (size_t)m * D) + F.lane)[64 * j] = o; }
        }
    }
    if (DLY_PH >= 0) { if (DLY_PH == 9) dly_t1 = __builtin_amdgcn_s_memrealtime(); const unsigned long long te = __builtin_amdgcn_s_memrealtime(); while (__builtin_amdgcn_s_memrealtime() - te < dly_t1 - dly_t0) __builtin_amdgcn_s_sleep(8); }
#undef IN
#undef BOTH
}

extern "C" void kernel_launch(void* const* d_in, const int* in_sizes, int n_in, void* d_out, int out_size, void* d_ws, size_t ws_size, hipStream_t stream) {
    static int grid = 0;
    if (grid == 0) {
        if (n_in != 25 || in_sizes[0] != M * D || out_size != M * D || ws_size < WS_END) { fprintf(stderr, "kernel_launch: unexpected shapes (n_in %d, in0 %d, out %d, ws %zu); nothing launched\n", n_in, n_in > 0 ? in_sizes[0] : -1, out_size, ws_size); grid = -1; return; }
        int dev = 0, cus = 0, per_cu = 0;
        if (hipGetDevice(&dev) != hipSuccess || hipDeviceGetAttribute(&cus, hipDeviceAttributeMultiprocessorCount, dev) != hipSuccess) { grid = -1; return; }
        if (hipFuncSetAttribute((const void*)mk_fwd, hipFuncAttributeMaxDynamicSharedMemorySize, LDS_BYTES) != hipSuccess) { fprintf(stderr, "kernel_launch: hipFuncSetAttribute failed\n"); grid = -1; return; }
        if (hipOccupancyMaxActiveBlocksPerMultiprocessor(&per_cu, (const void*)mk_fwd, NWAVES * 64, LDS_BYTES) != hipSuccess || per_cu < 1) { fprintf(stderr, "kernel_launch: occupancy query reports %d workgroups per CU\n", per_cu); (void)hipGetLastError(); }
        grid = cus;
    }
    if (grid < 0) return;
    if (hipMemsetAsync((char*)d_ws + WS_CTL, 0, CTL_ZERO_BYTES, stream) != hipSuccess) return;
    Args a{};
    for (int i = 0; i < 25; ++i) a.in[i] = (const float*)d_in[i];
    a.out = (float*)d_out; a.ws = (unsigned char*)d_ws;
#if MK_ONE_LAUNCH
    a.ph_lo = 0; a.ph_hi = NPHASE;
    hipLaunchKernelGGL(mk_fwd, dim3(grid), dim3(NWAVES * 64), LDS_BYTES, stream, a);
#else
    for (int p = 0; p < NPHASE; ++p) { a.ph_lo = p; a.ph_hi = p + 1; hipLaunchKernelGGL(mk_fwd, dim3(grid), dim3(NWAVES * 64), LDS_BYTES, stream, a); }
#endif
}
```

```cpp
#include <hip/hip_runtime.h>
#include <hip/hip_bf16.h>
#include <cstdio>
#include <cstdint>
#include <cmath>
#include <type_traits>

#ifndef MK_ONE_LAUNCH
#define MK_ONE_LAUNCH 1
#endif
#ifndef NAIVE_GEMM
#define NAIVE_GEMM 0
#endif
#ifndef DLY_PH
#define DLY_PH (-1)
#endif
#ifndef NAIVE_ATTN
#define NAIVE_ATTN 0
#endif

#define GAS __attribute__((address_space(1)))
#define LAS __attribute__((address_space(3)))

constexpr int NB = 8, SEQ = 2048, D = 1024, M = NB * SEQ;
constexpr int AW = 512;
constexpr int NIN = 2048;
constexpr int NE = 32, TOPK = 4, FF = 1024;
constexpr int ECAP = 16384;
constexpr int PMAX = (M * TOPK) / 256 + NE;
constexpr float LN_EPS = 1e-5f;
constexpr float DN_ALPHA = 1.189207115002721f;
constexpr float LAM_INIT = 0.2f;
constexpr float LOG2E = 1.4426950408889634f;
constexpr float QSCALE = 0.125f * LOG2E;
constexpr int NWAVES = 8;

namespace pg8 {
#define PG8_LAS __attribute__((address_space(3)))
typedef unsigned short bf16_t;
typedef short bf16x8 __attribute__((ext_vector_type(8)));
typedef float f32x4 __attribute__((ext_vector_type(4)));
typedef unsigned u32x4 __attribute__((ext_vector_type(4)));
constexpr int BM = 256, BK = 64, HALF = 128, HTB = HALF * BK * 2, STAGE_BYTES = 8 * HTB, NXCD = 8, WGM = 8;
constexpr int GK = 1024;

__host__ __device__ __forceinline__ int lds_byte(int r, int c) { const int st = (r >> 4) * 2 + (c >> 5), rr = r & 15, cc = c & 31, ob = rr * 64 + cc * 2; return st * 1024 + (ob ^ (((ob >> 9) & 1) << 5)); }
__host__ __device__ __forceinline__ void stage_rc(int b, int& R, int& C) { const int st = b / 1024, sb = b % 1024, swz = sb ^ (((sb >> 9) & 1) << 5); R = (st >> 1) * 16 + swz / 64; C = (st & 1) * 32 + (swz % 64) / 2; }
__host__ __device__ __forceinline__ int perm32(int rho) { const int n = rho >> 4, i = rho & 15; return 8 * (i >> 2) + 4 * n + (i & 3); }

struct Unit { int pm, pn, e, lrow0, cnt; };
struct Pre { f32x4 v[4]; };
__device__ __forceinline__ void asm_ld16(f32x4& d, const float* p) { asm volatile("global_load_dwordx4 %0, %1, off" : "=v"(d) : "v"((const __attribute__((address_space(1))) float*)p) : "memory"); }

__device__ __forceinline__ unsigned cvt_pk_bf16(float lo, float hi) { unsigned r; asm volatile("v_cvt_pk_bf16_f32 %0, %1, %2" : "=v"(r) : "v"(lo), "v"(hi)); return r; }
__device__ __forceinline__ float bf2f(unsigned short v) { return __uint_as_float((unsigned)v << 16); }

#if !NAIVE_GEMM
typedef int v8i32 __attribute__((ext_vector_type(8)));
typedef int v4i32 __attribute__((ext_vector_type(4)));
template <class Epi, class Sched, bool ALIGN_EPI, bool FP8 = false>
__device__ __forceinline__ void gemm_phase(PG8_LAS unsigned char* lds, const Sched& S, const Epi& E) {
    constexpr int RB = FP8 ? 1024 : 2048, nt = RB / 128;
    const int tid = threadIdx.x, wid = __builtin_amdgcn_readfirstlane(tid >> 6), lane = tid & 63, wr = wid >> 2, wc = wid & 3, fr = lane & 15, fq = lane >> 4;
    int Rr[2], Cc[2]; unsigned voffB[2];
#pragma unroll
    for (int i = 0; i < 2; ++i) { int R, C; stage_rc(tid * 16 + i * 8192, R, C); Rr[i] = R; Cc[i] = C; const int Rb = Epi::PERM ? ((R & ~31) + perm32(R & 31)) : R; voffB[i] = (unsigned)(Rb * RB + C * 2); }
    const size_t kstep = (size_t)(BK * 2);
    const size_t hB = S.b_hstep();
    const unsigned ldsw = (unsigned)wid * 1024u;
    const int aoff = lds_byte(wr * 64 + fr, fq * 8), boff = lds_byte(wc * 32 + fr, fq * 8);
#define PG8_SA(b, h) (((b) * 2 + (h)) * HTB)
#define PG8_SB(b, h) ((4 + (b) * 2 + (h)) * HTB)
#define PG8_STAGE(bufoff, gbase, voff) do { _Pragma("unroll") for (int _i = 0; _i < 2; ++_i) \
        __builtin_amdgcn_global_load_lds((const unsigned*)((const char*)(gbase) + (voff)[_i]), (PG8_LAS unsigned*)(lds + (bufoff) + ldsw + _i * 8192), 16, 0, 0); } while (0)
#define PG8_LD32(p) __builtin_shufflevector(*(const PG8_LAS v4i32*)(p), *(const PG8_LAS v4i32*)((p) + 1024), 0, 1, 2, 3, 4, 5, 6, 7)
#define PG8_LDA(dst, b, h) do { if constexpr (FP8) { _Pragma("unroll") for (int m = 0; m < 4; ++m) dst##8[m] = PG8_LD32(lds + PG8_SA(b, h) + aoff + m * 2048); } \
        else { _Pragma("unroll") for (int m = 0; m < 4; ++m) _Pragma("unroll") for (int k = 0; k < 2; ++k) dst[m][k] = *(const PG8_LAS bf16x8*)(lds + PG8_SA(b, h) + aoff + m * 2048 + k * 1024); } } while (0)
#define PG8_LDB(dst, b, h) do { if constexpr (FP8) { _Pragma("unroll") for (int n = 0; n < 2; ++n) dst##8[n] = PG8_LD32(lds + PG8_SB(b, h) + boff + n * 2048); } \
        else { _Pragma("unroll") for (int n = 0; n < 2; ++n) _Pragma("unroll") for (int k = 0; k < 2; ++k) dst[n][k] = *(const PG8_LAS bf16x8*)(lds + PG8_SB(b, h) + boff + n * 2048 + k * 1024); } } while (0)
#define PG8_CAT(x) __builtin_shufflevector(__builtin_bit_cast(v4i32, (x)[0]), __builtin_bit_cast(v4i32, (x)[1]), 0, 1, 2, 3, 4, 5, 6, 7)
#define PG8_MMA(ai, bj, At, Bt) do { __builtin_amdgcn_s_setprio(1); \
        if constexpr (FP8) { _Pragma("unroll") for (int m = 0; m < 4; ++m) _Pragma("unroll") for (int n = 0; n < 2; ++n) \
            asm volatile("v_mfma_scale_f32_16x16x128_f8f6f4 %0, %1, %2, %0, %3, %3 op_sel_hi:[0,0,0]" : "+v"(acc[ai][bj][m][n]) : "v"(Bt##8[n]), "v"(At##8[m]), "v"(one8)); } \
        else { _Pragma("unroll") for (int m = 0; m < 4; ++m) _Pragma("unroll") for (int n = 0; n < 2; ++n) _Pragma("unroll") for (int k = 0; k < 2; ++k) \
            acc[ai][bj][m][n] = __builtin_amdgcn_mfma_f32_16x16x32_bf16(Bt[n][k], At[m][k], acc[ai][bj][m][n], 0, 0, 0); } \
        __builtin_amdgcn_s_setprio(0); } while (0)
#define PG8_WAIT_V(n) asm volatile("s_waitcnt vmcnt(" #n ")" ::: "memory")
#define PG8_WAIT_L(n) asm volatile("s_waitcnt lgkmcnt(" #n ")" ::: "memory")
#define PG8_BAR __builtin_amdgcn_s_barrier()
#define PG8_SCHED __builtin_amdgcn_sched_barrier(0)
    Unit cur, nxt; int ui = 0; Pre pre;
    if (!S.next(0, cur)) return;
    f32x4 acc[2][2][4][2];
#pragma unroll
    for (int a = 0; a < 2; ++a)
#pragma unroll
        for (int b = 0; b < 2; ++b)
#pragma unroll
            for (int m = 0; m < 4; ++m)
#pragma unroll
                for (int n = 0; n < 2; ++n) acc[a][b][m][n] = (f32x4){0.f, 0.f, 0.f, 0.f};
    const int one8 = 0x7f7f7f7f;
    bf16x8 At[4][2], B0[2][2], B1[2][2]; v8i32 At8[4], B08[2], B18[2];
    const char* cA = S.a_base(cur); const char* cB = S.b_base(cur);
    unsigned va0[2], va1[2];
    S.a_voff(cur, Rr, Cc, va0, va1);
    PG8_STAGE(PG8_SB(0, 0), cB, voffB); PG8_STAGE(PG8_SB(0, 1), cB + hB, voffB); PG8_STAGE(PG8_SA(0, 0), cA, va0); PG8_STAGE(PG8_SA(0, 1), cA, va1);
    if (wr == 1) PG8_BAR;
    PG8_WAIT_V(2); PG8_BAR;
    PG8_STAGE(PG8_SB(1, 0), cB + kstep, voffB); PG8_STAGE(PG8_SA(1, 0), cA + kstep, va0); PG8_STAGE(PG8_SB(1, 1), cB + hB + kstep, voffB);
    PG8_WAIT_V(6); PG8_BAR;
    for (;;) {
        const bool has_next = S.next(ui + 1, nxt);
        const char* nA = has_next ? S.a_base(nxt) : cA; const char* nB = has_next ? S.b_base(nxt) : cB;
        unsigned vn0[2] = {va0[0], va0[1]}, vn1[2] = {va1[0], va1[1]}, tkn[4];
        { Unit tu = cur; if (has_next) tu = nxt; S.a_tok(tu, Rr, tkn); }
#define PG8_TRIP(LAST, t) do { \
            const char* a1 = cA + (size_t)((t) + 1) * kstep; \
            const char* a2 = (LAST) ? nA : cA + (size_t)((t) + 2) * kstep; const char* b2 = (LAST) ? nB : cB + (size_t)((t) + 2) * kstep; \
            const char* a3 = a2 + kstep; const char* b3 = b2 + kstep; \
            asm volatile("" : "+v"(voffB[0]), "+v"(voffB[1]), "+v"(va0[0]), "+v"(va0[1]), "+v"(va1[0]), "+v"(va1[1])); \
            unsigned v20[2] = {va0[0], va0[1]}, v21[2] = {va1[0], va1[1]}; \
            if (LAST) { E.pre(cur, wr, wc, fr, fq, pre); if (has_next) { S.a_voff_tok(tkn, Rr, Cc, vn0, vn1); v20[0] = vn0[0]; v20[1] = vn0[1]; v21[0] = vn1[0]; v21[1] = vn1[1]; } } \
            PG8_LDB(B0, 0, 0); PG8_LDB(B1, 0, 1); PG8_SCHED; PG8_LDA(At, 0, 0); PG8_STAGE(PG8_SA(1, 1), a1, va1); \
            PG8_WAIT_V(8); PG8_WAIT_L(0); PG8_BAR; PG8_MMA(0, 0, At, B0); PG8_MMA(0, 1, At, B1); PG8_BAR; PG8_SCHED; \
            PG8_LDA(At, 0, 1); PG8_STAGE(PG8_SB(0, 0), b2, voffB); PG8_STAGE(PG8_SB(0, 1), b2 + hB, voffB); PG8_STAGE(PG8_SA(0, 0), a2, v20); \
            PG8_WAIT_V(8); PG8_WAIT_L(0); PG8_BAR; PG8_MMA(1, 0, At, B0); PG8_MMA(1, 1, At, B1); PG8_BAR; PG8_SCHED; \
            PG8_LDB(B0, 1, 0); PG8_LDB(B1, 1, 1); PG8_SCHED; PG8_LDA(At, 1, 0); PG8_STAGE(PG8_SA(0, 1), a2, v21); \
            PG8_WAIT_V(8); PG8_WAIT_L(0); PG8_BAR; PG8_MMA(0, 0, At, B0); PG8_MMA(0, 1, At, B1); PG8_BAR; PG8_SCHED; \
            PG8_LDA(At, 1, 1); PG8_STAGE(PG8_SB(1, 0), b3, voffB); PG8_STAGE(PG8_SB(1, 1), b3 + hB, voffB); PG8_STAGE(PG8_SA(1, 0), a3, v20); \
            PG8_WAIT_V(8); PG8_WAIT_L(0); PG8_BAR; PG8_MMA(1, 0, At, B0); PG8_MMA(1, 1, At, B1); PG8_BAR; PG8_SCHED; \
        } while (0)
#pragma unroll 1
        for (int t = 0; t < nt - 2; t += 2) PG8_TRIP(0, t);
        PG8_TRIP(1, nt - 2);
#undef PG8_TRIP
        if constexpr (ALIGN_EPI) { if (wr == 0) PG8_BAR; }
        if constexpr (FP8) asm volatile("s_nop 15\n\ts_nop 15" ::: "memory");
        { int fr_ = fr, fq_ = fq; asm volatile("" : "+v"(fr_), "+v"(fq_));
          E(acc, cur, wr, wc, fr_, fq_, pre); }
        if (!has_next) break;
#pragma unroll
        for (int a = 0; a < 2; ++a)
#pragma unroll
            for (int b = 0; b < 2; ++b)
#pragma unroll
                for (int m = 0; m < 4; ++m)
#pragma unroll
                    for (int n = 0; n < 2; ++n) acc[a][b][m][n] = (f32x4){0.f, 0.f, 0.f, 0.f};
        cur = nxt; cA = nA; cB = nB; va0[0] = vn0[0]; va0[1] = vn0[1]; va1[0] = vn1[0]; va1[1] = vn1[1]; ++ui;
        if constexpr (ALIGN_EPI) { if (wr == 1) PG8_BAR; }
    }
    PG8_WAIT_V(0);
    if constexpr (!ALIGN_EPI) { if (wr == 0) PG8_BAR; }
    PG8_BAR;
#undef PG8_SA
#undef PG8_SB
#undef PG8_STAGE
#undef PG8_LDA
#undef PG8_LD32
#undef PG8_LDB
#undef PG8_MMA
#undef PG8_CAT
#undef PG8_WAIT_V
#undef PG8_WAIT_L
#undef PG8_BAR
#undef PG8_SCHED
}
#else
template <class Epi, class Sched, bool ALIGN_EPI, bool FP8 = false>
__device__ __forceinline__ void gemm_phase(PG8_LAS unsigned char*, const Sched& S, const Epi& E) {
    constexpr int K = GK;
    const int tid = threadIdx.x, wid = __builtin_amdgcn_readfirstlane(tid >> 6), lane = tid & 63, wr = wid >> 2, wc = wid & 3, fr = lane & 15, fq = lane >> 4;
    Unit u;
    for (int ui = 0; S.next(ui, u); ++ui) {
        f32x4 acc[2][2][4][2];
#pragma unroll
        for (int ai = 0; ai < 2; ++ai)
#pragma unroll
            for (int bj = 0; bj < 2; ++bj) {
                const bf16_t* ar[4]; const bf16_t* br[2][4];
#pragma unroll
                for (int m = 0; m < 4; ++m) ar[m] = S.a_row(u, ai * 128 + wr * 64 + m * 16 + fr);
#pragma unroll
                for (int n = 0; n < 2; ++n)
#pragma unroll
                    for (int x = 0; x < 4; ++x) br[n][x] = S.b_row(u, bj * 128 + wc * 32 + (Epi::PERM ? 8 * fq + 4 * n + x : 16 * n + 4 * fq + x));
                float s[4][2][4];
#pragma unroll
                for (int m = 0; m < 4; ++m)
#pragma unroll
                    for (int n = 0; n < 2; ++n)
#pragma unroll
                        for (int x = 0; x < 4; ++x) s[m][n][x] = 0.f;
                for (int k0 = 0; k0 < K; k0 += 8) {
                    bf16x8 av[4], bv[2][4];
#pragma unroll
                    for (int m = 0; m < 4; ++m) av[m] = *(const bf16x8*)(ar[m] + k0);
#pragma unroll
                    for (int n = 0; n < 2; ++n)
#pragma unroll
                        for (int x = 0; x < 4; ++x) bv[n][x] = *(const bf16x8*)(br[n][x] + k0);
#pragma unroll
                    for (int kk = 0; kk < 8; ++kk)
#pragma unroll
                        for (int m = 0; m < 4; ++m) { const float a = bf2f((unsigned short)av[m][kk]);
#pragma unroll
                            for (int n = 0; n < 2; ++n)
#pragma unroll
                                for (int x = 0; x < 4; ++x) s[m][n][x] += a * bf2f((unsigned short)bv[n][x][kk]); }
                }
#pragma unroll
                for (int m = 0; m < 4; ++m)
#pragma unroll
                    for (int n = 0; n < 2; ++n) acc[ai][bj][m][n] = (f32x4){s[m][n][0], s[m][n][1], s[m][n][2], s[m][n][3]};
            }
        Pre pre; E.pre(u, wr, wc, fr, fq, pre); asm volatile("s_waitcnt vmcnt(0)" ::: "memory"); E(acc, u, wr, wc, fr, fq, pre);
    }
}
#endif
}

constexpr size_t MiB = 1u << 20;
constexpr size_t WS_CTL = 0, CTL_ZERO_BYTES = 1 * MiB;
constexpr size_t WS_MOD = 1 * MiB;
constexpr size_t WS_WPOOL = 1 * MiB + 512 * 1024;
constexpr size_t WS_WIN = 2 * MiB;
constexpr size_t WS_WOUT = 6 * MiB;
constexpr size_t WS_WGU = 8 * MiB;
constexpr size_t WS_WD = 136 * MiB;
constexpr size_t WS_XN = 200 * MiB;
constexpr size_t WS_Q = 232 * MiB, WS_K = 248 * MiB, WS_V = 264 * MiB, WS_U = 280 * MiB;
constexpr size_t WS_OA = 296 * MiB;
constexpr size_t WS_MIX = 328 * MiB;
constexpr size_t WS_T1 = 360 * MiB;
constexpr size_t WS_X1 = 424 * MiB;
constexpr size_t WS_XN2 = 488 * MiB;
constexpr size_t WS_RE = 520 * MiB, WS_RP = 521 * MiB, WS_RG = 522 * MiB;
constexpr size_t WS_ROWTOK = 524 * MiB;
constexpr size_t WS_H = 528 * MiB;
constexpr size_t WS_Y = 672 * MiB;
constexpr size_t WS_MODP = 816 * MiB;
constexpr size_t WS_END = 818 * MiB;
static_assert((size_t)PMAX * 256 * 1024 * 2 == 144 * MiB, "H / Y size");
constexpr int CW_TMO = 0, CW_CODE = 1;
constexpr int CW_BAR = 4096;
constexpr int CW_AQ = 6144;
constexpr int CW_CNT = 8192;

constexpr int RING_BYTES = 131072;
constexpr int LDS_BYTES = 147456;
constexpr int LCTL_OFF = 139264;
constexpr int L_MISC = LCTL_OFF;
constexpr int L_CNT = LCTL_OFF + 128;
constexpr int L_PFIRST = LCTL_OFF + 256;
constexpr int L_PEXP = LCTL_OFF + 512;
constexpr int L_HIST = LCTL_OFF + 512 + 4 * 320;
constexpr int L_TB = 106496;
static_assert(L_TB + 4 * 704 * 4 <= RING_BYTES && L_HIST + 256 <= LDS_BYTES && PMAX <= 320, "LDS map");

typedef unsigned short bf16;
typedef unsigned v4u __attribute__((ext_vector_type(4)));
typedef unsigned v2u __attribute__((ext_vector_type(2)));
typedef float f32x4 __attribute__((ext_vector_type(4)));
typedef float f32x16 __attribute__((ext_vector_type(16)));
typedef short bf16x8 __attribute__((ext_vector_type(8)));
typedef GAS unsigned gu32;
#define RLX_AGENT __ATOMIC_RELAXED, __HIP_MEMORY_SCOPE_AGENT
#define LDS_WAIT() asm volatile("s_waitcnt lgkmcnt(0)" ::: "memory")
#define VM_WAIT() asm volatile("s_waitcnt vmcnt(0)" ::: "memory")
__device__ __forceinline__ unsigned f2bf(float f) { unsigned u = __builtin_bit_cast(unsigned, f); return (u + 0x7fffu + ((u >> 16) & 1u)) >> 16; }
__device__ __forceinline__ unsigned pk2(float lo, float hi) { return f2bf(lo) | (f2bf(hi) << 16); }
__device__ __forceinline__ float bfl(unsigned w) { return __uint_as_float(w << 16); }
__device__ __forceinline__ float bfh(unsigned w) { return __uint_as_float(w & 0xffff0000u); }

namespace attn_body {
using bf16=__hip_bfloat16;
using bf16x8=__attribute__((ext_vector_type(8)))short;
using s16x4=__attribute__((ext_vector_type(4)))short;
using f32x16=__attribute__((ext_vector_type(16)))float;
using u32x4=__attribute__((ext_vector_type(4)))unsigned;
constexpr int SEQ=2048,DH=64,PQ=512,PO=1024;
constexpr int NW=8,QBLK=32,QB=QBLK*NW,KVBLK=64,NQB=SEQ/QB;
__device__ __forceinline__ int crow(int r,int hi){return (r&3)+8*(r>>2)+4*hi;}
#define SBAR() __builtin_amdgcn_sched_barrier(0)
constexpr int TBN=704, TBOFF=447;
__device__ __forceinline__ void bandinit(f32x16&p0,f32x16&p1,int t,int q0,int wid,int r32,int hi,const __attribute__((address_space(3))) float*tb){
  const __attribute__((address_space(3))) float*tp=tb+(64*t+4*hi-(q0+32*wid+r32)+TBOFF);
  #pragma unroll
  for(int r=0;r<16;++r){p0[r]=tp[(r&3)+8*(r>>2)]; p1[r]=tp[(r&3)+8*(r>>2)+32];}
}
__device__ __forceinline__ void bandpost(f32x16&p0,f32x16&p1,const f32x16&negm,int t,int q0,int wid){
  const float nm=(t>(q0>>6)+(wid>>1))?-INFINITY:negm[0];
  #pragma unroll
  for(int r=0;r<16;++r){p0[r]+=nm;p1[r]+=nm;}
}
constexpr int NSLOT=3, SLOTB=8192;
constexpr int LDS_K=0, LDS_V=NSLOT*SLOTB, LDS_WS=2*NSLOT*SLOTB, LDS_OST=LDS_WS+NW*64*4, LDS_BYTES=LDS_OST+NW*4096;
__device__ __forceinline__ void glds16(const void*gsrc,unsigned lds_dst){unsigned keep;
  asm volatile("s_mov_b32 %0, m0\n\ts_mov_b32 m0, %2\n\ts_nop 0\n\tglobal_load_lds_dwordx4 %1, off\n\ts_mov_b32 m0, %0":"=&s"(keep):"v"(gsrc),"s"(lds_dst):"memory");}
__device__ __forceinline__ float max3f(float a,float b,float c){float r;asm("v_max3_f32 %0, %1, %2, %3":"=v"(r):"v"(a),"v"(b),"v"(c));return r;}
__device__ __forceinline__ float max2f(float a,float b){float r;asm("v_max_f32_e32 %0, %1, %2":"=v"(r):"v"(a),"v"(b));return r;}
__device__ __forceinline__ float fadd_s(float a,float b){float r;asm("v_add_f32_e32 %0, %1, %2":"=v"(r):"v"(a),"v"(b));return r;}
__device__ __forceinline__ float fsub_s(float a,float b){float r;asm("v_sub_f32_e32 %0, %1, %2":"=v"(r):"v"(a),"v"(b));return r;}
typedef float f32x2_t __attribute__((ext_vector_type(2))); typedef __bf16 bf16x2_t __attribute__((ext_vector_type(2)));
__device__ __forceinline__ unsigned cvtpk_s(float lo,float hi){f32x2_t v={lo,hi};bf16x2_t b=__builtin_convertvector(v,bf16x2_t);return __builtin_bit_cast(unsigned,b);}
#define WAIT_BAR(N) asm volatile("s_waitcnt vmcnt(" #N ") lgkmcnt(0)\n\ts_barrier":::"memory")

__device__ __forceinline__ void qkt(f32x16&p0,f32x16&p1,const char*Kslot,const bf16x8*qr,int r32,int hi){
  const char*kb=Kslot+hi*1024+r32*16;
  #pragma unroll
  for(int d0=0;d0<4;++d0){
    const bf16x8 b0=*reinterpret_cast<const bf16x8*>(kb+d0*2048);
    const bf16x8 b1=*reinterpret_cast<const bf16x8*>(kb+d0*2048+512);
    p0=__builtin_amdgcn_mfma_f32_32x32x16_bf16(b0,qr[d0],p0,0,0,0);p1=__builtin_amdgcn_mfma_f32_32x32x16_bf16(b1,qr[d0],p1,0,0,0);}
}
typedef __attribute__((address_space(3))) const char* lds_cptr;
typedef short v4i16_t __attribute__((ext_vector_type(4)));
__device__ __forceinline__ void kload8(bf16x8*kf,lds_cptr kp){
  kf[0]=*(const __attribute__((address_space(3))) bf16x8*)(kp);      kf[1]=*(const __attribute__((address_space(3))) bf16x8*)(kp+512);
  kf[2]=*(const __attribute__((address_space(3))) bf16x8*)(kp+2048); kf[3]=*(const __attribute__((address_space(3))) bf16x8*)(kp+2560);
  kf[4]=*(const __attribute__((address_space(3))) bf16x8*)(kp+4096); kf[5]=*(const __attribute__((address_space(3))) bf16x8*)(kp+4608);
  kf[6]=*(const __attribute__((address_space(3))) bf16x8*)(kp+6144); kf[7]=*(const __attribute__((address_space(3))) bf16x8*)(kp+6656);
}
__device__ __forceinline__ void kload2(bf16x8*kf,lds_cptr kp,int j){ kf[2*j]=*(const __attribute__((address_space(3))) bf16x8*)(kp+j*2048); kf[2*j+1]=*(const __attribute__((address_space(3))) bf16x8*)(kp+j*2048+512); }
__device__ __forceinline__ s16x4 vtr(lds_cptr p){ return __builtin_bit_cast(s16x4,__builtin_amdgcn_ds_read_tr16_b64_v4i16((__attribute__((address_space(3))) v4i16_t*)p)); }
__device__ __forceinline__ float rowmax(const f32x16&p0,const f32x16&p1){
  float a=max3f(p0[0],p0[1],p1[0]),b=max3f(p0[2],p0[3],p1[1]);a=max3f(a,p1[2],p1[3]);
  #pragma unroll
  for(int r=4;r<16;r+=4){a=max3f(a,p0[r],p0[r+1]);b=max3f(b,p0[r+2],p0[r+3]);a=max3f(a,p1[r],p1[r+1]);b=max3f(b,p1[r+2],p1[r+3]);}
  const float m=max2f(a,b);
  auto rr=__builtin_amdgcn_permlane32_swap(__float_as_uint(m),__float_as_uint(m),false,false);
  return max2f(__uint_as_float(rr[0]),__uint_as_float(rr[1]));
}
__device__ __forceinline__ void pv(f32x16*o,int vb,bf16x8 pa0,bf16x8 pa1,bf16x8 pa2,bf16x8 pa3){
  #pragma unroll
  for(int d0=0;d0<2;++d0){s16x4 lo[4],hi[4];
    #pragma unroll
    for(int ks=0;ks<4;++ks){
      asm volatile("ds_read_b64_tr_b16 %0,%1 offset:%c2":"=&v"(lo[ks]):"v"(vb),"i"(d0*4096+ks*1024):"memory");
      asm volatile("ds_read_b64_tr_b16 %0,%1 offset:%c2":"=&v"(hi[ks]):"v"(vb),"i"(d0*4096+ks*1024+512):"memory");}
    asm volatile("s_waitcnt lgkmcnt(0)":::"memory");SBAR();
    #define PK(k) (bf16x8){lo[k][0],lo[k][1],lo[k][2],lo[k][3],hi[k][0],hi[k][1],hi[k][2],hi[k][3]}
    o[d0]=__builtin_amdgcn_mfma_f32_32x32x16_bf16(pa0,PK(0),o[d0],0,0,0);
    o[d0]=__builtin_amdgcn_mfma_f32_32x32x16_bf16(pa1,PK(1),o[d0],0,0,0);
    o[d0]=__builtin_amdgcn_mfma_f32_32x32x16_bf16(pa2,PK(2),o[d0],0,0,0);
    o[d0]=__builtin_amdgcn_mfma_f32_32x32x16_bf16(pa3,PK(3),o[d0],0,0,0);
    #undef PK
  }
}
#define ATTN_STORE16(p,v) (*(u32x4*)(p)=(v))
template<int THRL> __device__ __forceinline__ void attn_unit(int b,int j,int vh,int qb,const bf16*Q,const bf16*__restrict__ K,const bf16*__restrict__ V,bf16*O,char*shm,const __attribute__((address_space(3))) float*tbh){
  int tid_=threadIdx.x; asm volatile("":"+v"(tid_));
  const int tid=tid_,lane=tid&63,r32=lane&31,hi=lane>>5; const int wid=__builtin_amdgcn_readfirstlane(tid>>6);
  const long rowbase=(long)b*SEQ; const int q0=qb*QB;
  const bf16*Qw=Q+(rowbase+q0+wid*QBLK)*PQ+j*DH;
  const bf16*Kh=K+rowbase*PQ+j*DH,*Vh=V+rowbase*PQ+(j>>1)*128+vh*64;
  const unsigned lds0=(unsigned)(uintptr_t)shm;
  float*wsf=(float*)(shm+LDS_WS)+wid*64;
  const bf16*ksrc=Kh+(long)lane*PQ+wid*8;
  const bf16*vsrc=Vh+(long)(16*(wid&3)+(lane>>2))*PQ+(wid>>2)*32+(lane&3)*8;
  const unsigned kdst=lds0+LDS_K+wid*1024, vdst=lds0+LDS_V+wid*1024;
  #define DMA_K(t,slot) glds16(ksrc+(long)(t)*KVBLK*PQ,(unsigned)__builtin_amdgcn_readfirstlane(kdst+(slot)))
  #define DMA_V(t,slot) glds16(vsrc+(long)(t)*KVBLK*PQ,(unsigned)__builtin_amdgcn_readfirstlane(vdst+(slot)))
  const int vb0=(int)(lds0+LDS_V)+((lane>>4)&1)*32+(lane&3)*8+(4*hi+((lane&15)>>2))*64;
  const char*Kbase=shm+LDS_K; bf16x8 kf[8];
  const lds_cptr shm3=(lds_cptr)shm; const lds_cptr kp0=shm3+LDS_K+hi*1024+r32*16; const lds_cptr vp0=shm3+LDS_V+((lane>>4)&1)*32+(lane&3)*8+(4*hi+((lane&15)>>2))*64;
  const int NT=(q0+QB)/KVBLK;
  DMA_K(0,0);DMA_V(0,0);DMA_K(1,SLOTB);
  bf16x8 qr[4];
  #pragma unroll
  for(int d0=0;d0<4;++d0)qr[d0]=*reinterpret_cast<const bf16x8*>(&Qw[(long)r32*PQ+d0*16+hi*8]);
  float mhat=0.f,l_reg=0.f;f32x16 o[2];o[0]=f32x16{};o[1]=f32x16{};f32x16 negm=f32x16{};asm volatile("":"+v"(negm));
  #define BINIT(C0,C1,t) bandinit(C0,C1,(t),q0,wid,r32,hi,tbh)
  bool resc=false;
  #define START(P0,P1) do{ const float rm=rowmax(P0,P1); resc=false; \
    { const float dl=rm; mhat=fadd_s(mhat,dl); \
      _Pragma("unroll") for(int r=0;r<16;++r){P0[r]=fsub_s(P0[r],dl);P1[r]=fsub_s(P1[r],dl);} \
      _Pragma("unroll") for(int r=0;r<16;++r)negm[r]=-mhat; asm volatile("":"+v"(negm)); } \
    _Pragma("unroll") for(int r=0;r<16;++r)P0[r]=__builtin_amdgcn_exp2f(P0[r]); }while(0)
  #define RESC() do{ if(resc){ asm volatile("s_waitcnt lgkmcnt(0)":::"memory"); \
      _Pragma("unroll") for(int d_=0;d_<2;++d_) _Pragma("unroll") for(int r=0;r<16;++r)o[d_][r]*=wsf[crow(r,hi)]; } }while(0)
  f32x16 pA0,pA1,pB0,pB1;
  int sl_prev=0,sl_cur=0,sl_next=SLOTB;
  #define ROT() do{sl_prev=sl_cur;sl_cur=sl_next;sl_next=(sl_next==(NSLOT-1)*SLOTB)?0:sl_next+SLOTB;}while(0)
  DMA_K(2,2*SLOTB);
  WAIT_BAR(3);
  if(NT<=7){BINIT(pA0,pA1,0);}else{pA0=f32x16{};pA1=f32x16{};}
  qkt(pA0,pA1,Kbase,qr,r32,hi);asm volatile("s_nop 15\n\ts_nop 7":"+v"(pA0),"+v"(pA1));
  START(pA0,pA1);
  _Pragma("unroll") for(int r=0;r<16;++r)pA1[r]=__builtin_amdgcn_exp2f(pA1[r]);
  WAIT_BAR(0);
  DMA_K(3,0);DMA_V(1,SLOTB);
  ROT();
  kload8(kf,kp0+sl_cur);
  WAIT_BAR(2);
  s16x4 vlo[8],vhi[8]; u32x4 pw0,pw1,pw2,pw3;
  #define PKW(P,B) cvtpk_s(P[B],P[B+1])
  #define PAF(k) __builtin_bit_cast(bf16x8,pw##k)
  #define VFR(i) (bf16x8){vlo[i][0],vlo[i][1],vlo[i][2],vlo[i][3],vhi[i][0],vhi[i][1],vhi[i][2],vhi[i][3]}
  #define PIN(x) asm volatile("":"+v"(x))
  #define MX3(a,b,c) __builtin_fmaxf(__builtin_fmaxf((a),(b)),(c))
  #define GAPA(MF,A0,A1,A2,A3,W0,W1,PW) do{ MF; sacc+=A0; sacc+=A1; sacc+=A2; sacc+=A3; PIN(sacc); W0; W1; PIN(PW); SBAR(); }while(0)
  #define EX(v) __builtin_amdgcn_exp2f(v)
  #define GAPB(MF,X,B) do{ MF; X[B]=EX(X[B]); X[B+1]=EX(X[B+1]); X[B+2]=EX(X[B+2]); X[B+3]=EX(X[B+3]); PIN(X); SBAR(); }while(0)
  #define VRD(i) do{ vlo[i]=vtr(vp_+(((i)>>2)*4096+((i)&3)*1024)); vhi[i]=vtr(vp_+(((i)>>2)*4096+((i)&3)*1024+512)); }while(0)
  #define KRD(G,j) do{ if(G){ kload2(kf,kp0+sl_next,j); SBAR(); } }while(0)
  #define STEP(C0,C1,P0,P1,t,GK,GV,GL,PRE,I0,I1,POST) do{ SBAR(); PRE; SBAR(); \
    const lds_cptr vp_=vp0+sl_prev; \
    VRD(0); SBAR(); float sacc=(P0[0]+P0[1]); \
    GAPA(C0=__builtin_amdgcn_mfma_f32_32x32x16_bf16(kf[0],qr[0],I0,0,0,0), P0[2],P0[3],P0[4],P0[5],     pw0[0]=PKW(P0,0), pw0[1]=PKW(P0,2), pw0); \
    VRD(4); SBAR(); GAPA(C1=__builtin_amdgcn_mfma_f32_32x32x16_bf16(kf[1],qr[0],I1,0,0,0), P0[6],P0[7],P0[8],P0[9],     pw0[2]=PKW(P0,4), pw0[3]=PKW(P0,6), pw0); \
    VRD(1); SBAR(); GAPA(C0=__builtin_amdgcn_mfma_f32_32x32x16_bf16(kf[2],qr[1],C0,0,0,0),   P0[10],P0[11],P0[12],P0[13], pw1[0]=PKW(P0,8), pw1[1]=PKW(P0,10), pw1); \
    VRD(5); SBAR(); GAPA(C1=__builtin_amdgcn_mfma_f32_32x32x16_bf16(kf[3],qr[1],C1,0,0,0),   P0[14],P0[15],P1[0],P1[1],   pw1[2]=PKW(P0,12),pw1[3]=PKW(P0,14), pw1); \
    VRD(2); SBAR(); GAPA(C0=__builtin_amdgcn_mfma_f32_32x32x16_bf16(kf[4],qr[2],C0,0,0,0),   P1[2],P1[3],P1[4],P1[5],     pw2[0]=PKW(P1,0), pw2[1]=PKW(P1,2), pw2); \
    VRD(6); SBAR(); GAPA(C1=__builtin_amdgcn_mfma_f32_32x32x16_bf16(kf[5],qr[2],C1,0,0,0),   P1[6],P1[7],P1[8],P1[9],     pw2[2]=PKW(P1,4), pw2[3]=PKW(P1,6), pw2); \
    VRD(3); SBAR(); GAPA(C0=__builtin_amdgcn_mfma_f32_32x32x16_bf16(kf[6],qr[3],C0,0,0,0),   P1[10],P1[11],P1[12],P1[13], pw3[0]=PKW(P1,8), pw3[1]=PKW(P1,10), pw3); \
    VRD(7); SBAR(); GAPA(C1=__builtin_amdgcn_mfma_f32_32x32x16_bf16(kf[7],qr[3],C1,0,0,0),   P1[14],P1[15],0.f,0.f,       pw3[2]=PKW(P1,12),pw3[3]=PKW(P1,14), pw3); \
    l_reg+=sacc; \
    if(GK){DMA_K((t)+3,sl_cur);} if(GV){DMA_V((t)+1,sl_next);} \
    POST; \
    { float a=MX3(C0[0],C0[1],C1[0]),b=MX3(C0[2],C0[3],C1[1]); a=MX3(a,C1[2],C1[3]); \
      _Pragma("unroll") for(int r=4;r<16;r+=4){a=MX3(a,C0[r],C0[r+1]);b=MX3(b,C0[r+2],C0[r+3]);a=MX3(a,C1[r],C1[r+1]);b=MX3(b,C1[r+2],C1[r+3]);} \
      float rm=__builtin_fmaxf(a,b); { auto rr=__builtin_amdgcn_permlane32_swap(__float_as_uint(rm),__float_as_uint(rm),false,false); rm=__builtin_fmaxf(__uint_as_float(rr[0]),__uint_as_float(rr[1])); } \
      resc=false; \
      if(__builtin_expect(__any(rm>(float)THRL),0)){ const float dl=__builtin_fmaxf(rm,0.f); mhat+=dl; \
        _Pragma("unroll") for(int r=0;r<16;++r){C0[r]-=dl;C1[r]-=dl;} \
        _Pragma("unroll") for(int r=0;r<16;++r)negm[r]=-mhat; asm volatile("":"+v"(negm)); \
        const float f=__builtin_amdgcn_exp2f(-dl); l_reg*=f; if(hi==0)wsf[r32]=f; resc=true; } } \
    SBAR(); \
    GAPB(o[0]=__builtin_amdgcn_mfma_f32_32x32x16_bf16(PAF(0),VFR(0),o[0],0,0,0), C0,0); \
    GAPB(o[1]=__builtin_amdgcn_mfma_f32_32x32x16_bf16(PAF(0),VFR(4),o[1],0,0,0), C0,4); \
    KRD(GL,0); GAPB(o[0]=__builtin_amdgcn_mfma_f32_32x32x16_bf16(PAF(1),VFR(1),o[0],0,0,0), C0,8); \
    KRD(GL,1); GAPB(o[1]=__builtin_amdgcn_mfma_f32_32x32x16_bf16(PAF(1),VFR(5),o[1],0,0,0), C0,12); \
    KRD(GL,2); GAPB(o[0]=__builtin_amdgcn_mfma_f32_32x32x16_bf16(PAF(2),VFR(2),o[0],0,0,0), C1,0); \
    KRD(GL,3); GAPB(o[1]=__builtin_amdgcn_mfma_f32_32x32x16_bf16(PAF(2),VFR(6),o[1],0,0,0), C1,4); \
    GAPB(o[0]=__builtin_amdgcn_mfma_f32_32x32x16_bf16(PAF(3),VFR(3),o[0],0,0,0), C1,8); \
    GAPB(o[1]=__builtin_amdgcn_mfma_f32_32x32x16_bf16(PAF(3),VFR(7),o[1],0,0,0), C1,12); \
    }while(0)
  int t=1;
  for(;t+7<NT;t+=2){
    STEP(pB0,pB1,pA0,pA1,t,true,true,true,,negm,negm,);     WAIT_BAR(2); RESC(); ROT();
    STEP(pA0,pA1,pB0,pB1,t+1,true,true,true,,negm,negm,);   WAIT_BAR(2); RESC(); ROT();
  }
  #define ENDW(tt) do{ if((tt)+3<NT){WAIT_BAR(2);} else if((tt)+2<NT){WAIT_BAR(1);} else {WAIT_BAR(0);} }while(0)
  for(;t+1<NT;t+=2){
    STEP(pB0,pB1,pA0,pA1,t,(t+3<NT),(t+1<NT),(t+1<NT),BINIT(pB0,pB1,t),pB0,pB1,bandpost(pB0,pB1,negm,t,q0,wid));           ENDW(t);   RESC(); ROT();
    STEP(pA0,pA1,pB0,pB1,t+1,(t+4<NT),(t+2<NT),(t+2<NT),BINIT(pA0,pA1,t+1),pA0,pA1,bandpost(pA0,pA1,negm,t+1,q0,wid));       ENDW(t+1); RESC(); ROT();
  }
  STEP(pB0,pB1,pA0,pA1,NT-1,false,false,false,BINIT(pB0,pB1,NT-1),pB0,pB1,bandpost(pB0,pB1,negm,NT-1,q0,wid)); RESC();
  { float sacc=pB0[0]+pB0[1]; _Pragma("unroll") for(int r=2;r<16;++r)sacc+=pB0[r]; _Pragma("unroll") for(int r=0;r<16;++r)sacc+=pB1[r]; l_reg+=sacc;
    pw0=(u32x4){PKW(pB0,0),PKW(pB0,2),PKW(pB0,4),PKW(pB0,6)};pw1=(u32x4){PKW(pB0,8),PKW(pB0,10),PKW(pB0,12),PKW(pB0,14)};pw2=(u32x4){PKW(pB1,0),PKW(pB1,2),PKW(pB1,4),PKW(pB1,6)};pw3=(u32x4){PKW(pB1,8),PKW(pB1,10),PKW(pB1,12),PKW(pB1,14)};
    SBAR(); pv(o,vb0+sl_cur,PAF(0),PAF(1),PAF(2),PAF(3)); }
  #undef PKW
  #undef PAF
  #undef VFR
  #undef PIN
  #undef MX3
  #undef GAPA
  #undef GAPB
  #undef EX
  #undef VRD
  #undef KRD
  #undef STEP
  #undef ENDW
  {auto rr=__builtin_amdgcn_permlane32_swap(__float_as_uint(l_reg),__float_as_uint(l_reg),false,false);l_reg=__uint_as_float(rr[0])+__uint_as_float(rr[1]);}
  if(hi==0)wsf[32+r32]=l_reg;asm volatile("s_waitcnt lgkmcnt(0)":::"memory");
  float rli[16];
  #pragma unroll
  for(int r=0;r<16;++r)rli[r]=__builtin_amdgcn_rcpf(wsf[32+crow(r,hi)]);
  bf16*Ow=O+(rowbase+q0+wid*QBLK)*PO+j*128+vh*64;
  { bf16*stg=(bf16*)(shm+LDS_OST)+wid*2048;
    #pragma unroll
    for(int r=0;r<16;++r){const int orow=crow(r,hi);
      #pragma unroll
      for(int d0=0;d0<2;++d0)stg[orow*64+d0*32+r32]=__float2bfloat16(o[d0][r]*rli[r]);}
    asm volatile("s_waitcnt lgkmcnt(0)":::"memory");
    #pragma unroll
    for(int i=0;i<4;++i){const int row=i*8+(lane>>3),ch=lane&7; const u32x4 v=*(const u32x4*)(stg+row*64+ch*8); ATTN_STORE16(Ow+(long)row*PO+ch*8,v);} }
  asm volatile("s_waitcnt lgkmcnt(0)\n\ts_barrier":::"memory");
  #undef DMA_K
  #undef DMA_V
  #undef BINIT
  #undef START
  #undef RESC
  #undef ROT
}
constexpr int ATTN_LDS_BYTES=LDS_BYTES;
#undef SBAR
#undef WAIT_BAR
}

#define XB_TMO      128
#define XB_XCNT(j)  (256  + 64 * (j))
#define XB_XSUB(j)  (1280 + 64 * (j))
#define XB_XGEN(j)  (2304 + 64 * (j))
#define XB_TOP      3328
#define XB_TOPGEN   3392
#define XCD_BAR_WORDS 3456
#define XB_SPIN_CAP (1u << 18)
__device__ __forceinline__ unsigned xb_ld(unsigned* p)              { return __hip_atomic_load(p, __ATOMIC_RELAXED, __HIP_MEMORY_SCOPE_AGENT); }
__device__ __forceinline__ unsigned xb_add(unsigned* p, unsigned v) { return __hip_atomic_fetch_add(p, v, __ATOMIC_RELAXED, __HIP_MEMORY_SCOPE_AGENT); }
__device__ __forceinline__ unsigned xb_xcc_id() { return (unsigned)__builtin_amdgcn_s_getreg((3 << 11) | 20) & 0xFu; }
#define XB_SPIN(cond, bar) do { unsigned _sp = 0; while (cond) { __builtin_amdgcn_s_sleep(1); \
    if ((++_sp & 255u) == 0u) { if (xb_ld(&(bar)[XB_TMO])) break; if (_sp > XB_SPIN_CAP) { atomicAdd(&(bar)[XB_TMO], 1u); break; } } } } while (0)
struct XcdBarrier { unsigned* bar; unsigned x; volatile LAS unsigned* st; };
__device__ __forceinline__ XcdBarrier xcd_barrier_post(unsigned* bar, volatile LAS unsigned* st) {
    XcdBarrier b; b.bar = bar; b.x = xb_xcc_id(); b.st = st;
    if (threadIdx.x == 0) (void)xb_add(&bar[XB_XCNT(b.x)], 1u);
    return b;
}
__device__ __forceinline__ void xcd_barrier_complete(unsigned* bar, unsigned x, unsigned& nloc, unsigned& nx) {
    const unsigned G = gridDim.x * gridDim.y * gridDim.z;
    unsigned sum, cnt, mine, sp = 0u;
    for (;;) {
        sum = 0u; cnt = 0u; mine = 0u;
#pragma unroll
        for (unsigned j = 0; j < 16; ++j) { const unsigned c = xb_ld(&bar[XB_XCNT(j)]); sum += c; cnt += (c > 0u) ? 1u : 0u; mine = (j == x) ? c : mine; }
        if (sum == G) break;
        __builtin_amdgcn_s_sleep(1);
        if ((++sp & 255u) == 0u) { if (xb_ld(&bar[XB_TMO])) break; if (sp > XB_SPIN_CAP) { atomicAdd(&bar[XB_TMO], 1u); break; } }
    }
    nloc = mine > 0u ? mine : 1u; nx = cnt > 0u ? cnt : 1u;
}
__device__ __forceinline__ void xcd_barrier(const XcdBarrier& b) {
    asm volatile("s_waitcnt vmcnt(0)" ::: "memory");
    __syncthreads();
    if (threadIdx.x == 0) {
        unsigned* bar = b.bar;
        __builtin_amdgcn_s_waitcnt(0);
        unsigned nloc = b.st[0], nx = b.st[1];
        if (nloc == 0u) { xcd_barrier_complete(bar, b.x, nloc, nx); b.st[0] = nloc; b.st[1] = nx; }
        const unsigned old = xb_add(&bar[XB_XSUB(b.x)], 1u);
        const unsigned gen = old / nloc;
        if (old + 1u == (gen + 1u) * nloc) {
            __builtin_amdgcn_fence(__ATOMIC_RELEASE, "agent");
            asm volatile("s_waitcnt vmcnt(0)" ::: "memory");
            const unsigned og = xb_add(&bar[XB_TOP], 1u);
            const unsigned tg = og / nx;
            if (og + 1u == (tg + 1u) * nx) xb_add(&bar[XB_TOPGEN], 1u);
            else XB_SPIN(xb_ld(&bar[XB_TOPGEN]) == tg, bar);
            __builtin_amdgcn_fence(__ATOMIC_ACQUIRE, "agent");
            xb_add(&bar[XB_XGEN(b.x)], 1u);
            asm volatile("s_waitcnt vmcnt(0)" ::: "memory");
        } else {
            XB_SPIN(xb_ld(&bar[XB_XGEN(b.x)]) == gen, bar);
            __builtin_amdgcn_fence(__ATOMIC_ACQUIRE, "agent");
            asm volatile("s_waitcnt vmcnt(0)" ::: "memory");
        }
    }
    __syncthreads();
}

struct Frame {
    LAS unsigned char* lds;
    unsigned char* ws;
    gu32* ctl;
    int tid, lane, wave;
    int vcu, G;
};
__device__ __forceinline__ float wave_sum(float v) {
#pragma unroll
    for (int o = 1; o < 64; o <<= 1) v += __shfl_xor(v, o);
    return v;
}
struct TItem { const float* src; bf16* dst; int K, N; };
__device__ __forceinline__ unsigned pk4_fp8(float a, float b, float c, float d) {
    int w = __builtin_amdgcn_cvt_pk_fp8_f32(a, b, 0, false); w = __builtin_amdgcn_cvt_pk_fp8_f32(c, d, w, true); return (unsigned)w; }
constexpr float W8_SCALE = 64.0f, W8_INV = 1.0f / 64.0f;
__device__ __forceinline__ void p0_load(const TItem& t, f32x4 (&v)[8], int wave, int lane) {
    const GAS float* sp = (const GAS float*)t.src + (size_t)(8 * (2 * wave + (lane >> 5))) * t.N + 4 * (lane & 31);
#pragma unroll
    for (int i = 0; i < 8; ++i) v[i] = __builtin_nontemporal_load((const GAS f32x4*)(sp + (size_t)i * t.N));
}
__device__ __forceinline__ void p0_store(const TItem& t, const f32x4 (&v)[8], LAS unsigned char* img, int wave, int lane) {
    const int kg = 2 * wave + (lane >> 5), n4 = lane & 31;
#pragma unroll
    for (int x = 0; x < 4; ++x) { v4u w; w.x = pg8::cvt_pk_bf16(v[0][x], v[1][x]); w.y = pg8::cvt_pk_bf16(v[2][x], v[3][x]); w.z = pg8::cvt_pk_bf16(v[4][x], v[5][x]); w.w = pg8::cvt_pk_bf16(v[6][x], v[7][x]);
        *(LAS v4u*)(img + (4 * n4 + x) * 272 + kg * 16) = w; }
    asm volatile("s_waitcnt lgkmcnt(0)\n\ts_barrier" ::: "memory");
#pragma unroll
    for (int j = 0; j < 4; ++j) { const int n = 16 * wave + 4 * j + (lane >> 4), kc = lane & 15;
        const v4u o = *(const LAS v4u*)(img + n * 272 + kc * 16);
        *(GAS v4u*)(t.dst + (size_t)n * t.K + 8 * kc) = o; }
}
__device__ __forceinline__ void p0_store8(const TItem& t, const f32x4 (&v)[8], LAS unsigned char* img, int wave, int lane) {
    const int kg = 2 * wave + (lane >> 5), n4 = lane & 31;
#pragma unroll
    for (int x = 0; x < 4; ++x) { v2u w; w.x = pk4_fp8(v[0][x] * W8_SCALE, v[1][x] * W8_SCALE, v[2][x] * W8_SCALE, v[3][x] * W8_SCALE); w.y = pk4_fp8(v[4][x] * W8_SCALE, v[5][x] * W8_SCALE, v[6][x] * W8_SCALE, v[7][x] * W8_SCALE);
        *(LAS v2u*)(img + (4 * n4 + x) * 144 + kg * 8) = w; }
    asm volatile("s_waitcnt lgkmcnt(0)\n\ts_barrier" ::: "memory");
    unsigned char* dst = (unsigned char*)t.dst;
#pragma unroll
    for (int j = 0; j < 2; ++j) { const int n = 16 * wave + 8 * j + (lane >> 3), kc = lane & 7;
        const v4u o = *(const LAS v4u*)(img + n * 144 + kc * 16);
        *(GAS v4u*)(dst + (size_t)n * t.K + 16 * kc) = o; }
}
__device__ __forceinline__ int t5_bucket(int rel) {
    const int n = rel < 0 ? -rel : rel; int b;
    if (n < 8) b = n; else if (n < 12) b = 8; else if (n < 16) b = 9; else if (n < 23) b = 10; else if (n < 32) b = 11; else if (n < 46) b = 12; else if (n < 64) b = 13; else if (n < 91) b = 14; else b = 15;
    return b + (rel > 0 ? 16 : 0);
}

struct DenseSched {
    const bf16* A; const bf16* Bt; int nM, nN, nwg, G, c;
    __device__ __forceinline__ void init(const bf16* A_, const bf16* Bt_, int M_, int N_, int G_, int c_) { A = A_; Bt = Bt_; nM = M_ / 256; nN = N_ / 256; nwg = nM * nN; G = G_; c = c_; }
    __device__ __forceinline__ bool next(int i, pg8::Unit& u) const {
        const long L = (long)i * G + c; if (L >= nwg) return false;
        int wgid = (int)L; { const int q = nwg / 8, r = nwg % 8, xcd = wgid % 8, off = wgid / 8; wgid = (xcd < r ? xcd * (q + 1) : r * (q + 1) + (xcd - r) * q) + off; }
        const int nig = 8 * nN, gid = wgid / nig, fm = gid * 8, gsz = (nM - fm) < 8 ? (nM - fm) : 8;
        u.pm = fm + ((wgid % nig) % gsz); u.pn = (wgid % nig) / gsz; u.e = 0; u.lrow0 = 0; u.cnt = 0; return true;
    }
    __device__ __forceinline__ const char* a_base(const pg8::Unit& u) const { return (const char*)A + (size_t)u.pm * (256 * 1024 * 2); }
    __device__ __forceinline__ const char* b_base(const pg8::Unit& u) const { return (const char*)Bt + (size_t)u.pn * (256 * 1024 * 2); }
    __device__ __forceinline__ size_t b_hstep() const { return (size_t)128 * 1024 * 2; }
    __device__ __forceinline__ void a_voff(const pg8::Unit&, const int (&R)[2], const int (&C)[2], unsigned (&v0)[2], unsigned (&v1)[2]) const {
#pragma unroll
        for (int i = 0; i < 2; ++i) { v0[i] = (unsigned)(R[i] * 1024 + C[i]) * 2u; v1[i] = v0[i] + 128u * 1024u * 2u; } }
    __device__ __forceinline__ const bf16* a_row(const pg8::Unit& u, int r) const { return A + (size_t)(u.pm * 256 + r) * 1024; }
    __device__ __forceinline__ const bf16* b_row(const pg8::Unit& u, int c_) const { return Bt + (size_t)(u.pn * 256 + c_) * 1024; }
    __device__ __forceinline__ void a_tok(const pg8::Unit&, const int (&)[2], unsigned (&tk)[4]) const { tk[0] = tk[1] = tk[2] = tk[3] = 0u; }
    __device__ __forceinline__ void a_voff_tok(const unsigned (&)[4], const int (&R)[2], const int (&C)[2], unsigned (&v0)[2], unsigned (&v1)[2]) const {
#pragma unroll
        for (int i = 0; i < 2; ++i) { v0[i] = (unsigned)(R[i] * 1024 + C[i]) * 2u; v1[i] = v0[i] + 128u * 1024u * 2u; } }
};
struct MoeSched {
    const bf16* A; const bf16* W; const int* rowtok; const LAS int* pexp; const LAS int* pfirst; const LAS int* cntl;
    int NP, NT, G, vcu; bool gather; int rowb  ; size_t wexp  , wtile  , whalf;
    __device__ __forceinline__ bool next(int i, pg8::Unit& u) const {
        const int L = i * G + vcu; if (L >= NP * NT) return false;
        const int pi = L / NT; const int e = __builtin_amdgcn_readfirstlane(pexp[pi]);
        u.pm = pi; u.pn = L - pi * NT; u.e = e; u.lrow0 = (pi - __builtin_amdgcn_readfirstlane(pfirst[e])) * 256; u.cnt = __builtin_amdgcn_readfirstlane(cntl[e]); return true;
    }
    __device__ __forceinline__ const char* a_base(const pg8::Unit& u) const { return gather ? (const char*)A : (const char*)A + (size_t)u.pm * 256 * (size_t)rowb; }
    __device__ __forceinline__ const char* b_base(const pg8::Unit& u) const { return (const char*)W + (size_t)u.e * wexp + (size_t)u.pn * wtile; }
    __device__ __forceinline__ size_t b_hstep() const { return whalf; }
    __device__ __forceinline__ int tok_of(const pg8::Unit& u, int r) const { int lr = u.lrow0 + r; lr = lr < u.cnt ? lr : u.cnt - 1; return ((const GAS int*)rowtok)[u.e * ECAP + lr]; }
    __device__ __forceinline__ void a_tok(const pg8::Unit& u, const int (&R)[2], unsigned (&tk)[4]) const {
        if (gather) {
#pragma unroll
            for (int q = 0; q < 4; ++q) { int lr = u.lrow0 + (q >> 1) * 128 + R[q & 1]; lr = lr < u.cnt ? lr : u.cnt - 1; const GAS int* ap = (const GAS int*)rowtok + (u.e * ECAP + lr);
                asm volatile("global_load_dword %0, %1, off" : "=v"(tk[q]) : "v"(ap) : "memory"); }
        } else { tk[0] = tk[1] = tk[2] = tk[3] = 0u; } }
    __device__ __forceinline__ void a_voff_tok(const unsigned (&tk)[4], const int (&R)[2], const int (&C)[2], unsigned (&v0)[2], unsigned (&v1)[2]) const {
        if (gather) {
#pragma unroll
            for (int i = 0; i < 2; ++i) { v0[i] = tk[i] * (unsigned)rowb + (unsigned)(C[i] * 2); v1[i] = tk[2 + i] * (unsigned)rowb + (unsigned)(C[i] * 2); }
        } else {
#pragma unroll
            for (int i = 0; i < 2; ++i) { v0[i] = (unsigned)(R[i] * rowb + C[i] * 2); v1[i] = v0[i] + 128u * (unsigned)rowb; }
        } }
    __device__ __forceinline__ void a_voff(const pg8::Unit& u, const int (&R)[2], const int (&C)[2], unsigned (&v0)[2], unsigned (&v1)[2]) const {
        if (gather) {
#pragma unroll
            for (int i = 0; i < 2; ++i) { v0[i] = (unsigned)(tok_of(u, R[i]) * rowb + C[i] * 2); v1[i] = (unsigned)(tok_of(u, 128 + R[i]) * rowb + C[i] * 2); }
        } else {
#pragma unroll
            for (int i = 0; i < 2; ++i) { v0[i] = (unsigned)(R[i] * rowb + C[i] * 2); v1[i] = v0[i] + 128u * (unsigned)rowb; }
        }
    }
    __device__ __forceinline__ const bf16* a_row(const pg8::Unit& u, int r) const { return gather ? A + (size_t)tok_of(u, r) * 1024 : A + (size_t)(u.pm * 256 + r) * 1024; }
    __device__ __forceinline__ const bf16* b_row(const pg8::Unit& u, int c_) const { return (const bf16*)((const char*)W + (size_t)u.e * wexp + (size_t)u.pn * wtile + (c_ >= 128 ? whalf : 0) + (size_t)(c_ & 127) * 2048); }
};

struct EpiQKVU {
    static constexpr bool PERM = true;
    bf16* O; size_t stride;
    __device__ __forceinline__ void pre(const pg8::Unit&, int, int, int, int, pg8::Pre&) const {}
    __device__ __forceinline__ void operator()(const pg8::f32x4 (&acc)[2][2][4][2], const pg8::Unit& u, int wr, int wc, int fr, int fq, const pg8::Pre&) const {
        const int t = u.pn >> 1; const float sc = t == 0 ? QSCALE : 1.f;
        bf16* base = O + (size_t)t * stride; const int col0 = (u.pn & 1) * 256 + wc * 32 + 8 * fq; const int row0 = u.pm * 256 + wr * 64 + fr;
#pragma unroll
        for (int ai = 0; ai < 2; ++ai)
#pragma unroll
            for (int m = 0; m < 4; ++m) { bf16* rowp = base + (size_t)(row0 + ai * 128 + m * 16) * 512 + col0;
#pragma unroll
                for (int bj = 0; bj < 2; ++bj) { const pg8::f32x4 v0 = acc[ai][bj][m][0] * sc, v1 = acc[ai][bj][m][1] * sc;
                    pg8::u32x4 w; w.x = pg8::cvt_pk_bf16(v0[0], v0[1]); w.y = pg8::cvt_pk_bf16(v0[2], v0[3]); w.z = pg8::cvt_pk_bf16(v1[0], v1[1]); w.w = pg8::cvt_pk_bf16(v1[2], v1[3]);
                    *(pg8::u32x4*)(rowp + bj * 128) = w; } }
    }
};
struct EpiT1 {
    static constexpr bool PERM = true;
    const float* mod; bf16* TG;
    __device__ __forceinline__ void pre(const pg8::Unit&, int, int, int, int, pg8::Pre&) const {}
    __device__ __forceinline__ void operator()(const pg8::f32x4 (&acc)[2][2][4][2], const pg8::Unit& u, int wr, int wc, int fr, int fq, const pg8::Pre&) const {
        const int b = u.pm >> 3; const float* g1 = mod + (size_t)b * 6144 + 2048;
        const int col0 = u.pn * 256 + wc * 32 + 8 * fq;
        pg8::f32x4 gv[2][2];
#pragma unroll
        for (int bj = 0; bj < 2; ++bj)
#pragma unroll
            for (int n = 0; n < 2; ++n) gv[bj][n] = *(const pg8::f32x4*)(g1 + col0 + bj * 128 + 4 * n);
#pragma unroll
        for (int ai = 0; ai < 2; ++ai)
#pragma unroll
            for (int m = 0; m < 4; ++m) { bf16* rowp = TG + (size_t)(u.pm * 256 + ai * 128 + wr * 64 + m * 16 + fr) * 1024 + col0;
#pragma unroll
                for (int bj = 0; bj < 2; ++bj) { const pg8::f32x4 v0 = acc[ai][bj][m][0] * gv[bj][0], v1 = acc[ai][bj][m][1] * gv[bj][1];
                    pg8::u32x4 w; w.x = pg8::cvt_pk_bf16(v0[0], v0[1]); w.y = pg8::cvt_pk_bf16(v0[2], v0[3]); w.z = pg8::cvt_pk_bf16(v1[0], v1[1]); w.w = pg8::cvt_pk_bf16(v1[2], v1[3]);
                    *(pg8::u32x4*)(rowp + bj * 128) = w; } }
    }
};
struct EpiSwiglu {
    static constexpr bool PERM = true;
    const float* bgu; unsigned char* H;
    __device__ __forceinline__ void pre(const pg8::Unit& u, int, int wc, int, int fq, pg8::Pre& P) const {
        const float* bg = bgu + (size_t)u.e * 2048 + u.pn * 128 + wc * 32 + 8 * fq;
        pg8::asm_ld16(P.v[0], bg); pg8::asm_ld16(P.v[1], bg + 4); pg8::asm_ld16(P.v[2], bg + 1024); pg8::asm_ld16(P.v[3], bg + 1028); }
    __device__ __forceinline__ void operator()(const pg8::f32x4 (&acc)[2][2][4][2], const pg8::Unit& u, int wr, int wc, int fr, int fq, const pg8::Pre& P) const {
        const int c0 = u.pn * 128 + wc * 32 + 8 * fq;
        const pg8::f32x4 bgv[2] = {P.v[0], P.v[1]}, buv[2] = {P.v[2], P.v[3]};
#pragma unroll
        for (int ai = 0; ai < 2; ++ai)
#pragma unroll
            for (int m = 0; m < 4; ++m) { float r[8];
#pragma unroll
                for (int n = 0; n < 2; ++n)
#pragma unroll
                    for (int x = 0; x < 4; ++x) { const float g = fminf(acc[ai][0][m][n][x] * W8_INV + bgv[n][x], 7.0f); const float up = fminf(fmaxf(acc[ai][1][m][n][x] * W8_INV + buv[n][x], -7.0f), 7.0f);
                        const float sg = __builtin_amdgcn_rcpf(1.0f + __builtin_amdgcn_exp2f(-1.702f * LOG2E * g)); r[4 * n + x] = (up + 1.0f) * (g * sg); }
                v2u w; w.x = pk4_fp8(r[0], r[1], r[2], r[3]); w.y = pk4_fp8(r[4], r[5], r[6], r[7]);
                *(v2u*)(H + (size_t)(u.pm * 256 + ai * 128 + wr * 64 + m * 16 + fr) * 1024 + c0) = w; }
    }
};
struct EpiDown {
    static constexpr bool PERM = true;
    const float* bd; unsigned char* Y;
    __device__ __forceinline__ void pre(const pg8::Unit& u, int, int wc, int, int fq, pg8::Pre& P) const {
        const float* bp = bd + (size_t)u.e * 1024 + u.pn * 256 + wc * 32 + 8 * fq;
        pg8::asm_ld16(P.v[0], bp); pg8::asm_ld16(P.v[1], bp + 4); pg8::asm_ld16(P.v[2], bp + 128); pg8::asm_ld16(P.v[3], bp + 132); }
    __device__ __forceinline__ void operator()(const pg8::f32x4 (&acc)[2][2][4][2], const pg8::Unit& u, int wr, int wc, int fr, int fq, const pg8::Pre& P) const {
        const int c0 = u.pn * 256 + wc * 32 + 8 * fq;
        const pg8::f32x4 bv[2][2] = {{P.v[0], P.v[1]}, {P.v[2], P.v[3]}};
#pragma unroll
        for (int ai = 0; ai < 2; ++ai)
#pragma unroll
            for (int m = 0; m < 4; ++m) { unsigned char* rowp = Y + (size_t)(u.pm * 256 + ai * 128 + wr * 64 + m * 16 + fr) * 1024 + c0;
#pragma unroll
                for (int bj = 0; bj < 2; ++bj) { const pg8::f32x4 v0 = acc[ai][bj][m][0] * W8_INV + bv[bj][0], v1 = acc[ai][bj][m][1] * W8_INV + bv[bj][1];
                    v2u w; w.x = pk4_fp8(v0[0], v0[1], v0[2], v0[3]); w.y = pk4_fp8(v1[0], v1[1], v1[2], v1[3]);
                    *(v2u*)(rowp + bj * 128) = w; } }
    }
};

__device__ __forceinline__ void build_expert_tables(Frame& F) {
    LAS int* cntl = (LAS int*)(F.lds + L_CNT); LAS int* pfirst = (LAS int*)(F.lds + L_PFIRST); LAS int* pexp = (LAS int*)(F.lds + L_PEXP);
    __syncthreads();
    if (F.tid < NE) { int c = (int)__hip_atomic_load(F.ctl + CW_CNT + 64 * F.tid, RLX_AGENT); c = c < 0 ? 0 : (c > ECAP ? ECAP : c); cntl[F.tid] = c; }
    __syncthreads();
    if (F.tid == 0) { int p = 0; for (int e = 0; e < NE; ++e) { pfirst[e] = p; const int np = (cntl[e] + 255) >> 8; for (int k = 0; k < np; ++k) if (p + k < PMAX) pexp[p + k] = e; p += np; if (p > PMAX) p = PMAX; } pfirst[NE] = p; }
    __syncthreads();
}

struct Args { const float* in[25]; float* out; unsigned char* ws; int ph_lo, ph_hi; };
constexpr int NPHASE = 10;

__global__ void __launch_bounds__(NWAVES * 64, 2) mk_fwd(Args args) {
    extern __shared__ __attribute__((aligned(16))) unsigned char lds[];
    Frame F;
    F.lds = (LAS unsigned char*)lds; F.ws = args.ws; F.ctl = (gu32*)(args.ws + WS_CTL);
    F.tid = threadIdx.x; F.lane = F.tid & 63; F.wave = __builtin_amdgcn_readfirstlane(F.tid >> 6);
    F.G = gridDim.x; { const int bx = blockIdx.x; F.vcu = (F.G % 8 == 0) ? (bx % 8) * (F.G / 8) + bx / 8 : bx; }
    volatile LAS unsigned* MISC = (volatile LAS unsigned*)(F.lds + L_MISC);
    for (int u = F.tid; u < (LDS_BYTES - LCTL_OFF) / 4; u += NWAVES * 64) ((LAS unsigned*)(F.lds + LCTL_OFF))[u] = 0u;
    __syncthreads();
    XcdBarrier bar; bar.bar = (unsigned*)(F.ctl + CW_BAR); bar.x = 0; bar.st = nullptr;
#if MK_ONE_LAUNCH
    bar = xcd_barrier_post((unsigned*)(F.ctl + CW_BAR), MISC + 8);
#define GRID_BAR() xcd_barrier(bar)
#else
#define GRID_BAR() do { } while (0)
#endif
#define PHASE_ENTRY() do { int t_ = threadIdx.x; asm volatile("" : "+v"(t_)); F.tid = t_; F.lane = t_ & 63; } while (0)
    const int lo = args.ph_lo, hi = args.ph_hi;
#ifndef PH_MASK
#define PH_MASK 0x3ff
#endif
#ifndef REP_MASK
#define REP_MASK 0x0
#endif
#define REPS(k) (1 + ((REP_MASK >> (k)) & 1))
#define IN(k) (((PH_MASK >> (k)) & 1) && lo <= (k) && (k) < hi)
#define BOTH(k) (IN(k) && IN((k) + 1))
    const float* x = args.in[0]; const float* cvec = args.in[1]; const float* w_ada = args.in[2]; const float* b_ada = args.in[3]; const float* w_in = args.in[4];
    const float* lq1 = args.in[5]; const float* lk1 = args.in[6]; const float* lq2 = args.in[7]; const float* lk2 = args.in[8]; const float* subln_g = args.in[9];
    const float* rel_bias = args.in[10]; const float* w_pool = args.in[11]; const float* b_pool = args.in[12]; const float* pool_scale = args.in[13]; const float* w_out = args.in[14];
    const float* ln1_g = args.in[15]; const float* ln1_b = args.in[16]; const float* w_router = args.in[17]; const float* b_router = args.in[18];
    const float* w_gu = args.in[19]; const float* b_gu = args.in[20]; const float* w_dn = args.in[21]; const float* b_dn = args.in[22]; const float* ln2_g = args.in[23]; const float* ln2_b = args.in[24];
    float* out = args.out; unsigned char* ws = args.ws;
    float* MOD = (float*)(ws + WS_MOD); float* MODP = (float*)(ws + WS_MODP); bf16* WPOOL = (bf16*)(ws + WS_WPOOL); bf16* WIN = (bf16*)(ws + WS_WIN); bf16* WOUT = (bf16*)(ws + WS_WOUT);
    bf16* WGU = (bf16*)(ws + WS_WGU); bf16* WD = (bf16*)(ws + WS_WD); bf16* XN = (bf16*)(ws + WS_XN);
    bf16* QB = (bf16*)(ws + WS_Q); bf16* KB = (bf16*)(ws + WS_K); bf16* VB = (bf16*)(ws + WS_V); bf16* UB = (bf16*)(ws + WS_U);
    bf16* OA = (bf16*)(ws + WS_OA); bf16* MIX = (bf16*)(ws + WS_MIX); float* T1 = (float*)(ws + WS_T1); float* X1 = (float*)(ws + WS_X1); bf16* XN2 = (bf16*)(ws + WS_XN2);
    int* RE = (int*)(ws + WS_RE); int* RP = (int*)(ws + WS_RP); float* RG = (float*)(ws + WS_RG); int* ROWTOK = (int*)(ws + WS_ROWTOK);
    bf16* HB = (bf16*)(ws + WS_H); bf16* YB = (bf16*)(ws + WS_Y);
    const int gw = F.vcu * NWAVES + F.wave, NGW = F.G * NWAVES;
    unsigned long long dly_t0 = 0, dly_t1 = 0;

    if (DLY_PH == 0) dly_t0 = __builtin_amdgcn_s_memrealtime();
    if (IN(0)) _Pragma("unroll") for (int rep_ = 0; rep_ < REPS(0); ++rep_) {
        PHASE_ENTRY();
        LAS float* sil = (LAS float*)(F.lds + 3 * 34816);
        for (int i = F.tid; i < NB * D; i += NWAVES * 64) { const float v = cvec[i]; sil[i] = v / (1.0f + __expf(-v)); }
        __syncthreads();
        constexpr int I_MOD = 6144 / 16, T_IN = (D / 128) * (NIN / 128), T_OUT = (D / 128) * (D / 128), T_POOL = 4, T_GU1 = (D / 128) * (2048 / 128), T_D1 = (FF / 128) * (D / 128);
        constexpr int NTR = T_IN + T_OUT + T_POOL + NE * T_GU1 + NE * T_D1;
        for (int r = gw; r < 8 * I_MOD; r += NGW) {
            const int cgp = r % I_MOD, kc = r / I_MOD, kq = F.lane >> 4, col = cgp * 16 + (F.lane & 15); float a[NB];
#pragma unroll
            for (int b = 0; b < NB; ++b) a[b] = 0.f;
#pragma unroll 16
            for (int i = 0; i < 32; ++i) { const int k = kc * 128 + kq + 4 * i; const float w = ((const GAS float*)w_ada)[(size_t)k * 6144 + col];
#pragma unroll
                for (int b = 0; b < NB; ++b) a[b] += sil[b * D + k] * w; }
#pragma unroll
            for (int b = 0; b < NB; ++b) { a[b] += __shfl_xor(a[b], 16); a[b] += __shfl_xor(a[b], 32); }
            if (kq == 0) {
#pragma unroll
                for (int b = 0; b < NB; ++b) MODP[((size_t)kc * NB + b) * 6144 + col] = a[b]; }
        }
        for (int r0 = F.vcu; r0 < T_IN + T_OUT + T_POOL; r0 += F.G) {
            int r = r0; const float* W; bf16* WT; int K, N, item;
            if (r < T_IN) { W = w_in; WT = WIN; K = D; N = NIN; item = r; }
            else if ((r -= T_IN) < T_OUT) { W = w_out; WT = WOUT; K = D; N = D; item = r; }
            else { r -= T_OUT; W = w_pool + (size_t)r * 128 * 128; WT = WPOOL + (size_t)r * 128 * 128; K = 128; N = 128; item = 0; }
            const int nblk = N / 128, kb = item / nblk, nb = item - kb * nblk;
            TItem t; t.src = W + (size_t)(128 * kb) * N + 128 * nb; t.dst = WT + (size_t)(128 * nb) * K + 128 * kb; t.K = K; t.N = N;
            f32x4 bb[8]; p0_load(t, bb, F.wave, F.lane); p0_store(t, bb, F.lds, F.wave, F.lane);
            asm volatile("s_waitcnt lgkmcnt(0)\n\ts_barrier" ::: "memory");
        }
        __syncthreads();
        if (BOTH(0) || rep_ + 1 < REPS(0)) GRID_BAR();
    }
    if (DLY_PH == 0) dly_t1 = __builtin_amdgcn_s_memrealtime();
    if (DLY_PH == 1) dly_t0 = __builtin_amdgcn_s_memrealtime();
    if (IN(1)) _Pragma("unroll") for (int rep_ = 0; rep_ < REPS(1); ++rep_) {
        PHASE_ENTRY();
        LAS float* modl = (LAS float*)F.lds;
        for (int blk = F.vcu; blk < M / 64; blk += F.G) {
            const int b = blk >> 5; const bool first = (blk & 31) == 0;
            __syncthreads();
            for (int c = F.tid; c < (first ? 6144 : 2048); c += NWAVES * 64) { float a = b_ada[c];
#pragma unroll
                for (int kc = 0; kc < 8; ++kc) a += ((const GAS float*)MODP)[((size_t)kc * NB + b) * 6144 + c];
                if (c < 2048) modl[c] = a; if (first) MOD[(size_t)b * 6144 + c] = a; }
            __syncthreads();
            {
                f32x4 v[8][4];
#pragma unroll
                for (int r8 = 0; r8 < 8; ++r8) { const GAS f32x4* xr = (const GAS f32x4*)(x + (size_t)(blk * 64 + F.wave * 8 + r8) * D) + F.lane;
#pragma unroll
                    for (int j = 0; j < 4; ++j) v[r8][j] = xr[64 * j]; }
#pragma unroll
                for (int r8 = 0; r8 < 8; ++r8) { const int m = blk * 64 + F.wave * 8 + r8; float s = 0.f;
#pragma unroll
                    for (int j = 0; j < 4; ++j) s += (v[r8][j].x + v[r8][j].y) + (v[r8][j].z + v[r8][j].w);
                    const float mean = wave_sum(s) * (1.f / D); float s2 = 0.f;
#pragma unroll
                    for (int j = 0; j < 4; ++j) { v[r8][j] = v[r8][j] - mean; s2 += (v[r8][j].x * v[r8][j].x + v[r8][j].y * v[r8][j].y) + (v[r8][j].z * v[r8][j].z + v[r8][j].w * v[r8][j].w); }
                    const float rstd = 1.f / sqrtf(wave_sum(s2) * (1.f / D) + LN_EPS);
                    GAS v2u* o8 = (GAS v2u*)(XN + (size_t)m * D) + F.lane;
#pragma unroll
                    for (int j = 0; j < 4; ++j) { const f32x4 hv = *(const LAS f32x4*)(modl + 4 * F.lane + 256 * j), sv = *(const LAS f32x4*)(modl + 1024 + 4 * F.lane + 256 * j);
                        const f32x4 h = (v[r8][j] * rstd) * (sv + 1.0f) + hv; v2u w; w.x = pk2(h.x, h.y); w.y = pk2(h.z, h.w); o8[64 * j] = w; } }
            }
        }
        if (BOTH(1) || rep_ + 1 < REPS(1)) GRID_BAR();
    }
    if (DLY_PH == 1) dly_t1 = __builtin_amdgcn_s_memrealtime();
    if (DLY_PH == 2) dly_t0 = __builtin_amdgcn_s_memrealtime();
    if (IN(2)) _Pragma("unroll") for (int rep_ = 0; rep_ < REPS(2); ++rep_) {
        PHASE_ENTRY();
        DenseSched S; S.init(XN, WIN, M, NIN, F.G, (int)blockIdx.x);
        EpiQKVU E{QB, (size_t)(WS_K - WS_Q) / 2};
        pg8::gemm_phase<EpiQKVU, DenseSched, true>(F.lds, S, E);
        if (BOTH(2) || rep_ + 1 < REPS(2)) GRID_BAR();
    }
    if (DLY_PH == 2) dly_t1 = __builtin_amdgcn_s_memrealtime();
    if (DLY_PH == 3) dly_t0 = __builtin_amdgcn_s_memrealtime();
    if (IN(3)) _Pragma("unroll") for (int rep_ = 0; rep_ < REPS(3); ++rep_) {
        PHASE_ENTRY();
        const bool g8 = (F.G % 8 == 0); const bool conv_cu = g8 ? (F.vcu & 7) < 3 : true; const int cG = g8 ? (F.G / 8) * 3 : F.G, cv = g8 ? (F.vcu >> 3) * 3 + (F.vcu & 7) : F.vcu;
        if (conv_cu) {
            __syncthreads();
            constexpr int T_GU1 = (D / 128) * (2048 / 128), T_D1 = (FF / 128) * (D / 128);
        auto pipe = [&](const float* W, bf16* WT, auto K_, auto N_, int ntiles) {
            constexpr int K = decltype(K_)::value, N = decltype(N_)::value, NBLK = N / 128, TPE = (K / 128) * NBLK;
            const int n_my = (ntiles - cv + cG - 1) / cG;
            auto tile_of = [&](int q) -> TItem { const int qq = q < n_my ? q : n_my - 1; const int r = cv + qq * cG; const int e = r / TPE, item = r % TPE, kb = item / NBLK, nb = item % NBLK;
                TItem t; t.src = W + (size_t)e * K * N + (size_t)(128 * kb) * N + 128 * nb; t.dst = (bf16*)((unsigned char*)WT + (size_t)e * K * N + (size_t)(128 * nb) * K + 128 * kb);     t.K = K; t.N = N; return t; };
            if (n_my > 0) {
                TItem t0 = tile_of(0), t1 = tile_of(1), t2; f32x4 b0[8], b1[8], b2[8];
                p0_load(t0, b0, F.wave, F.lane); p0_load(t1, b1, F.wave, F.lane);
                for (int q = 0; q < n_my; q += 3) {
                    t2 = tile_of(q + 2); p0_load(t2, b2, F.wave, F.lane); p0_store8(t0, b0, F.lds, F.wave, F.lane);
                    t0 = tile_of(q + 3); p0_load(t0, b0, F.wave, F.lane); p0_store8(t1, b1, F.lds + 34816, F.wave, F.lane);
                    t1 = tile_of(q + 4); p0_load(t1, b1, F.wave, F.lane); p0_store8(t2, b2, F.lds + 2 * 34816, F.wave, F.lane);
                }
                asm volatile("s_waitcnt lgkmcnt(0)\n\ts_barrier" ::: "memory");
            }
        };
        pipe(w_gu, WGU, std::integral_constant<int, D>{}, std::integral_constant<int, 2048>{}, NE * T_GU1);
        pipe(w_dn, WD, std::integral_constant<int, FF>{}, std::integral_constant<int, D>{}, NE * T_D1);
            __syncthreads();
        }
        LAS float* tb = (LAS float*)(F.lds + L_TB);
        for (int i = F.tid; i < 4 * attn_body::TBN; i += NWAVES * 64) { const int h = i / attn_body::TBN, idx = i % attn_body::TBN; const int d = idx - attn_body::TBOFF;
            tb[i] = (d <= 63) ? (rel_bias[t5_bucket(d) * 4 + h] - rel_bias[15 * 4 + h]) * LOG2E : 0.f; }
        __syncthreads();
#if !NAIVE_ATTN
        {
            volatile LAS int* qslot = (volatile LAS int*)(F.lds + L_MISC + 64);
            for (;;) {
                __syncthreads();
                if (F.tid == 0) *qslot = (int)__hip_atomic_fetch_add(F.ctl + CW_AQ + 64 * rep_, 1u, RLX_AGENT);
                __syncthreads();
                const int ui = __builtin_amdgcn_readfirstlane(*qslot);
                if (ui >= 1024) break;
                const int qb = 7 - (ui >> 7), c7 = ui & 127, b = c7 >> 4, j = (c7 >> 1) & 7, vh = c7 & 1;
                attn_body::attn_unit<8>(b, j, vh, qb, (const attn_body::bf16*)QB, (const attn_body::bf16*)KB, (const attn_body::bf16*)VB, (attn_body::bf16*)OA, (char*)lds, tb + (j >> 1) * attn_body::TBN);
            }
        }
#else
        for (int idx = blockIdx.x * 512 + F.tid; idx < NB * 8 * 2 * SEQ; idx += F.G * 512) {
            const int q = idx & 2047, vh = (idx >> 11) & 1, j = (idx >> 12) & 7, b = idx >> 15, h = j >> 1;
            const bf16* qp = QB + (size_t)(b * SEQ + q) * 512 + j * 64; float qv[64];
#pragma unroll
            for (int d = 0; d < 64; ++d) qv[d] = pg8::bf2f(qp[d]);
            float o[64];
#pragma unroll
            for (int d = 0; d < 64; ++d) o[d] = 0.f;
            float mx = -INFINITY, l = 0.f; const int kend = ((q >> 6) + 1) << 6;
            for (int k = 0; k < kend; ++k) {
                const bf16* kp = KB + (size_t)(b * SEQ + k) * 512 + j * 64; float sdot = 0.f;
#pragma unroll
                for (int d = 0; d < 64; ++d) sdot += qv[d] * pg8::bf2f(kp[d]);
                const int dd = k - q; const int ti = dd + attn_body::TBOFF < 0 ? 0 : dd + attn_body::TBOFF; sdot += tb[h * attn_body::TBN + ti];
                const float mn = fmaxf(mx, sdot), f = exp2f(mx - mn), p = exp2f(sdot - mn); l = l * f + p; mx = mn;
                const bf16* vp = VB + (size_t)(b * SEQ + k) * 512 + h * 128 + vh * 64;
#pragma unroll
                for (int d = 0; d < 64; ++d) o[d] = o[d] * f + p * pg8::bf2f(vp[d]);
            }
            bf16* op = OA + (size_t)(b * SEQ + q) * 1024 + j * 128 + vh * 64; const float il = 1.0f / l;
#pragma unroll
            for (int d = 0; d < 64; ++d) op[d] = (bf16)f2bf(o[d] * il);
        }
#endif
        if (BOTH(3) || rep_ + 1 < REPS(3)) GRID_BAR();
    }
    if (DLY_PH == 3) dly_t1 = __builtin_amdgcn_s_memrealtime();
    if (DLY_PH == 4) dly_t0 = __builtin_amdgcn_s_memrealtime();
    if (IN(4)) _Pragma("unroll") for (int rep_ = 0; rep_ < REPS(4); ++rep_) {
        PHASE_ENTRY();
        float lam;
        { const float a = lq1[F.lane] * lk1[F.lane], b2 = lq2[F.lane] * lk2[F.lane]; lam = __expf(wave_sum(a)) - __expf(wave_sum(b2)) + LAM_INIT; }
        for (int m0 = gw; m0 < M; m0 += 2 * NGW) {
            const int h = F.lane >> 4, e0 = (F.lane & 15) * 8; const bool two = m0 + NGW < M;
            v4u a[2], b2[2];
#pragma unroll
            for (int q = 0; q < 2; ++q) if (q == 0 || two) { const size_t m = (size_t)m0 + (size_t)q * NGW;
                a[q] = *(const GAS v4u*)(OA + m * 1024 + h * 256 + e0); b2[q] = *(const GAS v4u*)(OA + m * 1024 + h * 256 + 128 + e0); }
            const f32x4 g0 = *(const f32x4*)(subln_g + e0), g1v = *(const f32x4*)(subln_g + e0 + 4);
#pragma unroll
            for (int q = 0; q < 2; ++q) if (q == 0 || two) { const size_t m = (size_t)m0 + (size_t)q * NGW;
                float o[8];
                o[0] = bfl(a[q].x) - lam * bfl(b2[q].x); o[1] = bfh(a[q].x) - lam * bfh(b2[q].x); o[2] = bfl(a[q].y) - lam * bfl(b2[q].y); o[3] = bfh(a[q].y) - lam * bfh(b2[q].y);
                o[4] = bfl(a[q].z) - lam * bfl(b2[q].z); o[5] = bfh(a[q].z) - lam * bfh(b2[q].z); o[6] = bfl(a[q].w) - lam * bfl(b2[q].w); o[7] = bfh(a[q].w) - lam * bfh(b2[q].w);
                float ss = 0.f;
#pragma unroll
                for (int i = 0; i < 8; ++i) ss += o[i] * o[i];
                ss += __shfl_xor(ss, 1); ss += __shfl_xor(ss, 2); ss += __shfl_xor(ss, 4); ss += __shfl_xor(ss, 8);
                const float rs = (1.0f - LAM_INIT) / sqrtf(ss * (1.0f / 128.0f) + LN_EPS);
                v4u w; w.x = pk2(o[0] * rs * g0.x, o[1] * rs * g0.y); w.y = pk2(o[2] * rs * g0.z, o[3] * rs * g0.w); w.z = pk2(o[4] * rs * g1v.x, o[5] * rs * g1v.y); w.w = pk2(o[6] * rs * g1v.z, o[7] * rs * g1v.w);
                *(GAS v4u*)(MIX + m * 1024 + h * 128 + e0) = w; }
        }
        for (int it = gw; it < (M / 32) * 4; it += NGW) {
            const int g = it & 3, tile = it >> 2, row0 = tile * 32, r32 = F.lane & 31, hi = F.lane >> 5;
            const int row = row0 + r32, tpos = row & (SEQ - 1), tp0 = row0 & (SEQ - 1);
            LAS unsigned char* ut = F.lds + F.wave * 12800;
#pragma unroll
            for (int i = 0; i < 12; ++i) { const int pc = F.lane + 64 * i, rr = pc >> 4, c16 = pc & 15;
                if (rr < 47) { v4u v = (v4u){0u, 0u, 0u, 0u}; if (tp0 - 15 + rr >= 0) v = *(const GAS v4u*)(UB + (size_t)(row0 - 15 + rr) * 512 + g * 128 + c16 * 8); *(LAS v4u*)(ut + rr * 272 + c16 * 16) = v; } }
            LDS_WAIT(); asm volatile("" ::: "memory");
            bf16x8 pf[8];
            const LAS unsigned char* ub = ut + (r32 + 15) * 272 + hi * 16;
            auto pooled = [&](auto WIN_) {
                constexpr int WIN = decltype(WIN_)::value;
                const int nwin = tpos + 1 < WIN ? tpos + 1 : WIN; const float inv = 1.0f / (float)nwin;
#pragma unroll
                for (int s8 = 0; s8 < 8; ++s8) {
                    float sum[8];
#pragma unroll
                    for (int i = 0; i < 8; ++i) sum[i] = 0.f;
                    v4u self;
#pragma unroll
                    for (int k = 0; k < WIN; ++k) { const v4u u4 = *(const LAS v4u*)(ub - k * 272 + s8 * 32); if (k == 0) self = u4;
                        sum[0] += bfl(u4.x); sum[1] += bfh(u4.x); sum[2] += bfl(u4.y); sum[3] += bfh(u4.y); sum[4] += bfl(u4.z); sum[5] += bfh(u4.z); sum[6] += bfl(u4.w); sum[7] += bfh(u4.w); }
                    v4u w; w.x = pk2(sum[0] * inv - bfl(self.x), sum[1] * inv - bfh(self.x)); w.y = pk2(sum[2] * inv - bfl(self.y), sum[3] * inv - bfh(self.y));
                    w.z = pk2(sum[4] * inv - bfl(self.z), sum[5] * inv - bfh(self.z)); w.w = pk2(sum[6] * inv - bfl(self.w), sum[7] * inv - bfh(self.w));
                    pf[s8] = __builtin_bit_cast(bf16x8, w);
                }
            };
            if (g == 0) pooled(std::integral_constant<int, 2>{}); else if (g == 1) pooled(std::integral_constant<int, 4>{}); else if (g == 2) pooled(std::integral_constant<int, 8>{}); else pooled(std::integral_constant<int, 16>{});
            LDS_WAIT(); asm volatile("" ::: "memory");
#pragma unroll
            for (int db = 0; db < 4; ++db) {
                f32x16 acc = f32x16{};
                const bf16* wp = WPOOL + (size_t)g * 128 * 128 + (size_t)(db * 32 + r32) * 128 + hi * 8;
#pragma unroll
                for (int s8 = 0; s8 < 8; ++s8) { const bf16x8 wf = __builtin_bit_cast(bf16x8, *(const GAS v4u*)(wp + s8 * 16)); acc = __builtin_amdgcn_mfma_f32_32x32x16_bf16(wf, pf[s8], acc, 0, 0, 0); }
#pragma unroll
                for (int rq = 0; rq < 4; ++rq) { const int d0 = db * 32 + 8 * rq + 4 * hi; const int cg = g * 128 + d0;
                    const f32x4 bp = *(const f32x4*)(b_pool + cg), ps = *(const f32x4*)(pool_scale + cg);
                    v2u w; w.x = pk2((acc[4 * rq + 0] + bp.x) * ps.x, (acc[4 * rq + 1] + bp.y) * ps.y); w.y = pk2((acc[4 * rq + 2] + bp.z) * ps.z, (acc[4 * rq + 3] + bp.w) * ps.w);
                    *(GAS v2u*)(MIX + (size_t)row * 1024 + 512 + cg) = w; }
            }
        }
        if (BOTH(4) || rep_ + 1 < REPS(4)) GRID_BAR();
    }
    if (DLY_PH == 4) dly_t1 = __builtin_amdgcn_s_memrealtime();
    if (DLY_PH == 5) dly_t0 = __builtin_amdgcn_s_memrealtime();
    if (IN(5)) _Pragma("unroll") for (int rep_ = 0; rep_ < REPS(5); ++rep_) {
        PHASE_ENTRY();
        DenseSched S; S.init(MIX, WOUT, M, D, F.G, (int)blockIdx.x);
        EpiT1 E{MOD, (bf16*)T1};
        pg8::gemm_phase<EpiT1, DenseSched, true>(F.lds, S, E);
        if (BOTH(5) || rep_ + 1 < REPS(5)) GRID_BAR();
    }
    if (DLY_PH == 5) dly_t1 = __builtin_amdgcn_s_memrealtime();
    if (DLY_PH == 6) dly_t0 = __builtin_amdgcn_s_memrealtime();
    if (IN(6)) _Pragma("unroll 1") for (int rep_ = 0; rep_ < REPS(6); ++rep_) {
        PHASE_ENTRY();
        LAS float* H2 = (LAS float*)F.lds;
        LAS float* PART = (LAS float*)F.lds;
        LAS float* LOG = (LAS float*)(F.lds + 131200);
        LAS unsigned* hist = (LAS unsigned*)(F.lds + L_HIST); LAS unsigned* hbase = hist + 32;
        const int i32 = F.lane & 31, kh = F.lane >> 5, kb = F.wave * 128;
        float wreg[64];
#pragma unroll
        for (int kk = 0; kk < 64; ++kk) wreg[kk] = ((const GAS float*)w_router)[(size_t)(kb + 2 * kk + kh) * NE + i32];
        for (int tile = F.vcu; tile < M / 32; tile += F.G) {
            if (F.tid < 32) hist[F.tid] = 0u;
            const int b = (tile * 32) >> 11; const float* sh = MOD + (size_t)b * 6144 + 3072; const float* sc = sh + 1024;
#pragma unroll
            for (int pr = 0; pr < 2; ++pr) {
                f32x4 v[2][4];
#pragma unroll
                for (int r2 = 0; r2 < 2; ++r2) { const size_t m_ = (size_t)(tile * 32 + F.wave * 4 + 2 * pr + r2); const GAS f32x4* xr = (const GAS f32x4*)(x + m_ * D) + F.lane; const GAS v2u* tr = (const GAS v2u*)((const bf16*)T1 + m_ * D) + F.lane;
                    v2u tg[4];
#pragma unroll
                    for (int j = 0; j < 4; ++j) { v[r2][j] = xr[64 * j]; tg[j] = tr[64 * j]; }
#pragma unroll
                    for (int j = 0; j < 4; ++j) v[r2][j] = v[r2][j] * DN_ALPHA + (f32x4){bfl(tg[j].x), bfh(tg[j].x), bfl(tg[j].y), bfh(tg[j].y)}; }
#pragma unroll
                for (int r2 = 0; r2 < 2; ++r2) {
                    const int lr = F.wave * 4 + 2 * pr + r2, m = tile * 32 + lr;
                    float s = 0.f;
#pragma unroll
                    for (int j = 0; j < 4; ++j) s += (v[r2][j].x + v[r2][j].y) + (v[r2][j].z + v[r2][j].w);
                    float mean = wave_sum(s) * (1.f / D); float s2 = 0.f;
#pragma unroll
                    for (int j = 0; j < 4; ++j) { v[r2][j] = v[r2][j] - mean; s2 += (v[r2][j].x * v[r2][j].x + v[r2][j].y * v[r2][j].y) + (v[r2][j].z * v[r2][j].z + v[r2][j].w * v[r2][j].w); }
                    float rstd = 1.f / sqrtf(wave_sum(s2) * (1.f / D) + LN_EPS);
                    if (F.lane == 0) { typedef float f32x2s __attribute__((ext_vector_type(2))); *(GAS f32x2s*)(X1 + 2 * (size_t)m) = (f32x2s){mean, rstd}; }
                    s = 0.f;
#pragma unroll
                    for (int j = 0; j < 4; ++j) { const f32x4 gvj = *(const f32x4*)(ln1_g + 4 * F.lane + 256 * j), bvj = *(const f32x4*)(ln1_b + 4 * F.lane + 256 * j);
                        v[r2][j] = (v[r2][j] * rstd) * gvj + bvj; s += (v[r2][j].x + v[r2][j].y) + (v[r2][j].z + v[r2][j].w); }
                    mean = wave_sum(s) * (1.f / D); s2 = 0.f;
#pragma unroll
                    for (int j = 0; j < 4; ++j) { v[r2][j] = v[r2][j] - mean; s2 += (v[r2][j].x * v[r2][j].x + v[r2][j].y * v[r2][j].y) + (v[r2][j].z * v[r2][j].z + v[r2][j].w * v[r2][j].w); }
                    rstd = 1.f / sqrtf(wave_sum(s2) * (1.f / D) + LN_EPS);
                    GAS unsigned* o8 = (GAS unsigned*)((unsigned char*)XN2 + (size_t)m * D) + F.lane;
#pragma unroll
                    for (int j = 0; j < 4; ++j) { const f32x4 svj = *(const f32x4*)(sc + 4 * F.lane + 256 * j), hvj = *(const f32x4*)(sh + 4 * F.lane + 256 * j);
                        const f32x4 h = (v[r2][j] * rstd) * (svj + 1.0f) + hvj; o8[64 * j] = pk4_fp8(h.x, h.y, h.z, h.w);
                        LAS float* hp = H2 + lr * 1025 + 4 * F.lane + 256 * j; hp[0] = h.x; hp[1] = h.y; hp[2] = h.z; hp[3] = h.w; }
                    asm volatile("" ::: "memory");
                }
            }
            __syncthreads();
            f32x16 acc = f32x16{};
#pragma unroll
            for (int kk = 0; kk < 64; ++kk) acc = __builtin_amdgcn_mfma_f32_32x32x2f32(H2[i32 * 1025 + kb + 2 * kk + kh], wreg[kk], acc, 0, 0, 0);
            __syncthreads();
#pragma unroll
            for (int r = 0; r < 16; ++r) PART[(F.wave * 32 + ((r & 3) + 8 * (r >> 2) + 4 * kh)) * 32 + i32] = acc[r];
            __syncthreads();
#pragma unroll
            for (int q = 0; q < 2; ++q) { const int idx = F.tid + 512 * q, i = idx >> 5, e = idx & 31; float sl = b_router[e];
#pragma unroll
                for (int w = 0; w < 8; ++w) sl += PART[(w * 32 + i) * 32 + e];
                LOG[i * 33 + e] = sl; }
            __syncthreads();
            int myk[2]; unsigned lrk[2]; float mygate[2];
#pragma unroll
            for (int it2 = 0; it2 < 2; ++it2) {
                const int rowl = F.wave * 4 + 2 * it2 + kh; float cur = LOG[rowl * 33 + i32]; float bvv[4]; myk[it2] = -1;
#pragma unroll
                for (int k = 0; k < 4; ++k) { float mv = cur; int me = i32;
#pragma unroll
                    for (int off = 1; off < 32; off <<= 1) { const float ov = __shfl_xor(mv, off); const int oe = __shfl_xor(me, off); if (ov > mv || (ov == mv && oe < me)) { mv = ov; me = oe; } }
                    bvv[k] = mv; if (me == i32) { cur = -INFINITY; myk[it2] = k; } }
                float ex[4], ssum = 0.f;
#pragma unroll
                for (int k = 0; k < 4; ++k) { ex[k] = __expf(bvv[k] - bvv[0]); ssum += ex[k]; }
                const float is = 1.0f / ssum; mygate[it2] = 0.f; lrk[it2] = 0u;
#pragma unroll
                for (int k = 0; k < 4; ++k) if (myk[it2] == k) mygate[it2] = ex[k] * is;
                if (myk[it2] >= 0) lrk[it2] = __hip_atomic_fetch_add(hist + i32, 1u, __ATOMIC_RELAXED, __HIP_MEMORY_SCOPE_WORKGROUP);
            }
            __syncthreads();
            if (F.tid < 32) { const unsigned n = hist[F.tid]; hbase[F.tid] = n ? __hip_atomic_fetch_add(F.ctl + (rep_ + 1 < REPS(6) ? CW_CNT + 4096 : CW_CNT) + 64 * F.tid, n, RLX_AGENT) : 0u; }
            __syncthreads();
#pragma unroll
            for (int it2 = 0; it2 < 2; ++it2) if (myk[it2] >= 0) { const int m = tile * 32 + F.wave * 4 + 2 * it2 + kh; const int pp = (int)(hbase[i32] + lrk[it2]);
                RE[m * 4 + myk[it2]] = i32; RP[m * 4 + myk[it2]] = pp; RG[m * 4 + myk[it2]] = mygate[it2]; if (pp < ECAP) ROWTOK[i32 * ECAP + pp] = m; }
            __syncthreads();
        }
        if (BOTH(6) || rep_ + 1 < REPS(6)) GRID_BAR();
    }
    if (DLY_PH == 6) dly_t1 = __builtin_amdgcn_s_memrealtime();
    if (DLY_PH == 7) dly_t0 = __builtin_amdgcn_s_memrealtime();
    if (IN(7)) _Pragma("unroll") for (int rep_ = 0; rep_ < REPS(7); ++rep_) {
        PHASE_ENTRY();
        build_expert_tables(F);
        MoeSched S; S.A = XN2; S.W = WGU; S.rowtok = ROWTOK; S.pexp = (const LAS int*)(F.lds + L_PEXP); S.pfirst = (const LAS int*)(F.lds + L_PFIRST); S.cntl = (const LAS int*)(F.lds + L_CNT);
        S.NP = ((const LAS int*)(F.lds + L_PFIRST))[NE]; S.NT = 8; S.G = F.G; S.vcu = F.vcu; S.gather = true; S.rowb = 1024; S.wexp = (size_t)2048 * 1024; S.wtile = (size_t)128 * 1024; S.whalf = (size_t)1024 * 1024;
        EpiSwiglu E{b_gu, (unsigned char*)HB};
        pg8::gemm_phase<EpiSwiglu, MoeSched, true, true>(F.lds, S, E);
        if (BOTH(7) || rep_ + 1 < REPS(7)) GRID_BAR();
    }
    if (DLY_PH == 7) dly_t1 = __builtin_amdgcn_s_memrealtime();
    if (DLY_PH == 8) dly_t0 = __builtin_amdgcn_s_memrealtime();
    if (IN(8)) _Pragma("unroll") for (int rep_ = 0; rep_ < REPS(8); ++rep_) {
        PHASE_ENTRY();
        build_expert_tables(F);
        MoeSched S; S.A = HB; S.W = WD; S.rowtok = ROWTOK; S.pexp = (const LAS int*)(F.lds + L_PEXP); S.pfirst = (const LAS int*)(F.lds + L_PFIRST); S.cntl = (const LAS int*)(F.lds + L_CNT);
        S.NP = ((const LAS int*)(F.lds + L_PFIRST))[NE]; S.NT = 4; S.G = F.G; S.vcu = F.vcu; S.gather = false; S.rowb = 1024; S.wexp = (size_t)1024 * 1024; S.wtile = (size_t)256 * 1024; S.whalf = (size_t)128 * 1024;
        EpiDown E{b_dn, (unsigned char*)YB};
        pg8::gemm_phase<EpiDown, MoeSched, true, true>(F.lds, S, E);
        if (BOTH(8) || rep_ + 1 < REPS(8)) GRID_BAR();
    }
    if (DLY_PH == 8) dly_t1 = __builtin_amdgcn_s_memrealtime();
    if (DLY_PH == 9) dly_t0 = __builtin_amdgcn_s_memrealtime();
    if (IN(9)) _Pragma("unroll") for (int rep_ = 0; rep_ < REPS(9); ++rep_) {
        PHASE_ENTRY();
        build_expert_tables(F);
        const LAS int* pfirst = (const LAS int*)(F.lds + L_PFIRST);
        const unsigned bad = __hip_atomic_load(F.ctl + CW_BAR + XB_TMO, RLX_AGENT);
        for (int m0 = gw; m0 < M; m0 += 2 * NGW) {
            f32x4 tv[2][4]; v2u tgv[2][4]; unsigned yv[2][4][4]; float gk[2][4]; float mu[2], rs[2];
#pragma unroll
            for (int q = 0; q < 2; ++q) { const int m = m0 + q * NGW; if (m < M) {
                mu[q] = X1[2 * (size_t)m]; rs[q] = X1[2 * (size_t)m + 1];
#pragma unroll
                for (int k = 0; k < 4; ++k) { const int e = __builtin_amdgcn_readfirstlane(RE[m * 4 + k]), pp = __builtin_amdgcn_readfirstlane(RP[m * 4 + k]); gk[q][k] = RG[m * 4 + k];
                    const size_t yrow = (size_t)pfirst[e] * 256 + (size_t)pp; const GAS unsigned* yp = (const GAS unsigned*)((const unsigned char*)YB + yrow * 1024) + F.lane;
#pragma unroll
                    for (int j = 0; j < 4; ++j) yv[q][k][j] = yp[64 * j]; }
#pragma unroll
                for (int j = 0; j < 4; ++j) { tv[q][j] = ((const GAS f32x4*)(x + (size_t)m * D) + F.lane)[64 * j]; tgv[q][j] = ((const GAS v2u*)((const bf16*)T1 + (size_t)m * D) + F.lane)[64 * j]; } } }
#pragma unroll
            for (int q = 0; q < 2; ++q) { const int m = m0 + q * NGW; if (m < M) {
                const int b = m >> 11; const float* g2 = MOD + (size_t)b * 6144 + 5120;
                f32x4 v[4]; float s = 0.f;
#pragma unroll
                for (int j = 0; j < 4; ++j) { f32x4 a = (f32x4){0.f, 0.f, 0.f, 0.f};
#pragma unroll
                    for (int k = 0; k < 4; ++k) { typedef float f32x2s __attribute__((ext_vector_type(2))); const int w = (int)yv[q][k][j]; const f32x2s lo2 = __builtin_amdgcn_cvt_pk_f32_fp8(w, false), hi2 = __builtin_amdgcn_cvt_pk_f32_fp8(w, true);
                        a += (f32x4){lo2.x, lo2.y, hi2.x, hi2.y} * gk[q][k]; }
                    const f32x4 g1v = *(const f32x4*)(ln1_g + 4 * F.lane + 256 * j), b1v = *(const f32x4*)(ln1_b + 4 * F.lane + 256 * j), gv = *(const f32x4*)(g2 + 4 * F.lane + 256 * j);
                    const f32x4 t1 = tv[q][j] * DN_ALPHA + (f32x4){bfl(tgv[q][j].x), bfh(tgv[q][j].x), bfl(tgv[q][j].y), bfh(tgv[q][j].y)};
                    const f32x4 xv = ((t1 - mu[q]) * rs[q]) * g1v + b1v;
                    v[j] = xv * DN_ALPHA + gv * a; s += (v[j].x + v[j].y) + (v[j].z + v[j].w); }
                const float mean = wave_sum(s) * (1.f / D); float s2 = 0.f;
#pragma unroll
                for (int j = 0; j < 4; ++j) { v[j] = v[j] - mean; s2 += (v[j].x * v[j].x + v[j].y * v[j].y) + (v[j].z * v[j].z + v[j].w * v[j].w); }
                const float rstd = 1.f / sqrtf(wave_sum(s2) * (1.f / D) + LN_EPS);
#pragma unroll
                for (int j = 0; j < 4; ++j) { const f32x4 gv = *(const f32x4*)(ln2_g + 4 * F.lane + 256 * j), bv = *(const f32x4*)(ln2_b + 4 * F.lane + 256 * j);
                    f32x4 o = (v[j] * rstd) * gv + bv; if (bad) { const float qn = __builtin_nanf(""); o = (f32x4){qn, qn, qn, qn}; }
                    ((GAS f32x4*)(out + (size_t)m * D) + F.lane)[64 * j] = o; } } }
        }
    }
    if (DLY_PH >= 0) { if (DLY_PH == 9) dly_t1 = __builtin_amdgcn_s_memrealtime(); const unsigned long long te = __builtin_amdgcn_s_memrealtime(); while (__builtin_amdgcn_s_memrealtime() - te < dly_t1 - dly_t0) __builtin_amdgcn_s_sleep(8); }
#undef IN
#undef BOTH
}

extern "C" void kernel_launch(void* const* d_in, const int* in_sizes, int n_in, void* d_out, int out_size, void* d_ws, size_t ws_size, hipStream_t stream) {
    static int grid = 0;
    if (grid == 0) {
        if (n_in != 25 || in_sizes[0] != M * D || out_size != M * D || ws_size < WS_END) { fprintf(stderr, "kernel_launch: unexpected shapes (n_in %d, in0 %d, out %d, ws %zu); nothing launched\n", n_in, n_in > 0 ? in_sizes[0] : -1, out_size, ws_size); grid = -1; return; }
        int dev = 0, cus = 0, per_cu = 0;
        if (hipGetDevice(&dev) != hipSuccess || hipDeviceGetAttribute(&cus, hipDeviceAttributeMultiprocessorCount, dev) != hipSuccess) { grid = -1; return; }
        if (hipFuncSetAttribute((const void*)mk_fwd, hipFuncAttributeMaxDynamicSharedMemorySize, LDS_BYTES) != hipSuccess) { fprintf(stderr, "kernel_launch: hipFuncSetAttribute failed\n"); grid = -1; return; }
        if (hipOccupancyMaxActiveBlocksPerMultiprocessor(&per_cu, (const void*)mk_fwd, NWAVES * 64, LDS_BYTES) != hipSuccess || per_cu < 1) { fprintf(stderr, "kernel_launch: occupancy query reports %d workgroups per CU\n", per_cu); (void)hipGetLastError(); }
        grid = cus;
    }
    if (grid < 0) return;
    if (hipMemsetAsync((char*)d_ws + WS_CTL, 0, CTL_ZERO_BYTES, stream) != hipSuccess) return;
    Args a{};
    for (int i = 0; i < 25; ++i) a.in[i] = (const float*)d_in[i];
    a.out = (float*)d_out; a.ws = (unsigned char*)d_ws;
#if MK_ONE_LAUNCH
    a.ph_lo = 0; a.ph_hi = NPHASE;
    hipLaunchKernelGGL(mk_fwd, dim3(grid), dim3(NWAVES * 64), LDS_BYTES, stream, a);
#else
    for (int p = 0; p < NPHASE; ++p) { a.ph_lo = p; a.ph_hi = p + 1; hipLaunchKernelGGL(mk_fwd, dim3(grid), dim3(NWAVES * 64), LDS_BYTES, stream, a); }
#endif
}
```

```cpp
#include <hip/hip_runtime.h>
#include <hip/hip_bf16.h>
#include <cstdio>
#include <cstdint>
#include <cmath>
#include <type_traits>

#ifndef MK_ONE_LAUNCH
#define MK_ONE_LAUNCH 1
#endif
#ifndef NAIVE_GEMM
#define NAIVE_GEMM 0
#endif
#ifndef DLY_PH
#define DLY_PH (-1)
#endif
#ifndef NAIVE_ATTN
#define NAIVE_ATTN 0
#endif

#define GAS __attribute__((address_space(1)))
#define LAS __attribute__((address_space(3)))

constexpr int NB = 8, SEQ = 2048, D = 1024, M = NB * SEQ;
constexpr int AW = 512;
constexpr int NIN = 2048;
constexpr int NE = 32, TOPK = 4, FF = 1024;
constexpr int ECAP = 16384;
constexpr int PMAX = (M * TOPK) / 256 + NE;
constexpr float LN_EPS = 1e-5f;
constexpr float DN_ALPHA = 1.189207115002721f;
constexpr float LAM_INIT = 0.2f;
constexpr float LOG2E = 1.4426950408889634f;
constexpr float QSCALE = 0.125f * LOG2E;
constexpr int NWAVES = 8;

namespace pg8 {
#define PG8_LAS __attribute__((address_space(3)))
typedef unsigned short bf16_t;
typedef short bf16x8 __attribute__((ext_vector_type(8)));
typedef float f32x4 __attribute__((ext_vector_type(4)));
typedef unsigned u32x4 __attribute__((ext_vector_type(4)));
constexpr int BM = 256, BK = 64, HALF = 128, HTB = HALF * BK * 2, STAGE_BYTES = 8 * HTB, NXCD = 8, WGM = 8;
constexpr int GK = 1024;

__host__ __device__ __forceinline__ int lds_byte(int r, int c) { const int st = (r >> 4) * 2 + (c >> 5), rr = r & 15, cc = c & 31, ob = rr * 64 + cc * 2; return st * 1024 + (ob ^ (((ob >> 9) & 1) << 5)); }
__host__ __device__ __forceinline__ void stage_rc(int b, int& R, int& C) { const int st = b / 1024, sb = b % 1024, swz = sb ^ (((sb >> 9) & 1) << 5); R = (st >> 1) * 16 + swz / 64; C = (st & 1) * 32 + (swz % 64) / 2; }
__host__ __device__ __forceinline__ int perm32(int rho) { const int n = rho >> 4, i = rho & 15; return 8 * (i >> 2) + 4 * n + (i & 3); }

struct Unit { int pm, pn, e, lrow0, cnt; };
struct Pre { f32x4 v[4]; };
__device__ __forceinline__ void asm_ld16(f32x4& d, const float* p) { asm volatile("global_load_dwordx4 %0, %1, off" : "=v"(d) : "v"((const __attribute__((address_space(1))) float*)p) : "memory"); }

__device__ __forceinline__ unsigned cvt_pk_bf16(float lo, float hi) { unsigned r; asm volatile("v_cvt_pk_bf16_f32 %0, %1, %2" : "=v"(r) : "v"(lo), "v"(hi)); return r; }
__device__ __forceinline__ float bf2f(unsigned short v) { return __uint_as_float((unsigned)v << 16); }

#if !NAIVE_GEMM
typedef int v8i32 __attribute__((ext_vector_type(8)));
typedef int v4i32 __attribute__((ext_vector_type(4)));
template <class Epi, class Sched, bool ALIGN_EPI, bool FP8 = false>
__device__ __forceinline__ void gemm_phase(PG8_LAS unsigned char* lds, const Sched& S, const Epi& E) {
    constexpr int RB = FP8 ? 1024 : 2048, nt = RB / 128;
    const int tid = threadIdx.x, wid = __builtin_amdgcn_readfirstlane(tid >> 6), lane = tid & 63, wr = wid >> 2, wc = wid & 3, fr = lane & 15, fq = lane >> 4;
    int Rr[2], Cc[2]; unsigned voffB[2];
#pragma unroll
    for (int i = 0; i < 2; ++i) { int R, C; stage_rc(tid * 16 + i * 8192, R, C); Rr[i] = R; Cc[i] = C; const int Rb = Epi::PERM ? ((R & ~31) + perm32(R & 31)) : R; voffB[i] = (unsigned)(Rb * RB + C * 2); }
    const size_t kstep = (size_t)(BK * 2);
    const size_t hB = S.b_hstep();
    const unsigned ldsw = (unsigned)wid * 1024u;
    const int aoff = lds_byte(wr * 64 + fr, fq * 8), boff = lds_byte(wc * 32 + fr, fq * 8);
#define PG8_SA(b, h) (((b) * 2 + (h)) * HTB)
#define PG8_SB(b, h) ((4 + (b) * 2 + (h)) * HTB)
#define PG8_STAGE(bufoff, gbase, voff) do { _Pragma("unroll") for (int _i = 0; _i < 2; ++_i) \
        __builtin_amdgcn_global_load_lds((const unsigned*)((const char*)(gbase) + (voff)[_i]), (PG8_LAS unsigned*)(lds + (bufoff) + ldsw + _i * 8192), 16, 0, 0); } while (0)
#define PG8_LD32(p) __builtin_shufflevector(*(const PG8_LAS v4i32*)(p), *(const PG8_LAS v4i32*)((p) + 1024), 0, 1, 2, 3, 4, 5, 6, 7)
#define PG8_LDA(dst, b, h) do { if constexpr (FP8) { _Pragma("unroll") for (int m = 0; m < 4; ++m) dst##8[m] = PG8_LD32(lds + PG8_SA(b, h) + aoff + m * 2048); } \
        else { _Pragma("unroll") for (int m = 0; m < 4; ++m) _Pragma("unroll") for (int k = 0; k < 2; ++k) dst[m][k] = *(const PG8_LAS bf16x8*)(lds + PG8_SA(b, h) + aoff + m * 2048 + k * 1024); } } while (0)
#define PG8_LDB(dst, b, h) do { if constexpr (FP8) { _Pragma("unroll") for (int n = 0; n < 2; ++n) dst##8[n] = PG8_LD32(lds + PG8_SB(b, h) + boff + n * 2048); } \
        else { _Pragma("unroll") for (int n = 0; n < 2; ++n) _Pragma("unroll") for (int k = 0; k < 2; ++k) dst[n][k] = *(const PG8_LAS bf16x8*)(lds + PG8_SB(b, h) + boff + n * 2048 + k * 1024); } } while (0)
#define PG8_CAT(x) __builtin_shufflevector(__builtin_bit_cast(v4i32, (x)[0]), __builtin_bit_cast(v4i32, (x)[1]), 0, 1, 2, 3, 4, 5, 6, 7)
#define PG8_MMA(ai, bj, At, Bt) do { __builtin_amdgcn_s_setprio(1); \
        if constexpr (FP8) { _Pragma("unroll") for (int m = 0; m < 4; ++m) _Pragma("unroll") for (int n = 0; n < 2; ++n) \
            asm volatile("v_mfma_scale_f32_16x16x128_f8f6f4 %0, %1, %2, %0, %3, %3 op_sel_hi:[0,0,0]" : "+v"(acc[ai][bj][m][n]) : "v"(Bt##8[n]), "v"(At##8[m]), "v"(one8)); } \
        else { _Pragma("unroll") for (int m = 0; m < 4; ++m) _Pragma("unroll") for (int n = 0; n < 2; ++n) _Pragma("unroll") for (int k = 0; k < 2; ++k) \
            acc[ai][bj][m][n] = __builtin_amdgcn_mfma_f32_16x16x32_bf16(Bt[n][k], At[m][k], acc[ai][bj][m][n], 0, 0, 0); } \
        __builtin_amdgcn_s_setprio(0); } while (0)
#define PG8_WAIT_V(n) asm volatile("s_waitcnt vmcnt(" #n ")" ::: "memory")
#define PG8_WAIT_L(n) asm volatile("s_waitcnt lgkmcnt(" #n ")" ::: "memory")
#define PG8_BAR __builtin_amdgcn_s_barrier()
#define PG8_SCHED __builtin_amdgcn_sched_barrier(0)
    Unit cur, nxt; int ui = 0; Pre pre;
    if (!S.next(0, cur)) return;
    f32x4 acc[2][2][4][2];
#pragma unroll
    for (int a = 0; a < 2; ++a)
#pragma unroll
        for (int b = 0; b < 2; ++b)
#pragma unroll
            for (int m = 0; m < 4; ++m)
#pragma unroll
                for (int n = 0; n < 2; ++n) acc[a][b][m][n] = (f32x4){0.f, 0.f, 0.f, 0.f};
    const int one8 = 0x7f7f7f7f;
    bf16x8 At[4][2], B0[2][2], B1[2][2]; v8i32 At8[4], B08[2], B18[2];
    const char* cA = S.a_base(cur); const char* cB = S.b_base(cur);
    unsigned va0[2], va1[2];
    S.a_voff(cur, Rr, Cc, va0, va1);
    PG8_STAGE(PG8_SB(0, 0), cB, voffB); PG8_STAGE(PG8_SB(0, 1), cB + hB, voffB); PG8_STAGE(PG8_SA(0, 0), cA, va0); PG8_STAGE(PG8_SA(0, 1), cA, va1);
    if (wr == 1) PG8_BAR;
    PG8_WAIT_V(2); PG8_BAR;
    PG8_STAGE(PG8_SB(1, 0), cB + kstep, voffB); PG8_STAGE(PG8_SA(1, 0), cA + kstep, va0); PG8_STAGE(PG8_SB(1, 1), cB + hB + kstep, voffB);
    PG8_WAIT_V(6); PG8_BAR;
    for (;;) {
        const bool has_next = S.next(ui + 1, nxt);
        const char* nA = has_next ? S.a_base(nxt) : cA; const char* nB = has_next ? S.b_base(nxt) : cB;
        unsigned vn0[2] = {va0[0], va0[1]}, vn1[2] = {va1[0], va1[1]}, tkn[4];
        { Unit tu = cur; if (has_next) tu = nxt; S.a_tok(tu, Rr, tkn); }
#define PG8_TRIP(LAST, t) do { \
            const char* a1 = cA + (size_t)((t) + 1) * kstep; \
            const char* a2 = (LAST) ? nA : cA + (size_t)((t) + 2) * kstep; const char* b2 = (LAST) ? nB : cB + (size_t)((t) + 2) * kstep; \
            const char* a3 = a2 + kstep; const char* b3 = b2 + kstep; \
            asm volatile("" : "+v"(voffB[0]), "+v"(voffB[1]), "+v"(va0[0]), "+v"(va0[1]), "+v"(va1[0]), "+v"(va1[1])); \
            unsigned v20[2] = {va0[0], va0[1]}, v21[2] = {va1[0], va1[1]}; \
            if (LAST) { E.pre(cur, wr, wc, fr, fq, pre); if (has_next) { S.a_voff_tok(tkn, Rr, Cc, vn0, vn1); v20[0] = vn0[0]; v20[1] = vn0[1]; v21[0] = vn1[0]; v21[1] = vn1[1]; } } \
            PG8_LDB(B0, 0, 0); PG8_LDB(B1, 0, 1); PG8_SCHED; PG8_LDA(At, 0, 0); PG8_STAGE(PG8_SA(1, 1), a1, va1); \
            PG8_WAIT_V(8); PG8_WAIT_L(0); PG8_BAR; PG8_MMA(0, 0, At, B0); PG8_MMA(0, 1, At, B1); PG8_BAR; PG8_SCHED; \
            PG8_LDA(At, 0, 1); PG8_STAGE(PG8_SB(0, 0), b2, voffB); PG8_STAGE(PG8_SB(0, 1), b2 + hB, voffB); PG8_STAGE(PG8_SA(0, 0), a2, v20); \
            PG8_WAIT_V(8); PG8_WAIT_L(0); PG8_BAR; PG8_MMA(1, 0, At, B0); PG8_MMA(1, 1, At, B1); PG8_BAR; PG8_SCHED; \
            PG8_LDB(B0, 1, 0); PG8_LDB(B1, 1, 1); PG8_SCHED; PG8_LDA(At, 1, 0); PG8_STAGE(PG8_SA(0, 1), a2, v21); \
            PG8_WAIT_V(8); PG8_WAIT_L(0); PG8_BAR; PG8_MMA(0, 0, At, B0); PG8_MMA(0, 1, At, B1); PG8_BAR; PG8_SCHED; \
            PG8_LDA(At, 1, 1); PG8_STAGE(PG8_SB(1, 0), b3, voffB); PG8_STAGE(PG8_SB(1, 1), b3 + hB, voffB); PG8_STAGE(PG8_SA(1, 0), a3, v20); \
            PG8_WAIT_V(8); PG8_WAIT_L(0); PG8_BAR; PG8_MMA(1, 0, At, B0); PG8_MMA(1, 1, At, B1); PG8_BAR; PG8_SCHED; \
        } while (0)
#pragma unroll 1
        for (int t = 0; t < nt - 2; t += 2) PG8_TRIP(0, t);
        PG8_TRIP(1, nt - 2);
#undef PG8_TRIP
        if constexpr (ALIGN_EPI) { if (wr == 0) PG8_BAR; }
        if constexpr (FP8) asm volatile("s_nop 15\n\ts_nop 15" ::: "memory");
        { int fr_ = fr, fq_ = fq; asm volatile("" : "+v"(fr_), "+v"(fq_));
          E(acc, cur, wr, wc, fr_, fq_, pre); }
        if (!has_next) break;
#pragma unroll
        for (int a = 0; a < 2; ++a)
#pragma unroll
            for (int b = 0; b < 2; ++b)
#pragma unroll
                for (int m = 0; m < 4; ++m)
#pragma unroll
                    for (int n = 0; n < 2; ++n) acc[a][b][m][n] = (f32x4){0.f, 0.f, 0.f, 0.f};
        cur = nxt; cA = nA; cB = nB; va0[0] = vn0[0]; va0[1] = vn0[1]; va1[0] = vn1[0]; va1[1] = vn1[1]; ++ui;
        if constexpr (ALIGN_EPI) { if (wr == 1) PG8_BAR; }
    }
    PG8_WAIT_V(0);
    if constexpr (!ALIGN_EPI) { if (wr == 0) PG8_BAR; }
    PG8_BAR;
#undef PG8_SA
#undef PG8_SB
#undef PG8_STAGE
#undef PG8_LDA
#undef PG8_LD32
#undef PG8_LDB
#undef PG8_MMA
#undef PG8_CAT
#undef PG8_WAIT_V
#undef PG8_WAIT_L
#undef PG8_BAR
#undef PG8_SCHED
}
#else
template <class Epi, class Sched, bool ALIGN_EPI, bool FP8 = false>
__device__ __forceinline__ void gemm_phase(PG8_LAS unsigned char*, const Sched& S, const Epi& E) {
    constexpr int K = GK;
    const int tid = threadIdx.x, wid = __builtin_amdgcn_readfirstlane(tid >> 6), lane = tid & 63, wr = wid >> 2, wc = wid & 3, fr = lane & 15, fq = lane >> 4;
    Unit u;
    for (int ui = 0; S.next(ui, u); ++ui) {
        f32x4 acc[2][2][4][2];
#pragma unroll
        for (int ai = 0; ai < 2; ++ai)
#pragma unroll
            for (int bj = 0; bj < 2; ++bj) {
                const bf16_t* ar[4]; const bf16_t* br[2][4];
#pragma unroll
                for (int m = 0; m < 4; ++m) ar[m] = S.a_row(u, ai * 128 + wr * 64 + m * 16 + fr);
#pragma unroll
                for (int n = 0; n < 2; ++n)
#pragma unroll
                    for (int x = 0; x < 4; ++x) br[n][x] = S.b_row(u, bj * 128 + wc * 32 + (Epi::PERM ? 8 * fq + 4 * n + x : 16 * n + 4 * fq + x));
                float s[4][2][4];
#pragma unroll
                for (int m = 0; m < 4; ++m)
#pragma unroll
                    for (int n = 0; n < 2; ++n)
#pragma unroll
                        for (int x = 0; x < 4; ++x) s[m][n][x] = 0.f;
                for (int k0 = 0; k0 < K; k0 += 8) {
                    bf16x8 av[4], bv[2][4];
#pragma unroll
                    for (int m = 0; m < 4; ++m) av[m] = *(const bf16x8*)(ar[m] + k0);
#pragma unroll
                    for (int n = 0; n < 2; ++n)
#pragma unroll
                        for (int x = 0; x < 4; ++x) bv[n][x] = *(const bf16x8*)(br[n][x] + k0);
#pragma unroll
                    for (int kk = 0; kk < 8; ++kk)
#pragma unroll
                        for (int m = 0; m < 4; ++m) { const float a = bf2f((unsigned short)av[m][kk]);
#pragma unroll
                            for (int n = 0; n < 2; ++n)
#pragma unroll
                                for (int x = 0; x < 4; ++x) s[m][n][x] += a * bf2f((unsigned short)bv[n][x][kk]); }
                }
#pragma unroll
                for (int m = 0; m < 4; ++m)
#pragma unroll
                    for (int n = 0; n < 2; ++n) acc[ai][bj][m][n] = (f32x4){s[m][n][0], s[m][n][1], s[m][n][2], s[m][n][3]};
            }
        Pre pre; E.pre(u, wr, wc, fr, fq, pre); asm volatile("s_waitcnt vmcnt(0)" ::: "memory"); E(acc, u, wr, wc, fr, fq, pre);
    }
}
#endif
}

constexpr size_t MiB = 1u << 20;
constexpr size_t WS_CTL = 0, CTL_ZERO_BYTES = 1 * MiB;
constexpr size_t WS_MOD = 1 * MiB;
constexpr size_t WS_WPOOL = 1 * MiB + 512 * 1024;
constexpr size_t WS_WIN = 2 * MiB;
constexpr size_t WS_WOUT = 6 * MiB;
constexpr size_t WS_WGU = 8 * MiB;
constexpr size_t WS_WD = 136 * MiB;
constexpr size_t WS_XN = 200 * MiB;
constexpr size_t WS_Q = 232 * MiB, WS_K = 248 * MiB, WS_V = 264 * MiB, WS_U = 280 * MiB;
constexpr size_t WS_OA = 296 * MiB;
constexpr size_t WS_MIX = 328 * MiB;
constexpr size_t WS_T1 = 360 * MiB;
constexpr size_t WS_X1 = 424 * MiB;
constexpr size_t WS_XN2 = 488 * MiB;
constexpr size_t WS_RE = 520 * MiB, WS_RP = 521 * MiB, WS_RG = 522 * MiB;
constexpr size_t WS_ROWTOK = 524 * MiB;
constexpr size_t WS_H = 528 * MiB;
constexpr size_t WS_Y = 672 * MiB;
constexpr size_t WS_MODP = 816 * MiB;
constexpr size_t WS_END = 818 * MiB;
static_assert((size_t)PMAX * 256 * 1024 * 2 == 144 * MiB, "H / Y size");
constexpr int CW_TMO = 0, CW_CODE = 1;
constexpr int CW_BAR = 4096;
constexpr int CW_AQ = 6144;
constexpr int CW_CNT = 8192;

constexpr int RING_BYTES = 131072;
constexpr int LDS_BYTES = 147456;
constexpr int LCTL_OFF = 139264;
constexpr int L_MISC = LCTL_OFF;
constexpr int L_CNT = LCTL_OFF + 128;
constexpr int L_PFIRST = LCTL_OFF + 256;
constexpr int L_PEXP = LCTL_OFF + 512;
constexpr int L_HIST = LCTL_OFF + 512 + 4 * 320;
constexpr int L_TB = 106496;
static_assert(L_TB + 4 * 704 * 4 <= RING_BYTES && L_HIST + 256 <= LDS_BYTES && PMAX <= 320, "LDS map");

typedef unsigned short bf16;
typedef unsigned v4u __attribute__((ext_vector_type(4)));
typedef unsigned v2u __attribute__((ext_vector_type(2)));
typedef float f32x4 __attribute__((ext_vector_type(4)));
typedef float f32x16 __attribute__((ext_vector_type(16)));
typedef short bf16x8 __attribute__((ext_vector_type(8)));
typedef GAS unsigned gu32;
#define RLX_AGENT __ATOMIC_RELAXED, __HIP_MEMORY_SCOPE_AGENT
#define LDS_WAIT() asm volatile("s_waitcnt lgkmcnt(0)" ::: "memory")
#define VM_WAIT() asm volatile("s_waitcnt vmcnt(0)" ::: "memory")
__device__ __forceinline__ unsigned f2bf(float f) { unsigned u = __builtin_bit_cast(unsigned, f); return (u + 0x7fffu + ((u >> 16) & 1u)) >> 16; }
__device__ __forceinline__ unsigned pk2(float lo, float hi) { return f2bf(lo) | (f2bf(hi) << 16); }
__device__ __forceinline__ float bfl(unsigned w) { return __uint_as_float(w << 16); }
__device__ __forceinline__ float bfh(unsigned w) { return __uint_as_float(w & 0xffff0000u); }

namespace attn_body {
using bf16=__hip_bfloat16;
using bf16x8=__attribute__((ext_vector_type(8)))short;
using s16x4=__attribute__((ext_vector_type(4)))short;
using f32x16=__attribute__((ext_vector_type(16)))float;
using u32x4=__attribute__((ext_vector_type(4)))unsigned;
constexpr int SEQ=2048,DH=64,PQ=512,PO=1024;
constexpr int NW=8,QBLK=32,QB=QBLK*NW,KVBLK=64,NQB=SEQ/QB;
__device__ __forceinline__ int crow(int r,int hi){return (r&3)+8*(r>>2)+4*hi;}
#define SBAR() __builtin_amdgcn_sched_barrier(0)
constexpr int TBN=704, TBOFF=447;
__device__ __forceinline__ void bandinit(f32x16&p0,f32x16&p1,int t,int q0,int wid,int r32,int hi,const __attribute__((address_space(3))) float*tb){
  const __attribute__((address_space(3))) float*tp=tb+(64*t+4*hi-(q0+32*wid+r32)+TBOFF);
  #pragma unroll
  for(int r=0;r<16;++r){p0[r]=tp[(r&3)+8*(r>>2)]; p1[r]=tp[(r&3)+8*(r>>2)+32];}
}
__device__ __forceinline__ void bandpost(f32x16&p0,f32x16&p1,const f32x16&negm,int t,int q0,int wid){
  const float nm=(t>(q0>>6)+(wid>>1))?-INFINITY:negm[0];
  #pragma unroll
  for(int r=0;r<16;++r){p0[r]+=nm;p1[r]+=nm;}
}
constexpr int NSLOT=3, SLOTB=8192;
constexpr int LDS_K=0, LDS_V=NSLOT*SLOTB, LDS_WS=2*NSLOT*SLOTB, LDS_OST=LDS_WS+NW*64*4, LDS_BYTES=LDS_OST+NW*4096;
__device__ __forceinline__ void glds16(const void*gsrc,unsigned lds_dst){unsigned keep;
  asm volatile("s_mov_b32 %0, m0\n\ts_mov_b32 m0, %2\n\ts_nop 0\n\tglobal_load_lds_dwordx4 %1, off\n\ts_mov_b32 m0, %0":"=&s"(keep):"v"(gsrc),"s"(lds_dst):"memory");}
__device__ __forceinline__ float max3f(float a,float b,float c){float r;asm("v_max3_f32 %0, %1, %2, %3":"=v"(r):"v"(a),"v"(b),"v"(c));return r;}
__device__ __forceinline__ float max2f(float a,float b){float r;asm("v_max_f32_e32 %0, %1, %2":"=v"(r):"v"(a),"v"(b));return r;}
__device__ __forceinline__ float fadd_s(float a,float b){float r;asm("v_add_f32_e32 %0, %1, %2":"=v"(r):"v"(a),"v"(b));return r;}
__device__ __forceinline__ float fsub_s(float a,float b){float r;asm("v_sub_f32_e32 %0, %1, %2":"=v"(r):"v"(a),"v"(b));return r;}
typedef float f32x2_t __attribute__((ext_vector_type(2))); typedef __bf16 bf16x2_t __attribute__((ext_vector_type(2)));
__device__ __forceinline__ unsigned cvtpk_s(float lo,float hi){f32x2_t v={lo,hi};bf16x2_t b=__builtin_convertvector(v,bf16x2_t);return __builtin_bit_cast(unsigned,b);}
#define WAIT_BAR(N) asm volatile("s_waitcnt vmcnt(" #N ") lgkmcnt(0)\n\ts_barrier":::"memory")

__device__ __forceinline__ void qkt(f32x16&p0,f32x16&p1,const char*Kslot,const bf16x8*qr,int r32,int hi){
  const char*kb=Kslot+hi*1024+r32*16;
  #pragma unroll
  for(int d0=0;d0<4;++d0){
    const bf16x8 b0=*reinterpret_cast<const bf16x8*>(kb+d0*2048);
    const bf16x8 b1=*reinterpret_cast<const bf16x8*>(kb+d0*2048+512);
    p0=__builtin_amdgcn_mfma_f32_32x32x16_bf16(b0,qr[d0],p0,0,0,0);p1=__builtin_amdgcn_mfma_f32_32x32x16_bf16(b1,qr[d0],p1,0,0,0);}
}
typedef __attribute__((address_space(3))) const char* lds_cptr;
typedef short v4i16_t __attribute__((ext_vector_type(4)));
__device__ __forceinline__ void kload8(bf16x8*kf,lds_cptr kp){
  kf[0]=*(const __attribute__((address_space(3))) bf16x8*)(kp);      kf[1]=*(const __attribute__((address_space(3))) bf16x8*)(kp+512);
  kf[2]=*(const __attribute__((address_space(3))) bf16x8*)(kp+2048); kf[3]=*(const __attribute__((address_space(3))) bf16x8*)(kp+2560);
  kf[4]=*(const __attribute__((address_space(3))) bf16x8*)(kp+4096); kf[5]=*(const __attribute__((address_space(3))) bf16x8*)(kp+4608);
  kf[6]=*(const __attribute__((address_space(3))) bf16x8*)(kp+6144); kf[7]=*(const __attribute__((address_space(3))) bf16x8*)(kp+6656);
}
__device__ __forceinline__ void kload2(bf16x8*kf,lds_cptr kp,int j){ kf[2*j]=*(const __attribute__((address_space(3))) bf16x8*)(kp+j*2048); kf[2*j+1]=*(const __attribute__((address_space(3))) bf16x8*)(kp+j*2048+512); }
__device__ __forceinline__ s16x4 vtr(lds_cptr p){ return __builtin_bit_cast(s16x4,__builtin_amdgcn_ds_read_tr16_b64_v4i16((__attribute__((address_space(3))) v4i16_t*)p)); }
__device__ __forceinline__ float rowmax(const f32x16&p0,const f32x16&p1){
  float a=max3f(p0[0],p0[1],p1[0]),b=max3f(p0[2],p0[3],p1[1]);a=max3f(a,p1[2],p1[3]);
  #pragma unroll
  for(int r=4;r<16;r+=4){a=max3f(a,p0[r],p0[r+1]);b=max3f(b,p0[r+2],p0[r+3]);a=max3f(a,p1[r],p1[r+1]);b=max3f(b,p1[r+2],p1[r+3]);}
  const float m=max2f(a,b);
  auto rr=__builtin_amdgcn_permlane32_swap(__float_as_uint(m),__float_as_uint(m),false,false);
  return max2f(__uint_as_float(rr[0]),__uint_as_float(rr[1]));
}
__device__ __forceinline__ void pv(f32x16*o,int vb,bf16x8 pa0,bf16x8 pa1,bf16x8 pa2,bf16x8 pa3){
  #pragma unroll
  for(int d0=0;d0<2;++d0){s16x4 lo[4],hi[4];
    #pragma unroll
    for(int ks=0;ks<4;++ks){
      asm volatile("ds_read_b64_tr_b16 %0,%1 offset:%c2":"=&v"(lo[ks]):"v"(vb),"i"(d0*4096+ks*1024):"memory");
      asm volatile("ds_read_b64_tr_b16 %0,%1 offset:%c2":"=&v"(hi[ks]):"v"(vb),"i"(d0*4096+ks*1024+512):"memory");}
    asm volatile("s_waitcnt lgkmcnt(0)":::"memory");SBAR();
    #define PK(k) (bf16x8){lo[k][0],lo[k][1],lo[k][2],lo[k][3],hi[k][0],hi[k][1],hi[k][2],hi[k][3]}
    o[d0]=__builtin_amdgcn_mfma_f32_32x32x16_bf16(pa0,PK(0),o[d0],0,0,0);
    o[d0]=__builtin_amdgcn_mfma_f32_32x32x16_bf16(pa1,PK(1),o[d0],0,0,0);
    o[d0]=__builtin_amdgcn_mfma_f32_32x32x16_bf16(pa2,PK(2),o[d0],0,0,0);
    o[d0]=__builtin_amdgcn_mfma_f32_32x32x16_bf16(pa3,PK(3),o[d0],0,0,0);
    #undef PK
  }
}
#define ATTN_STORE16(p,v) (*(u32x4*)(p)=(v))
template<int THRL> __device__ __forceinline__ void attn_unit(int b,int j,int vh,int qb,const bf16*Q,const bf16*__restrict__ K,const bf16*__restrict__ V,bf16*O,char*shm,const __attribute__((address_space(3))) float*tbh){
  int tid_=threadIdx.x; asm volatile("":"+v"(tid_));
  const int tid=tid_,lane=tid&63,r32=lane&31,hi=lane>>5; const int wid=__builtin_amdgcn_readfirstlane(tid>>6);
  const long rowbase=(long)b*SEQ; const int q0=qb*QB;
  const bf16*Qw=Q+(rowbase+q0+wid*QBLK)*PQ+j*DH;
  const bf16*Kh=K+rowbase*PQ+j*DH,*Vh=V+rowbase*PQ+(j>>1)*128+vh*64;
  const unsigned lds0=(unsigned)(uintptr_t)shm;
  float*wsf=(float*)(shm+LDS_WS)+wid*64;
  const bf16*ksrc=Kh+(long)lane*PQ+wid*8;
  const bf16*vsrc=Vh+(long)(16*(wid&3)+(lane>>2))*PQ+(wid>>2)*32+(lane&3)*8;
  const unsigned kdst=lds0+LDS_K+wid*1024, vdst=lds0+LDS_V+wid*1024;
  #define DMA_K(t,slot) glds16(ksrc+(long)(t)*KVBLK*PQ,(unsigned)__builtin_amdgcn_readfirstlane(kdst+(slot)))
  #define DMA_V(t,slot) glds16(vsrc+(long)(t)*KVBLK*PQ,(unsigned)__builtin_amdgcn_readfirstlane(vdst+(slot)))
  const int vb0=(int)(lds0+LDS_V)+((lane>>4)&1)*32+(lane&3)*8+(4*hi+((lane&15)>>2))*64;
  const char*Kbase=shm+LDS_K; bf16x8 kf[8];
  const lds_cptr shm3=(lds_cptr)shm; const lds_cptr kp0=shm3+LDS_K+hi*1024+r32*16; const lds_cptr vp0=shm3+LDS_V+((lane>>4)&1)*32+(lane&3)*8+(4*hi+((lane&15)>>2))*64;
  const int NT=(q0+QB)/KVBLK;
  DMA_K(0,0);DMA_V(0,0);DMA_K(1,SLOTB);
  bf16x8 qr[4];
  #pragma unroll
  for(int d0=0;d0<4;++d0)qr[d0]=*reinterpret_cast<const bf16x8*>(&Qw[(long)r32*PQ+d0*16+hi*8]);
  float mhat=0.f,l_reg=0.f;f32x16 o[2];o[0]=f32x16{};o[1]=f32x16{};f32x16 negm=f32x16{};asm volatile("":"+v"(negm));
  #define BINIT(C0,C1,t) bandinit(C0,C1,(t),q0,wid,r32,hi,tbh)
  bool resc=false;
  #define START(P0,P1) do{ const float rm=rowmax(P0,P1); resc=false; \
    { const float dl=rm; mhat=fadd_s(mhat,dl); \
      _Pragma("unroll") for(int r=0;r<16;++r){P0[r]=fsub_s(P0[r],dl);P1[r]=fsub_s(P1[r],dl);} \
      _Pragma("unroll") for(int r=0;r<16;++r)negm[r]=-mhat; asm volatile("":"+v"(negm)); } \
    _Pragma("unroll") for(int r=0;r<16;++r)P0[r]=__builtin_amdgcn_exp2f(P0[r]); }while(0)
  #define RESC() do{ if(resc){ asm volatile("s_waitcnt lgkmcnt(0)":::"memory"); \
      _Pragma("unroll") for(int d_=0;d_<2;++d_) _Pragma("unroll") for(int r=0;r<16;++r)o[d_][r]*=wsf[crow(r,hi)]; } }while(0)
  f32x16 pA0,pA1,pB0,pB1;
  int sl_prev=0,sl_cur=0,sl_next=SLOTB;
  #define ROT() do{sl_prev=sl_cur;sl_cur=sl_next;sl_next=(sl_next==(NSLOT-1)*SLOTB)?0:sl_next+SLOTB;}while(0)
  DMA_K(2,2*SLOTB);
  WAIT_BAR(3);
  if(NT<=7){BINIT(pA0,pA1,0);}else{pA0=f32x16{};pA1=f32x16{};}
  qkt(pA0,pA1,Kbase,qr,r32,hi);asm volatile("s_nop 15\n\ts_nop 7":"+v"(pA0),"+v"(pA1));
  START(pA0,pA1);
  _Pragma("unroll") for(int r=0;r<16;++r)pA1[r]=__builtin_amdgcn_exp2f(pA1[r]);
  WAIT_BAR(0);
  DMA_K(3,0);DMA_V(1,SLOTB);
  ROT();
  kload8(kf,kp0+sl_cur);
  WAIT_BAR(2);
  s16x4 vlo[8],vhi[8]; u32x4 pw0,pw1,pw2,pw3;
  #define PKW(P,B) cvtpk_s(P[B],P[B+1])
  #define PAF(k) __builtin_bit_cast(bf16x8,pw##k)
  #define VFR(i) (bf16x8){vlo[i][0],vlo[i][1],vlo[i][2],vlo[i][3],vhi[i][0],vhi[i][1],vhi[i][2],vhi[i][3]}
  #define PIN(x) asm volatile("":"+v"(x))
  #define MX3(a,b,c) __builtin_fmaxf(__builtin_fmaxf((a),(b)),(c))
  #define GAPA(MF,A0,A1,A2,A3,W0,W1,PW) do{ MF; sacc+=A0; sacc+=A1; sacc+=A2; sacc+=A3; PIN(sacc); W0; W1; PIN(PW); SBAR(); }while(0)
  #define EX(v) __builtin_amdgcn_exp2f(v)
  #define GAPB(MF,X,B) do{ MF; X[B]=EX(X[B]); X[B+1]=EX(X[B+1]); X[B+2]=EX(X[B+2]); X[B+3]=EX(X[B+3]); PIN(X); SBAR(); }while(0)
  #define VRD(i) do{ vlo[i]=vtr(vp_+(((i)>>2)*4096+((i)&3)*1024)); vhi[i]=vtr(vp_+(((i)>>2)*4096+((i)&3)*1024+512)); }while(0)
  #define KRD(G,j) do{ if(G){ kload2(kf,kp0+sl_next,j); SBAR(); } }while(0)
  #define STEP(C0,C1,P0,P1,t,GK,GV,GL,PRE,I0,I1,POST) do{ SBAR(); PRE; SBAR(); \
    const lds_cptr vp_=vp0+sl_prev; \
    VRD(0); SBAR(); float sacc=(P0[0]+P0[1]); \
    GAPA(C0=__builtin_amdgcn_mfma_f32_32x32x16_bf16(kf[0],qr[0],I0,0,0,0), P0[2],P0[3],P0[4],P0[5],     pw0[0]=PKW(P0,0), pw0[1]=PKW(P0,2), pw0); \
    VRD(4); SBAR(); GAPA(C1=__builtin_amdgcn_mfma_f32_32x32x16_bf16(kf[1],qr[0],I1,0,0,0), P0[6],P0[7],P0[8],P0[9],     pw0[2]=PKW(P0,4), pw0[3]=PKW(P0,6), pw0); \
    VRD(1); SBAR(); GAPA(C0=__builtin_amdgcn_mfma_f32_32x32x16_bf16(kf[2],qr[1],C0,0,0,0),   P0[10],P0[11],P0[12],P0[13], pw1[0]=PKW(P0,8), pw1[1]=PKW(P0,10), pw1); \
    VRD(5); SBAR(); GAPA(C1=__builtin_amdgcn_mfma_f32_32x32x16_bf16(kf[3],qr[1],C1,0,0,0),   P0[14],P0[15],P1[0],P1[1],   pw1[2]=PKW(P0,12),pw1[3]=PKW(P0,14), pw1); \
    VRD(2); SBAR(); GAPA(C0=__builtin_amdgcn_mfma_f32_32x32x16_bf16(kf[4],qr[2],C0,0,0,0),   P1[2],P1[3],P1[4],P1[5],     pw2[0]=PKW(P1,0), pw2[1]=PKW(P1,2), pw2); \
    VRD(6); SBAR(); GAPA(C1=__builtin_amdgcn_mfma_f32_32x32x16_bf16(kf[5],qr[2],C1,0,0,0),   P1[6],P1[7],P1[8],P1[9],     pw2[2]=PKW(P1,4), pw2[3]=PKW(P1,6), pw2); \
    VRD(3); SBAR(); GAPA(C0=__builtin_amdgcn_mfma_f32_32x32x16_bf16(kf[6],qr[3],C0,0,0,0),   P1[10],P1[11],P1[12],P1[13], pw3[0]=PKW(P1,8), pw3[1]=PKW(P1,10), pw3); \
    VRD(7); SBAR(); GAPA(C1=__builtin_amdgcn_mfma_f32_32x32x16_bf16(kf[7],qr[3],C1,0,0,0),   P1[14],P1[15],0.f,0.f,       pw3[2]=PKW(P1,12),pw3[3]=PKW(P1,14), pw3); \
    l_reg+=sacc; \
    if(GK){DMA_K((t)+3,sl_cur);} if(GV){DMA_V((t)+1,sl_next);} \
    POST; \
    { float a=MX3(C0[0],C0[1],C1[0]),b=MX3(C0[2],C0[3],C1[1]); a=MX3(a,C1[2],C1[3]); \
      _Pragma("unroll") for(int r=4;r<16;r+=4){a=MX3(a,C0[r],C0[r+1]);b=MX3(b,C0[r+2],C0[r+3]);a=MX3(a,C1[r],C1[r+1]);b=MX3(b,C1[r+2],C1[r+3]);} \
      float rm=__builtin_fmaxf(a,b); { auto rr=__builtin_amdgcn_permlane32_swap(__float_as_uint(rm),__float_as_uint(rm),false,false); rm=__builtin_fmaxf(__uint_as_float(rr[0]),__uint_as_float(rr[1])); } \
      resc=false; \
      if(__builtin_expect(__any(rm>(float)THRL),0)){ const float dl=__builtin_fmaxf(rm,0.f); mhat+=dl; \
        _Pragma("unroll") for(int r=0;r<16;++r){C0[r]-=dl;C1[r]-=dl;} \
        _Pragma("unroll") for(int r=0;r<16;++r)negm[r]=-mhat; asm volatile("":"+v"(negm)); \
        const float f=__builtin_amdgcn_exp2f(-dl); l_reg*=f; if(hi==0)wsf[r32]=f; resc=true; } } \
    SBAR(); \
    GAPB(o[0]=__builtin_amdgcn_mfma_f32_32x32x16_bf16(PAF(0),VFR(0),o[0],0,0,0), C0,0); \
    GAPB(o[1]=__builtin_amdgcn_mfma_f32_32x32x16_bf16(PAF(0),VFR(4),o[1],0,0,0), C0,4); \
    KRD(GL,0); GAPB(o[0]=__builtin_amdgcn_mfma_f32_32x32x16_bf16(PAF(1),VFR(1),o[0],0,0,0), C0,8); \
    KRD(GL,1); GAPB(o[1]=__builtin_amdgcn_mfma_f32_32x32x16_bf16(PAF(1),VFR(5),o[1],0,0,0), C0,12); \
    KRD(GL,2); GAPB(o[0]=__builtin_amdgcn_mfma_f32_32x32x16_bf16(PAF(2),VFR(2),o[0],0,0,0), C1,0); \
    KRD(GL,3); GAPB(o[1]=__builtin_amdgcn_mfma_f32_32x32x16_bf16(PAF(2),VFR(6),o[1],0,0,0), C1,4); \
    GAPB(o[0]=__builtin_amdgcn_mfma_f32_32x32x16_bf16(PAF(3),VFR(3),o[0],0,0,0), C1,8); \
    GAPB(o[1]=__builtin_amdgcn_mfma_f32_32x32x16_bf16(PAF(3),VFR(7),o[1],0,0,0), C1,12); \
    }while(0)
  int t=1;
  for(;t+7<NT;t+=2){
    STEP(pB0,pB1,pA0,pA1,t,true,true,true,,negm,negm,);     WAIT_BAR(2); RESC(); ROT();
    STEP(pA0,pA1,pB0,pB1,t+1,true,true,true,,negm,negm,);   WAIT_BAR(2); RESC(); ROT();
  }
  #define ENDW(tt) do{ if((tt)+3<NT){WAIT_BAR(2);} else if((tt)+2<NT){WAIT_BAR(1);} else {WAIT_BAR(0);} }while(0)
  for(;t+1<NT;t+=2){
    STEP(pB0,pB1,pA0,pA1,t,(t+3<NT),(t+1<NT),(t+1<NT),BINIT(pB0,pB1,t),pB0,pB1,bandpost(pB0,pB1,negm,t,q0,wid));           ENDW(t);   RESC(); ROT();
    STEP(pA0,pA1,pB0,pB1,t+1,(t+4<NT),(t+2<NT),(t+2<NT),BINIT(pA0,pA1,t+1),pA0,pA1,bandpost(pA0,pA1,negm,t+1,q0,wid));       ENDW(t+1); RESC(); ROT();
  }
  STEP(pB0,pB1,pA0,pA1,NT-1,false,false,false,BINIT(pB0,pB1,NT-1),pB0,pB1,bandpost(pB0,pB1,negm,NT-1,q0,wid)); RESC();
  { float sacc=pB0[0]+pB0[1]; _Pragma("unroll") for(int r=2;r<16;++r)sacc+=pB0[r]; _Pragma("unroll") for(int r=0;r<16;++r)sacc+=pB1[r]; l_reg+=sacc;
    pw0=(u32x4){PKW(pB0,0),PKW(pB0,2),PKW(pB0,4),PKW(pB0,6)};pw1=(u32x4){PKW(pB0,8),PKW(pB0,10),PKW(pB0,12),PKW(pB0,14)};pw2=(u32x4){PKW(pB1,0),PKW(pB1,2),PKW(pB1,4),PKW(pB1,6)};pw3=(u32x4){PKW(pB1,8),PKW(pB1,10),PKW(pB1,12),PKW(pB1,14)};
    SBAR(); pv(o,vb0+sl_cur,PAF(0),PAF(1),PAF(2),PAF(3)); }
  #undef PKW
  #undef PAF
  #undef VFR
  #undef PIN
  #undef MX3
  #undef GAPA
  #undef GAPB
  #undef EX
  #undef VRD
  #undef KRD
  #undef STEP
  #undef ENDW
  {auto rr=__builtin_amdgcn_permlane32_swap(__float_as_uint(l_reg),__float_as_uint(l_reg),false,false);l_reg=__uint_as_float(rr[0])+__uint_as_float(rr[1]);}
  if(hi==0)wsf[32+r32]=l_reg;asm volatile("s_waitcnt lgkmcnt(0)":::"memory");
  float rli[16];
  #pragma unroll
  for(int r=0;r<16;++r)rli[r]=__builtin_amdgcn_rcpf(wsf[32+crow(r,hi)]);
  bf16*Ow=O+(rowbase+q0+wid*QBLK)*PO+j*128+vh*64;
  { bf16*stg=(bf16*)(shm+LDS_OST)+wid*2048;
    #pragma unroll
    for(int r=0;r<16;++r){const int orow=crow(r,hi);
      #pragma unroll
      for(int d0=0;d0<2;++d0)stg[orow*64+d0*32+r32]=__float2bfloat16(o[d0][r]*rli[r]);}
    asm volatile("s_waitcnt lgkmcnt(0)":::"memory");
    #pragma unroll
    for(int i=0;i<4;++i){const int row=i*8+(lane>>3),ch=lane&7; const u32x4 v=*(const u32x4*)(stg+row*64+ch*8); ATTN_STORE16(Ow+(long)row*PO+ch*8,v);} }
  asm volatile("s_waitcnt lgkmcnt(0)\n\ts_barrier":::"memory");
  #undef DMA_K
  #undef DMA_V
  #undef BINIT
  #undef START
  #undef RESC
  #undef ROT
}
constexpr int ATTN_LDS_BYTES=LDS_BYTES;
#undef SBAR
#undef WAIT_BAR
}

#define XB_TMO      128
#define XB_XCNT(j)  (256  + 64 * (j))
#define XB_XSUB(j)  (1280 + 64 * (j))
#define XB_XGEN(j)  (2304 + 64 * (j))
#define XB_TOP      3328
#define XB_TOPGEN   3392
#define XCD_BAR_WORDS 3456
#define XB_SPIN_CAP (1u << 18)
__device__ __forceinline__ unsigned xb_ld(unsigned* p)              { return __hip_atomic_load(p, __ATOMIC_RELAXED, __HIP_MEMORY_SCOPE_AGENT); }
__device__ __forceinline__ unsigned xb_add(unsigned* p, unsigned v) { return __hip_atomic_fetch_add(p, v, __ATOMIC_RELAXED, __HIP_MEMORY_SCOPE_AGENT); }
__device__ __forceinline__ unsigned xb_xcc_id() { return (unsigned)__builtin_amdgcn_s_getreg((3 << 11) | 20) & 0xFu; }
#define XB_SPIN(cond, bar) do { unsigned _sp = 0; while (cond) { __builtin_amdgcn_s_sleep(1); \
    if ((++_sp & 255u) == 0u) { if (xb_ld(&(bar)[XB_TMO])) break; if (_sp > XB_SPIN_CAP) { atomicAdd(&(bar)[XB_TMO], 1u); break; } } } } while (0)
struct XcdBarrier { unsigned* bar; unsigned x; volatile LAS unsigned* st; };
__device__ __forceinline__ XcdBarrier xcd_barrier_post(unsigned* bar, volatile LAS unsigned* st) {
    XcdBarrier b; b.bar = bar; b.x = xb_xcc_id(); b.st = st;
    if (threadIdx.x == 0) (void)xb_add(&bar[XB_XCNT(b.x)], 1u);
    return b;
}
__device__ __forceinline__ void xcd_barrier_complete(unsigned* bar, unsigned x, unsigned& nloc, unsigned& nx) {
    const unsigned G = gridDim.x * gridDim.y * gridDim.z;
    unsigned sum, cnt, mine, sp = 0u;
    for (;;) {
        sum = 0u; cnt = 0u; mine = 0u;
#pragma unroll
        for (unsigned j = 0; j < 16; ++j) { const unsigned c = xb_ld(&bar[XB_XCNT(j)]); sum += c; cnt += (c > 0u) ? 1u : 0u; mine = (j == x) ? c : mine; }
        if (sum == G) break;
        __builtin_amdgcn_s_sleep(1);
        if ((++sp & 255u) == 0u) { if (xb_ld(&bar[XB_TMO])) break; if (sp > XB_SPIN_CAP) { atomicAdd(&bar[XB_TMO], 1u); break; } }
    }
    nloc = mine > 0u ? mine : 1u; nx = cnt > 0u ? cnt : 1u;
}
__device__ __forceinline__ void xcd_barrier(const XcdBarrier& b) {
    asm volatile("s_waitcnt vmcnt(0)" ::: "memory");
    __syncthreads();
    if (threadIdx.x == 0) {
        unsigned* bar = b.bar;
        __builtin_amdgcn_s_waitcnt(0);
        unsigned nloc = b.st[0], nx = b.st[1];
        if (nloc == 0u) { xcd_barrier_complete(bar, b.x, nloc, nx); b.st[0] = nloc; b.st[1] = nx; }
        const unsigned old = xb_add(&bar[XB_XSUB(b.x)], 1u);
        const unsigned gen = old / nloc;
        if (old + 1u == (gen + 1u) * nloc) {
            __builtin_amdgcn_fence(__ATOMIC_RELEASE, "agent");
            asm volatile("s_waitcnt vmcnt(0)" ::: "memory");
            const unsigned og = xb_add(&bar[XB_TOP], 1u);
            const unsigned tg = og / nx;
            if (og + 1u == (tg + 1u) * nx) xb_add(&bar[XB_TOPGEN], 1u);
            else XB_SPIN(xb_ld(&bar[XB_TOPGEN]) == tg, bar);
            __builtin_amdgcn_fence(__ATOMIC_ACQUIRE, "agent");
            xb_add(&bar[XB_XGEN(b.x)], 1u);
            asm volatile("s_waitcnt vmcnt(0)" ::: "memory");
        } else {
            XB_SPIN(xb_ld(&bar[XB_XGEN(b.x)]) == gen, bar);
            __builtin_amdgcn_fence(__ATOMIC_ACQUIRE, "agent");
            asm volatile("s_waitcnt vmcnt(0)" ::: "memory");
        }
    }
    __syncthreads();
}

struct Frame {
    LAS unsigned char* lds;
    unsigned char* ws;
    gu32* ctl;
    int tid, lane, wave;
    int vcu, G;
};
#define DPP_ADD(v, ctrl, rmask) ((v) + __builtin_bit_cast(float, __builtin_amdgcn_update_dpp(0, __builtin_bit_cast(int, (v)), (ctrl), (rmask), 0xf, false)))
__device__ __forceinline__ float row16_sum(float v) {
    v = DPP_ADD(v, 0xB1, 0xf);
    v = DPP_ADD(v, 0x4E, 0xf);
    v = DPP_ADD(v, 0x141, 0xf);
    v = DPP_ADD(v, 0x140, 0xf);
    return v;
}
__device__ __forceinline__ float wave_sum(float v) {
    v = row16_sum(v);
    v = DPP_ADD(v, 0x142, 0xa);
    v = DPP_ADD(v, 0x143, 0xc);
    return __builtin_bit_cast(float, __builtin_amdgcn_readlane(__builtin_bit_cast(int, v), 63));
}
struct TItem { const float* src; bf16* dst; int K, N; };
__device__ __forceinline__ unsigned pk4_fp8(float a, float b, float c, float d) {
    int w = __builtin_amdgcn_cvt_pk_fp8_f32(a, b, 0, false); w = __builtin_amdgcn_cvt_pk_fp8_f32(c, d, w, true); return (unsigned)w; }
constexpr float W8_SCALE = 64.0f, W8_INV = 1.0f / 64.0f;
__device__ __forceinline__ void p0_load(const TItem& t, f32x4 (&v)[8], int wave, int lane) {
    const GAS float* sp = (const GAS float*)t.src + (size_t)(8 * (2 * wave + (lane >> 5))) * t.N + 4 * (lane & 31);
#pragma unroll
    for (int i = 0; i < 8; ++i) v[i] = __builtin_nontemporal_load((const GAS f32x4*)(sp + (size_t)i * t.N));
}
__device__ __forceinline__ void p0_store(const TItem& t, const f32x4 (&v)[8], LAS unsigned char* img, int wave, int lane) {
    const int kg = 2 * wave + (lane >> 5), n4 = lane & 31;
#pragma unroll
    for (int x = 0; x < 4; ++x) { v4u w; w.x = pg8::cvt_pk_bf16(v[0][x], v[1][x]); w.y = pg8::cvt_pk_bf16(v[2][x], v[3][x]); w.z = pg8::cvt_pk_bf16(v[4][x], v[5][x]); w.w = pg8::cvt_pk_bf16(v[6][x], v[7][x]);
        *(LAS v4u*)(img + (4 * n4 + x) * 272 + kg * 16) = w; }
    asm volatile("s_waitcnt lgkmcnt(0)\n\ts_barrier" ::: "memory");
#pragma unroll
    for (int j = 0; j < 4; ++j) { const int n = 16 * wave + 4 * j + (lane >> 4), kc = lane & 15;
        const v4u o = *(const LAS v4u*)(img + n * 272 + kc * 16);
        *(GAS v4u*)(t.dst + (size_t)n * t.K + 8 * kc) = o; }
}
__device__ __forceinline__ void p0_store8(const TItem& t, const f32x4 (&v)[8], LAS unsigned char* img, int wave, int lane) {
    const int kg = 2 * wave + (lane >> 5), n4 = lane & 31;
#pragma unroll
    for (int x = 0; x < 4; ++x) { v2u w; w.x = pk4_fp8(v[0][x] * W8_SCALE, v[1][x] * W8_SCALE, v[2][x] * W8_SCALE, v[3][x] * W8_SCALE); w.y = pk4_fp8(v[4][x] * W8_SCALE, v[5][x] * W8_SCALE, v[6][x] * W8_SCALE, v[7][x] * W8_SCALE);
        *(LAS v2u*)(img + (4 * n4 + x) * 144 + kg * 8) = w; }
    asm volatile("s_waitcnt lgkmcnt(0)\n\ts_barrier" ::: "memory");
    unsigned char* dst = (unsigned char*)t.dst;
#pragma unroll
    for (int j = 0; j < 2; ++j) { const int n = 16 * wave + 8 * j + (lane >> 3), kc = lane & 7;
        const v4u o = *(const LAS v4u*)(img + n * 144 + kc * 16);
        *(GAS v4u*)(dst + (size_t)n * t.K + 16 * kc) = o; }
}
__device__ __forceinline__ int t5_bucket(int rel) {
    const int n = rel < 0 ? -rel : rel; int b;
    if (n < 8) b = n; else if (n < 12) b = 8; else if (n < 16) b = 9; else if (n < 23) b = 10; else if (n < 32) b = 11; else if (n < 46) b = 12; else if (n < 64) b = 13; else if (n < 91) b = 14; else b = 15;
    return b + (rel > 0 ? 16 : 0);
}

struct DenseSched {
    const bf16* A; const bf16* Bt; int nM, nN, nwg, G, c;
    __device__ __forceinline__ void init(const bf16* A_, const bf16* Bt_, int M_, int N_, int G_, int c_) { A = A_; Bt = Bt_; nM = M_ / 256; nN = N_ / 256; nwg = nM * nN; G = G_; c = c_; }
    __device__ __forceinline__ bool next(int i, pg8::Unit& u) const {
        const long L = (long)i * G + c; if (L >= nwg) return false;
        int wgid = (int)L; { const int q = nwg / 8, r = nwg % 8, xcd = wgid % 8, off = wgid / 8; wgid = (xcd < r ? xcd * (q + 1) : r * (q + 1) + (xcd - r) * q) + off; }
        const int nig = 8 * nN, gid = wgid / nig, fm = gid * 8, gsz = (nM - fm) < 8 ? (nM - fm) : 8;
        u.pm = fm + ((wgid % nig) % gsz); u.pn = (wgid % nig) / gsz; u.e = 0; u.lrow0 = 0; u.cnt = 0; return true;
    }
    __device__ __forceinline__ const char* a_base(const pg8::Unit& u) const { return (const char*)A + (size_t)u.pm * (256 * 1024 * 2); }
    __device__ __forceinline__ const char* b_base(const pg8::Unit& u) const { return (const char*)Bt + (size_t)u.pn * (256 * 1024 * 2); }
    __device__ __forceinline__ size_t b_hstep() const { return (size_t)128 * 1024 * 2; }
    __device__ __forceinline__ void a_voff(const pg8::Unit&, const int (&R)[2], const int (&C)[2], unsigned (&v0)[2], unsigned (&v1)[2]) const {
#pragma unroll
        for (int i = 0; i < 2; ++i) { v0[i] = (unsigned)(R[i] * 1024 + C[i]) * 2u; v1[i] = v0[i] + 128u * 1024u * 2u; } }
    __device__ __forceinline__ const bf16* a_row(const pg8::Unit& u, int r) const { return A + (size_t)(u.pm * 256 + r) * 1024; }
    __device__ __forceinline__ const bf16* b_row(const pg8::Unit& u, int c_) const { return Bt + (size_t)(u.pn * 256 + c_) * 1024; }
    __device__ __forceinline__ void a_tok(const pg8::Unit&, const int (&)[2], unsigned (&tk)[4]) const { tk[0] = tk[1] = tk[2] = tk[3] = 0u; }
    __device__ __forceinline__ void a_voff_tok(const unsigned (&)[4], const int (&R)[2], const int (&C)[2], unsigned (&v0)[2], unsigned (&v1)[2]) const {
#pragma unroll
        for (int i = 0; i < 2; ++i) { v0[i] = (unsigned)(R[i] * 1024 + C[i]) * 2u; v1[i] = v0[i] + 128u * 1024u * 2u; } }
};
struct MoeSched {
    const bf16* A; const bf16* W; const int* rowtok; const LAS int* pexp; const LAS int* pfirst; const LAS int* cntl;
    int NP, NT, G, vcu; bool gather; int rowb  ; size_t wexp  , wtile  , whalf;
    __device__ __forceinline__ bool next(int i, pg8::Unit& u) const {
        const int L = i * G + vcu; if (L >= NP * NT) return false;
        const int pi = L / NT; const int e = __builtin_amdgcn_readfirstlane(pexp[pi]);
        u.pm = pi; u.pn = L - pi * NT; u.e = e; u.lrow0 = (pi - __builtin_amdgcn_readfirstlane(pfirst[e])) * 256; u.cnt = __builtin_amdgcn_readfirstlane(cntl[e]); return true;
    }
    __device__ __forceinline__ const char* a_base(const pg8::Unit& u) const { return gather ? (const char*)A : (const char*)A + (size_t)u.pm * 256 * (size_t)rowb; }
    __device__ __forceinline__ const char* b_base(const pg8::Unit& u) const { return (const char*)W + (size_t)u.e * wexp + (size_t)u.pn * wtile; }
    __device__ __forceinline__ size_t b_hstep() const { return whalf; }
    __device__ __forceinline__ int tok_of(const pg8::Unit& u, int r) const { int lr = u.lrow0 + r; lr = lr < u.cnt ? lr : u.cnt - 1; return ((const GAS int*)rowtok)[u.e * ECAP + lr]; }
    __device__ __forceinline__ void a_tok(const pg8::Unit& u, const int (&R)[2], unsigned (&tk)[4]) const {
        if (gather) {
#pragma unroll
            for (int q = 0; q < 4; ++q) { int lr = u.lrow0 + (q >> 1) * 128 + R[q & 1]; lr = lr < u.cnt ? lr : u.cnt - 1; const GAS int* ap = (const GAS int*)rowtok + (u.e * ECAP + lr);
                asm volatile("global_load_dword %0, %1, off" : "=v"(tk[q]) : "v"(ap) : "memory"); }
        } else { tk[0] = tk[1] = tk[2] = tk[3] = 0u; } }
    __device__ __forceinline__ void a_voff_tok(const unsigned (&tk)[4], const int (&R)[2], const int (&C)[2], unsigned (&v0)[2], unsigned (&v1)[2]) const {
        if (gather) {
#pragma unroll
            for (int i = 0; i < 2; ++i) { v0[i] = tk[i] * (unsigned)rowb + (unsigned)(C[i] * 2); v1[i] = tk[2 + i] * (unsigned)rowb + (unsigned)(C[i] * 2); }
        } else {
#pragma unroll
            for (int i = 0; i < 2; ++i) { v0[i] = (unsigned)(R[i] * rowb + C[i] * 2); v1[i] = v0[i] + 128u * (unsigned)rowb; }
        } }
    __device__ __forceinline__ void a_voff(const pg8::Unit& u, const int (&R)[2], const int (&C)[2], unsigned (&v0)[2], unsigned (&v1)[2]) const {
        if (gather) {
#pragma unroll
            for (int i = 0; i < 2; ++i) { v0[i] = (unsigned)(tok_of(u, R[i]) * rowb + C[i] * 2); v1[i] = (unsigned)(tok_of(u, 128 + R[i]) * rowb + C[i] * 2); }
        } else {
#pragma unroll
            for (int i = 0; i < 2; ++i) { v0[i] = (unsigned)(R[i] * rowb + C[i] * 2); v1[i] = v0[i] + 128u * (unsigned)rowb; }
        }
    }
    __device__ __forceinline__ const bf16* a_row(const pg8::Unit& u, int r) const { return gather ? A + (size_t)tok_of(u, r) * 1024 : A + (size_t)(u.pm * 256 + r) * 1024; }
    __device__ __forceinline__ const bf16* b_row(const pg8::Unit& u, int c_) const { return (const bf16*)((const char*)W + (size_t)u.e * wexp + (size_t)u.pn * wtile + (c_ >= 128 ? whalf : 0) + (size_t)(c_ & 127) * 2048); }
};

struct EpiQKVU {
    static constexpr bool PERM = true;
    bf16* O; size_t stride;
    __device__ __forceinline__ void pre(const pg8::Unit&, int, int, int, int, pg8::Pre&) const {}
    __device__ __forceinline__ void operator()(const pg8::f32x4 (&acc)[2][2][4][2], const pg8::Unit& u, int wr, int wc, int fr, int fq, const pg8::Pre&) const {
        const int t = u.pn >> 1; const float sc = t == 0 ? QSCALE : 1.f;
        bf16* base = O + (size_t)t * stride; const int col0 = (u.pn & 1) * 256 + wc * 32 + 8 * fq; const int row0 = u.pm * 256 + wr * 64 + fr;
#pragma unroll
        for (int ai = 0; ai < 2; ++ai)
#pragma unroll
            for (int m = 0; m < 4; ++m) { bf16* rowp = base + (size_t)(row0 + ai * 128 + m * 16) * 512 + col0;
#pragma unroll
                for (int bj = 0; bj < 2; ++bj) { const pg8::f32x4 v0 = acc[ai][bj][m][0] * sc, v1 = acc[ai][bj][m][1] * sc;
                    pg8::u32x4 w; w.x = pg8::cvt_pk_bf16(v0[0], v0[1]); w.y = pg8::cvt_pk_bf16(v0[2], v0[3]); w.z = pg8::cvt_pk_bf16(v1[0], v1[1]); w.w = pg8::cvt_pk_bf16(v1[2], v1[3]);
                    *(pg8::u32x4*)(rowp + bj * 128) = w; } }
    }
};
struct EpiT1 {
    static constexpr bool PERM = true;
    const float* mod; bf16* TG;
    __device__ __forceinline__ void pre(const pg8::Unit&, int, int, int, int, pg8::Pre&) const {}
    __device__ __forceinline__ void operator()(const pg8::f32x4 (&acc)[2][2][4][2], const pg8::Unit& u, int wr, int wc, int fr, int fq, const pg8::Pre&) const {
        const int b = u.pm >> 3; const float* g1 = mod + (size_t)b * 6144 + 2048;
        const int col0 = u.pn * 256 + wc * 32 + 8 * fq;
        pg8::f32x4 gv[2][2];
#pragma unroll
        for (int bj = 0; bj < 2; ++bj)
#pragma unroll
            for (int n = 0; n < 2; ++n) gv[bj][n] = *(const pg8::f32x4*)(g1 + col0 + bj * 128 + 4 * n);
#pragma unroll
        for (int ai = 0; ai < 2; ++ai)
#pragma unroll
            for (int m = 0; m < 4; ++m) { bf16* rowp = TG + (size_t)(u.pm * 256 + ai * 128 + wr * 64 + m * 16 + fr) * 1024 + col0;
#pragma unroll
                for (int bj = 0; bj < 2; ++bj) { const pg8::f32x4 v0 = acc[ai][bj][m][0] * gv[bj][0], v1 = acc[ai][bj][m][1] * gv[bj][1];
                    pg8::u32x4 w; w.x = pg8::cvt_pk_bf16(v0[0], v0[1]); w.y = pg8::cvt_pk_bf16(v0[2], v0[3]); w.z = pg8::cvt_pk_bf16(v1[0], v1[1]); w.w = pg8::cvt_pk_bf16(v1[2], v1[3]);
                    *(pg8::u32x4*)(rowp + bj * 128) = w; } }
    }
};
struct EpiSwiglu {
    static constexpr bool PERM = true;
    const float* bgu; unsigned char* H;
    __device__ __forceinline__ void pre(const pg8::Unit& u, int, int wc, int, int fq, pg8::Pre& P) const {
        const float* bg = bgu + (size_t)u.e * 2048 + u.pn * 128 + wc * 32 + 8 * fq;
        pg8::asm_ld16(P.v[0], bg); pg8::asm_ld16(P.v[1], bg + 4); pg8::asm_ld16(P.v[2], bg + 1024); pg8::asm_ld16(P.v[3], bg + 1028); }
    __device__ __forceinline__ void operator()(const pg8::f32x4 (&acc)[2][2][4][2], const pg8::Unit& u, int wr, int wc, int fr, int fq, const pg8::Pre& P) const {
        const int c0 = u.pn * 128 + wc * 32 + 8 * fq;
        const pg8::f32x4 bgv[2] = {P.v[0], P.v[1]}, buv[2] = {P.v[2], P.v[3]};
#pragma unroll
        for (int ai = 0; ai < 2; ++ai)
#pragma unroll
            for (int m = 0; m < 4; ++m) { float r[8];
#pragma unroll
                for (int n = 0; n < 2; ++n)
#pragma unroll
                    for (int x = 0; x < 4; ++x) { const float g = fminf(acc[ai][0][m][n][x] * W8_INV + bgv[n][x], 7.0f); const float up = fminf(fmaxf(acc[ai][1][m][n][x] * W8_INV + buv[n][x], -7.0f), 7.0f);
                        const float sg = __builtin_amdgcn_rcpf(1.0f + __builtin_amdgcn_exp2f(-1.702f * LOG2E * g)); r[4 * n + x] = (up + 1.0f) * (g * sg); }
                v2u w; w.x = pk4_fp8(r[0], r[1], r[2], r[3]); w.y = pk4_fp8(r[4], r[5], r[6], r[7]);
                *(v2u*)(H + (size_t)(u.pm * 256 + ai * 128 + wr * 64 + m * 16 + fr) * 1024 + c0) = w; }
    }
};
struct EpiDown {
    static constexpr bool PERM = true;
    const float* bd; unsigned char* Y;
    __device__ __forceinline__ void pre(const pg8::Unit& u, int, int wc, int, int fq, pg8::Pre& P) const {
        const float* bp = bd + (size_t)u.e * 1024 + u.pn * 256 + wc * 32 + 8 * fq;
        pg8::asm_ld16(P.v[0], bp); pg8::asm_ld16(P.v[1], bp + 4); pg8::asm_ld16(P.v[2], bp + 128); pg8::asm_ld16(P.v[3], bp + 132); }
    __device__ __forceinline__ void operator()(const pg8::f32x4 (&acc)[2][2][4][2], const pg8::Unit& u, int wr, int wc, int fr, int fq, const pg8::Pre& P) const {
        const int c0 = u.pn * 256 + wc * 32 + 8 * fq;
        const pg8::f32x4 bv[2][2] = {{P.v[0], P.v[1]}, {P.v[2], P.v[3]}};
#pragma unroll
        for (int ai = 0; ai < 2; ++ai)
#pragma unroll
            for (int m = 0; m < 4; ++m) { unsigned char* rowp = Y + (size_t)(u.pm * 256 + ai * 128 + wr * 64 + m * 16 + fr) * 1024 + c0;
#pragma unroll
                for (int bj = 0; bj < 2; ++bj) { const pg8::f32x4 v0 = acc[ai][bj][m][0] * W8_INV + bv[bj][0], v1 = acc[ai][bj][m][1] * W8_INV + bv[bj][1];
                    v2u w; w.x = pk4_fp8(v0[0], v0[1], v0[2], v0[3]); w.y = pk4_fp8(v1[0], v1[1], v1[2], v1[3]);
                    *(v2u*)(rowp + bj * 128) = w; } }
    }
};

__device__ __forceinline__ void build_expert_tables(Frame& F) {
    LAS int* cntl = (LAS int*)(F.lds + L_CNT); LAS int* pfirst = (LAS int*)(F.lds + L_PFIRST); LAS int* pexp = (LAS int*)(F.lds + L_PEXP);
    __syncthreads();
    if (F.tid < NE) { int c = (int)__hip_atomic_load(F.ctl + CW_CNT + 64 * F.tid, RLX_AGENT); c = c < 0 ? 0 : (c > ECAP ? ECAP : c); cntl[F.tid] = c; }
    __syncthreads();
    if (F.tid == 0) { int p = 0; for (int e = 0; e < NE; ++e) { pfirst[e] = p; const int np = (cntl[e] + 255) >> 8; for (int k = 0; k < np; ++k) if (p + k < PMAX) pexp[p + k] = e; p += np; if (p > PMAX) p = PMAX; } pfirst[NE] = p; }
    __syncthreads();
}

struct Args { const float* in[25]; float* out; unsigned char* ws; int ph_lo, ph_hi; };
constexpr int NPHASE = 10;

__global__ void __launch_bounds__(NWAVES * 64, 2) mk_fwd(Args args) {
    extern __shared__ __attribute__((aligned(16))) unsigned char lds[];
    Frame F;
    F.lds = (LAS unsigned char*)lds; F.ws = args.ws; F.ctl = (gu32*)(args.ws + WS_CTL);
    F.tid = threadIdx.x; F.lane = F.tid & 63; F.wave = __builtin_amdgcn_readfirstlane(F.tid >> 6);
    F.G = gridDim.x; { const int bx = blockIdx.x; F.vcu = (F.G % 8 == 0) ? (bx % 8) * (F.G / 8) + bx / 8 : bx; }
    volatile LAS unsigned* MISC = (volatile LAS unsigned*)(F.lds + L_MISC);
    for (int u = F.tid; u < (LDS_BYTES - LCTL_OFF) / 4; u += NWAVES * 64) ((LAS unsigned*)(F.lds + LCTL_OFF))[u] = 0u;
    __syncthreads();
    XcdBarrier bar; bar.bar = (unsigned*)(F.ctl + CW_BAR); bar.x = 0; bar.st = nullptr;
#if MK_ONE_LAUNCH
    bar = xcd_barrier_post((unsigned*)(F.ctl + CW_BAR), MISC + 8);
#define GRID_BAR() xcd_barrier(bar)
#else
#define GRID_BAR() do { } while (0)
#endif
#define PHASE_ENTRY() do { int t_ = threadIdx.x; asm volatile("" : "+v"(t_)); F.tid = t_; F.lane = t_ & 63; } while (0)
    const int lo = args.ph_lo, hi = args.ph_hi;
#ifndef PH_MASK
#define PH_MASK 0x3ff
#endif
#ifndef REP_MASK
#define REP_MASK 0x0
#endif
#define REPS(k) (1 + ((REP_MASK >> (k)) & 1))
#define IN(k) (((PH_MASK >> (k)) & 1) && lo <= (k) && (k) < hi)
#define BOTH(k) (IN(k) && IN((k) + 1))
    const float* x = args.in[0]; const float* cvec = args.in[1]; const float* w_ada = args.in[2]; const float* b_ada = args.in[3]; const float* w_in = args.in[4];
    const float* lq1 = args.in[5]; const float* lk1 = args.in[6]; const float* lq2 = args.in[7]; const float* lk2 = args.in[8]; const float* subln_g = args.in[9];
    const float* rel_bias = args.in[10]; const float* w_pool = args.in[11]; const float* b_pool = args.in[12]; const float* pool_scale = args.in[13]; const float* w_out = args.in[14];
    const float* ln1_g = args.in[15]; const float* ln1_b = args.in[16]; const float* w_router = args.in[17]; const float* b_router = args.in[18];
    const float* w_gu = args.in[19]; const float* b_gu = args.in[20]; const float* w_dn = args.in[21]; const float* b_dn = args.in[22]; const float* ln2_g = args.in[23]; const float* ln2_b = args.in[24];
    float* out = args.out; unsigned char* ws = args.ws;
    float* MOD = (float*)(ws + WS_MOD); float* MODP = (float*)(ws + WS_MODP); bf16* WPOOL = (bf16*)(ws + WS_WPOOL); bf16* WIN = (bf16*)(ws + WS_WIN); bf16* WOUT = (bf16*)(ws + WS_WOUT);
    bf16* WGU = (bf16*)(ws + WS_WGU); bf16* WD = (bf16*)(ws + WS_WD); bf16* XN = (bf16*)(ws + WS_XN);
    bf16* QB = (bf16*)(ws + WS_Q); bf16* KB = (bf16*)(ws + WS_K); bf16* VB = (bf16*)(ws + WS_V); bf16* UB = (bf16*)(ws + WS_U);
    bf16* OA = (bf16*)(ws + WS_OA); bf16* MIX = (bf16*)(ws + WS_MIX); float* T1 = (float*)(ws + WS_T1); float* X1 = (float*)(ws + WS_X1); bf16* XN2 = (bf16*)(ws + WS_XN2);
    int* RE = (int*)(ws + WS_RE); int* RP = (int*)(ws + WS_RP); float* RG = (float*)(ws + WS_RG); int* ROWTOK = (int*)(ws + WS_ROWTOK);
    bf16* HB = (bf16*)(ws + WS_H); bf16* YB = (bf16*)(ws + WS_Y);
    const int gw = F.vcu * NWAVES + F.wave, NGW = F.G * NWAVES;
    unsigned long long dly_t0 = 0, dly_t1 = 0;

    if (DLY_PH == 0) dly_t0 = __builtin_amdgcn_s_memrealtime();
    if (IN(0)) _Pragma("unroll") for (int rep_ = 0; rep_ < REPS(0); ++rep_) {
        PHASE_ENTRY();
        LAS float* sil = (LAS float*)(F.lds + 3 * 34816);
        for (int i = F.tid; i < NB * D; i += NWAVES * 64) { const float v = cvec[i]; sil[i] = v / (1.0f + __expf(-v)); }
        __syncthreads();
        constexpr int I_MOD = 6144 / 16, T_IN = (D / 128) * (NIN / 128), T_OUT = (D / 128) * (D / 128), T_POOL = 4, T_GU1 = (D / 128) * (2048 / 128), T_D1 = (FF / 128) * (D / 128);
        constexpr int NTR = T_IN + T_OUT + T_POOL + NE * T_GU1 + NE * T_D1;
        for (int r = gw; r < 8 * I_MOD; r += NGW) {
            const int cgp = r % I_MOD, kc = r / I_MOD, kq = F.lane >> 4, col = cgp * 16 + (F.lane & 15); float a[NB];
#pragma unroll
            for (int b = 0; b < NB; ++b) a[b] = 0.f;
#pragma unroll 16
            for (int i = 0; i < 32; ++i) { const int k = kc * 128 + kq + 4 * i; const float w = ((const GAS float*)w_ada)[(size_t)k * 6144 + col];
#pragma unroll
                for (int b = 0; b < NB; ++b) a[b] += sil[b * D + k] * w; }
#pragma unroll
            for (int b = 0; b < NB; ++b) { a[b] += __shfl_xor(a[b], 16); a[b] += __shfl_xor(a[b], 32); }
            if (kq == 0) {
#pragma unroll
                for (int b = 0; b < NB; ++b) MODP[((size_t)kc * NB + b) * 6144 + col] = a[b]; }
        }
        for (int r0 = F.vcu; r0 < T_IN + T_OUT + T_POOL; r0 += F.G) {
            int r = r0; const float* W; bf16* WT; int K, N, item;
            if (r < T_IN) { W = w_in; WT = WIN; K = D; N = NIN; item = r; }
            else if ((r -= T_IN) < T_OUT) { W = w_out; WT = WOUT; K = D; N = D; item = r; }
            else { r -= T_OUT; W = w_pool + (size_t)r * 128 * 128; WT = WPOOL + (size_t)r * 128 * 128; K = 128; N = 128; item = 0; }
            const int nblk = N / 128, kb = item / nblk, nb = item - kb * nblk;
            TItem t; t.src = W + (size_t)(128 * kb) * N + 128 * nb; t.dst = WT + (size_t)(128 * nb) * K + 128 * kb; t.K = K; t.N = N;
            f32x4 bb[8]; p0_load(t, bb, F.wave, F.lane); p0_store(t, bb, F.lds, F.wave, F.lane);
            asm volatile("s_waitcnt lgkmcnt(0)\n\ts_barrier" ::: "memory");
        }
        __syncthreads();
        if (BOTH(0) || rep_ + 1 < REPS(0)) GRID_BAR();
    }
    if (DLY_PH == 0) dly_t1 = __builtin_amdgcn_s_memrealtime();
    if (DLY_PH == 1) dly_t0 = __builtin_amdgcn_s_memrealtime();
    if (IN(1)) _Pragma("unroll") for (int rep_ = 0; rep_ < REPS(1); ++rep_) {
        PHASE_ENTRY();
        LAS float* modl = (LAS float*)F.lds;
        for (int blk = F.vcu; blk < M / 64; blk += F.G) {
            const int b = blk >> 5; const bool first = (blk & 31) == 0;
            __syncthreads();
            for (int c = F.tid; c < (first ? 6144 : 2048); c += NWAVES * 64) { float a = b_ada[c];
#pragma unroll
                for (int kc = 0; kc < 8; ++kc) a += ((const GAS float*)MODP)[((size_t)kc * NB + b) * 6144 + c];
                if (c < 2048) modl[c] = a; if (first) MOD[(size_t)b * 6144 + c] = a; }
            __syncthreads();
            {
                f32x4 v[8][4];
#pragma unroll
                for (int r8 = 0; r8 < 8; ++r8) { const GAS f32x4* xr = (const GAS f32x4*)(x + (size_t)(blk * 64 + F.wave * 8 + r8) * D) + F.lane;
#pragma unroll
                    for (int j = 0; j < 4; ++j) v[r8][j] = xr[64 * j]; }
#pragma unroll
                for (int r8 = 0; r8 < 8; ++r8) { const int m = blk * 64 + F.wave * 8 + r8; float s = 0.f;
#pragma unroll
                    for (int j = 0; j < 4; ++j) s += (v[r8][j].x + v[r8][j].y) + (v[r8][j].z + v[r8][j].w);
                    const float mean = wave_sum(s) * (1.f / D); float s2 = 0.f;
#pragma unroll
                    for (int j = 0; j < 4; ++j) { v[r8][j] = v[r8][j] - mean; s2 += (v[r8][j].x * v[r8][j].x + v[r8][j].y * v[r8][j].y) + (v[r8][j].z * v[r8][j].z + v[r8][j].w * v[r8][j].w); }
                    const float rstd = 1.f / sqrtf(wave_sum(s2) * (1.f / D) + LN_EPS);
                    GAS v2u* o8 = (GAS v2u*)(XN + (size_t)m * D) + F.lane;
#pragma unroll
                    for (int j = 0; j < 4; ++j) { const f32x4 hv = *(const LAS f32x4*)(modl + 4 * F.lane + 256 * j), sv = *(const LAS f32x4*)(modl + 1024 + 4 * F.lane + 256 * j);
                        const f32x4 h = (v[r8][j] * rstd) * (sv + 1.0f) + hv; v2u w; w.x = pk2(h.x, h.y); w.y = pk2(h.z, h.w); o8[64 * j] = w; } }
            }
        }
        if (BOTH(1) || rep_ + 1 < REPS(1)) GRID_BAR();
    }
    if (DLY_PH == 1) dly_t1 = __builtin_amdgcn_s_memrealtime();
    if (DLY_PH == 2) dly_t0 = __builtin_amdgcn_s_memrealtime();
    if (IN(2)) _Pragma("unroll") for (int rep_ = 0; rep_ < REPS(2); ++rep_) {
        PHASE_ENTRY();
        DenseSched S; S.init(XN, WIN, M, NIN, F.G, (int)blockIdx.x);
        EpiQKVU E{QB, (size_t)(WS_K - WS_Q) / 2};
        pg8::gemm_phase<EpiQKVU, DenseSched, true>(F.lds, S, E);
        if (BOTH(2) || rep_ + 1 < REPS(2)) GRID_BAR();
    }
    if (DLY_PH == 2) dly_t1 = __builtin_amdgcn_s_memrealtime();
    if (DLY_PH == 3) dly_t0 = __builtin_amdgcn_s_memrealtime();
    if (IN(3)) _Pragma("unroll") for (int rep_ = 0; rep_ < REPS(3); ++rep_) {
        PHASE_ENTRY();
        const bool g8 = (F.G % 8 == 0); const bool conv_cu = g8 ? (F.vcu & 7) < 3 : true; const int cG = g8 ? (F.G / 8) * 3 : F.G, cv = g8 ? (F.vcu >> 3) * 3 + (F.vcu & 7) : F.vcu;
        if (conv_cu) {
            __syncthreads();
            constexpr int T_GU1 = (D / 128) * (2048 / 128), T_D1 = (FF / 128) * (D / 128);
        auto pipe = [&](const float* W, bf16* WT, auto K_, auto N_, int ntiles) {
            constexpr int K = decltype(K_)::value, N = decltype(N_)::value, NBLK = N / 128, TPE = (K / 128) * NBLK;
            const int n_my = (ntiles - cv + cG - 1) / cG;
            auto tile_of = [&](int q) -> TItem { const int qq = q < n_my ? q : n_my - 1; const int r = cv + qq * cG; const int e = r / TPE, item = r % TPE, kb = item / NBLK, nb = item % NBLK;
                TItem t; t.src = W + (size_t)e * K * N + (size_t)(128 * kb) * N + 128 * nb; t.dst = (bf16*)((unsigned char*)WT + (size_t)e * K * N + (size_t)(128 * nb) * K + 128 * kb);     t.K = K; t.N = N; return t; };
            if (n_my > 0) {
                TItem t0 = tile_of(0), t1 = tile_of(1), t2; f32x4 b0[8], b1[8], b2[8];
                p0_load(t0, b0, F.wave, F.lane); p0_load(t1, b1, F.wave, F.lane);
                for (int q = 0; q < n_my; q += 3) {
                    t2 = tile_of(q + 2); p0_load(t2, b2, F.wave, F.lane); p0_store8(t0, b0, F.lds, F.wave, F.lane);
                    t0 = tile_of(q + 3); p0_load(t0, b0, F.wave, F.lane); p0_store8(t1, b1, F.lds + 34816, F.wave, F.lane);
                    t1 = tile_of(q + 4); p0_load(t1, b1, F.wave, F.lane); p0_store8(t2, b2, F.lds + 2 * 34816, F.wave, F.lane);
                }
                asm volatile("s_waitcnt lgkmcnt(0)\n\ts_barrier" ::: "memory");
            }
        };
        pipe(w_gu, WGU, std::integral_constant<int, D>{}, std::integral_constant<int, 2048>{}, NE * T_GU1);
        pipe(w_dn, WD, std::integral_constant<int, FF>{}, std::integral_constant<int, D>{}, NE * T_D1);
            __syncthreads();
        }
        LAS float* tb = (LAS float*)(F.lds + L_TB);
        for (int i = F.tid; i < 4 * attn_body::TBN; i += NWAVES * 64) { const int h = i / attn_body::TBN, idx = i % attn_body::TBN; const int d = idx - attn_body::TBOFF;
            tb[i] = (d <= 63) ? (rel_bias[t5_bucket(d) * 4 + h] - rel_bias[15 * 4 + h]) * LOG2E : 0.f; }
        __syncthreads();
#if !NAIVE_ATTN
        {
            volatile LAS int* qslot = (volatile LAS int*)(F.lds + L_MISC + 64);
            for (;;) {
                __syncthreads();
                if (F.tid == 0) *qslot = (int)__hip_atomic_fetch_add(F.ctl + CW_AQ + 64 * rep_, 1u, RLX_AGENT);
                __syncthreads();
                const int ui = __builtin_amdgcn_readfirstlane(*qslot);
                if (ui >= 1024) break;
                const int qb = 7 - (ui >> 7), c7 = ui & 127, b = c7 >> 4, j = (c7 >> 1) & 7, vh = c7 & 1;
                attn_body::attn_unit<8>(b, j, vh, qb, (const attn_body::bf16*)QB, (const attn_body::bf16*)KB, (const attn_body::bf16*)VB, (attn_body::bf16*)OA, (char*)lds, tb + (j >> 1) * attn_body::TBN);
            }
        }
#else
        for (int idx = blockIdx.x * 512 + F.tid; idx < NB * 8 * 2 * SEQ; idx += F.G * 512) {
            const int q = idx & 2047, vh = (idx >> 11) & 1, j = (idx >> 12) & 7, b = idx >> 15, h = j >> 1;
            const bf16* qp = QB + (size_t)(b * SEQ + q) * 512 + j * 64; float qv[64];
#pragma unroll
            for (int d = 0; d < 64; ++d) qv[d] = pg8::bf2f(qp[d]);
            float o[64];
#pragma unroll
            for (int d = 0; d < 64; ++d) o[d] = 0.f;
            float mx = -INFINITY, l = 0.f; const int kend = ((q >> 6) + 1) << 6;
            for (int k = 0; k < kend; ++k) {
                const bf16* kp = KB + (size_t)(b * SEQ + k) * 512 + j * 64; float sdot = 0.f;
#pragma unroll
                for (int d = 0; d < 64; ++d) sdot += qv[d] * pg8::bf2f(kp[d]);
                const int dd = k - q; const int ti = dd + attn_body::TBOFF < 0 ? 0 : dd + attn_body::TBOFF; sdot += tb[h * attn_body::TBN + ti];
                const float mn = fmaxf(mx, sdot), f = exp2f(mx - mn), p = exp2f(sdot - mn); l = l * f + p; mx = mn;
                const bf16* vp = VB + (size_t)(b * SEQ + k) * 512 + h * 128 + vh * 64;
#pragma unroll
                for (int d = 0; d < 64; ++d) o[d] = o[d] * f + p * pg8::bf2f(vp[d]);
            }
            bf16* op = OA + (size_t)(b * SEQ + q) * 1024 + j * 128 + vh * 64; const float il = 1.0f / l;
#pragma unroll
            for (int d = 0; d < 64; ++d) op[d] = (bf16)f2bf(o[d] * il);
        }
#endif
        if (BOTH(3) || rep_ + 1 < REPS(3)) GRID_BAR();
    }
    if (DLY_PH == 3) dly_t1 = __builtin_amdgcn_s_memrealtime();
    if (DLY_PH == 4) dly_t0 = __builtin_amdgcn_s_memrealtime();
    if (IN(4)) _Pragma("unroll") for (int rep_ = 0; rep_ < REPS(4); ++rep_) {
        PHASE_ENTRY();
        float lam;
        { const float a = lq1[F.lane] * lk1[F.lane], b2 = lq2[F.lane] * lk2[F.lane]; lam = __expf(wave_sum(a)) - __expf(wave_sum(b2)) + LAM_INIT; }
        for (int m0 = gw; m0 < M; m0 += 2 * NGW) {
            const int h = F.lane >> 4, e0 = (F.lane & 15) * 8; const bool two = m0 + NGW < M;
            v4u a[2], b2[2];
#pragma unroll
            for (int q = 0; q < 2; ++q) if (q == 0 || two) { const size_t m = (size_t)m0 + (size_t)q * NGW;
                a[q] = *(const GAS v4u*)(OA + m * 1024 + h * 256 + e0); b2[q] = *(const GAS v4u*)(OA + m * 1024 + h * 256 + 128 + e0); }
            const f32x4 g0 = *(const f32x4*)(subln_g + e0), g1v = *(const f32x4*)(subln_g + e0 + 4);
#pragma unroll
            for (int q = 0; q < 2; ++q) if (q == 0 || two) { const size_t m = (size_t)m0 + (size_t)q * NGW;
                float o[8];
                o[0] = bfl(a[q].x) - lam * bfl(b2[q].x); o[1] = bfh(a[q].x) - lam * bfh(b2[q].x); o[2] = bfl(a[q].y) - lam * bfl(b2[q].y); o[3] = bfh(a[q].y) - lam * bfh(b2[q].y);
                o[4] = bfl(a[q].z) - lam * bfl(b2[q].z); o[5] = bfh(a[q].z) - lam * bfh(b2[q].z); o[6] = bfl(a[q].w) - lam * bfl(b2[q].w); o[7] = bfh(a[q].w) - lam * bfh(b2[q].w);
                float ss = 0.f;
#pragma unroll
                for (int i = 0; i < 8; ++i) ss += o[i] * o[i];
                ss = row16_sum(ss);
                const float rs = (1.0f - LAM_INIT) / sqrtf(ss * (1.0f / 128.0f) + LN_EPS);
                v4u w; w.x = pk2(o[0] * rs * g0.x, o[1] * rs * g0.y); w.y = pk2(o[2] * rs * g0.z, o[3] * rs * g0.w); w.z = pk2(o[4] * rs * g1v.x, o[5] * rs * g1v.y); w.w = pk2(o[6] * rs * g1v.z, o[7] * rs * g1v.w);
                *(GAS v4u*)(MIX + m * 1024 + h * 128 + e0) = w; }
        }
        for (int it = gw; it < (M / 32) * 4; it += NGW) {
            const int g = it & 3, tile = it >> 2, row0 = tile * 32, r32 = F.lane & 31, hi = F.lane >> 5;
            const int row = row0 + r32, tpos = row & (SEQ - 1), tp0 = row0 & (SEQ - 1);
            LAS unsigned char* ut = F.lds + F.wave * 12800;
#pragma unroll
            for (int i = 0; i < 12; ++i) { const int pc = F.lane + 64 * i, rr = pc >> 4, c16 = pc & 15;
                if (rr < 47) { v4u v = (v4u){0u, 0u, 0u, 0u}; if (tp0 - 15 + rr >= 0) v = *(const GAS v4u*)(UB + (size_t)(row0 - 15 + rr) * 512 + g * 128 + c16 * 8); *(LAS v4u*)(ut + rr * 272 + c16 * 16) = v; } }
            LDS_WAIT(); asm volatile("" ::: "memory");
            bf16x8 pf[8];
            const LAS unsigned char* ub = ut + (r32 + 15) * 272 + hi * 16;
            auto pooled = [&](auto WIN_) {
                constexpr int WIN = decltype(WIN_)::value;
                const int nwin = tpos + 1 < WIN ? tpos + 1 : WIN; const float inv = 1.0f / (float)nwin;
#pragma unroll
                for (int s8 = 0; s8 < 8; ++s8) {
                    float sum[8];
#pragma unroll
                    for (int i = 0; i < 8; ++i) sum[i] = 0.f;
                    v4u self;
#pragma unroll
                    for (int k = 0; k < WIN; ++k) { const v4u u4 = *(const LAS v4u*)(ub - k * 272 + s8 * 32); if (k == 0) self = u4;
                        sum[0] += bfl(u4.x); sum[1] += bfh(u4.x); sum[2] += bfl(u4.y); sum[3] += bfh(u4.y); sum[4] += bfl(u4.z); sum[5] += bfh(u4.z); sum[6] += bfl(u4.w); sum[7] += bfh(u4.w); }
                    v4u w; w.x = pk2(sum[0] * inv - bfl(self.x), sum[1] * inv - bfh(self.x)); w.y = pk2(sum[2] * inv - bfl(self.y), sum[3] * inv - bfh(self.y));
                    w.z = pk2(sum[4] * inv - bfl(self.z), sum[5] * inv - bfh(self.z)); w.w = pk2(sum[6] * inv - bfl(self.w), sum[7] * inv - bfh(self.w));
                    pf[s8] = __builtin_bit_cast(bf16x8, w);
                }
            };
            if (g == 0) pooled(std::integral_constant<int, 2>{}); else if (g == 1) pooled(std::integral_constant<int, 4>{}); else if (g == 2) pooled(std::integral_constant<int, 8>{}); else pooled(std::integral_constant<int, 16>{});
            LDS_WAIT(); asm volatile("" ::: "memory");
#pragma unroll
            for (int db = 0; db < 4; ++db) {
                f32x16 acc = f32x16{};
                const bf16* wp = WPOOL + (size_t)g * 128 * 128 + (size_t)(db * 32 + r32) * 128 + hi * 8;
#pragma unroll
                for (int s8 = 0; s8 < 8; ++s8) { const bf16x8 wf = __builtin_bit_cast(bf16x8, *(const GAS v4u*)(wp + s8 * 16)); acc = __builtin_amdgcn_mfma_f32_32x32x16_bf16(wf, pf[s8], acc, 0, 0, 0); }
#pragma unroll
                for (int rq = 0; rq < 4; ++rq) { const int d0 = db * 32 + 8 * rq + 4 * hi; const int cg = g * 128 + d0;
                    const f32x4 bp = *(const f32x4*)(b_pool + cg), ps = *(const f32x4*)(pool_scale + cg);
                    v2u w; w.x = pk2((acc[4 * rq + 0] + bp.x) * ps.x, (acc[4 * rq + 1] + bp.y) * ps.y); w.y = pk2((acc[4 * rq + 2] + bp.z) * ps.z, (acc[4 * rq + 3] + bp.w) * ps.w);
                    *(GAS v2u*)(MIX + (size_t)row * 1024 + 512 + cg) = w; }
            }
        }
        if (BOTH(4) || rep_ + 1 < REPS(4)) GRID_BAR();
    }
    if (DLY_PH == 4) dly_t1 = __builtin_amdgcn_s_memrealtime();
    if (DLY_PH == 5) dly_t0 = __builtin_amdgcn_s_memrealtime();
    if (IN(5)) _Pragma("unroll") for (int rep_ = 0; rep_ < REPS(5); ++rep_) {
        PHASE_ENTRY();
        DenseSched S; S.init(MIX, WOUT, M, D, F.G, (int)blockIdx.x);
        EpiT1 E{MOD, (bf16*)T1};
        pg8::gemm_phase<EpiT1, DenseSched, true>(F.lds, S, E);
        if (BOTH(5) || rep_ + 1 < REPS(5)) GRID_BAR();
    }
    if (DLY_PH == 5) dly_t1 = __builtin_amdgcn_s_memrealtime();
    if (DLY_PH == 6) dly_t0 = __builtin_amdgcn_s_memrealtime();
    if (IN(6)) _Pragma("unroll 1") for (int rep_ = 0; rep_ < REPS(6); ++rep_) {
        PHASE_ENTRY();
        LAS float* H2 = (LAS float*)F.lds;
        LAS float* PART = (LAS float*)F.lds;
        LAS float* LOG = (LAS float*)(F.lds + 131200);
        LAS unsigned* hist = (LAS unsigned*)(F.lds + L_HIST); LAS unsigned* hbase = hist + 32;
        const int i32 = F.lane & 31, kh = F.lane >> 5, kb = F.wave * 128;
        for (int t0 = F.vcu; t0 < M / 32; t0 += 2 * F.G) {
            if (F.tid < 32) hist[F.tid] = 0u;
            int myk[2][2]; unsigned lrk[2][2]; float mygate[2][2];
#pragma unroll
            for (int ti = 0; ti < 2; ++ti) { const int tile = t0 + ti * F.G; myk[ti][0] = -1; myk[ti][1] = -1; lrk[ti][0] = 0u; lrk[ti][1] = 0u; mygate[ti][0] = 0.f; mygate[ti][1] = 0.f;
              if (tile < M / 32) {
            const int b = (tile * 32) >> 11; const float* sh = MOD + (size_t)b * 6144 + 3072; const float* sc = sh + 1024;
#pragma unroll
            for (int pr = 0; pr < 2; ++pr) {
                f32x4 v[2][4];
#pragma unroll
                for (int r2 = 0; r2 < 2; ++r2) { const size_t m_ = (size_t)(tile * 32 + F.wave * 4 + 2 * pr + r2); const GAS f32x4* xr = (const GAS f32x4*)(x + m_ * D) + F.lane; const GAS v2u* tr = (const GAS v2u*)((const bf16*)T1 + m_ * D) + F.lane;
                    v2u tg[4];
#pragma unroll
                    for (int j = 0; j < 4; ++j) { v[r2][j] = xr[64 * j]; tg[j] = tr[64 * j]; }
#pragma unroll
                    for (int j = 0; j < 4; ++j) v[r2][j] = v[r2][j] * DN_ALPHA + (f32x4){bfl(tg[j].x), bfh(tg[j].x), bfl(tg[j].y), bfh(tg[j].y)}; }
                f32x4 gvv[4], bvv4[4], svv[4], hvv[4];
#pragma unroll
                for (int j = 0; j < 4; ++j) { gvv[j] = *(const f32x4*)(ln1_g + 4 * F.lane + 256 * j); bvv4[j] = *(const f32x4*)(ln1_b + 4 * F.lane + 256 * j); svv[j] = *(const f32x4*)(sc + 4 * F.lane + 256 * j); hvv[j] = *(const f32x4*)(sh + 4 * F.lane + 256 * j); }
#pragma unroll
                for (int r2 = 0; r2 < 2; ++r2) {
                    const int lr = F.wave * 4 + 2 * pr + r2, m = tile * 32 + lr;
                    float s = 0.f;
#pragma unroll
                    for (int j = 0; j < 4; ++j) s += (v[r2][j].x + v[r2][j].y) + (v[r2][j].z + v[r2][j].w);
                    float mean = wave_sum(s) * (1.f / D); float s2 = 0.f;
#pragma unroll
                    for (int j = 0; j < 4; ++j) { v[r2][j] = v[r2][j] - mean; s2 += (v[r2][j].x * v[r2][j].x + v[r2][j].y * v[r2][j].y) + (v[r2][j].z * v[r2][j].z + v[r2][j].w * v[r2][j].w); }
                    float rstd = 1.f / sqrtf(wave_sum(s2) * (1.f / D) + LN_EPS);
                    if (F.lane == 0) { typedef float f32x2s __attribute__((ext_vector_type(2))); *(GAS f32x2s*)(X1 + 2 * (size_t)m) = (f32x2s){mean, rstd}; }
                    s = 0.f;
#pragma unroll
                    for (int j = 0; j < 4; ++j) { const f32x4 gvj = gvv[j], bvj = bvv4[j];
                        v[r2][j] = (v[r2][j] * rstd) * gvj + bvj; s += (v[r2][j].x + v[r2][j].y) + (v[r2][j].z + v[r2][j].w); }
                    mean = wave_sum(s) * (1.f / D); s2 = 0.f;
#pragma unroll
                    for (int j = 0; j < 4; ++j) { v[r2][j] = v[r2][j] - mean; s2 += (v[r2][j].x * v[r2][j].x + v[r2][j].y * v[r2][j].y) + (v[r2][j].z * v[r2][j].z + v[r2][j].w * v[r2][j].w); }
                    rstd = 1.f / sqrtf(wave_sum(s2) * (1.f / D) + LN_EPS);
                    GAS unsigned* o8 = (GAS unsigned*)((unsigned char*)XN2 + (size_t)m * D) + F.lane;
#pragma unroll
                    for (int j = 0; j < 4; ++j) { const f32x4 svj = svv[j], hvj = hvv[j];
                        const f32x4 h = (v[r2][j] * rstd) * (svj + 1.0f) + hvj; o8[64 * j] = pk4_fp8(h.x, h.y, h.z, h.w);
                        LAS float* hp = H2 + lr * 1025 + 4 * F.lane + 256 * j; hp[0] = h.x; hp[1] = h.y; hp[2] = h.z; hp[3] = h.w; }
                    asm volatile("" ::: "memory");
                }
            }
            float wreg[64];
            int i32w = (kb + kh) * NE + i32; asm volatile("" : "+v"(i32w));
            const GAS float* wrp = (const GAS float*)w_router + i32w;
#pragma unroll
            for (int kk = 0; kk < 64; ++kk) wreg[kk] = wrp[kk * 2 * NE];
            __syncthreads();
            f32x16 acc = f32x16{};
#pragma unroll
            for (int kk = 0; kk < 64; ++kk) acc = __builtin_amdgcn_mfma_f32_32x32x2f32(H2[i32 * 1025 + kb + 2 * kk + kh], wreg[kk], acc, 0, 0, 0);
            __syncthreads();
#pragma unroll
            for (int r = 0; r < 16; ++r) PART[(F.wave * 32 + ((r & 3) + 8 * (r >> 2) + 4 * kh)) * 32 + i32] = acc[r];
            __syncthreads();
#pragma unroll
            for (int q = 0; q < 2; ++q) { const int idx = F.tid + 512 * q, i = idx >> 5, e = idx & 31; float sl = b_router[e];
#pragma unroll
                for (int w = 0; w < 8; ++w) sl += PART[(w * 32 + i) * 32 + e];
                LOG[i * 33 + e] = sl; }
            __syncthreads();
#pragma unroll
            for (int it2 = 0; it2 < 2; ++it2) {
                const int rowl = F.wave * 4 + 2 * it2 + kh; float cur = LOG[rowl * 33 + i32]; float bvv[4]; myk[ti][it2] = -1;
#pragma unroll
                for (int k = 0; k < 4; ++k) { float mv = cur; int me = i32;
#pragma unroll
                    for (int off = 1; off < 32; off <<= 1) { const float ov = __shfl_xor(mv, off); const int oe = __shfl_xor(me, off); if (ov > mv || (ov == mv && oe < me)) { mv = ov; me = oe; } }
                    bvv[k] = mv; if (me == i32) { cur = -INFINITY; myk[ti][it2] = k; } }
                float ex[4], ssum = 0.f;
#pragma unroll
                for (int k = 0; k < 4; ++k) { ex[k] = __expf(bvv[k] - bvv[0]); ssum += ex[k]; }
                const float is = 1.0f / ssum; mygate[ti][it2] = 0.f; lrk[ti][it2] = 0u;
#pragma unroll
                for (int k = 0; k < 4; ++k) if (myk[ti][it2] == k) mygate[ti][it2] = ex[k] * is;
                if (myk[ti][it2] >= 0) lrk[ti][it2] = __hip_atomic_fetch_add(hist + i32, 1u, __ATOMIC_RELAXED, __HIP_MEMORY_SCOPE_WORKGROUP);
            }
            __syncthreads();
              } }
            __syncthreads();
            if (F.tid < 32) { const unsigned n = hist[F.tid]; hbase[F.tid] = n ? __hip_atomic_fetch_add(F.ctl + (rep_ + 1 < REPS(6) ? CW_CNT + 4096 : CW_CNT) + 64 * F.tid, n, RLX_AGENT) : 0u; }
            __syncthreads();
#pragma unroll
            for (int ti = 0; ti < 2; ++ti) { const int tile = t0 + ti * F.G;
#pragma unroll
              for (int it2 = 0; it2 < 2; ++it2) if (myk[ti][it2] >= 0) { const int m = tile * 32 + F.wave * 4 + 2 * it2 + kh; const int pp = (int)(hbase[i32] + lrk[ti][it2]);
                RE[m * 4 + myk[ti][it2]] = i32; RP[m * 4 + myk[ti][it2]] = pp; RG[m * 4 + myk[ti][it2]] = mygate[ti][it2]; if (pp < ECAP) ROWTOK[i32 * ECAP + pp] = m; } }
            __syncthreads();
        }
        if (BOTH(6) || rep_ + 1 < REPS(6)) GRID_BAR();
    }
    if (DLY_PH == 6) dly_t1 = __builtin_amdgcn_s_memrealtime();
    if (DLY_PH == 7) dly_t0 = __builtin_amdgcn_s_memrealtime();
    if (IN(7)) _Pragma("unroll") for (int rep_ = 0; rep_ < REPS(7); ++rep_) {
        PHASE_ENTRY();
        build_expert_tables(F);
        MoeSched S; S.A = XN2; S.W = WGU; S.rowtok = ROWTOK; S.pexp = (const LAS int*)(F.lds + L_PEXP); S.pfirst = (const LAS int*)(F.lds + L_PFIRST); S.cntl = (const LAS int*)(F.lds + L_CNT);
        S.NP = ((const LAS int*)(F.lds + L_PFIRST))[NE]; S.NT = 8; S.G = F.G; S.vcu = F.vcu; S.gather = true; S.rowb = 1024; S.wexp = (size_t)2048 * 1024; S.wtile = (size_t)128 * 1024; S.whalf = (size_t)1024 * 1024;
        EpiSwiglu E{b_gu, (unsigned char*)HB};
        pg8::gemm_phase<EpiSwiglu, MoeSched, true, true>(F.lds, S, E);
        if (BOTH(7) || rep_ + 1 < REPS(7)) GRID_BAR();
    }
    if (DLY_PH == 7) dly_t1 = __builtin_amdgcn_s_memrealtime();
    if (DLY_PH == 8) dly_t0 = __builtin_amdgcn_s_memrealtime();
    if (IN(8)) _Pragma("unroll") for (int rep_ = 0; rep_ < REPS(8); ++rep_) {
        PHASE_ENTRY();
        build_expert_tables(F);
        MoeSched S; S.A = HB; S.W = WD; S.rowtok = ROWTOK; S.pexp = (const LAS int*)(F.lds + L_PEXP); S.pfirst = (const LAS int*)(F.lds + L_PFIRST); S.cntl = (const LAS int*)(F.lds + L_CNT);
        S.NP = ((const LAS int*)(F.lds + L_PFIRST))[NE]; S.NT = 4; S.G = F.G; S.vcu = F.vcu; S.gather = false; S.rowb = 1024; S.wexp = (size_t)1024 * 1024; S.wtile = (size_t)256 * 1024; S.whalf = (size_t)128 * 1024;
        EpiDown E{b_dn, (unsigned char*)YB};
        pg8::gemm_phase<EpiDown, MoeSched, true, true>(F.lds, S, E);
        if (BOTH(8) || rep_ + 1 < REPS(8)) GRID_BAR();
    }
    if (DLY_PH == 8) dly_t1 = __builtin_amdgcn_s_memrealtime();
    if (DLY_PH == 9) dly_t0 = __builtin_amdgcn_s_memrealtime();
    if (IN(9)) _Pragma("unroll") for (int rep_ = 0; rep_ < REPS(9); ++rep_) {
        PHASE_ENTRY();
        build_expert_tables(F);
        const LAS int* pfirst = (const LAS int*)(F.lds + L_PFIRST);
        const unsigned bad = __hip_atomic_load(F.ctl + CW_BAR + XB_TMO, RLX_AGENT);
        for (int m0 = gw; m0 < M; m0 += 2 * NGW) {
            f32x4 tv[2][4]; v2u tgv[2][4]; unsigned yv[2][4][4]; float gk[2][4]; float mu[2], rs[2];
#pragma unroll
            for (int q = 0; q < 2; ++q) { const int m = m0 + q * NGW; if (m < M) {
                mu[q] = X1[2 * (size_t)m]; rs[q] = X1[2 * (size_t)m + 1];
#pragma unroll
                for (int k = 0; k < 4; ++k) { const int e = __builtin_amdgcn_readfirstlane(RE[m * 4 + k]), pp = __builtin_amdgcn_readfirstlane(RP[m * 4 + k]); gk[q][k] = RG[m * 4 + k];
                    const size_t yrow = (size_t)pfirst[e] * 256 + (size_t)pp; const GAS unsigned* yp = (const GAS unsigned*)((const unsigned char*)YB + yrow * 1024) + F.lane;
#pragma unroll
                    for (int j = 0; j < 4; ++j) yv[q][k][j] = yp[64 * j]; }
#pragma unroll
                for (int j = 0; j < 4; ++j) { tv[q][j] = ((const GAS f32x4*)(x + (size_t)m * D) + F.lane)[64 * j]; tgv[q][j] = ((const GAS v2u*)((const bf16*)T1 + (size_t)m * D) + F.lane)[64 * j]; } } }
#pragma unroll
            for (int q = 0; q < 2; ++q) { const int m = m0 + q * NGW; if (m < M) {
                const int b = m >> 11; const float* g2 = MOD + (size_t)b * 6144 + 5120;
                f32x4 v[4]; float s = 0.f;
#pragma unroll
                for (int j = 0; j < 4; ++j) { f32x4 a = (f32x4){0.f, 0.f, 0.f, 0.f};
#pragma unroll
                    for (int k = 0; k < 4; ++k) { typedef float f32x2s __attribute__((ext_vector_type(2))); const int w = (int)yv[q][k][j]; const f32x2s lo2 = __builtin_amdgcn_cvt_pk_f32_fp8(w, false), hi2 = __builtin_amdgcn_cvt_pk_f32_fp8(w, true);
                        a += (f32x4){lo2.x, lo2.y, hi2.x, hi2.y} * gk[q][k]; }
                    const f32x4 g1v = *(const f32x4*)(ln1_g + 4 * F.lane + 256 * j), b1v = *(const f32x4*)(ln1_b + 4 * F.lane + 256 * j), gv = *(const f32x4*)(g2 + 4 * F.lane + 256 * j);
                    const f32x4 t1 = tv[q][j] * DN_ALPHA + (f32x4){bfl(tgv[q][j].x), bfh(tgv[q][j].x), bfl(tgv[q][j].y), bfh(tgv[q][j].y)};
                    const f32x4 xv = ((t1 - mu[q]) * rs[q]) * g1v + b1v;
                    v[j] = xv * DN_ALPHA + gv * a; s += (v[j].x + v[j].y) + (v[j].z + v[j].w); }
                const float mean = wave_sum(s) * (1.f / D); float s2 = 0.f;
#pragma unroll
                for (int j = 0; j < 4; ++j) { v[j] = v[j] - mean; s2 += (v[j].x * v[j].x + v[j].y * v[j].y) + (v[j].z * v[j].z + v[j].w * v[j].w); }
                const float rstd = 1.f / sqrtf(wave_sum(s2) * (1.f / D) + LN_EPS);
#pragma unroll
                for (int j = 0; j < 4; ++j) { const f32x4 gv = *(const f32x4*)(ln2_g + 4 * F.lane + 256 * j), bv = *(const f32x4*)(ln2_b + 4 * F.lane + 256 * j);
                    f32x4 o = (v[j] * rstd) * gv + bv; if (bad) { const float qn = __builtin_nanf(""); o = (f32x4){qn, qn, qn, qn}; }
                    ((GAS f32x4*)(out + (size_t)m * D) + F.lane)[64 * j] = o; } } }
        }
    }
    if (DLY_PH >= 0) { if (DLY_PH == 9) dly_t1 = __builtin_amdgcn_s_memrealtime(); const unsigned long long te = __builtin_amdgcn_s_memrealtime(); while (__builtin_amdgcn_s_memrealtime() - te < dly_t1 - dly_t0) __builtin_amdgcn_s_sleep(8); }
#undef IN
#undef BOTH
}

extern "C" void kernel_launch(void* const* d_in, const int* in_sizes, int n_in, void* d_out, int out_size, void* d_ws, size_t ws_size, hipStream_t stream) {
    static int grid = 0;
    if (grid == 0) {
        if (n_in != 25 || in_sizes[0] != M * D || out_size != M * D || ws_size < WS_END) { fprintf(stderr, "kernel_launch: unexpected shapes (n_in %d, in0 %d, out %d, ws %zu); nothing launched\n", n_in, n_in > 0 ? in_sizes[0] : -1, out_size, ws_size); grid = -1; return; }
        int dev = 0, cus = 0, per_cu = 0;
        if (hipGetDevice(&dev) != hipSuccess || hipDeviceGetAttribute(&cus, hipDeviceAttributeMultiprocessorCount, dev) != hipSuccess) { grid = -1; return; }
        if (hipFuncSetAttribute((const void*)mk_fwd, hipFuncAttributeMaxDynamicSharedMemorySize, LDS_BYTES) != hipSuccess) { fprintf(stderr, "kernel_launch: hipFuncSetAttribute failed\n"); grid = -1; return; }
        if (hipOccupancyMaxActiveBlocksPerMultiprocessor(&per_cu, (const void*)mk_fwd, NWAVES * 64, LDS_BYTES) != hipSuccess || per_cu < 1) { fprintf(stderr, "kernel_launch: occupancy query reports %d workgroups per CU\n", per_cu); (void)hipGetLastError(); }
        grid = cus;
    }
    if (grid < 0) return;
    if (hipMemsetAsync((char*)d_ws + WS_CTL, 0, CTL_ZERO_BYTES, stream) != hipSuccess) return;
    Args a{};
    for (int i = 0; i < 25; ++i) a.in[i] = (const float*)d_in[i];
    a.out = (float*)d_out; a.ws = (unsigned char*)d_ws;
#if MK_ONE_LAUNCH
    a.ph_lo = 0; a.ph_hi = NPHASE;
    hipLaunchKernelGGL(mk_fwd, dim3(grid), dim3(NWAVES * 64), LDS_BYTES, stream, a);
#else
    for (int p = 0; p < NPHASE; ++p) { a.ph_lo = p; a.ph_hi = p + 1; hipLaunchKernelGGL(mk_fwd, dim3(grid), dim3(NWAVES * 64), LDS_BYTES, stream, a); }
#endif
}
```

```cpp
#include <hip/hip_runtime.h>
#include <hip/hip_bf16.h>
#include <cstdio>
#include <cstdint>
#include <cmath>
#include <type_traits>

#ifndef MK_ONE_LAUNCH
#define MK_ONE_LAUNCH 1
#endif
#ifndef NAIVE_GEMM
#define NAIVE_GEMM 0
#endif
#ifndef DLY_PH
#define DLY_PH (-1)
#endif
#ifndef NAIVE_ATTN
#define NAIVE_ATTN 0
#endif

#define GAS __attribute__((address_space(1)))
#define LAS __attribute__((address_space(3)))

constexpr int NB = 8, SEQ = 2048, D = 1024, M = NB * SEQ;
constexpr int AW = 512;
constexpr int NIN = 2048;
constexpr int NE = 32, TOPK = 4, FF = 1024;
constexpr int ECAP = 16384;
constexpr int PMAX = (M * TOPK) / 256 + NE;
constexpr float LN_EPS = 1e-5f;
constexpr float DN_ALPHA = 1.189207115002721f;
constexpr float LAM_INIT = 0.2f;
constexpr float LOG2E = 1.4426950408889634f;
constexpr float QSCALE = 0.125f * LOG2E;
constexpr int NWAVES = 8;
constexpr int CONV8 = 4;

namespace pg8 {
#define PG8_LAS __attribute__((address_space(3)))
typedef unsigned short bf16_t;
typedef short bf16x8 __attribute__((ext_vector_type(8)));
typedef float f32x4 __attribute__((ext_vector_type(4)));
typedef unsigned u32x4 __attribute__((ext_vector_type(4)));
constexpr int BM = 256, BK = 64, HALF = 128, HTB = HALF * BK * 2, STAGE_BYTES = 8 * HTB, NXCD = 8, WGM = 8;
constexpr int GK = 1024;

__host__ __device__ __forceinline__ int lds_byte(int r, int c) { const int st = (r >> 4) * 2 + (c >> 5), rr = r & 15, cc = c & 31, ob = rr * 64 + cc * 2; return st * 1024 + (ob ^ (((ob >> 9) & 1) << 5)); }
__host__ __device__ __forceinline__ void stage_rc(int b, int& R, int& C) { const int st = b / 1024, sb = b % 1024, swz = sb ^ (((sb >> 9) & 1) << 5); R = (st >> 1) * 16 + swz / 64; C = (st & 1) * 32 + (swz % 64) / 2; }
__host__ __device__ __forceinline__ int perm32(int rho) { const int n = rho >> 4, i = rho & 15; return 8 * (i >> 2) + 4 * n + (i & 3); }

struct Unit { int pm, pn, e, lrow0, cnt; };
struct Pre { f32x4 v[4]; };
__device__ __forceinline__ void asm_ld16(f32x4& d, const float* p) { asm volatile("global_load_dwordx4 %0, %1, off" : "=v"(d) : "v"((const __attribute__((address_space(1))) float*)p) : "memory"); }

__device__ __forceinline__ unsigned cvt_pk_bf16(float lo, float hi) { unsigned r; asm volatile("v_cvt_pk_bf16_f32 %0, %1, %2" : "=v"(r) : "v"(lo), "v"(hi)); return r; }
__device__ __forceinline__ float bf2f(unsigned short v) { return __uint_as_float((unsigned)v << 16); }

#if !NAIVE_GEMM
typedef int v8i32 __attribute__((ext_vector_type(8)));
typedef int v4i32 __attribute__((ext_vector_type(4)));
template <class Epi, class Sched, bool ALIGN_EPI, bool FP8 = false>
__device__ __forceinline__ void gemm_phase(PG8_LAS unsigned char* lds, const Sched& S, const Epi& E) {
    constexpr int RB = FP8 ? 1024 : 2048, nt = RB / 128;
    const int tid = threadIdx.x, wid = __builtin_amdgcn_readfirstlane(tid >> 6), lane = tid & 63, wr = wid >> 2, wc = wid & 3, fr = lane & 15, fq = lane >> 4;
    int Rr[2], Cc[2]; unsigned voffB[2];
#pragma unroll
    for (int i = 0; i < 2; ++i) { int R, C; stage_rc(tid * 16 + i * 8192, R, C); Rr[i] = R; Cc[i] = C; const int Rb = Epi::PERM ? ((R & ~31) + perm32(R & 31)) : R; voffB[i] = (unsigned)(Rb * RB + C * 2); }
    const size_t kstep = (size_t)(BK * 2);
    const size_t hB = S.b_hstep();
    const unsigned ldsw = (unsigned)wid * 1024u;
    const int aoff = lds_byte(wr * 64 + fr, fq * 8), boff = lds_byte(wc * 32 + fr, fq * 8);
#define PG8_SA(b, h) (((b) * 2 + (h)) * HTB)
#define PG8_SB(b, h) ((4 + (b) * 2 + (h)) * HTB)
#define PG8_STAGE(bufoff, gbase, voff) do { _Pragma("unroll") for (int _i = 0; _i < 2; ++_i) \
        __builtin_amdgcn_global_load_lds((const unsigned*)((const char*)(gbase) + (voff)[_i]), (PG8_LAS unsigned*)(lds + (bufoff) + ldsw + _i * 8192), 16, 0, 0); } while (0)
#define PG8_LD32(p) __builtin_shufflevector(*(const PG8_LAS v4i32*)(p), *(const PG8_LAS v4i32*)((p) + 1024), 0, 1, 2, 3, 4, 5, 6, 7)
#define PG8_LDA(dst, b, h) do { if constexpr (FP8) { _Pragma("unroll") for (int m = 0; m < 4; ++m) dst##8[m] = PG8_LD32(lds + PG8_SA(b, h) + aoff + m * 2048); } \
        else { _Pragma("unroll") for (int m = 0; m < 4; ++m) _Pragma("unroll") for (int k = 0; k < 2; ++k) dst[m][k] = *(const PG8_LAS bf16x8*)(lds + PG8_SA(b, h) + aoff + m * 2048 + k * 1024); } } while (0)
#define PG8_LDB(dst, b, h) do { if constexpr (FP8) { _Pragma("unroll") for (int n = 0; n < 2; ++n) dst##8[n] = PG8_LD32(lds + PG8_SB(b, h) + boff + n * 2048); } \
        else { _Pragma("unroll") for (int n = 0; n < 2; ++n) _Pragma("unroll") for (int k = 0; k < 2; ++k) dst[n][k] = *(const PG8_LAS bf16x8*)(lds + PG8_SB(b, h) + boff + n * 2048 + k * 1024); } } while (0)
#define PG8_CAT(x) __builtin_shufflevector(__builtin_bit_cast(v4i32, (x)[0]), __builtin_bit_cast(v4i32, (x)[1]), 0, 1, 2, 3, 4, 5, 6, 7)
#define PG8_MMA(ai, bj, At, Bt) do { __builtin_amdgcn_s_setprio(1); \
        if constexpr (FP8) { _Pragma("unroll") for (int m = 0; m < 4; ++m) _Pragma("unroll") for (int n = 0; n < 2; ++n) \
            asm volatile("v_mfma_scale_f32_16x16x128_f8f6f4 %0, %1, %2, %0, %3, %3 op_sel_hi:[0,0,0]" : "+v"(acc[ai][bj][m][n]) : "v"(Bt##8[n]), "v"(At##8[m]), "v"(one8)); } \
        else { _Pragma("unroll") for (int m = 0; m < 4; ++m) _Pragma("unroll") for (int n = 0; n < 2; ++n) _Pragma("unroll") for (int k = 0; k < 2; ++k) \
            acc[ai][bj][m][n] = __builtin_amdgcn_mfma_f32_16x16x32_bf16(Bt[n][k], At[m][k], acc[ai][bj][m][n], 0, 0, 0); } \
        __builtin_amdgcn_s_setprio(0); } while (0)
#define PG8_WAIT_V(n) asm volatile("s_waitcnt vmcnt(" #n ")" ::: "memory")
#define PG8_WAIT_L(n) asm volatile("s_waitcnt lgkmcnt(" #n ")" ::: "memory")
#define PG8_BAR __builtin_amdgcn_s_barrier()
#define PG8_SCHED __builtin_amdgcn_sched_barrier(0)
    Unit cur, nxt; int ui = 0; Pre pre;
    if (!S.next(0, cur)) return;
    f32x4 acc[2][2][4][2];
#pragma unroll
    for (int a = 0; a < 2; ++a)
#pragma unroll
        for (int b = 0; b < 2; ++b)
#pragma unroll
            for (int m = 0; m < 4; ++m)
#pragma unroll
                for (int n = 0; n < 2; ++n) acc[a][b][m][n] = (f32x4){0.f, 0.f, 0.f, 0.f};
    const int one8 = 0x7f7f7f7f;
    bf16x8 At[4][2], B0[2][2], B1[2][2]; v8i32 At8[4], B08[2], B18[2];
    const char* cA = S.a_base(cur); const char* cB = S.b_base(cur);
    unsigned va0[2], va1[2];
    S.a_voff(cur, Rr, Cc, va0, va1);
    PG8_STAGE(PG8_SB(0, 0), cB, voffB); PG8_STAGE(PG8_SB(0, 1), cB + hB, voffB); PG8_STAGE(PG8_SA(0, 0), cA, va0); PG8_STAGE(PG8_SA(0, 1), cA, va1);
    if (wr == 1) PG8_BAR;
    PG8_WAIT_V(2); PG8_BAR;
    PG8_STAGE(PG8_SB(1, 0), cB + kstep, voffB); PG8_STAGE(PG8_SA(1, 0), cA + kstep, va0); PG8_STAGE(PG8_SB(1, 1), cB + hB + kstep, voffB);
    PG8_WAIT_V(6); PG8_BAR;
    for (;;) {
        const bool has_next = S.next(ui + 1, nxt);
        const char* nA = has_next ? S.a_base(nxt) : cA; const char* nB = has_next ? S.b_base(nxt) : cB;
        unsigned vn0[2] = {va0[0], va0[1]}, vn1[2] = {va1[0], va1[1]}, tkn[4];
        { Unit tu = cur; if (has_next) tu = nxt; S.a_tok(tu, Rr, tkn); }
#define PG8_TRIP(LAST, t) do { \
            const char* a1 = cA + (size_t)((t) + 1) * kstep; \
            const char* a2 = (LAST) ? nA : cA + (size_t)((t) + 2) * kstep; const char* b2 = (LAST) ? nB : cB + (size_t)((t) + 2) * kstep; \
            const char* a3 = a2 + kstep; const char* b3 = b2 + kstep; \
            asm volatile("" : "+v"(voffB[0]), "+v"(voffB[1]), "+v"(va0[0]), "+v"(va0[1]), "+v"(va1[0]), "+v"(va1[1])); \
            unsigned v20[2] = {va0[0], va0[1]}, v21[2] = {va1[0], va1[1]}; \
            if (LAST) { E.pre(cur, wr, wc, fr, fq, pre); if (has_next) { S.a_voff_tok(tkn, Rr, Cc, vn0, vn1); v20[0] = vn0[0]; v20[1] = vn0[1]; v21[0] = vn1[0]; v21[1] = vn1[1]; } } \
            PG8_LDB(B0, 0, 0); PG8_LDB(B1, 0, 1); PG8_SCHED; PG8_LDA(At, 0, 0); PG8_STAGE(PG8_SA(1, 1), a1, va1); \
            PG8_WAIT_V(8); PG8_WAIT_L(0); PG8_BAR; PG8_MMA(0, 0, At, B0); PG8_MMA(0, 1, At, B1); PG8_BAR; PG8_SCHED; \
            PG8_LDA(At, 0, 1); PG8_STAGE(PG8_SB(0, 0), b2, voffB); PG8_STAGE(PG8_SB(0, 1), b2 + hB, voffB); PG8_STAGE(PG8_SA(0, 0), a2, v20); \
            PG8_WAIT_V(8); PG8_WAIT_L(0); PG8_BAR; PG8_MMA(1, 0, At, B0); PG8_MMA(1, 1, At, B1); PG8_BAR; PG8_SCHED; \
            PG8_LDB(B0, 1, 0); PG8_LDB(B1, 1, 1); PG8_SCHED; PG8_LDA(At, 1, 0); PG8_STAGE(PG8_SA(0, 1), a2, v21); \
            PG8_WAIT_V(8); PG8_WAIT_L(0); PG8_BAR; PG8_MMA(0, 0, At, B0); PG8_MMA(0, 1, At, B1); PG8_BAR; PG8_SCHED; \
            PG8_LDA(At, 1, 1); PG8_STAGE(PG8_SB(1, 0), b3, voffB); PG8_STAGE(PG8_SB(1, 1), b3 + hB, voffB); PG8_STAGE(PG8_SA(1, 0), a3, v20); \
            PG8_WAIT_V(8); PG8_WAIT_L(0); PG8_BAR; PG8_MMA(1, 0, At, B0); PG8_MMA(1, 1, At, B1); PG8_BAR; PG8_SCHED; \
        } while (0)
#pragma unroll 1
        for (int t = 0; t < nt - 2; t += 2) PG8_TRIP(0, t);
        PG8_TRIP(1, nt - 2);
#undef PG8_TRIP
        if constexpr (ALIGN_EPI) { if (wr == 0) PG8_BAR; }
        if constexpr (FP8) asm volatile("s_nop 15\n\ts_nop 15" ::: "memory");
        { int fr_ = fr, fq_ = fq; asm volatile("" : "+v"(fr_), "+v"(fq_));
          E(acc, cur, wr, wc, fr_, fq_, pre); }
        if (!has_next) break;
#pragma unroll
        for (int a = 0; a < 2; ++a)
#pragma unroll
            for (int b = 0; b < 2; ++b)
#pragma unroll
                for (int m = 0; m < 4; ++m)
#pragma unroll
                    for (int n = 0; n < 2; ++n) acc[a][b][m][n] = (f32x4){0.f, 0.f, 0.f, 0.f};
        cur = nxt; cA = nA; cB = nB; va0[0] = vn0[0]; va0[1] = vn0[1]; va1[0] = vn1[0]; va1[1] = vn1[1]; ++ui;
        if constexpr (ALIGN_EPI) { if (wr == 1) PG8_BAR; }
    }
    PG8_WAIT_V(0);
    if constexpr (!ALIGN_EPI) { if (wr == 0) PG8_BAR; }
    PG8_BAR;
#undef PG8_SA
#undef PG8_SB
#undef PG8_STAGE
#undef PG8_LDA
#undef PG8_LD32
#undef PG8_LDB
#undef PG8_MMA
#undef PG8_CAT
#undef PG8_WAIT_V
#undef PG8_WAIT_L
#undef PG8_BAR
#undef PG8_SCHED
}
#else
template <class Epi, class Sched, bool ALIGN_EPI, bool FP8 = false>
__device__ __forceinline__ void gemm_phase(PG8_LAS unsigned char*, const Sched& S, const Epi& E) {
    constexpr int K = GK;
    const int tid = threadIdx.x, wid = __builtin_amdgcn_readfirstlane(tid >> 6), lane = tid & 63, wr = wid >> 2, wc = wid & 3, fr = lane & 15, fq = lane >> 4;
    Unit u;
    for (int ui = 0; S.next(ui, u); ++ui) {
        f32x4 acc[2][2][4][2];
#pragma unroll
        for (int ai = 0; ai < 2; ++ai)
#pragma unroll
            for (int bj = 0; bj < 2; ++bj) {
                const bf16_t* ar[4]; const bf16_t* br[2][4];
#pragma unroll
                for (int m = 0; m < 4; ++m) ar[m] = S.a_row(u, ai * 128 + wr * 64 + m * 16 + fr);
#pragma unroll
                for (int n = 0; n < 2; ++n)
#pragma unroll
                    for (int x = 0; x < 4; ++x) br[n][x] = S.b_row(u, bj * 128 + wc * 32 + (Epi::PERM ? 8 * fq + 4 * n + x : 16 * n + 4 * fq + x));
                float s[4][2][4];
#pragma unroll
                for (int m = 0; m < 4; ++m)
#pragma unroll
                    for (int n = 0; n < 2; ++n)
#pragma unroll
                        for (int x = 0; x < 4; ++x) s[m][n][x] = 0.f;
                for (int k0 = 0; k0 < K; k0 += 8) {
                    bf16x8 av[4], bv[2][4];
#pragma unroll
                    for (int m = 0; m < 4; ++m) av[m] = *(const bf16x8*)(ar[m] + k0);
#pragma unroll
                    for (int n = 0; n < 2; ++n)
#pragma unroll
                        for (int x = 0; x < 4; ++x) bv[n][x] = *(const bf16x8*)(br[n][x] + k0);
#pragma unroll
                    for (int kk = 0; kk < 8; ++kk)
#pragma unroll
                        for (int m = 0; m < 4; ++m) { const float a = bf2f((unsigned short)av[m][kk]);
#pragma unroll
                            for (int n = 0; n < 2; ++n)
#pragma unroll
                                for (int x = 0; x < 4; ++x) s[m][n][x] += a * bf2f((unsigned short)bv[n][x][kk]); }
                }
#pragma unroll
                for (int m = 0; m < 4; ++m)
#pragma unroll
                    for (int n = 0; n < 2; ++n) acc[ai][bj][m][n] = (f32x4){s[m][n][0], s[m][n][1], s[m][n][2], s[m][n][3]};
            }
        Pre pre; E.pre(u, wr, wc, fr, fq, pre); asm volatile("s_waitcnt vmcnt(0)" ::: "memory"); E(acc, u, wr, wc, fr, fq, pre);
    }
}
#endif
}

constexpr size_t MiB = 1u << 20;
constexpr size_t WS_CTL = 0, CTL_ZERO_BYTES = 1 * MiB;
constexpr size_t WS_MOD = 1 * MiB;
constexpr size_t WS_WPOOL = 1 * MiB + 512 * 1024;
constexpr size_t WS_WIN = 2 * MiB;
constexpr size_t WS_WOUT = 6 * MiB;
constexpr size_t WS_WGU = 8 * MiB;
constexpr size_t WS_WD = 136 * MiB;
constexpr size_t WS_XN = 200 * MiB;
constexpr size_t WS_Q = 232 * MiB, WS_K = 248 * MiB, WS_V = 264 * MiB, WS_U = 280 * MiB;
constexpr size_t WS_OA = 296 * MiB;
constexpr size_t WS_MIX = 328 * MiB;
constexpr size_t WS_T1 = 360 * MiB;
constexpr size_t WS_X1 = 424 * MiB;
constexpr size_t WS_XN2 = 488 * MiB;
constexpr size_t WS_RE = 520 * MiB, WS_RP = 521 * MiB, WS_RG = 522 * MiB;
constexpr size_t WS_ROWTOK = 524 * MiB;
constexpr size_t WS_H = 528 * MiB;
constexpr size_t WS_Y = 672 * MiB;
constexpr size_t WS_MODP = 816 * MiB;
constexpr size_t WS_END = 818 * MiB;
static_assert((size_t)PMAX * 256 * 1024 * 2 == 144 * MiB, "H / Y size");
constexpr int CW_TMO = 0, CW_CODE = 1;
constexpr int CW_BAR = 4096;
constexpr int CW_AQ = 6144;
constexpr int CW_CNT = 8192;

constexpr int RING_BYTES = 131072;
constexpr int LDS_BYTES = 147456;
constexpr int LCTL_OFF = 139264;
constexpr int L_MISC = LCTL_OFF;
constexpr int L_CNT = LCTL_OFF + 128;
constexpr int L_PFIRST = LCTL_OFF + 256;
constexpr int L_PEXP = LCTL_OFF + 512;
constexpr int L_HIST = LCTL_OFF + 512 + 4 * 320;
constexpr int L_TB = 110592;
static_assert(L_TB + 4 * 704 * 4 <= RING_BYTES && L_HIST + 256 <= LDS_BYTES && PMAX <= 320, "LDS map");

typedef unsigned short bf16;
typedef unsigned v4u __attribute__((ext_vector_type(4)));
typedef unsigned v2u __attribute__((ext_vector_type(2)));
typedef float f32x4 __attribute__((ext_vector_type(4)));
typedef float f32x16 __attribute__((ext_vector_type(16)));
typedef short bf16x8 __attribute__((ext_vector_type(8)));
typedef GAS unsigned gu32;
#define RLX_AGENT __ATOMIC_RELAXED, __HIP_MEMORY_SCOPE_AGENT
#define LDS_WAIT() asm volatile("s_waitcnt lgkmcnt(0)" ::: "memory")
#define VM_WAIT() asm volatile("s_waitcnt vmcnt(0)" ::: "memory")
__device__ __forceinline__ unsigned f2bf(float f) { unsigned u = __builtin_bit_cast(unsigned, f); return (u + 0x7fffu + ((u >> 16) & 1u)) >> 16; }
__device__ __forceinline__ unsigned pk2(float lo, float hi) { return f2bf(lo) | (f2bf(hi) << 16); }
__device__ __forceinline__ float bfl(unsigned w) { return __uint_as_float(w << 16); }
__device__ __forceinline__ float bfh(unsigned w) { return __uint_as_float(w & 0xffff0000u); }

namespace attn_body {
using bf16=__hip_bfloat16;
using bf16x8=__attribute__((ext_vector_type(8)))short;
using s16x4=__attribute__((ext_vector_type(4)))short;
using f32x16=__attribute__((ext_vector_type(16)))float;
using u32x4=__attribute__((ext_vector_type(4)))unsigned;
constexpr int SEQ=2048,DH=64,PQ=512,PO=1024;
constexpr int NW=8,QBLK=32,QB=QBLK*NW,KVBLK=64,NQB=SEQ/QB;
__device__ __forceinline__ int crow(int r,int hi){return (r&3)+8*(r>>2)+4*hi;}
#define SBAR() __builtin_amdgcn_sched_barrier(0)
constexpr int TBN=704, TBOFF=447;
__device__ __forceinline__ void bandinit(f32x16&p0,f32x16&p1,int t,int q0,int wid,int r32,int hi,const __attribute__((address_space(3))) float*tb){
  const __attribute__((address_space(3))) float*tp=tb+(64*t+4*hi-(q0+32*wid+r32)+TBOFF);
  #pragma unroll
  for(int r=0;r<16;++r){p0[r]=tp[(r&3)+8*(r>>2)]; p1[r]=tp[(r&3)+8*(r>>2)+32];}
}
__device__ __forceinline__ void bandpost(f32x16&p0,f32x16&p1,const f32x16&negm,int t,int q0,int wid){
  const float nm=(t>(q0>>6)+(wid>>1))?-INFINITY:negm[0];
  #pragma unroll
  for(int r=0;r<16;++r){p0[r]+=nm;p1[r]+=nm;}
}
constexpr int NSLOT=3, SLOTB=8192;
constexpr int LDS_K=0, LDS_V=NSLOT*SLOTB, LDS_WS=2*NSLOT*SLOTB, LDS_OST=LDS_WS+NW*64*4, LDS_BYTES=LDS_OST+NW*4096;
__device__ __forceinline__ void glds16(const void*gsrc,unsigned lds_dst){unsigned keep;
  asm volatile("s_mov_b32 %0, m0\n\ts_mov_b32 m0, %2\n\ts_nop 0\n\tglobal_load_lds_dwordx4 %1, off\n\ts_mov_b32 m0, %0":"=&s"(keep):"v"(gsrc),"s"(lds_dst):"memory");}
__device__ __forceinline__ float max3f(float a,float b,float c){float r;asm("v_max3_f32 %0, %1, %2, %3":"=v"(r):"v"(a),"v"(b),"v"(c));return r;}
__device__ __forceinline__ float max2f(float a,float b){float r;asm("v_max_f32_e32 %0, %1, %2":"=v"(r):"v"(a),"v"(b));return r;}
__device__ __forceinline__ float fadd_s(float a,float b){float r;asm("v_add_f32_e32 %0, %1, %2":"=v"(r):"v"(a),"v"(b));return r;}
__device__ __forceinline__ float fsub_s(float a,float b){float r;asm("v_sub_f32_e32 %0, %1, %2":"=v"(r):"v"(a),"v"(b));return r;}
typedef float f32x2_t __attribute__((ext_vector_type(2))); typedef __bf16 bf16x2_t __attribute__((ext_vector_type(2)));
__device__ __forceinline__ unsigned cvtpk_s(float lo,float hi){f32x2_t v={lo,hi};bf16x2_t b=__builtin_convertvector(v,bf16x2_t);return __builtin_bit_cast(unsigned,b);}
#define WAIT_BAR(N) asm volatile("s_waitcnt vmcnt(" #N ") lgkmcnt(0)\n\ts_barrier":::"memory")

__device__ __forceinline__ void qkt(f32x16&p0,f32x16&p1,const char*Kslot,const bf16x8*qr,int r32,int hi){
  const char*kb=Kslot+hi*1024+r32*16;
  #pragma unroll
  for(int d0=0;d0<4;++d0){
    const bf16x8 b0=*reinterpret_cast<const bf16x8*>(kb+d0*2048);
    const bf16x8 b1=*reinterpret_cast<const bf16x8*>(kb+d0*2048+512);
    p0=__builtin_amdgcn_mfma_f32_32x32x16_bf16(b0,qr[d0],p0,0,0,0);p1=__builtin_amdgcn_mfma_f32_32x32x16_bf16(b1,qr[d0],p1,0,0,0);}
}
typedef __attribute__((address_space(3))) const char* lds_cptr;
typedef short v4i16_t __attribute__((ext_vector_type(4)));
__device__ __forceinline__ void kload8(bf16x8*kf,lds_cptr kp){
  kf[0]=*(const __attribute__((address_space(3))) bf16x8*)(kp);      kf[1]=*(const __attribute__((address_space(3))) bf16x8*)(kp+512);
  kf[2]=*(const __attribute__((address_space(3))) bf16x8*)(kp+2048); kf[3]=*(const __attribute__((address_space(3))) bf16x8*)(kp+2560);
  kf[4]=*(const __attribute__((address_space(3))) bf16x8*)(kp+4096); kf[5]=*(const __attribute__((address_space(3))) bf16x8*)(kp+4608);
  kf[6]=*(const __attribute__((address_space(3))) bf16x8*)(kp+6144); kf[7]=*(const __attribute__((address_space(3))) bf16x8*)(kp+6656);
}
__device__ __forceinline__ void kload2(bf16x8*kf,lds_cptr kp,int j){ kf[2*j]=*(const __attribute__((address_space(3))) bf16x8*)(kp+j*2048); kf[2*j+1]=*(const __attribute__((address_space(3))) bf16x8*)(kp+j*2048+512); }
__device__ __forceinline__ s16x4 vtr(lds_cptr p){ return __builtin_bit_cast(s16x4,__builtin_amdgcn_ds_read_tr16_b64_v4i16((__attribute__((address_space(3))) v4i16_t*)p)); }
__device__ __forceinline__ float rowmax(const f32x16&p0,const f32x16&p1){
  float a=max3f(p0[0],p0[1],p1[0]),b=max3f(p0[2],p0[3],p1[1]);a=max3f(a,p1[2],p1[3]);
  #pragma unroll
  for(int r=4;r<16;r+=4){a=max3f(a,p0[r],p0[r+1]);b=max3f(b,p0[r+2],p0[r+3]);a=max3f(a,p1[r],p1[r+1]);b=max3f(b,p1[r+2],p1[r+3]);}
  const float m=max2f(a,b);
  auto rr=__builtin_amdgcn_permlane32_swap(__float_as_uint(m),__float_as_uint(m),false,false);
  return max2f(__uint_as_float(rr[0]),__uint_as_float(rr[1]));
}
__device__ __forceinline__ void pv(f32x16*o,int vb,bf16x8 pa0,bf16x8 pa1,bf16x8 pa2,bf16x8 pa3){
  #pragma unroll
  for(int d0=0;d0<2;++d0){s16x4 lo[4],hi[4];
    #pragma unroll
    for(int ks=0;ks<4;++ks){
      asm volatile("ds_read_b64_tr_b16 %0,%1 offset:%c2":"=&v"(lo[ks]):"v"(vb),"i"(d0*4096+ks*1024):"memory");
      asm volatile("ds_read_b64_tr_b16 %0,%1 offset:%c2":"=&v"(hi[ks]):"v"(vb),"i"(d0*4096+ks*1024+512):"memory");}
    asm volatile("s_waitcnt lgkmcnt(0)":::"memory");SBAR();
    #define PK(k) (bf16x8){lo[k][0],lo[k][1],lo[k][2],lo[k][3],hi[k][0],hi[k][1],hi[k][2],hi[k][3]}
    o[d0]=__builtin_amdgcn_mfma_f32_32x32x16_bf16(pa0,PK(0),o[d0],0,0,0);
    o[d0]=__builtin_amdgcn_mfma_f32_32x32x16_bf16(pa1,PK(1),o[d0],0,0,0);
    o[d0]=__builtin_amdgcn_mfma_f32_32x32x16_bf16(pa2,PK(2),o[d0],0,0,0);
    o[d0]=__builtin_amdgcn_mfma_f32_32x32x16_bf16(pa3,PK(3),o[d0],0,0,0);
    #undef PK
  }
}
#define ATTN_STORE16(p,v) (*(u32x4*)(p)=(v))
template<int THRL> __device__ __forceinline__ void attn_unit(int b,int j,int vh,int qb,const bf16*Q,const bf16*__restrict__ K,const bf16*__restrict__ V,bf16*O,char*shm,const __attribute__((address_space(3))) float*tbh){
  int tid_=threadIdx.x; asm volatile("":"+v"(tid_));
  const int tid=tid_,lane=tid&63,r32=lane&31,hi=lane>>5; const int wid=__builtin_amdgcn_readfirstlane(tid>>6);
  const long rowbase=(long)b*SEQ; const int q0=qb*QB;
  const bf16*Qw=Q+(rowbase+q0+wid*QBLK)*PQ+j*DH;
  const bf16*Kh=K+rowbase*PQ+j*DH,*Vh=V+rowbase*PQ+(j>>1)*128+vh*64;
  const unsigned lds0=(unsigned)(uintptr_t)shm;
  float*wsf=(float*)(shm+LDS_WS)+wid*64;
  const bf16*ksrc=Kh+(long)lane*PQ+wid*8;
  const bf16*vsrc=Vh+(long)(16*(wid&3)+(lane>>2))*PQ+(wid>>2)*32+(lane&3)*8;
  const unsigned kdst=lds0+LDS_K+wid*1024, vdst=lds0+LDS_V+wid*1024;
  #define DMA_K(t,slot) glds16(ksrc+(long)(t)*KVBLK*PQ,(unsigned)__builtin_amdgcn_readfirstlane(kdst+(slot)))
  #define DMA_V(t,slot) glds16(vsrc+(long)(t)*KVBLK*PQ,(unsigned)__builtin_amdgcn_readfirstlane(vdst+(slot)))
  const int vb0=(int)(lds0+LDS_V)+((lane>>4)&1)*32+(lane&3)*8+(4*hi+((lane&15)>>2))*64;
  const char*Kbase=shm+LDS_K; bf16x8 kf[8];
  const lds_cptr shm3=(lds_cptr)shm; const lds_cptr kp0=shm3+LDS_K+hi*1024+r32*16; const lds_cptr vp0=shm3+LDS_V+((lane>>4)&1)*32+(lane&3)*8+(4*hi+((lane&15)>>2))*64;
  const int NT=(q0+QB)/KVBLK;
  DMA_K(0,0);DMA_V(0,0);DMA_K(1,SLOTB);
  bf16x8 qr[4];
  #pragma unroll
  for(int d0=0;d0<4;++d0)qr[d0]=*reinterpret_cast<const bf16x8*>(&Qw[(long)r32*PQ+d0*16+hi*8]);
  float mhat=0.f,l_reg=0.f;f32x16 o[2];o[0]=f32x16{};o[1]=f32x16{};f32x16 negm=f32x16{};asm volatile("":"+v"(negm));
  #define BINIT(C0,C1,t) bandinit(C0,C1,(t),q0,wid,r32,hi,tbh)
  bool resc=false;
  #define START(P0,P1) do{ const float rm=rowmax(P0,P1); resc=false; \
    { const float dl=rm; mhat=fadd_s(mhat,dl); \
      _Pragma("unroll") for(int r=0;r<16;++r){P0[r]=fsub_s(P0[r],dl);P1[r]=fsub_s(P1[r],dl);} \
      _Pragma("unroll") for(int r=0;r<16;++r)negm[r]=-mhat; asm volatile("":"+v"(negm)); } \
    _Pragma("unroll") for(int r=0;r<16;++r)P0[r]=__builtin_amdgcn_exp2f(P0[r]); }while(0)
  #define RESC() do{ if(resc){ asm volatile("s_waitcnt lgkmcnt(0)":::"memory"); \
      _Pragma("unroll") for(int d_=0;d_<2;++d_) _Pragma("unroll") for(int r=0;r<16;++r)o[d_][r]*=wsf[crow(r,hi)]; } }while(0)
  f32x16 pA0,pA1,pB0,pB1;
  int sl_prev=0,sl_cur=0,sl_next=SLOTB;
  #define ROT() do{sl_prev=sl_cur;sl_cur=sl_next;sl_next=(sl_next==(NSLOT-1)*SLOTB)?0:sl_next+SLOTB;}while(0)
  DMA_K(2,2*SLOTB);
  WAIT_BAR(3);
  if(NT<=7){BINIT(pA0,pA1,0);}else{pA0=f32x16{};pA1=f32x16{};}
  qkt(pA0,pA1,Kbase,qr,r32,hi);asm volatile("s_nop 15\n\ts_nop 7":"+v"(pA0),"+v"(pA1));
  START(pA0,pA1);
  _Pragma("unroll") for(int r=0;r<16;++r)pA1[r]=__builtin_amdgcn_exp2f(pA1[r]);
  WAIT_BAR(0);
  DMA_K(3,0);DMA_V(1,SLOTB);
  ROT();
  kload8(kf,kp0+sl_cur);
  WAIT_BAR(2);
  s16x4 vlo[8],vhi[8]; u32x4 pw0,pw1,pw2,pw3;
  #define PKW(P,B) cvtpk_s(P[B],P[B+1])
  #define PAF(k) __builtin_bit_cast(bf16x8,pw##k)
  #define VFR(i) (bf16x8){vlo[i][0],vlo[i][1],vlo[i][2],vlo[i][3],vhi[i][0],vhi[i][1],vhi[i][2],vhi[i][3]}
  #define PIN(x) asm volatile("":"+v"(x))
  #define MX3(a,b,c) __builtin_fmaxf(__builtin_fmaxf((a),(b)),(c))
  #define GAPA(MF,A0,A1,A2,A3,W0,W1,PW) do{ MF; sacc+=A0; sacc+=A1; sacc+=A2; sacc+=A3; PIN(sacc); W0; W1; PIN(PW); SBAR(); }while(0)
  #define EX(v) __builtin_amdgcn_exp2f(v)
  #define GAPB(MF,X,B) do{ MF; X[B]=EX(X[B]); X[B+1]=EX(X[B+1]); X[B+2]=EX(X[B+2]); X[B+3]=EX(X[B+3]); PIN(X); SBAR(); }while(0)
  #define VRD(i) do{ vlo[i]=vtr(vp_+(((i)>>2)*4096+((i)&3)*1024)); vhi[i]=vtr(vp_+(((i)>>2)*4096+((i)&3)*1024+512)); }while(0)
  #define KRD(G,j) do{ if(G){ kload2(kf,kp0+sl_next,j); SBAR(); } }while(0)
  #define STEP(C0,C1,P0,P1,t,GK,GV,GL,PRE,I0,I1,POST) do{ SBAR(); PRE; SBAR(); \
    const lds_cptr vp_=vp0+sl_prev; \
    VRD(0); SBAR(); float sacc=(P0[0]+P0[1]); \
    GAPA(C0=__builtin_amdgcn_mfma_f32_32x32x16_bf16(kf[0],qr[0],I0,0,0,0), P0[2],P0[3],P0[4],P0[5],     pw0[0]=PKW(P0,0), pw0[1]=PKW(P0,2), pw0); \
    VRD(4); SBAR(); GAPA(C1=__builtin_amdgcn_mfma_f32_32x32x16_bf16(kf[1],qr[0],I1,0,0,0), P0[6],P0[7],P0[8],P0[9],     pw0[2]=PKW(P0,4), pw0[3]=PKW(P0,6), pw0); \
    VRD(1); SBAR(); GAPA(C0=__builtin_amdgcn_mfma_f32_32x32x16_bf16(kf[2],qr[1],C0,0,0,0),   P0[10],P0[11],P0[12],P0[13], pw1[0]=PKW(P0,8), pw1[1]=PKW(P0,10), pw1); \
    VRD(5); SBAR(); GAPA(C1=__builtin_amdgcn_mfma_f32_32x32x16_bf16(kf[3],qr[1],C1,0,0,0),   P0[14],P0[15],P1[0],P1[1],   pw1[2]=PKW(P0,12),pw1[3]=PKW(P0,14), pw1); \
    VRD(2); SBAR(); GAPA(C0=__builtin_amdgcn_mfma_f32_32x32x16_bf16(kf[4],qr[2],C0,0,0,0),   P1[2],P1[3],P1[4],P1[5],     pw2[0]=PKW(P1,0), pw2[1]=PKW(P1,2), pw2); \
    VRD(6); SBAR(); GAPA(C1=__builtin_amdgcn_mfma_f32_32x32x16_bf16(kf[5],qr[2],C1,0,0,0),   P1[6],P1[7],P1[8],P1[9],     pw2[2]=PKW(P1,4), pw2[3]=PKW(P1,6), pw2); \
    VRD(3); SBAR(); GAPA(C0=__builtin_amdgcn_mfma_f32_32x32x16_bf16(kf[6],qr[3],C0,0,0,0),   P1[10],P1[11],P1[12],P1[13], pw3[0]=PKW(P1,8), pw3[1]=PKW(P1,10), pw3); \
    VRD(7); SBAR(); GAPA(C1=__builtin_amdgcn_mfma_f32_32x32x16_bf16(kf[7],qr[3],C1,0,0,0),   P1[14],P1[15],0.f,0.f,       pw3[2]=PKW(P1,12),pw3[3]=PKW(P1,14), pw3); \
    l_reg+=sacc; \
    if(GK){DMA_K((t)+3,sl_cur);} if(GV){DMA_V((t)+1,sl_next);} \
    POST; \
    { float a=MX3(C0[0],C0[1],C1[0]),b=MX3(C0[2],C0[3],C1[1]); a=MX3(a,C1[2],C1[3]); \
      _Pragma("unroll") for(int r=4;r<16;r+=4){a=MX3(a,C0[r],C0[r+1]);b=MX3(b,C0[r+2],C0[r+3]);a=MX3(a,C1[r],C1[r+1]);b=MX3(b,C1[r+2],C1[r+3]);} \
      float rm=__builtin_fmaxf(a,b); { auto rr=__builtin_amdgcn_permlane32_swap(__float_as_uint(rm),__float_as_uint(rm),false,false); rm=__builtin_fmaxf(__uint_as_float(rr[0]),__uint_as_float(rr[1])); } \
      resc=false; \
      if(__builtin_expect(__any(rm>(float)THRL),0)){ const float dl=__builtin_fmaxf(rm,0.f); mhat+=dl; \
        _Pragma("unroll") for(int r=0;r<16;++r){C0[r]-=dl;C1[r]-=dl;} \
        _Pragma("unroll") for(int r=0;r<16;++r)negm[r]=-mhat; asm volatile("":"+v"(negm)); \
        const float f=__builtin_amdgcn_exp2f(-dl); l_reg*=f; if(hi==0)wsf[r32]=f; resc=true; } } \
    SBAR(); \
    GAPB(o[0]=__builtin_amdgcn_mfma_f32_32x32x16_bf16(PAF(0),VFR(0),o[0],0,0,0), C0,0); \
    GAPB(o[1]=__builtin_amdgcn_mfma_f32_32x32x16_bf16(PAF(0),VFR(4),o[1],0,0,0), C0,4); \
    KRD(GL,0); GAPB(o[0]=__builtin_amdgcn_mfma_f32_32x32x16_bf16(PAF(1),VFR(1),o[0],0,0,0), C0,8); \
    KRD(GL,1); GAPB(o[1]=__builtin_amdgcn_mfma_f32_32x32x16_bf16(PAF(1),VFR(5),o[1],0,0,0), C0,12); \
    KRD(GL,2); GAPB(o[0]=__builtin_amdgcn_mfma_f32_32x32x16_bf16(PAF(2),VFR(2),o[0],0,0,0), C1,0); \
    KRD(GL,3); GAPB(o[1]=__builtin_amdgcn_mfma_f32_32x32x16_bf16(PAF(2),VFR(6),o[1],0,0,0), C1,4); \
    GAPB(o[0]=__builtin_amdgcn_mfma_f32_32x32x16_bf16(PAF(3),VFR(3),o[0],0,0,0), C1,8); \
    GAPB(o[1]=__builtin_amdgcn_mfma_f32_32x32x16_bf16(PAF(3),VFR(7),o[1],0,0,0), C1,12); \
    }while(0)
  int t=1;
  for(;t+7<NT;t+=2){
    STEP(pB0,pB1,pA0,pA1,t,true,true,true,,negm,negm,);     WAIT_BAR(2); RESC(); ROT();
    STEP(pA0,pA1,pB0,pB1,t+1,true,true,true,,negm,negm,);   WAIT_BAR(2); RESC(); ROT();
  }
  #define ENDW(tt) do{ if((tt)+3<NT){WAIT_BAR(2);} else if((tt)+2<NT){WAIT_BAR(1);} else {WAIT_BAR(0);} }while(0)
  for(;t+1<NT;t+=2){
    STEP(pB0,pB1,pA0,pA1,t,(t+3<NT),(t+1<NT),(t+1<NT),BINIT(pB0,pB1,t),pB0,pB1,bandpost(pB0,pB1,negm,t,q0,wid));           ENDW(t);   RESC(); ROT();
    STEP(pA0,pA1,pB0,pB1,t+1,(t+4<NT),(t+2<NT),(t+2<NT),BINIT(pA0,pA1,t+1),pA0,pA1,bandpost(pA0,pA1,negm,t+1,q0,wid));       ENDW(t+1); RESC(); ROT();
  }
  STEP(pB0,pB1,pA0,pA1,NT-1,false,false,false,BINIT(pB0,pB1,NT-1),pB0,pB1,bandpost(pB0,pB1,negm,NT-1,q0,wid)); RESC();
  { float sacc=pB0[0]+pB0[1]; _Pragma("unroll") for(int r=2;r<16;++r)sacc+=pB0[r]; _Pragma("unroll") for(int r=0;r<16;++r)sacc+=pB1[r]; l_reg+=sacc;
    pw0=(u32x4){PKW(pB0,0),PKW(pB0,2),PKW(pB0,4),PKW(pB0,6)};pw1=(u32x4){PKW(pB0,8),PKW(pB0,10),PKW(pB0,12),PKW(pB0,14)};pw2=(u32x4){PKW(pB1,0),PKW(pB1,2),PKW(pB1,4),PKW(pB1,6)};pw3=(u32x4){PKW(pB1,8),PKW(pB1,10),PKW(pB1,12),PKW(pB1,14)};
    SBAR(); pv(o,vb0+sl_cur,PAF(0),PAF(1),PAF(2),PAF(3)); }
  #undef PKW
  #undef PAF
  #undef VFR
  #undef PIN
  #undef MX3
  #undef GAPA
  #undef GAPB
  #undef EX
  #undef VRD
  #undef KRD
  #undef STEP
  #undef ENDW
  {auto rr=__builtin_amdgcn_permlane32_swap(__float_as_uint(l_reg),__float_as_uint(l_reg),false,false);l_reg=__uint_as_float(rr[0])+__uint_as_float(rr[1]);}
  if(hi==0)wsf[32+r32]=l_reg;asm volatile("s_waitcnt lgkmcnt(0)":::"memory");
  float rli[16];
  #pragma unroll
  for(int r=0;r<16;++r)rli[r]=__builtin_amdgcn_rcpf(wsf[32+crow(r,hi)]);
  bf16*Ow=O+(rowbase+q0+wid*QBLK)*PO+j*128+vh*64;
  { bf16*stg=(bf16*)(shm+LDS_OST)+wid*2048;
    #pragma unroll
    for(int r=0;r<16;++r){const int orow=crow(r,hi);
      #pragma unroll
      for(int d0=0;d0<2;++d0)stg[orow*64+d0*32+r32]=__float2bfloat16(o[d0][r]*rli[r]);}
    asm volatile("s_waitcnt lgkmcnt(0)":::"memory");
    #pragma unroll
    for(int i=0;i<4;++i){const int row=i*8+(lane>>3),ch=lane&7; const u32x4 v=*(const u32x4*)(stg+row*64+ch*8); ATTN_STORE16(Ow+(long)row*PO+ch*8,v);} }
  asm volatile("s_waitcnt lgkmcnt(0)\n\ts_barrier":::"memory");
  #undef DMA_K
  #undef DMA_V
  #undef BINIT
  #undef START
  #undef RESC
  #undef ROT
}

constexpr int L2_K=0, L2_V=3*8192, L2_WS=L2_V+3*16384, L2_OST=L2_WS+NW*64*4, L2_BYTES=L2_OST+NW*4096;
__device__ __forceinline__ void addnm(f32x16&p0,f32x16&p1,float nm){
  #pragma unroll
  for(int r=0;r<16;++r){p0[r]+=nm;p1[r]+=nm;}
}
template<int THRL> __device__ __forceinline__ void attn_unit2(int b,int j,int qb,const bf16*Q,const bf16*__restrict__ K,const bf16*__restrict__ V,bf16*O,char*shm,const __attribute__((address_space(3))) float*tbh){
  int tid_=threadIdx.x; asm volatile("":"+v"(tid_));
  const int tid=tid_,lane=tid&63,r32=lane&31,hi=lane>>5; const int wid=__builtin_amdgcn_readfirstlane(tid>>6);
  const long rowbase=(long)b*SEQ; const int q0=qb*QB;
  const bf16*Qw=Q+(rowbase+q0+wid*QBLK)*PQ+j*DH;
  const bf16*Kh=K+rowbase*PQ+j*DH,*Vh=V+rowbase*PQ+(j>>1)*128;
  const unsigned lds0=(unsigned)(uintptr_t)shm;
  float*wsf=(float*)(shm+L2_WS)+wid*64;
  const bf16*ksrc=Kh+(long)lane*PQ+wid*8;
  const bf16*vsrc=Vh+(long)(16*(wid&3)+(lane>>2))*PQ+(wid>>2)*32+(lane&3)*8;
  const unsigned kdst=lds0+L2_K+wid*1024, vdst=lds0+L2_V+wid*1024;
  #define DMA_K(t,slot) glds16(ksrc+(long)(t)*KVBLK*PQ,(unsigned)__builtin_amdgcn_readfirstlane(kdst+(slot)))
  #define DMA_V(t,slot) do{ glds16(vsrc+(long)(t)*KVBLK*PQ,(unsigned)__builtin_amdgcn_readfirstlane(vdst+2*(slot))); glds16(vsrc+(long)(t)*KVBLK*PQ+64,(unsigned)__builtin_amdgcn_readfirstlane(vdst+2*(slot)+8192)); }while(0)
  const char*Kbase=shm+L2_K; bf16x8 kf[8];
  const lds_cptr shm3=(lds_cptr)shm; const lds_cptr kp0=shm3+L2_K+hi*1024+r32*16; const lds_cptr vp0=shm3+L2_V+((lane>>4)&1)*32+(lane&3)*8+(4*hi+((lane&15)>>2))*64;
  const int NT=(q0+QB)/KVBLK;
  DMA_K(0,0);DMA_V(0,0);DMA_K(1,SLOTB);
  bf16x8 qr[4];
  #pragma unroll
  for(int d0=0;d0<4;++d0)qr[d0]=*reinterpret_cast<const bf16x8*>(&Qw[(long)r32*PQ+d0*16+hi*8]);
  float mhat=0.f,l_reg=0.f;f32x16 o[4];o[0]=f32x16{};o[1]=f32x16{};o[2]=f32x16{};o[3]=f32x16{};
  const int cwv=(q0>>6)+(wid>>1);
  #define BINIT(C0,C1,t) bandinit(C0,C1,(t),q0,wid,r32,hi,tbh)
  bool resc=false;
  #define START(P0,P1) do{ const float rm=rowmax(P0,P1); resc=false; \
    { const float dl=rm; mhat=fadd_s(mhat,dl); \
      _Pragma("unroll") for(int r=0;r<16;++r){P0[r]=fsub_s(P0[r],dl);P1[r]=fsub_s(P1[r],dl);} } \
    _Pragma("unroll") for(int r=0;r<16;++r)P0[r]=__builtin_amdgcn_exp2f(P0[r]); }while(0)
  #define RESC() do{ if(resc){ asm volatile("s_waitcnt lgkmcnt(0)":::"memory"); \
      _Pragma("unroll") for(int d_=0;d_<4;++d_) _Pragma("unroll") for(int r=0;r<16;++r)o[d_][r]*=wsf[crow(r,hi)]; } }while(0)
  f32x16 pA0,pA1,pB0,pB1;
  int sl_prev=0,sl_cur=0,sl_next=SLOTB;
  #define ROT() do{sl_prev=sl_cur;sl_cur=sl_next;sl_next=(sl_next==(NSLOT-1)*SLOTB)?0:sl_next+SLOTB;}while(0)
  DMA_K(2,2*SLOTB);
  WAIT_BAR(4);
  if(NT<=7){BINIT(pA0,pA1,0);}else{pA0=f32x16{};pA1=f32x16{};}
  qkt(pA0,pA1,Kbase,qr,r32,hi);asm volatile("s_nop 15\n\ts_nop 7":"+v"(pA0),"+v"(pA1));
  START(pA0,pA1);
  _Pragma("unroll") for(int r=0;r<16;++r)pA1[r]=__builtin_amdgcn_exp2f(pA1[r]);
  WAIT_BAR(0);
  DMA_K(3,0);DMA_V(1,SLOTB);
  ROT();
  kload8(kf,kp0+sl_cur);
  WAIT_BAR(3);
  s16x4 vl[4],vh[4]; u32x4 pw0,pw1,pw2,pw3;
  #define PKW(P,B) cvtpk_s(P[B],P[B+1])
  #define PAF(k) __builtin_bit_cast(bf16x8,pw##k)
  #define PIN(x) asm volatile("":"+v"(x))
  #define MX3(a,b,c) __builtin_fmaxf(__builtin_fmaxf((a),(b)),(c))
  #define GAPA(MF,A0,A1,A2,A3,W0,W1,PW) do{ MF; sacc+=A0; sacc+=A1; sacc+=A2; sacc+=A3; PIN(sacc); W0; W1; PIN(PW); SBAR(); }while(0)
  #define EX(v) __builtin_amdgcn_exp2f(v)
  #define VRDW(n) do{ vl[(n)&3]=vtr(vp_+(((n)&3)*4096+((n)>>2)*1024)); vh[(n)&3]=vtr(vp_+(((n)&3)*4096+((n)>>2)*1024+512)); }while(0)
  #define VFW(n) (bf16x8){vl[(n)&3][0],vl[(n)&3][1],vl[(n)&3][2],vl[(n)&3][3],vh[(n)&3][0],vh[(n)&3][1],vh[(n)&3][2],vh[(n)&3][3]}
  #define KRD(G,jj) do{ if(G){ kload2(kf,kp0+sl_next,jj); SBAR(); } }while(0)
  #define GAPV(n,PK,X,B) do{ o[(n)&3]=__builtin_amdgcn_mfma_f32_32x32x16_bf16(PK,VFW(n),o[(n)&3],0,0,0); X[B]=EX(X[B]); X[B+1]=EX(X[B+1]); PIN(X); if((n)+2<16){VRDW((n)+2);} SBAR(); }while(0)
  #define STEP(C0,C1,P0,P1,t,GK,GV,GL,PRE,I0,I1) do{ SBAR(); PRE; SBAR(); \
    const lds_cptr vp_=vp0+2*sl_prev; \
    float sacc=(P0[0]+P0[1]); \
    GAPA(C0=__builtin_amdgcn_mfma_f32_32x32x16_bf16(kf[0],qr[0],I0,0,0,0), P0[2],P0[3],P0[4],P0[5],     pw0[0]=PKW(P0,0), pw0[1]=PKW(P0,2), pw0); \
    GAPA(C1=__builtin_amdgcn_mfma_f32_32x32x16_bf16(kf[1],qr[0],I1,0,0,0), P0[6],P0[7],P0[8],P0[9],     pw0[2]=PKW(P0,4), pw0[3]=PKW(P0,6), pw0); \
    GAPA(C0=__builtin_amdgcn_mfma_f32_32x32x16_bf16(kf[2],qr[1],C0,0,0,0),   P0[10],P0[11],P0[12],P0[13], pw1[0]=PKW(P0,8), pw1[1]=PKW(P0,10), pw1); \
    GAPA(C1=__builtin_amdgcn_mfma_f32_32x32x16_bf16(kf[3],qr[1],C1,0,0,0),   P0[14],P0[15],P1[0],P1[1],   pw1[2]=PKW(P0,12),pw1[3]=PKW(P0,14), pw1); \
    GAPA(C0=__builtin_amdgcn_mfma_f32_32x32x16_bf16(kf[4],qr[2],C0,0,0,0),   P1[2],P1[3],P1[4],P1[5],     pw2[0]=PKW(P1,0), pw2[1]=PKW(P1,2), pw2); \
    GAPA(C1=__builtin_amdgcn_mfma_f32_32x32x16_bf16(kf[5],qr[2],C1,0,0,0),   P1[6],P1[7],P1[8],P1[9],     pw2[2]=PKW(P1,4), pw2[3]=PKW(P1,6), pw2); \
    VRDW(0); SBAR(); GAPA(C0=__builtin_amdgcn_mfma_f32_32x32x16_bf16(kf[6],qr[3],C0,0,0,0),   P1[10],P1[11],P1[12],P1[13], pw3[0]=PKW(P1,8), pw3[1]=PKW(P1,10), pw3); \
    VRDW(1); SBAR(); GAPA(C1=__builtin_amdgcn_mfma_f32_32x32x16_bf16(kf[7],qr[3],C1,0,0,0),   P1[14],P1[15],0.f,0.f,       pw3[2]=PKW(P1,12),pw3[3]=PKW(P1,14), pw3); \
    l_reg+=sacc; \
    if(GK){DMA_K((t)+3,sl_cur);} if(GV){DMA_V((t)+1,sl_next);} \
    addnm(C0,C1,((t)>cwv)?-INFINITY:-mhat); \
    { float a=MX3(C0[0],C0[1],C1[0]),b_=MX3(C0[2],C0[3],C1[1]); a=MX3(a,C1[2],C1[3]); \
      _Pragma("unroll") for(int r=4;r<16;r+=4){a=MX3(a,C0[r],C0[r+1]);b_=MX3(b_,C0[r+2],C0[r+3]);a=MX3(a,C1[r],C1[r+1]);b_=MX3(b_,C1[r+2],C1[r+3]);} \
      float rm=__builtin_fmaxf(a,b_); { auto rr=__builtin_amdgcn_permlane32_swap(__float_as_uint(rm),__float_as_uint(rm),false,false); rm=__builtin_fmaxf(__uint_as_float(rr[0]),__uint_as_float(rr[1])); } \
      resc=false; \
      if(__builtin_expect(__any(rm>(float)THRL),0)){ const float dl=__builtin_fmaxf(rm,0.f); mhat+=dl; \
        _Pragma("unroll") for(int r=0;r<16;++r){C0[r]-=dl;C1[r]-=dl;} \
        const float f=__builtin_amdgcn_exp2f(-dl); l_reg*=f; if(hi==0)wsf[r32]=f; resc=true; } } \
    SBAR(); \
    GAPV(0,PAF(0),C0,0);  GAPV(1,PAF(0),C0,2);  GAPV(2,PAF(0),C0,4);  GAPV(3,PAF(0),C0,6); \
    KRD(GL,0); GAPV(4,PAF(1),C0,8);  KRD(GL,1); GAPV(5,PAF(1),C0,10); KRD(GL,2); GAPV(6,PAF(1),C0,12); KRD(GL,3); GAPV(7,PAF(1),C0,14); \
    GAPV(8,PAF(2),C1,0);  GAPV(9,PAF(2),C1,2);  GAPV(10,PAF(2),C1,4); GAPV(11,PAF(2),C1,6); \
    GAPV(12,PAF(3),C1,8); GAPV(13,PAF(3),C1,10);GAPV(14,PAF(3),C1,12);GAPV(15,PAF(3),C1,14); \
    }while(0)
  const f32x16 zero16=f32x16{};
  int t=1;
  for(;t+7<NT;t+=2){
    STEP(pB0,pB1,pA0,pA1,t,true,true,true,,zero16,zero16);     WAIT_BAR(3); RESC(); ROT();
    STEP(pA0,pA1,pB0,pB1,t+1,true,true,true,,zero16,zero16);   WAIT_BAR(3); RESC(); ROT();
  }
  #define ENDW(tt) do{ if((tt)+3<NT){WAIT_BAR(3);} else if((tt)+2<NT){WAIT_BAR(2);} else {WAIT_BAR(0);} }while(0)
  for(;t+1<NT;t+=2){
    STEP(pB0,pB1,pA0,pA1,t,(t+3<NT),(t+1<NT),(t+1<NT),BINIT(pB0,pB1,t),pB0,pB1);           ENDW(t);   RESC(); ROT();
    STEP(pA0,pA1,pB0,pB1,t+1,(t+4<NT),(t+2<NT),(t+2<NT),BINIT(pA0,pA1,t+1),pA0,pA1);       ENDW(t+1); RESC(); ROT();
  }
  STEP(pB0,pB1,pA0,pA1,NT-1,false,false,false,BINIT(pB0,pB1,NT-1),pB0,pB1); RESC();
  { float sacc=pB0[0]+pB0[1]; _Pragma("unroll") for(int r=2;r<16;++r)sacc+=pB0[r]; _Pragma("unroll") for(int r=0;r<16;++r)sacc+=pB1[r]; l_reg+=sacc;
    pw0=(u32x4){PKW(pB0,0),PKW(pB0,2),PKW(pB0,4),PKW(pB0,6)};pw1=(u32x4){PKW(pB0,8),PKW(pB0,10),PKW(pB0,12),PKW(pB0,14)};pw2=(u32x4){PKW(pB1,0),PKW(pB1,2),PKW(pB1,4),PKW(pB1,6)};pw3=(u32x4){PKW(pB1,8),PKW(pB1,10),PKW(pB1,12),PKW(pB1,14)};
    SBAR(); const int vbd=(int)(lds0+L2_V)+((lane>>4)&1)*32+(lane&3)*8+(4*hi+((lane&15)>>2))*64+2*sl_cur;
    pv(o,vbd,PAF(0),PAF(1),PAF(2),PAF(3)); pv(o+2,vbd+8192,PAF(0),PAF(1),PAF(2),PAF(3)); }
  #undef PKW
  #undef PAF
  #undef PIN
  #undef MX3
  #undef GAPA
  #undef EX
  #undef VRDW
  #undef VFW
  #undef KRD
  #undef GAPV
  #undef STEP
  #undef ENDW
  {auto rr=__builtin_amdgcn_permlane32_swap(__float_as_uint(l_reg),__float_as_uint(l_reg),false,false);l_reg=__uint_as_float(rr[0])+__uint_as_float(rr[1]);}
  if(hi==0)wsf[32+r32]=l_reg;asm volatile("s_waitcnt lgkmcnt(0)":::"memory");
  float rli[16];
  #pragma unroll
  for(int r=0;r<16;++r)rli[r]=__builtin_amdgcn_rcpf(wsf[32+crow(r,hi)]);
  bf16*Ow=O+(rowbase+q0+wid*QBLK)*PO+j*128;
  #pragma unroll
  for(int hf=0;hf<2;++hf){ bf16*stg=(bf16*)(shm+L2_OST)+wid*2048;
    #pragma unroll
    for(int r=0;r<16;++r){const int orow=crow(r,hi);
      #pragma unroll
      for(int d0=0;d0<2;++d0)stg[orow*64+d0*32+r32]=__float2bfloat16(o[2*hf+d0][r]*rli[r]);}
    asm volatile("s_waitcnt lgkmcnt(0)":::"memory");
    #pragma unroll
    for(int i=0;i<4;++i){const int row=i*8+(lane>>3),ch=lane&7; const u32x4 v=*(const u32x4*)(stg+row*64+ch*8); ATTN_STORE16(Ow+(long)row*PO+hf*64+ch*8,v);}
    asm volatile("s_waitcnt lgkmcnt(0)":::"memory"); }
  asm volatile("s_waitcnt lgkmcnt(0)\n\ts_barrier":::"memory");
  #undef DMA_K
  #undef DMA_V
  #undef BINIT
  #undef START
  #undef RESC
  #undef ROT
}
constexpr int ATTN_LDS_BYTES=LDS_BYTES;
#undef SBAR
#undef WAIT_BAR
}

#define XB_TMO      128
#define XB_XCNT(j)  (256  + 64 * (j))
#define XB_XSUB(j)  (1280 + 64 * (j))
#define XB_XGEN(j)  (2304 + 64 * (j))
#define XB_TOP      3328
#define XB_TOPGEN   3392
#define XCD_BAR_WORDS 3456
#define XB_SPIN_CAP (1u << 18)
__device__ __forceinline__ unsigned xb_ld(unsigned* p)              { return __hip_atomic_load(p, __ATOMIC_RELAXED, __HIP_MEMORY_SCOPE_AGENT); }
__device__ __forceinline__ unsigned xb_add(unsigned* p, unsigned v) { return __hip_atomic_fetch_add(p, v, __ATOMIC_RELAXED, __HIP_MEMORY_SCOPE_AGENT); }
__device__ __forceinline__ unsigned xb_xcc_id() { return (unsigned)__builtin_amdgcn_s_getreg((3 << 11) | 20) & 0xFu; }
#define XB_SPIN(cond, bar) do { unsigned _sp = 0; while (cond) { __builtin_amdgcn_s_sleep(1); \
    if ((++_sp & 255u) == 0u) { if (xb_ld(&(bar)[XB_TMO])) break; if (_sp > XB_SPIN_CAP) { atomicAdd(&(bar)[XB_TMO], 1u); break; } } } } while (0)
struct XcdBarrier { unsigned* bar; unsigned x; volatile LAS unsigned* st; };
__device__ __forceinline__ XcdBarrier xcd_barrier_post(unsigned* bar, volatile LAS unsigned* st) {
    XcdBarrier b; b.bar = bar; b.x = xb_xcc_id(); b.st = st;
    if (threadIdx.x == 0) (void)xb_add(&bar[XB_XCNT(b.x)], 1u);
    return b;
}
__device__ __forceinline__ void xcd_barrier_complete(unsigned* bar, unsigned x, unsigned& nloc, unsigned& nx) {
    const unsigned G = gridDim.x * gridDim.y * gridDim.z;
    unsigned sum, cnt, mine, sp = 0u;
    for (;;) {
        sum = 0u; cnt = 0u; mine = 0u;
#pragma unroll
        for (unsigned j = 0; j < 16; ++j) { const unsigned c = xb_ld(&bar[XB_XCNT(j)]); sum += c; cnt += (c > 0u) ? 1u : 0u; mine = (j == x) ? c : mine; }
        if (sum == G) break;
        __builtin_amdgcn_s_sleep(1);
        if ((++sp & 255u) == 0u) { if (xb_ld(&bar[XB_TMO])) break; if (sp > XB_SPIN_CAP) { atomicAdd(&bar[XB_TMO], 1u); break; } }
    }
    nloc = mine > 0u ? mine : 1u; nx = cnt > 0u ? cnt : 1u;
}
__device__ __forceinline__ void xcd_barrier(const XcdBarrier& b) {
    asm volatile("s_waitcnt vmcnt(0)" ::: "memory");
    __syncthreads();
    if (threadIdx.x == 0) {
        unsigned* bar = b.bar;
        __builtin_amdgcn_s_waitcnt(0);
        unsigned nloc = b.st[0], nx = b.st[1];
        if (nloc == 0u) { xcd_barrier_complete(bar, b.x, nloc, nx); b.st[0] = nloc; b.st[1] = nx; }
        const unsigned old = xb_add(&bar[XB_XSUB(b.x)], 1u);
        const unsigned gen = old / nloc;
        if (old + 1u == (gen + 1u) * nloc) {
            __builtin_amdgcn_fence(__ATOMIC_RELEASE, "agent");
            asm volatile("s_waitcnt vmcnt(0)" ::: "memory");
            const unsigned og = xb_add(&bar[XB_TOP], 1u);
            const unsigned tg = og / nx;
            if (og + 1u == (tg + 1u) * nx) xb_add(&bar[XB_TOPGEN], 1u);
            else XB_SPIN(xb_ld(&bar[XB_TOPGEN]) == tg, bar);
            __builtin_amdgcn_fence(__ATOMIC_ACQUIRE, "agent");
            xb_add(&bar[XB_XGEN(b.x)], 1u);
            asm volatile("s_waitcnt vmcnt(0)" ::: "memory");
        } else {
            XB_SPIN(xb_ld(&bar[XB_XGEN(b.x)]) == gen, bar);
            __builtin_amdgcn_fence(__ATOMIC_ACQUIRE, "agent");
            asm volatile("s_waitcnt vmcnt(0)" ::: "memory");
        }
    }
    __syncthreads();
}

struct Frame {
    LAS unsigned char* lds;
    unsigned char* ws;
    gu32* ctl;
    int tid, lane, wave;
    int vcu, G;
};
#define DPP_ADD(v, ctrl, rmask) ((v) + __builtin_bit_cast(float, __builtin_amdgcn_update_dpp(0, __builtin_bit_cast(int, (v)), (ctrl), (rmask), 0xf, false)))
__device__ __forceinline__ float row16_sum(float v) {
    v = DPP_ADD(v, 0xB1, 0xf);
    v = DPP_ADD(v, 0x4E, 0xf);
    v = DPP_ADD(v, 0x141, 0xf);
    v = DPP_ADD(v, 0x140, 0xf);
    return v;
}
__device__ __forceinline__ float wave_sum(float v) {
    v = row16_sum(v);
    v = DPP_ADD(v, 0x142, 0xa);
    v = DPP_ADD(v, 0x143, 0xc);
    return __builtin_bit_cast(float, __builtin_amdgcn_readlane(__builtin_bit_cast(int, v), 63));
}
struct TItem { const float* src; bf16* dst; int K, N; };
__device__ __forceinline__ unsigned pk4_fp8(float a, float b, float c, float d) {
    int w = __builtin_amdgcn_cvt_pk_fp8_f32(a, b, 0, false); w = __builtin_amdgcn_cvt_pk_fp8_f32(c, d, w, true); return (unsigned)w; }
constexpr float W8_SCALE = 64.0f, W8_INV = 1.0f / 64.0f;
__device__ __forceinline__ void p0_load(const TItem& t, f32x4 (&v)[8], int wave, int lane) {
    const GAS float* sp = (const GAS float*)t.src + (size_t)(8 * (2 * wave + (lane >> 5))) * t.N + 4 * (lane & 31);
#pragma unroll
    for (int i = 0; i < 8; ++i) v[i] = __builtin_nontemporal_load((const GAS f32x4*)(sp + (size_t)i * t.N));
}
__device__ __forceinline__ void p0_store(const TItem& t, const f32x4 (&v)[8], LAS unsigned char* img, int wave, int lane) {
    const int kg = 2 * wave + (lane >> 5), n4 = lane & 31;
#pragma unroll
    for (int x = 0; x < 4; ++x) { v4u w; w.x = pg8::cvt_pk_bf16(v[0][x], v[1][x]); w.y = pg8::cvt_pk_bf16(v[2][x], v[3][x]); w.z = pg8::cvt_pk_bf16(v[4][x], v[5][x]); w.w = pg8::cvt_pk_bf16(v[6][x], v[7][x]);
        *(LAS v4u*)(img + (4 * n4 + x) * 272 + kg * 16) = w; }
    asm volatile("s_waitcnt lgkmcnt(0)\n\ts_barrier" ::: "memory");
#pragma unroll
    for (int j = 0; j < 4; ++j) { const int n = 16 * wave + 4 * j + (lane >> 4), kc = lane & 15;
        const v4u o = *(const LAS v4u*)(img + n * 272 + kc * 16);
        *(GAS v4u*)(t.dst + (size_t)n * t.K + 8 * kc) = o; }
}
__device__ __forceinline__ void p0_store8(const TItem& t, const f32x4 (&v)[8], LAS unsigned char* img, int wave, int lane) {
    const int kg = 2 * wave + (lane >> 5), n4 = lane & 31;
#pragma unroll
    for (int x = 0; x < 4; ++x) { v2u w; w.x = pk4_fp8(v[0][x] * W8_SCALE, v[1][x] * W8_SCALE, v[2][x] * W8_SCALE, v[3][x] * W8_SCALE); w.y = pk4_fp8(v[4][x] * W8_SCALE, v[5][x] * W8_SCALE, v[6][x] * W8_SCALE, v[7][x] * W8_SCALE);
        *(LAS v2u*)(img + (4 * n4 + x) * 144 + kg * 8) = w; }
    asm volatile("s_waitcnt lgkmcnt(0)\n\ts_barrier" ::: "memory");
    unsigned char* dst = (unsigned char*)t.dst;
#pragma unroll
    for (int j = 0; j < 2; ++j) { const int n = 16 * wave + 8 * j + (lane >> 3), kc = lane & 7;
        const v4u o = *(const LAS v4u*)(img + n * 144 + kc * 16);
        *(GAS v4u*)(dst + (size_t)n * t.K + 16 * kc) = o; }
}
__device__ __forceinline__ int t5_bucket(int rel) {
    const int n = rel < 0 ? -rel : rel; int b;
    if (n < 8) b = n; else if (n < 12) b = 8; else if (n < 16) b = 9; else if (n < 23) b = 10; else if (n < 32) b = 11; else if (n < 46) b = 12; else if (n < 64) b = 13; else if (n < 91) b = 14; else b = 15;
    return b + (rel > 0 ? 16 : 0);
}

struct DenseSched {
    const bf16* A; const bf16* Bt; int nM, nN, nwg, G, c;
    __device__ __forceinline__ void init(const bf16* A_, const bf16* Bt_, int M_, int N_, int G_, int c_) { A = A_; Bt = Bt_; nM = M_ / 256; nN = N_ / 256; nwg = nM * nN; G = G_; c = c_; }
    __device__ __forceinline__ bool next(int i, pg8::Unit& u) const {
        const long L = (long)i * G + c; if (L >= nwg) return false;
        int wgid = (int)L; { const int q = nwg / 8, r = nwg % 8, xcd = wgid % 8, off = wgid / 8; wgid = (xcd < r ? xcd * (q + 1) : r * (q + 1) + (xcd - r) * q) + off; }
        const int nig = 8 * nN, gid = wgid / nig, fm = gid * 8, gsz = (nM - fm) < 8 ? (nM - fm) : 8;
        u.pm = fm + ((wgid % nig) % gsz); u.pn = (wgid % nig) / gsz; u.e = 0; u.lrow0 = 0; u.cnt = 0; return true;
    }
    __device__ __forceinline__ const char* a_base(const pg8::Unit& u) const { return (const char*)A + (size_t)u.pm * (256 * 1024 * 2); }
    __device__ __forceinline__ const char* b_base(const pg8::Unit& u) const { return (const char*)Bt + (size_t)u.pn * (256 * 1024 * 2); }
    __device__ __forceinline__ size_t b_hstep() const { return (size_t)128 * 1024 * 2; }
    __device__ __forceinline__ void a_voff(const pg8::Unit&, const int (&R)[2], const int (&C)[2], unsigned (&v0)[2], unsigned (&v1)[2]) const {
#pragma unroll
        for (int i = 0; i < 2; ++i) { v0[i] = (unsigned)(R[i] * 1024 + C[i]) * 2u; v1[i] = v0[i] + 128u * 1024u * 2u; } }
    __device__ __forceinline__ const bf16* a_row(const pg8::Unit& u, int r) const { return A + (size_t)(u.pm * 256 + r) * 1024; }
    __device__ __forceinline__ const bf16* b_row(const pg8::Unit& u, int c_) const { return Bt + (size_t)(u.pn * 256 + c_) * 1024; }
    __device__ __forceinline__ void a_tok(const pg8::Unit&, const int (&)[2], unsigned (&tk)[4]) const { tk[0] = tk[1] = tk[2] = tk[3] = 0u; }
    __device__ __forceinline__ void a_voff_tok(const unsigned (&)[4], const int (&R)[2], const int (&C)[2], unsigned (&v0)[2], unsigned (&v1)[2]) const {
#pragma unroll
        for (int i = 0; i < 2; ++i) { v0[i] = (unsigned)(R[i] * 1024 + C[i]) * 2u; v1[i] = v0[i] + 128u * 1024u * 2u; } }
};
struct MoeSched {
    const bf16* A; const bf16* W; const int* rowtok; const LAS int* pexp; const LAS int* pfirst; const LAS int* cntl;
    int NP, NT, G, vcu; bool gather; int rowb  ; size_t wexp  , wtile  , whalf;
    __device__ __forceinline__ bool next(int i, pg8::Unit& u) const {
        const int L = i * G + vcu; if (L >= NP * NT) return false;
        const int pi = L / NT; const int e = __builtin_amdgcn_readfirstlane(pexp[pi]);
        u.pm = pi; u.pn = L - pi * NT; u.e = e; u.lrow0 = (pi - __builtin_amdgcn_readfirstlane(pfirst[e])) * 256; u.cnt = __builtin_amdgcn_readfirstlane(cntl[e]); return true;
    }
    __device__ __forceinline__ const char* a_base(const pg8::Unit& u) const { return gather ? (const char*)A : (const char*)A + (size_t)u.pm * 256 * (size_t)rowb; }
    __device__ __forceinline__ const char* b_base(const pg8::Unit& u) const { return (const char*)W + (size_t)u.e * wexp + (size_t)u.pn * wtile; }
    __device__ __forceinline__ size_t b_hstep() const { return whalf; }
    __device__ __forceinline__ int tok_of(const pg8::Unit& u, int r) const { int lr = u.lrow0 + r; lr = lr < u.cnt ? lr : u.cnt - 1; return ((const GAS int*)rowtok)[u.e * ECAP + lr]; }
    __device__ __forceinline__ void a_tok(const pg8::Unit& u, const int (&R)[2], unsigned (&tk)[4]) const {
        if (gather) {
#pragma unroll
            for (int q = 0; q < 4; ++q) { int lr = u.lrow0 + (q >> 1) * 128 + R[q & 1]; lr = lr < u.cnt ? lr : u.cnt - 1; const GAS int* ap = (const GAS int*)rowtok + (u.e * ECAP + lr);
                asm volatile("global_load_dword %0, %1, off" : "=v"(tk[q]) : "v"(ap) : "memory"); }
        } else { tk[0] = tk[1] = tk[2] = tk[3] = 0u; } }
    __device__ __forceinline__ void a_voff_tok(const unsigned (&tk)[4], const int (&R)[2], const int (&C)[2], unsigned (&v0)[2], unsigned (&v1)[2]) const {
        if (gather) {
#pragma unroll
            for (int i = 0; i < 2; ++i) { v0[i] = tk[i] * (unsigned)rowb + (unsigned)(C[i] * 2); v1[i] = tk[2 + i] * (unsigned)rowb + (unsigned)(C[i] * 2); }
        } else {
#pragma unroll
            for (int i = 0; i < 2; ++i) { v0[i] = (unsigned)(R[i] * rowb + C[i] * 2); v1[i] = v0[i] + 128u * (unsigned)rowb; }
        } }
    __device__ __forceinline__ void a_voff(const pg8::Unit& u, const int (&R)[2], const int (&C)[2], unsigned (&v0)[2], unsigned (&v1)[2]) const {
        if (gather) {
#pragma unroll
            for (int i = 0; i < 2; ++i) { v0[i] = (unsigned)(tok_of(u, R[i]) * rowb + C[i] * 2); v1[i] = (unsigned)(tok_of(u, 128 + R[i]) * rowb + C[i] * 2); }
        } else {
#pragma unroll
            for (int i = 0; i < 2; ++i) { v0[i] = (unsigned)(R[i] * rowb + C[i] * 2); v1[i] = v0[i] + 128u * (unsigned)rowb; }
        }
    }
    __device__ __forceinline__ const bf16* a_row(const pg8::Unit& u, int r) const { return gather ? A + (size_t)tok_of(u, r) * 1024 : A + (size_t)(u.pm * 256 + r) * 1024; }
    __device__ __forceinline__ const bf16* b_row(const pg8::Unit& u, int c_) const { return (const bf16*)((const char*)W + (size_t)u.e * wexp + (size_t)u.pn * wtile + (c_ >= 128 ? whalf : 0) + (size_t)(c_ & 127) * 2048); }
};

struct EpiQKVU {
    static constexpr bool PERM = true;
    bf16* O; size_t stride;
    __device__ __forceinline__ void pre(const pg8::Unit&, int, int, int, int, pg8::Pre&) const {}
    __device__ __forceinline__ void operator()(const pg8::f32x4 (&acc)[2][2][4][2], const pg8::Unit& u, int wr, int wc, int fr, int fq, const pg8::Pre&) const {
        const int t = u.pn >> 1; const float sc = t == 0 ? QSCALE : 1.f;
        bf16* base = O + (size_t)t * stride; const int col0 = (u.pn & 1) * 256 + wc * 32 + 8 * fq; const int row0 = u.pm * 256 + wr * 64 + fr;
#pragma unroll
        for (int ai = 0; ai < 2; ++ai)
#pragma unroll
            for (int m = 0; m < 4; ++m) { bf16* rowp = base + (size_t)(row0 + ai * 128 + m * 16) * 512 + col0;
#pragma unroll
                for (int bj = 0; bj < 2; ++bj) { const pg8::f32x4 v0 = acc[ai][bj][m][0] * sc, v1 = acc[ai][bj][m][1] * sc;
                    pg8::u32x4 w; w.x = pg8::cvt_pk_bf16(v0[0], v0[1]); w.y = pg8::cvt_pk_bf16(v0[2], v0[3]); w.z = pg8::cvt_pk_bf16(v1[0], v1[1]); w.w = pg8::cvt_pk_bf16(v1[2], v1[3]);
                    *(pg8::u32x4*)(rowp + bj * 128) = w; } }
    }
};
struct EpiT1 {
    static constexpr bool PERM = true;
    const float* mod; bf16* TG;
    __device__ __forceinline__ void pre(const pg8::Unit&, int, int, int, int, pg8::Pre&) const {}
    __device__ __forceinline__ void operator()(const pg8::f32x4 (&acc)[2][2][4][2], const pg8::Unit& u, int wr, int wc, int fr, int fq, const pg8::Pre&) const {
        const int b = u.pm >> 3; const float* g1 = mod + (size_t)b * 6144 + 2048;
        const int col0 = u.pn * 256 + wc * 32 + 8 * fq;
        pg8::f32x4 gv[2][2];
#pragma unroll
        for (int bj = 0; bj < 2; ++bj)
#pragma unroll
            for (int n = 0; n < 2; ++n) gv[bj][n] = *(const pg8::f32x4*)(g1 + col0 + bj * 128 + 4 * n);
#pragma unroll
        for (int ai = 0; ai < 2; ++ai)
#pragma unroll
            for (int m = 0; m < 4; ++m) { bf16* rowp = TG + (size_t)(u.pm * 256 + ai * 128 + wr * 64 + m * 16 + fr) * 1024 + col0;
#pragma unroll
                for (int bj = 0; bj < 2; ++bj) { const pg8::f32x4 v0 = acc[ai][bj][m][0] * gv[bj][0], v1 = acc[ai][bj][m][1] * gv[bj][1];
                    pg8::u32x4 w; w.x = pg8::cvt_pk_bf16(v0[0], v0[1]); w.y = pg8::cvt_pk_bf16(v0[2], v0[3]); w.z = pg8::cvt_pk_bf16(v1[0], v1[1]); w.w = pg8::cvt_pk_bf16(v1[2], v1[3]);
                    *(pg8::u32x4*)(rowp + bj * 128) = w; } }
    }
};
struct EpiSwiglu {
    static constexpr bool PERM = true;
    const float* bgu; unsigned char* H;
    __device__ __forceinline__ void pre(const pg8::Unit& u, int, int wc, int, int fq, pg8::Pre& P) const {
        const float* bg = bgu + (size_t)u.e * 2048 + u.pn * 128 + wc * 32 + 8 * fq;
        pg8::asm_ld16(P.v[0], bg); pg8::asm_ld16(P.v[1], bg + 4); pg8::asm_ld16(P.v[2], bg + 1024); pg8::asm_ld16(P.v[3], bg + 1028); }
    __device__ __forceinline__ void operator()(const pg8::f32x4 (&acc)[2][2][4][2], const pg8::Unit& u, int wr, int wc, int fr, int fq, const pg8::Pre& P) const {
        const int c0 = u.pn * 128 + wc * 32 + 8 * fq;
        const pg8::f32x4 bgv[2] = {P.v[0], P.v[1]}, buv[2] = {P.v[2], P.v[3]};
#pragma unroll
        for (int ai = 0; ai < 2; ++ai)
#pragma unroll
            for (int m = 0; m < 4; ++m) { float r[8];
#pragma unroll
                for (int n = 0; n < 2; ++n)
#pragma unroll
                    for (int x = 0; x < 4; ++x) { const float g = fminf(acc[ai][0][m][n][x] * W8_INV + bgv[n][x], 7.0f); const float up = fminf(fmaxf(acc[ai][1][m][n][x] * W8_INV + buv[n][x], -7.0f), 7.0f);
                        const float sg = __builtin_amdgcn_rcpf(1.0f + __builtin_amdgcn_exp2f(-1.702f * LOG2E * g)); r[4 * n + x] = (up + 1.0f) * (g * sg); }
                v2u w; w.x = pk4_fp8(r[0], r[1], r[2], r[3]); w.y = pk4_fp8(r[4], r[5], r[6], r[7]);
                *(v2u*)(H + (size_t)(u.pm * 256 + ai * 128 + wr * 64 + m * 16 + fr) * 1024 + c0) = w; }
    }
};
struct EpiDown {
    static constexpr bool PERM = true;
    const float* bd; unsigned char* Y;
    __device__ __forceinline__ void pre(const pg8::Unit& u, int, int wc, int, int fq, pg8::Pre& P) const {
        const float* bp = bd + (size_t)u.e * 1024 + u.pn * 256 + wc * 32 + 8 * fq;
        pg8::asm_ld16(P.v[0], bp); pg8::asm_ld16(P.v[1], bp + 4); pg8::asm_ld16(P.v[2], bp + 128); pg8::asm_ld16(P.v[3], bp + 132); }
    __device__ __forceinline__ void operator()(const pg8::f32x4 (&acc)[2][2][4][2], const pg8::Unit& u, int wr, int wc, int fr, int fq, const pg8::Pre& P) const {
        const int c0 = u.pn * 256 + wc * 32 + 8 * fq;
        const pg8::f32x4 bv[2][2] = {{P.v[0], P.v[1]}, {P.v[2], P.v[3]}};
#pragma unroll
        for (int ai = 0; ai < 2; ++ai)
#pragma unroll
            for (int m = 0; m < 4; ++m) { unsigned char* rowp = Y + (size_t)(u.pm * 256 + ai * 128 + wr * 64 + m * 16 + fr) * 1024 + c0;
#pragma unroll
                for (int bj = 0; bj < 2; ++bj) { const pg8::f32x4 v0 = acc[ai][bj][m][0] * W8_INV + bv[bj][0], v1 = acc[ai][bj][m][1] * W8_INV + bv[bj][1];
                    v2u w; w.x = pk4_fp8(v0[0], v0[1], v0[2], v0[3]); w.y = pk4_fp8(v1[0], v1[1], v1[2], v1[3]);
                    *(v2u*)(rowp + bj * 128) = w; } }
    }
};

__device__ __forceinline__ void build_expert_tables(Frame& F) {
    LAS int* cntl = (LAS int*)(F.lds + L_CNT); LAS int* pfirst = (LAS int*)(F.lds + L_PFIRST); LAS int* pexp = (LAS int*)(F.lds + L_PEXP);
    __syncthreads();
    if (F.tid < NE) { int c = (int)__hip_atomic_load(F.ctl + CW_CNT + 64 * F.tid, RLX_AGENT); c = c < 0 ? 0 : (c > ECAP ? ECAP : c); cntl[F.tid] = c; }
    __syncthreads();
    if (F.tid == 0) { int p = 0; for (int e = 0; e < NE; ++e) { pfirst[e] = p; const int np = (cntl[e] + 255) >> 8; for (int k = 0; k < np; ++k) if (p + k < PMAX) pexp[p + k] = e; p += np; if (p > PMAX) p = PMAX; } pfirst[NE] = p; }
    __syncthreads();
}

struct Args { const float* in[25]; float* out; unsigned char* ws; int ph_lo, ph_hi; };
constexpr int NPHASE = 10;

__global__ void __launch_bounds__(NWAVES * 64, 2) mk_fwd(Args args) {
    extern __shared__ __attribute__((aligned(16))) unsigned char lds[];
    Frame F;
    F.lds = (LAS unsigned char*)lds; F.ws = args.ws; F.ctl = (gu32*)(args.ws + WS_CTL);
    F.tid = threadIdx.x; F.lane = F.tid & 63; F.wave = __builtin_amdgcn_readfirstlane(F.tid >> 6);
    F.G = gridDim.x; { const int bx = blockIdx.x; F.vcu = (F.G % 8 == 0) ? (bx % 8) * (F.G / 8) + bx / 8 : bx; }
    volatile LAS unsigned* MISC = (volatile LAS unsigned*)(F.lds + L_MISC);
    for (int u = F.tid; u < (LDS_BYTES - LCTL_OFF) / 4; u += NWAVES * 64) ((LAS unsigned*)(F.lds + LCTL_OFF))[u] = 0u;
    __syncthreads();
    XcdBarrier bar; bar.bar = (unsigned*)(F.ctl + CW_BAR); bar.x = 0; bar.st = nullptr;
#if MK_ONE_LAUNCH
    bar = xcd_barrier_post((unsigned*)(F.ctl + CW_BAR), MISC + 8);
#define GRID_BAR() xcd_barrier(bar)
#else
#define GRID_BAR() do { } while (0)
#endif
#define PHASE_ENTRY() do { int t_ = threadIdx.x; asm volatile("" : "+v"(t_)); F.tid = t_; F.lane = t_ & 63; } while (0)
    const int lo = args.ph_lo, hi = args.ph_hi;
#ifndef PH_MASK
#define PH_MASK 0x3ff
#endif
#ifndef REP_MASK
#define REP_MASK 0x0
#endif
#define REPS(k) (1 + ((REP_MASK >> (k)) & 1))
#define IN(k) (((PH_MASK >> (k)) & 1) && lo <= (k) && (k) < hi)
#define BOTH(k) (IN(k) && IN((k) + 1))
    const float* x = args.in[0]; const float* cvec = args.in[1]; const float* w_ada = args.in[2]; const float* b_ada = args.in[3]; const float* w_in = args.in[4];
    const float* lq1 = args.in[5]; const float* lk1 = args.in[6]; const float* lq2 = args.in[7]; const float* lk2 = args.in[8]; const float* subln_g = args.in[9];
    const float* rel_bias = args.in[10]; const float* w_pool = args.in[11]; const float* b_pool = args.in[12]; const float* pool_scale = args.in[13]; const float* w_out = args.in[14];
    const float* ln1_g = args.in[15]; const float* ln1_b = args.in[16]; const float* w_router = args.in[17]; const float* b_router = args.in[18];
    const float* w_gu = args.in[19]; const float* b_gu = args.in[20]; const float* w_dn = args.in[21]; const float* b_dn = args.in[22]; const float* ln2_g = args.in[23]; const float* ln2_b = args.in[24];
    float* out = args.out; unsigned char* ws = args.ws;
    float* MOD = (float*)(ws + WS_MOD); float* MODP = (float*)(ws + WS_MODP); bf16* WPOOL = (bf16*)(ws + WS_WPOOL); bf16* WIN = (bf16*)(ws + WS_WIN); bf16* WOUT = (bf16*)(ws + WS_WOUT);
    bf16* WGU = (bf16*)(ws + WS_WGU); bf16* WD = (bf16*)(ws + WS_WD); bf16* XN = (bf16*)(ws + WS_XN);
    bf16* QB = (bf16*)(ws + WS_Q); bf16* KB = (bf16*)(ws + WS_K); bf16* VB = (bf16*)(ws + WS_V); bf16* UB = (bf16*)(ws + WS_U);
    bf16* OA = (bf16*)(ws + WS_OA); bf16* MIX = (bf16*)(ws + WS_MIX); float* T1 = (float*)(ws + WS_T1); float* X1 = (float*)(ws + WS_X1); bf16* XN2 = (bf16*)(ws + WS_XN2);
    int* RE = (int*)(ws + WS_RE); int* RP = (int*)(ws + WS_RP); float* RG = (float*)(ws + WS_RG); int* ROWTOK = (int*)(ws + WS_ROWTOK);
    bf16* HB = (bf16*)(ws + WS_H); bf16* YB = (bf16*)(ws + WS_Y);
    const int gw = F.vcu * NWAVES + F.wave, NGW = F.G * NWAVES;
    unsigned long long dly_t0 = 0, dly_t1 = 0;
    if (DLY_PH == 10) dly_t0 = __builtin_amdgcn_s_memrealtime();

    if (DLY_PH == 0) dly_t0 = __builtin_amdgcn_s_memrealtime();
    if (IN(0)) _Pragma("unroll") for (int rep_ = 0; rep_ < REPS(0); ++rep_) {
        PHASE_ENTRY();
        LAS float* sil = (LAS float*)(F.lds + 3 * 34816);
        for (int i = F.tid; i < NB * D; i += NWAVES * 64) { const float v = cvec[i]; sil[i] = v / (1.0f + __expf(-v)); }
        __syncthreads();
        constexpr int I_MOD = 6144 / 16, T_IN = (D / 128) * (NIN / 128), T_OUT = (D / 128) * (D / 128), T_POOL = 4, T_GU1 = (D / 128) * (2048 / 128), T_D1 = (FF / 128) * (D / 128);
        constexpr int NTR = T_IN + T_OUT + T_POOL + NE * T_GU1 + NE * T_D1;
        for (int r = gw; r < 8 * I_MOD; r += NGW) {
            const int cgp = r % I_MOD, kc = r / I_MOD, kq = F.lane >> 4, col = cgp * 16 + (F.lane & 15); float a[NB];
#pragma unroll
            for (int b = 0; b < NB; ++b) a[b] = 0.f;
#pragma unroll 16
            for (int i = 0; i < 32; ++i) { const int k = kc * 128 + kq + 4 * i; const float w = ((const GAS float*)w_ada)[(size_t)k * 6144 + col];
#pragma unroll
                for (int b = 0; b < NB; ++b) a[b] += sil[b * D + k] * w; }
#pragma unroll
            for (int b = 0; b < NB; ++b) { a[b] += __shfl_xor(a[b], 16); a[b] += __shfl_xor(a[b], 32); }
            if (kq == 0) {
#pragma unroll
                for (int b = 0; b < NB; ++b) MODP[((size_t)kc * NB + b) * 6144 + col] = a[b]; }
        }
        for (int r0 = F.vcu; r0 < T_IN + T_OUT + T_POOL; r0 += F.G) {
            int r = r0; const float* W; bf16* WT; int K, N, item;
            if (r < T_IN) { W = w_in; WT = WIN; K = D; N = NIN; item = r; }
            else if ((r -= T_IN) < T_OUT) { W = w_out; WT = WOUT; K = D; N = D; item = r; }
            else { r -= T_OUT; W = w_pool + (size_t)r * 128 * 128; WT = WPOOL + (size_t)r * 128 * 128; K = 128; N = 128; item = 0; }
            const int nblk = N / 128, kb = item / nblk, nb = item - kb * nblk;
            TItem t; t.src = W + (size_t)(128 * kb) * N + 128 * nb; t.dst = WT + (size_t)(128 * nb) * K + 128 * kb; t.K = K; t.N = N;
            f32x4 bb[8]; p0_load(t, bb, F.wave, F.lane); p0_store(t, bb, F.lds, F.wave, F.lane);
            asm volatile("s_waitcnt lgkmcnt(0)\n\ts_barrier" ::: "memory");
        }
        __syncthreads();
        if (BOTH(0) || rep_ + 1 < REPS(0)) GRID_BAR();
    }
    if (DLY_PH == 0) dly_t1 = __builtin_amdgcn_s_memrealtime();
    if (DLY_PH == 1) dly_t0 = __builtin_amdgcn_s_memrealtime();
    if (IN(1)) _Pragma("unroll") for (int rep_ = 0; rep_ < REPS(1); ++rep_) {
        PHASE_ENTRY();
        LAS float* modl = (LAS float*)F.lds;
        for (int blk = F.vcu; blk < M / 64; blk += F.G) {
            const int b = blk >> 5; const bool first = (blk & 31) == 0;
            __syncthreads();
            for (int c = F.tid; c < (first ? 6144 : 2048); c += NWAVES * 64) { float a = b_ada[c];
#pragma unroll
                for (int kc = 0; kc < 8; ++kc) a += ((const GAS float*)MODP)[((size_t)kc * NB + b) * 6144 + c];
                if (c < 2048) modl[c] = a; if (first) MOD[(size_t)b * 6144 + c] = a; }
            __syncthreads();
            {
                f32x4 v[8][4];
#pragma unroll
                for (int r8 = 0; r8 < 8; ++r8) { const GAS f32x4* xr = (const GAS f32x4*)(x + (size_t)(blk * 64 + F.wave * 8 + r8) * D) + F.lane;
#pragma unroll
                    for (int j = 0; j < 4; ++j) v[r8][j] = xr[64 * j]; }
#pragma unroll
                for (int r8 = 0; r8 < 8; ++r8) { const int m = blk * 64 + F.wave * 8 + r8; float s = 0.f;
#pragma unroll
                    for (int j = 0; j < 4; ++j) s += (v[r8][j].x + v[r8][j].y) + (v[r8][j].z + v[r8][j].w);
                    const float mean = wave_sum(s) * (1.f / D); float s2 = 0.f;
#pragma unroll
                    for (int j = 0; j < 4; ++j) { v[r8][j] = v[r8][j] - mean; s2 += (v[r8][j].x * v[r8][j].x + v[r8][j].y * v[r8][j].y) + (v[r8][j].z * v[r8][j].z + v[r8][j].w * v[r8][j].w); }
                    const float rstd = 1.f / sqrtf(wave_sum(s2) * (1.f / D) + LN_EPS);
                    GAS v2u* o8 = (GAS v2u*)(XN + (size_t)m * D) + F.lane;
#pragma unroll
                    for (int j = 0; j < 4; ++j) { const f32x4 hv = *(const LAS f32x4*)(modl + 4 * F.lane + 256 * j), sv = *(const LAS f32x4*)(modl + 1024 + 4 * F.lane + 256 * j);
                        const f32x4 h = (v[r8][j] * rstd) * (sv + 1.0f) + hv; v2u w; w.x = pk2(h.x, h.y); w.y = pk2(h.z, h.w); o8[64 * j] = w; } }
            }
        }
        if (BOTH(1) || rep_ + 1 < REPS(1)) GRID_BAR();
    }
    if (DLY_PH == 1) dly_t1 = __builtin_amdgcn_s_memrealtime();
    if (DLY_PH == 2) dly_t0 = __builtin_amdgcn_s_memrealtime();
    if (IN(2)) _Pragma("unroll") for (int rep_ = 0; rep_ < REPS(2); ++rep_) {
        PHASE_ENTRY();
        DenseSched S; S.init(XN, WIN, M, NIN, F.G, (int)blockIdx.x);
        EpiQKVU E{QB, (size_t)(WS_K - WS_Q) / 2};
        pg8::gemm_phase<EpiQKVU, DenseSched, true>(F.lds, S, E);
        if (BOTH(2) || rep_ + 1 < REPS(2)) GRID_BAR();
    }
    if (DLY_PH == 2) dly_t1 = __builtin_amdgcn_s_memrealtime();
    if (DLY_PH == 3) dly_t0 = __builtin_amdgcn_s_memrealtime();
    if (IN(3)) _Pragma("unroll") for (int rep_ = 0; rep_ < REPS(3); ++rep_) {
        PHASE_ENTRY();
        const bool g8 = (F.G % 8 == 0); const bool conv_cu = g8 ? (F.vcu & 7) < CONV8 : true; const int cG = g8 ? (F.G / 8) * CONV8 : F.G, cv = g8 ? (F.vcu >> 3) * CONV8 + (F.vcu & 7) : F.vcu;
        if (conv_cu) {
            __syncthreads();
            constexpr int T_GU1 = (D / 128) * (2048 / 128), T_D1 = (FF / 128) * (D / 128);
        auto pipe = [&](const float* W, bf16* WT, auto K_, auto N_, int ntiles) {
            constexpr int K = decltype(K_)::value, N = decltype(N_)::value, NBLK = N / 128, TPE = (K / 128) * NBLK;
            const int n_my = (ntiles - cv + cG - 1) / cG;
            auto tile_of = [&](int q) -> TItem { const int qq = q < n_my ? q : n_my - 1; const int r = cv + qq * cG; const int e = r / TPE, item = r % TPE, kb = item / NBLK, nb = item % NBLK;
                TItem t; t.src = W + (size_t)e * K * N + (size_t)(128 * kb) * N + 128 * nb; t.dst = (bf16*)((unsigned char*)WT + (size_t)e * K * N + (size_t)(128 * nb) * K + 128 * kb);     t.K = K; t.N = N; return t; };
            if (n_my > 0) {
                TItem t0 = tile_of(0), t1 = tile_of(1), t2; f32x4 b0[8], b1[8], b2[8];
                p0_load(t0, b0, F.wave, F.lane); p0_load(t1, b1, F.wave, F.lane);
                for (int q = 0; q < n_my; q += 3) {
                    t2 = tile_of(q + 2); p0_load(t2, b2, F.wave, F.lane); p0_store8(t0, b0, F.lds, F.wave, F.lane);
                    t0 = tile_of(q + 3); p0_load(t0, b0, F.wave, F.lane); p0_store8(t1, b1, F.lds + 34816, F.wave, F.lane);
                    t1 = tile_of(q + 4); p0_load(t1, b1, F.wave, F.lane); p0_store8(t2, b2, F.lds + 2 * 34816, F.wave, F.lane);
                }
                asm volatile("s_waitcnt lgkmcnt(0)\n\ts_barrier" ::: "memory");
            }
        };
        pipe(w_gu, WGU, std::integral_constant<int, D>{}, std::integral_constant<int, 2048>{}, NE * T_GU1);
        pipe(w_dn, WD, std::integral_constant<int, FF>{}, std::integral_constant<int, D>{}, NE * T_D1);
            __syncthreads();
        }
        LAS float* tb = (LAS float*)(F.lds + L_TB);
        for (int i = F.tid; i < 4 * attn_body::TBN; i += NWAVES * 64) { const int h = i / attn_body::TBN, idx = i % attn_body::TBN; const int d = idx - attn_body::TBOFF;
            tb[i] = (d <= 63) ? (rel_bias[t5_bucket(d) * 4 + h] - rel_bias[15 * 4 + h]) * LOG2E : 0.f; }
        __syncthreads();
#if !NAIVE_ATTN
        {
            volatile LAS int* qslot = (volatile LAS int*)(F.lds + L_MISC + 64);
            for (;;) {
                __syncthreads();
                if (F.tid == 0) *qslot = (int)__hip_atomic_fetch_add(F.ctl + CW_AQ + 64 * rep_, 1u, RLX_AGENT);
                __syncthreads();
                const int ui = __builtin_amdgcn_readfirstlane(*qslot);
                if (ui >= 512) break;
                const int qb = 7 - (ui >> 6), c6 = ui & 63, b = c6 >> 3, j = c6 & 7;
                attn_body::attn_unit2<8>(b, j, qb, (const attn_body::bf16*)QB, (const attn_body::bf16*)KB, (const attn_body::bf16*)VB, (attn_body::bf16*)OA, (char*)lds, tb + (j >> 1) * attn_body::TBN);
            }
        }
#else
        for (int idx = blockIdx.x * 512 + F.tid; idx < NB * 8 * 2 * SEQ; idx += F.G * 512) {
            const int q = idx & 2047, vh = (idx >> 11) & 1, j = (idx >> 12) & 7, b = idx >> 15, h = j >> 1;
            const bf16* qp = QB + (size_t)(b * SEQ + q) * 512 + j * 64; float qv[64];
#pragma unroll
            for (int d = 0; d < 64; ++d) qv[d] = pg8::bf2f(qp[d]);
            float o[64];
#pragma unroll
            for (int d = 0; d < 64; ++d) o[d] = 0.f;
            float mx = -INFINITY, l = 0.f; const int kend = ((q >> 6) + 1) << 6;
            for (int k = 0; k < kend; ++k) {
                const bf16* kp = KB + (size_t)(b * SEQ + k) * 512 + j * 64; float sdot = 0.f;
#pragma unroll
                for (int d = 0; d < 64; ++d) sdot += qv[d] * pg8::bf2f(kp[d]);
                const int dd = k - q; const int ti = dd + attn_body::TBOFF < 0 ? 0 : dd + attn_body::TBOFF; sdot += tb[h * attn_body::TBN + ti];
                const float mn = fmaxf(mx, sdot), f = exp2f(mx - mn), p = exp2f(sdot - mn); l = l * f + p; mx = mn;
                const bf16* vp = VB + (size_t)(b * SEQ + k) * 512 + h * 128 + vh * 64;
#pragma unroll
                for (int d = 0; d < 64; ++d) o[d] = o[d] * f + p * pg8::bf2f(vp[d]);
            }
            bf16* op = OA + (size_t)(b * SEQ + q) * 1024 + j * 128 + vh * 64; const float il = 1.0f / l;
#pragma unroll
            for (int d = 0; d < 64; ++d) op[d] = (bf16)f2bf(o[d] * il);
        }
#endif
        if (BOTH(3) || rep_ + 1 < REPS(3)) GRID_BAR();
    }
    if (DLY_PH == 3) dly_t1 = __builtin_amdgcn_s_memrealtime();
    if (DLY_PH == 4) dly_t0 = __builtin_amdgcn_s_memrealtime();
    if (IN(4)) _Pragma("unroll") for (int rep_ = 0; rep_ < REPS(4); ++rep_) {
        PHASE_ENTRY();
        float lam;
        { const float a = lq1[F.lane] * lk1[F.lane], b2 = lq2[F.lane] * lk2[F.lane]; lam = __expf(wave_sum(a)) - __expf(wave_sum(b2)) + LAM_INIT; }
        for (int m0 = gw; m0 < M; m0 += 2 * NGW) {
            const int h = F.lane >> 4, e0 = (F.lane & 15) * 8; const bool two = m0 + NGW < M;
            v4u a[2], b2[2];
#pragma unroll
            for (int q = 0; q < 2; ++q) if (q == 0 || two) { const size_t m = (size_t)m0 + (size_t)q * NGW;
                a[q] = *(const GAS v4u*)(OA + m * 1024 + h * 256 + e0); b2[q] = *(const GAS v4u*)(OA + m * 1024 + h * 256 + 128 + e0); }
            const f32x4 g0 = *(const f32x4*)(subln_g + e0), g1v = *(const f32x4*)(subln_g + e0 + 4);
#pragma unroll
            for (int q = 0; q < 2; ++q) if (q == 0 || two) { const size_t m = (size_t)m0 + (size_t)q * NGW;
                float o[8];
                o[0] = bfl(a[q].x) - lam * bfl(b2[q].x); o[1] = bfh(a[q].x) - lam * bfh(b2[q].x); o[2] = bfl(a[q].y) - lam * bfl(b2[q].y); o[3] = bfh(a[q].y) - lam * bfh(b2[q].y);
                o[4] = bfl(a[q].z) - lam * bfl(b2[q].z); o[5] = bfh(a[q].z) - lam * bfh(b2[q].z); o[6] = bfl(a[q].w) - lam * bfl(b2[q].w); o[7] = bfh(a[q].w) - lam * bfh(b2[q].w);
                float ss = 0.f;
#pragma unroll
                for (int i = 0; i < 8; ++i) ss += o[i] * o[i];
                ss = row16_sum(ss);
                const float rs = (1.0f - LAM_INIT) / sqrtf(ss * (1.0f / 128.0f) + LN_EPS);
                v4u w; w.x = pk2(o[0] * rs * g0.x, o[1] * rs * g0.y); w.y = pk2(o[2] * rs * g0.z, o[3] * rs * g0.w); w.z = pk2(o[4] * rs * g1v.x, o[5] * rs * g1v.y); w.w = pk2(o[6] * rs * g1v.z, o[7] * rs * g1v.w);
                *(GAS v4u*)(MIX + m * 1024 + h * 128 + e0) = w; }
        }
        for (int it = gw; it < (M / 32) * 4; it += NGW) {
            const int g = it & 3, tile = it >> 2, row0 = tile * 32, r32 = F.lane & 31, hi = F.lane >> 5;
            const int row = row0 + r32, tpos = row & (SEQ - 1), tp0 = row0 & (SEQ - 1);
            LAS unsigned char* ut = F.lds + F.wave * 12800;
#pragma unroll
            for (int i = 0; i < 12; ++i) { const int pc = F.lane + 64 * i, rr = pc >> 4, c16 = pc & 15;
                if (rr < 47) { v4u v = (v4u){0u, 0u, 0u, 0u}; if (tp0 - 15 + rr >= 0) v = *(const GAS v4u*)(UB + (size_t)(row0 - 15 + rr) * 512 + g * 128 + c16 * 8); *(LAS v4u*)(ut + rr * 272 + c16 * 16) = v; } }
            LDS_WAIT(); asm volatile("" ::: "memory");
            bf16x8 pf[8];
            const LAS unsigned char* ub = ut + (r32 + 15) * 272 + hi * 16;
            auto pooled = [&](auto WIN_) {
                constexpr int WIN = decltype(WIN_)::value;
                const int nwin = tpos + 1 < WIN ? tpos + 1 : WIN; const float inv = 1.0f / (float)nwin;
#pragma unroll
                for (int s8 = 0; s8 < 8; ++s8) {
                    float sum[8];
#pragma unroll
                    for (int i = 0; i < 8; ++i) sum[i] = 0.f;
                    v4u self;
#pragma unroll
                    for (int k = 0; k < WIN; ++k) { const v4u u4 = *(const LAS v4u*)(ub - k * 272 + s8 * 32); if (k == 0) self = u4;
                        sum[0] += bfl(u4.x); sum[1] += bfh(u4.x); sum[2] += bfl(u4.y); sum[3] += bfh(u4.y); sum[4] += bfl(u4.z); sum[5] += bfh(u4.z); sum[6] += bfl(u4.w); sum[7] += bfh(u4.w); }
                    v4u w; w.x = pk2(sum[0] * inv - bfl(self.x), sum[1] * inv - bfh(self.x)); w.y = pk2(sum[2] * inv - bfl(self.y), sum[3] * inv - bfh(self.y));
                    w.z = pk2(sum[4] * inv - bfl(self.z), sum[5] * inv - bfh(self.z)); w.w = pk2(sum[6] * inv - bfl(self.w), sum[7] * inv - bfh(self.w));
                    pf[s8] = __builtin_bit_cast(bf16x8, w);
                }
            };
            if (g == 0) pooled(std::integral_constant<int, 2>{}); else if (g == 1) pooled(std::integral_constant<int, 4>{}); else if (g == 2) pooled(std::integral_constant<int, 8>{}); else pooled(std::integral_constant<int, 16>{});
            LDS_WAIT(); asm volatile("" ::: "memory");
#pragma unroll
            for (int db = 0; db < 4; ++db) {
                f32x16 acc = f32x16{};
                const bf16* wp = WPOOL + (size_t)g * 128 * 128 + (size_t)(db * 32 + r32) * 128 + hi * 8;
#pragma unroll
                for (int s8 = 0; s8 < 8; ++s8) { const bf16x8 wf = __builtin_bit_cast(bf16x8, *(const GAS v4u*)(wp + s8 * 16)); acc = __builtin_amdgcn_mfma_f32_32x32x16_bf16(wf, pf[s8], acc, 0, 0, 0); }
#pragma unroll
                for (int rq = 0; rq < 4; ++rq) { const int d0 = db * 32 + 8 * rq + 4 * hi; const int cg = g * 128 + d0;
                    const f32x4 bp = *(const f32x4*)(b_pool + cg), ps = *(const f32x4*)(pool_scale + cg);
                    v2u w; w.x = pk2((acc[4 * rq + 0] + bp.x) * ps.x, (acc[4 * rq + 1] + bp.y) * ps.y); w.y = pk2((acc[4 * rq + 2] + bp.z) * ps.z, (acc[4 * rq + 3] + bp.w) * ps.w);
                    *(GAS v2u*)(MIX + (size_t)row * 1024 + 512 + cg) = w; }
            }
        }
        if (BOTH(4) || rep_ + 1 < REPS(4)) GRID_BAR();
    }
    if (DLY_PH == 4) dly_t1 = __builtin_amdgcn_s_memrealtime();
    if (DLY_PH == 5) dly_t0 = __builtin_amdgcn_s_memrealtime();
    if (IN(5)) _Pragma("unroll") for (int rep_ = 0; rep_ < REPS(5); ++rep_) {
        PHASE_ENTRY();
        DenseSched S; S.init(MIX, WOUT, M, D, F.G, (int)blockIdx.x);
        EpiT1 E{MOD, (bf16*)T1};
        pg8::gemm_phase<EpiT1, DenseSched, true>(F.lds, S, E);
        if (BOTH(5) || rep_ + 1 < REPS(5)) GRID_BAR();
    }
    if (DLY_PH == 5) dly_t1 = __builtin_amdgcn_s_memrealtime();
    if (DLY_PH == 6) dly_t0 = __builtin_amdgcn_s_memrealtime();
    if (IN(6)) _Pragma("unroll 1") for (int rep_ = 0; rep_ < REPS(6); ++rep_) {
        PHASE_ENTRY();
        LAS float* H2 = (LAS float*)F.lds;
        LAS float* PART = (LAS float*)F.lds;
        LAS float* LOG = (LAS float*)(F.lds + 131200);
        LAS unsigned* hist = (LAS unsigned*)(F.lds + L_HIST); LAS unsigned* hbase = hist + 32;
        const int i32 = F.lane & 31, kh = F.lane >> 5, kb = F.wave * 128;
        for (int t0 = F.vcu; t0 < M / 32; t0 += 2 * F.G) {
            if (F.tid < 32) hist[F.tid] = 0u;
            int myk[2][2]; unsigned lrk[2][2]; float mygate[2][2];
#pragma unroll
            for (int ti = 0; ti < 2; ++ti) { const int tile = t0 + ti * F.G; myk[ti][0] = -1; myk[ti][1] = -1; lrk[ti][0] = 0u; lrk[ti][1] = 0u; mygate[ti][0] = 0.f; mygate[ti][1] = 0.f;
              if (tile < M / 32) {
            const int b = (tile * 32) >> 11; const float* sh = MOD + (size_t)b * 6144 + 3072; const float* sc = sh + 1024;
#pragma unroll
            for (int pr = 0; pr < 2; ++pr) {
                f32x4 v[2][4];
#pragma unroll
                for (int r2 = 0; r2 < 2; ++r2) { const size_t m_ = (size_t)(tile * 32 + F.wave * 4 + 2 * pr + r2); const GAS f32x4* xr = (const GAS f32x4*)(x + m_ * D) + F.lane; const GAS v2u* tr = (const GAS v2u*)((const bf16*)T1 + m_ * D) + F.lane;
                    v2u tg[4];
#pragma unroll
                    for (int j = 0; j < 4; ++j) { v[r2][j] = xr[64 * j]; tg[j] = tr[64 * j]; }
#pragma unroll
                    for (int j = 0; j < 4; ++j) v[r2][j] = v[r2][j] * DN_ALPHA + (f32x4){bfl(tg[j].x), bfh(tg[j].x), bfl(tg[j].y), bfh(tg[j].y)}; }
                f32x4 gvv[4], bvv4[4], svv[4], hvv[4];
#pragma unroll
                for (int j = 0; j < 4; ++j) { gvv[j] = *(const f32x4*)(ln1_g + 4 * F.lane + 256 * j); bvv4[j] = *(const f32x4*)(ln1_b + 4 * F.lane + 256 * j); svv[j] = *(const f32x4*)(sc + 4 * F.lane + 256 * j); hvv[j] = *(const f32x4*)(sh + 4 * F.lane + 256 * j); }
#pragma unroll
                for (int r2 = 0; r2 < 2; ++r2) {
                    const int lr = F.wave * 4 + 2 * pr + r2, m = tile * 32 + lr;
                    float s = 0.f;
#pragma unroll
                    for (int j = 0; j < 4; ++j) s += (v[r2][j].x + v[r2][j].y) + (v[r2][j].z + v[r2][j].w);
                    float mean = wave_sum(s) * (1.f / D); float s2 = 0.f;
#pragma unroll
                    for (int j = 0; j < 4; ++j) { v[r2][j] = v[r2][j] - mean; s2 += (v[r2][j].x * v[r2][j].x + v[r2][j].y * v[r2][j].y) + (v[r2][j].z * v[r2][j].z + v[r2][j].w * v[r2][j].w); }
                    float rstd = 1.f / sqrtf(wave_sum(s2) * (1.f / D) + LN_EPS);
                    if (F.lane == 0) { typedef float f32x2s __attribute__((ext_vector_type(2))); *(GAS f32x2s*)(X1 + 2 * (size_t)m) = (f32x2s){mean, rstd}; }
                    s = 0.f;
#pragma unroll
                    for (int j = 0; j < 4; ++j) { const f32x4 gvj = gvv[j], bvj = bvv4[j];
                        v[r2][j] = (v[r2][j] * rstd) * gvj + bvj; s += (v[r2][j].x + v[r2][j].y) + (v[r2][j].z + v[r2][j].w); }
                    mean = wave_sum(s) * (1.f / D); s2 = 0.f;
#pragma unroll
                    for (int j = 0; j < 4; ++j) { v[r2][j] = v[r2][j] - mean; s2 += (v[r2][j].x * v[r2][j].x + v[r2][j].y * v[r2][j].y) + (v[r2][j].z * v[r2][j].z + v[r2][j].w * v[r2][j].w); }
                    rstd = 1.f / sqrtf(wave_sum(s2) * (1.f / D) + LN_EPS);
                    GAS unsigned* o8 = (GAS unsigned*)((unsigned char*)XN2 + (size_t)m * D) + F.lane;
#pragma unroll
                    for (int j = 0; j < 4; ++j) { const f32x4 svj = svv[j], hvj = hvv[j];
                        const f32x4 h = (v[r2][j] * rstd) * (svj + 1.0f) + hvj; o8[64 * j] = pk4_fp8(h.x, h.y, h.z, h.w);
                        LAS float* hp = H2 + lr * 1025 + 4 * F.lane + 256 * j; hp[0] = h.x; hp[1] = h.y; hp[2] = h.z; hp[3] = h.w; }
                    asm volatile("" ::: "memory");
                }
            }
            float wreg[64];
            int i32w = (kb + kh) * NE + i32; asm volatile("" : "+v"(i32w));
            const GAS float* wrp = (const GAS float*)w_router + i32w;
#pragma unroll
            for (int kk = 0; kk < 64; ++kk) wreg[kk] = wrp[kk * 2 * NE];
            __syncthreads();
            f32x16 acc = f32x16{};
#pragma unroll
            for (int kk = 0; kk < 64; ++kk) acc = __builtin_amdgcn_mfma_f32_32x32x2f32(H2[i32 * 1025 + kb + 2 * kk + kh], wreg[kk], acc, 0, 0, 0);
            __syncthreads();
#pragma unroll
            for (int r = 0; r < 16; ++r) PART[(F.wave * 32 + ((r & 3) + 8 * (r >> 2) + 4 * kh)) * 32 + i32] = acc[r];
            __syncthreads();
#pragma unroll
            for (int q = 0; q < 2; ++q) { const int idx = F.tid + 512 * q, i = idx >> 5, e = idx & 31; float sl = b_router[e];
#pragma unroll
                for (int w = 0; w < 8; ++w) sl += PART[(w * 32 + i) * 32 + e];
                LOG[i * 33 + e] = sl; }
            __syncthreads();
#pragma unroll
            for (int it2 = 0; it2 < 2; ++it2) {
                const int rowl = F.wave * 4 + 2 * it2 + kh; float cur = LOG[rowl * 33 + i32]; float bvv[4]; myk[ti][it2] = -1;
#pragma unroll
                for (int k = 0; k < 4; ++k) { float mv = cur; int me = i32;
#pragma unroll
                    for (int off = 1; off < 32; off <<= 1) { const float ov = __shfl_xor(mv, off); const int oe = __shfl_xor(me, off); if (ov > mv || (ov == mv && oe < me)) { mv = ov; me = oe; } }
                    bvv[k] = mv; if (me == i32) { cur = -INFINITY; myk[ti][it2] = k; } }
                float ex[4], ssum = 0.f;
#pragma unroll
                for (int k = 0; k < 4; ++k) { ex[k] = __expf(bvv[k] - bvv[0]); ssum += ex[k]; }
                const float is = 1.0f / ssum; mygate[ti][it2] = 0.f; lrk[ti][it2] = 0u;
#pragma unroll
                for (int k = 0; k < 4; ++k) if (myk[ti][it2] == k) mygate[ti][it2] = ex[k] * is;
                if (myk[ti][it2] >= 0) lrk[ti][it2] = __hip_atomic_fetch_add(hist + i32, 1u, __ATOMIC_RELAXED, __HIP_MEMORY_SCOPE_WORKGROUP);
            }
            __syncthreads();
              } }
            __syncthreads();
            if (F.tid < 32) { const unsigned n = hist[F.tid]; hbase[F.tid] = n ? __hip_atomic_fetch_add(F.ctl + (rep_ + 1 < REPS(6) ? CW_CNT + 4096 : CW_CNT) + 64 * F.tid, n, RLX_AGENT) : 0u; }
            __syncthreads();
#pragma unroll
            for (int ti = 0; ti < 2; ++ti) { const int tile = t0 + ti * F.G;
#pragma unroll
              for (int it2 = 0; it2 < 2; ++it2) if (myk[ti][it2] >= 0) { const int m = tile * 32 + F.wave * 4 + 2 * it2 + kh; const int pp = (int)(hbase[i32] + lrk[ti][it2]);
                RE[m * 4 + myk[ti][it2]] = i32; RP[m * 4 + myk[ti][it2]] = pp; RG[m * 4 + myk[ti][it2]] = mygate[ti][it2]; if (pp < ECAP) ROWTOK[i32 * ECAP + pp] = m; } }
            __syncthreads();
        }
        if (BOTH(6) || rep_ + 1 < REPS(6)) GRID_BAR();
    }
    if (DLY_PH == 6) dly_t1 = __builtin_amdgcn_s_memrealtime();
    if (DLY_PH == 7) dly_t0 = __builtin_amdgcn_s_memrealtime();
    if (IN(7)) _Pragma("unroll") for (int rep_ = 0; rep_ < REPS(7); ++rep_) {
        PHASE_ENTRY();
        build_expert_tables(F);
        MoeSched S; S.A = XN2; S.W = WGU; S.rowtok = ROWTOK; S.pexp = (const LAS int*)(F.lds + L_PEXP); S.pfirst = (const LAS int*)(F.lds + L_PFIRST); S.cntl = (const LAS int*)(F.lds + L_CNT);
        S.NP = ((const LAS int*)(F.lds + L_PFIRST))[NE]; S.NT = 8; S.G = F.G; S.vcu = F.vcu; S.gather = true; S.rowb = 1024; S.wexp = (size_t)2048 * 1024; S.wtile = (size_t)128 * 1024; S.whalf = (size_t)1024 * 1024;
        EpiSwiglu E{b_gu, (unsigned char*)HB};
        pg8::gemm_phase<EpiSwiglu, MoeSched, true, true>(F.lds, S, E);
        if (BOTH(7) || rep_ + 1 < REPS(7)) GRID_BAR();
    }
    if (DLY_PH == 7) dly_t1 = __builtin_amdgcn_s_memrealtime();
    if (DLY_PH == 8) dly_t0 = __builtin_amdgcn_s_memrealtime();
    if (IN(8)) _Pragma("unroll") for (int rep_ = 0; rep_ < REPS(8); ++rep_) {
        PHASE_ENTRY();
        build_expert_tables(F);
        MoeSched S; S.A = HB; S.W = WD; S.rowtok = ROWTOK; S.pexp = (const LAS int*)(F.lds + L_PEXP); S.pfirst = (const LAS int*)(F.lds + L_PFIRST); S.cntl = (const LAS int*)(F.lds + L_CNT);
        S.NP = ((const LAS int*)(F.lds + L_PFIRST))[NE]; S.NT = 4; S.G = F.G; S.vcu = F.vcu; S.gather = false; S.rowb = 1024; S.wexp = (size_t)1024 * 1024; S.wtile = (size_t)256 * 1024; S.whalf = (size_t)128 * 1024;
        EpiDown E{b_dn, (unsigned char*)YB};
        pg8::gemm_phase<EpiDown, MoeSched, true, true>(F.lds, S, E);
        if (BOTH(8) || rep_ + 1 < REPS(8)) GRID_BAR();
    }
    if (DLY_PH == 8) dly_t1 = __builtin_amdgcn_s_memrealtime();
    if (DLY_PH == 9) dly_t0 = __builtin_amdgcn_s_memrealtime();
    if (IN(9)) _Pragma("unroll") for (int rep_ = 0; rep_ < REPS(9); ++rep_) {
        PHASE_ENTRY();
        build_expert_tables(F);
        const LAS int* pfirst = (const LAS int*)(F.lds + L_PFIRST);
        const unsigned bad = __hip_atomic_load(F.ctl + CW_BAR + XB_TMO, RLX_AGENT);
        for (int m0 = gw; m0 < M; m0 += 2 * NGW) {
            f32x4 tv[2][4]; v2u tgv[2][4]; unsigned yv[2][4][4]; float gk[2][4]; float mu[2], rs[2];
#pragma unroll
            for (int q = 0; q < 2; ++q) { const int m = m0 + q * NGW; if (m < M) {
                mu[q] = X1[2 * (size_t)m]; rs[q] = X1[2 * (size_t)m + 1];
#pragma unroll
                for (int k = 0; k < 4; ++k) { const int e = __builtin_amdgcn_readfirstlane(RE[m * 4 + k]), pp = __builtin_amdgcn_readfirstlane(RP[m * 4 + k]); gk[q][k] = RG[m * 4 + k];
                    const size_t yrow = (size_t)pfirst[e] * 256 + (size_t)pp; const GAS unsigned* yp = (const GAS unsigned*)((const unsigned char*)YB + yrow * 1024) + F.lane;
#pragma unroll
                    for (int j = 0; j < 4; ++j) yv[q][k][j] = yp[64 * j]; }
#pragma unroll
                for (int j = 0; j < 4; ++j) { tv[q][j] = ((const GAS f32x4*)(x + (size_t)m * D) + F.lane)[64 * j]; tgv[q][j] = ((const GAS v2u*)((const bf16*)T1 + (size_t)m * D) + F.lane)[64 * j]; } } }
#pragma unroll
            for (int q = 0; q < 2; ++q) { const int m = m0 + q * NGW; if (m < M) {
                const int b = m >> 11; const float* g2 = MOD + (size_t)b * 6144 + 5120;
                f32x4 v[4]; float s = 0.f;
#pragma unroll
                for (int j = 0; j < 4; ++j) { f32x4 a = (f32x4){0.f, 0.f, 0.f, 0.f};
#pragma unroll
                    for (int k = 0; k < 4; ++k) { typedef float f32x2s __attribute__((ext_vector_type(2))); const int w = (int)yv[q][k][j]; const f32x2s lo2 = __builtin_amdgcn_cvt_pk_f32_fp8(w, false), hi2 = __builtin_amdgcn_cvt_pk_f32_fp8(w, true);
                        a += (f32x4){lo2.x, lo2.y, hi2.x, hi2.y} * gk[q][k]; }
                    const f32x4 g1v = *(const f32x4*)(ln1_g + 4 * F.lane + 256 * j), b1v = *(const f32x4*)(ln1_b + 4 * F.lane + 256 * j), gv = *(const f32x4*)(g2 + 4 * F.lane + 256 * j);
                    const f32x4 t1 = tv[q][j] * DN_ALPHA + (f32x4){bfl(tgv[q][j].x), bfh(tgv[q][j].x), bfl(tgv[q][j].y), bfh(tgv[q][j].y)};
                    const f32x4 xv = ((t1 - mu[q]) * rs[q]) * g1v + b1v;
                    v[j] = xv * DN_ALPHA + gv * a; s += (v[j].x + v[j].y) + (v[j].z + v[j].w); }
                const float mean = wave_sum(s) * (1.f / D); float s2 = 0.f;
#pragma unroll
                for (int j = 0; j < 4; ++j) { v[j] = v[j] - mean; s2 += (v[j].x * v[j].x + v[j].y * v[j].y) + (v[j].z * v[j].z + v[j].w * v[j].w); }
                const float rstd = 1.f / sqrtf(wave_sum(s2) * (1.f / D) + LN_EPS);
#pragma unroll
                for (int j = 0; j < 4; ++j) { const f32x4 gv = *(const f32x4*)(ln2_g + 4 * F.lane + 256 * j), bv = *(const f32x4*)(ln2_b + 4 * F.lane + 256 * j);
                    f32x4 o = (v[j] * rstd) * gv + bv; if (bad) { const float qn = __builtin_nanf(""); o = (f32x4){qn, qn, qn, qn}; }
                    ((GAS f32x4*)(out + (size_t)m * D) + F.lane)[64 * j] = o; } } }
        }
    }
    if (DLY_PH >= 0) { if (DLY_PH == 10) dly_t1 = __builtin_amdgcn_s_memrealtime(); if (DLY_PH == 9) dly_t1 = __builtin_amdgcn_s_memrealtime(); const unsigned long long te = __builtin_amdgcn_s_memrealtime(); while (__builtin_amdgcn_s_memrealtime() - te < dly_t1 - dly_t0) __builtin_amdgcn_s_sleep(8); }
#undef IN
#undef BOTH
}

extern "C" void kernel_launch(void* const* d_in, const int* in_sizes, int n_in, void* d_out, int out_size, void* d_ws, size_t ws_size, hipStream_t stream) {
    static int grid = 0;
    if (grid == 0) {
        if (n_in != 25 || in_sizes[0] != M * D || out_size != M * D || ws_size < WS_END) { fprintf(stderr, "kernel_launch: unexpected shapes (n_in %d, in0 %d, out %d, ws %zu); nothing launched\n", n_in, n_in > 0 ? in_sizes[0] : -1, out_size, ws_size); grid = -1; return; }
        int dev = 0, cus = 0, per_cu = 0;
        if (hipGetDevice(&dev) != hipSuccess || hipDeviceGetAttribute(&cus, hipDeviceAttributeMultiprocessorCount, dev) != hipSuccess) { grid = -1; return; }
        if (hipFuncSetAttribute((const void*)mk_fwd, hipFuncAttributeMaxDynamicSharedMemorySize, LDS_BYTES) != hipSuccess) { fprintf(stderr, "kernel_launch: hipFuncSetAttribute failed\n"); grid = -1; return; }
        if (hipOccupancyMaxActiveBlocksPerMultiprocessor(&per_cu, (const void*)mk_fwd, NWAVES * 64, LDS_BYTES) != hipSuccess || per_cu < 1) { fprintf(stderr, "kernel_launch: occupancy query reports %d workgroups per CU\n", per_cu); (void)hipGetLastError(); }
        grid = cus;
    }
    if (grid < 0) return;
    if (hipMemsetAsync((char*)d_ws + WS_CTL, 0, CTL_ZERO_BYTES, stream) != hipSuccess) return;
    Args a{};
    for (int i = 0; i < 25; ++i) a.in[i] = (const float*)d_in[i];
    a.out = (float*)d_out; a.ws = (unsigned char*)d_ws;
#if MK_ONE_LAUNCH
    a.ph_lo = 0; a.ph_hi = NPHASE;
    hipLaunchKernelGGL(mk_fwd, dim3(grid), dim3(NWAVES * 64), LDS_BYTES, stream, a);
#else
    for (int p = 0; p < NPHASE; ++p) { a.ph_lo = p; a.ph_hi = p + 1; hipLaunchKernelGGL(mk_fwd, dim3(grid), dim3(NWAVES * 64), LDS_BYTES, stream, a); }
#endif
}
```
